# Optimizing an MI355X kernel written in HIP

```python
import math
import jax, jax.numpy as jnp
from jax import lax
import numpy as np

D_MODEL = 1024
BATCH = 1
SEQ = 16384
DEPTH = 2

GRID_W = 64
CTX_LEN = 256
N_EVEN = (DEPTH + 1) // 2
N_ODD = DEPTH // 2
D_FF = -(-8 * D_MODEL // (3 * 256)) * 256
CHUNK = 64
EPS = 1e-6
SSD_WIDTH = D_MODEL
SSD_HEAD_DIM = 64
SSD_HEADS = SSD_WIDTH // SSD_HEAD_DIM
SSD_STATE = 128
SSD_GROUPS = 2
SSD_CONV = 5
SSD_XBC = SSD_WIDTH + 2 * SSD_GROUPS * SSD_STATE
HG_WIDTH = D_MODEL
HG_HEAD_DIM = 128
HG_HEADS = HG_WIDTH // HG_HEAD_DIM
EVEN_SIZES = (SSD_WIDTH, SSD_XBC, 2 * SSD_HEADS, HG_WIDTH, 2 * HG_WIDTH, HG_WIDTH, HG_WIDTH)
EVEN_OFFSETS = tuple(sum(EVEN_SIZES[:i + 1]) for i in range(len(EVEN_SIZES) - 1))
EVEN_IN = sum(EVEN_SIZES)
MIX_EVEN = SSD_WIDTH + HG_WIDTH
S5_WIDTH = D_MODEL // 2
S5_GROUP = 16
S5_GROUPS = S5_WIDTH // S5_GROUP
S5_STATE = 64

kernel_name = "hybrid_ssd_hgrn2_s5_context_prefix"

F32 = jnp.float32


def rms(x):
    xf = x.astype(F32)
    return xf * lax.rsqrt(jnp.mean(xf * xf, axis=-1, keepdims=True) + EPS)


def modulate(h, gain, shift, scale):
    return rms(h) * gain * (1.0 + scale) + shift


def ada(cvec, w, b):
    m = jax.nn.silu(cvec.astype(F32)) @ w + b
    return jnp.split(m, 6, axis=-1)


def swiglu(h, wg, wu, wd):
    return (jax.nn.silu(h @ wg) * (h @ wu)) @ wd


def identity(t):
    return t


def flip_seq(t):
    return jnp.flip(t, axis=1)


def centred_dwconv(u, w, b):
    k = w.shape[0]
    out = lax.conv_general_dilated(u, w[:, None, :].astype(u.dtype), window_strides=(1,),
                                   padding=((k // 2, k // 2),), dimension_numbers=('NWC', 'WIO', 'NWC'),
                                   feature_group_count=u.shape[-1])
    return out + b


def to_chunks(t):
    n_chunks = t.shape[1] // CHUNK
    return jnp.moveaxis(t.reshape(t.shape[0], n_chunks, CHUNK, *t.shape[2:]), 1, 0)


def from_chunks(t):
    t = jnp.moveaxis(t, 0, 1)
    return t.reshape(t.shape[0], t.shape[1] * CHUNK, *t.shape[3:])


def in_chunk_mask():
    return jnp.tril(jnp.ones((CHUNK, CHUNK), dtype=bool))[None, :, :, None, None]


def ssd_scan(xdt, log_a, bm, cm, h0):
    b, l, h, p = xdt.shape
    g = bm.shape[2]
    r = h // g
    mask = in_chunk_mask()
    xs = (to_chunks(xdt.reshape(b, l, g, r, p)), to_chunks(log_a.reshape(b, l, g, r)),
          to_chunks(bm), to_chunks(cm))

    def step(state, inp):
        xc, ac, bc, cc = inp
        acum = jnp.cumsum(ac, axis=1)
        seg = acum[:, :, None] - acum[:, None, :]
        decay = jnp.exp(jnp.where(mask, seg, -jnp.inf))
        cb = jnp.einsum('btgn,bsgn->btsg', cc, bc)
        y = jnp.einsum('btsg,btsgr,bsgrp->btgrp', cb, decay, xc)
        y = y + jnp.einsum('btgn,bgrpn->btgrp', cc, state) * jnp.exp(acum)[..., None]
        last = acum[:, -1]
        to_end = jnp.exp(last[:, None] - acum)
        state = state * jnp.exp(last)[..., None, None] + jnp.einsum('bsgn,bsgr,bsgrp->bgrpn', bc, to_end, xc)
        return state, y

    state, ys = lax.scan(step, h0, xs)
    return from_chunks(ys).reshape(b, l, h, p), state


def hgrn2_scan(q, k, v, log_f, h0):
    mask = in_chunk_mask()
    xs = (to_chunks(q), to_chunks(k), to_chunks(v), to_chunks(log_f))

    def step(state, inp):
        qc, kc, vc, gc = inp
        bcum = jnp.cumsum(gc, axis=1)
        seg = bcum[:, :, None] - bcum[:, None, :]
        decay = jnp.exp(jnp.where(mask, seg, -jnp.inf))
        att = jnp.einsum('bthk,bshk,btshk->bhts', qc, kc, decay)
        o = jnp.einsum('bhts,bshv->bthv', att, vc) + jnp.einsum('bthk,bhkv->bthv', qc * jnp.exp(bcum), state)
        last = bcum[:, -1]
        state = state * jnp.exp(last)[..., None] + jnp.einsum('bshk,bshv->bhkv', kc * jnp.exp(last[:, None] - bcum), vc)
        return state, o

    state, os_ = lax.scan(step, h0, xs)
    return from_chunks(os_), state


def run_bidir(scan_fn, ctx_dirs, lat_dirs, h0):
    y_ctx = 0.0
    y_lat = 0.0
    for d in range(2):
        rev = flip_seq if d == 1 else identity
        yc, state = scan_fn(*[rev(t) for t in ctx_dirs[d]], h0)
        yl, _ = scan_fn(*[rev(t) for t in lat_dirs[d]], state)
        y_ctx = y_ctx + rev(yc)
        y_lat = y_lat + rev(yl)
    return y_ctx, y_lat


def even_mixer(h_lat, h_ctx, lb, w_in, w_out, conv_w, conv_b, dt_bias, a_log, d_skip, ssd_norm_g, hg_norm_g, ctx_out):
    bsz = h_lat.shape[0]

    def prep(h):
        zs = (h @ w_in).astype(F32)
        b, l = zs.shape[:2]
        z, xbc, dt_raw, q, f_raw, v, g = jnp.split(zs, EVEN_OFFSETS, axis=-1)
        xbc = jax.nn.silu(centred_dwconv(xbc, conv_w, conv_b))
        xs, bm, cm = jnp.split(xbc, [SSD_WIDTH, SSD_WIDTH + SSD_GROUPS * SSD_STATE], axis=-1)
        xs = xs.reshape(b, l, SSD_HEADS, SSD_HEAD_DIM)
        bm = bm.reshape(b, l, SSD_GROUPS, SSD_STATE)
        cm = cm.reshape(b, l, SSD_GROUPS, SSD_STATE)
        dt = jax.nn.softplus(dt_raw.reshape(b, l, 2, SSD_HEADS) + dt_bias)
        log_a = -dt * jnp.exp(a_log)
        ssd_dirs = [(xs * dt[:, :, d, :, None], log_a[:, :, d], bm, cm) for d in range(2)]
        q = jax.nn.silu(q).reshape(b, l, HG_HEADS, HG_HEAD_DIM)
        v = v.reshape(b, l, HG_HEADS, HG_HEAD_DIM)
        f = lb + (1.0 - lb) * jax.nn.sigmoid(f_raw.reshape(b, l, 2, HG_WIDTH))
        f = f.reshape(b, l, 2, HG_HEADS, HG_HEAD_DIM)
        hg_dirs = [(q, 1.0 - f[:, :, d], v, jnp.log(f[:, :, d])) for d in range(2)]
        return ssd_dirs, hg_dirs, xs, z, g

    c_ssd, c_hg, c_x, c_z, c_g = prep(h_ctx)
    l_ssd, l_hg, l_x, l_z, l_g = prep(h_lat)
    ssd_h0 = jnp.zeros((bsz, SSD_GROUPS, SSD_HEADS // SSD_GROUPS, SSD_HEAD_DIM, SSD_STATE), F32)
    hg_h0 = jnp.zeros((bsz, HG_HEADS, HG_HEAD_DIM, HG_HEAD_DIM), F32)
    ssd_c, ssd_l = run_bidir(ssd_scan, c_ssd, l_ssd, ssd_h0)
    hg_c, hg_l = run_bidir(hgrn2_scan, c_hg, l_hg, hg_h0)

    def finish(y_ssd, xs, z, o_hg, g):
        b, l = z.shape[:2]
        y = (y_ssd + d_skip[:, None] * xs).reshape(b, l, SSD_GROUPS, -1) * jax.nn.silu(z).reshape(b, l, SSD_GROUPS, -1)
        y = (rms(y) * ssd_norm_g.reshape(SSD_GROUPS, -1)).reshape(b, l, SSD_WIDTH)
        o = (rms(o_hg) * hg_norm_g).reshape(b, l, HG_WIDTH) * jax.nn.silu(g)
        return jnp.concatenate([y, o], axis=-1) @ w_out

    y_lat = finish(ssd_l, l_x, l_z, hg_l, l_g)
    y_ctx = finish(ssd_c, c_x, c_z, hg_c, c_g) if ctx_out else None
    return y_lat, y_ctx


def to_colmajor(t, rows):
    b, l, w = t.shape
    return t.reshape(b, rows, GRID_W, w).transpose(0, 2, 1, 3).reshape(b, l, w)


def to_rowmajor(t, rows):
    b, l, w = t.shape
    return t.reshape(b, GRID_W, rows, w).transpose(0, 2, 1, 3).reshape(b, l, w)


def zoh(a_re, a_im, log_dt, b_re, b_im):
    a_re, a_im, b_re, b_im = (t.astype(F32) for t in (a_re, a_im, b_re, b_im))
    dt = jnp.exp(log_dt.astype(F32))[:, None]
    mag = jnp.exp(a_re * dt)
    lr, li = mag * jnp.cos(a_im * dt), mag * jnp.sin(a_im * dt)
    den = a_re * a_re + a_im * a_im
    cr = ((lr - 1.0) * a_re + li * a_im) / den
    ci = (li * a_re - (lr - 1.0) * a_im) / den
    cr, ci = cr[..., None], ci[..., None]
    return lr, li, cr * b_re - ci * b_im, cr * b_im + ci * b_re


def s5_drive(u, bb_re, bb_im):
    b, l, _ = u.shape
    ug = u.reshape(b, l, S5_GROUPS, S5_GROUP)
    return jnp.einsum('blgc,gpc->blgp', ug, bb_re), jnp.einsum('blgc,gpc->blgp', ug, bb_im)


def s5_readout(c_re, c_im, s_re, s_im):
    b, l = s_re.shape[:2]
    y = jnp.einsum('gcp,blgp->blgc', c_re, s_re) - jnp.einsum('gcp,blgp->blgc', c_im, s_im)
    return y.reshape(b, l, S5_WIDTH)


def complex_linear_combine(e1, e2):
    a1r, a1i, b1r, b1i = e1
    a2r, a2i, b2r, b2i = e2
    return (a2r * a1r - a2i * a1i, a2r * a1i + a2i * a1r,
            a2r * b1r - a2i * b1i + b2r, a2r * b1i + a2i * b1r + b2i)


def diag_scan(lam_re, lam_im, b_re, b_im, h0=None):
    if h0 is not None:
        h0_re, h0_im = h0
        b_re = b_re.at[:, 0].add(lam_re * h0_re - lam_im * h0_im)
        b_im = b_im.at[:, 0].add(lam_re * h0_im + lam_im * h0_re)
    a_re = jnp.broadcast_to(lam_re, b_re.shape)
    a_im = jnp.broadcast_to(lam_im, b_im.shape)
    _, _, s_re, s_im = lax.associative_scan(complex_linear_combine, (a_re, a_im, b_re, b_im), axis=1)
    return s_re, s_im


def s5_glu(y, w_val, w_gate):
    a = jax.nn.gelu(y)
    return (a @ w_val) * jax.nn.sigmoid(a @ w_gate)


def odd_mixer(h_lat, h_ctx, rows, w_in, a_re, a_im, log_dt, b_re, b_im, c_re, c_im, d_skip, w_val, w_gate, ctx_out):
    u_lat = to_colmajor((h_lat @ w_in).astype(F32), rows)
    u_ctx = (h_ctx @ w_in).astype(F32)
    y_lat = d_skip * u_lat
    y_ctx = d_skip * u_ctx if ctx_out else None
    for d in range(2):
        rev = flip_seq if d == 1 else identity
        lr, li, bb_re, bb_im = zoh(a_re[d], a_im[d], log_dt[d], b_re[d], b_im[d])
        cr, ci = c_re[d].astype(F32), c_im[d].astype(F32)
        sc_re, sc_im = diag_scan(lr, li, *s5_drive(rev(u_ctx), bb_re, bb_im))
        sl_re, sl_im = diag_scan(lr, li, *s5_drive(rev(u_lat), bb_re, bb_im), h0=(sc_re[:, -1], sc_im[:, -1]))
        y_lat = y_lat + rev(s5_readout(cr, ci, sl_re, sl_im))
        if ctx_out:
            y_ctx = y_ctx + rev(s5_readout(cr, ci, sc_re, sc_im))
    out_lat = s5_glu(to_rowmajor(y_lat, rows), w_val, w_gate)
    out_ctx = s5_glu(y_ctx, w_val, w_gate) if ctx_out else None
    return out_lat, out_ctx


def setup_inputs(seed: int = 0) -> dict:
    key = jax.random.key(seed)
    ks = iter(jax.random.split(key, 48))

    def nrm(shape, scale):
        return jax.random.normal(next(ks), shape, F32) * scale

    def unif(shape, lo, hi):
        return jax.random.uniform(next(ks), shape, F32, lo, hi)

    dt0 = jnp.exp(unif((N_EVEN, 2, SSD_HEADS), math.log(1e-3), math.log(1e-1)))
    return {
        "x": nrm((BATCH, SEQ, D_MODEL), 1.0),
        "c": nrm((BATCH, D_MODEL), 1.0),
        "ctx": nrm((BATCH, CTX_LEN, D_MODEL), 1.0),
        "c_ctx": nrm((D_MODEL,), 1.0),
        "ada_w": nrm((DEPTH, D_MODEL, 6 * D_MODEL), 0.5 * D_MODEL ** -0.5),
        "ada_b": nrm((DEPTH, 6 * D_MODEL), 0.02),
        "norm_mix_g": 1.0 + nrm((DEPTH, D_MODEL), 0.02),
        "norm_ffn_g": 1.0 + nrm((DEPTH, D_MODEL), 0.02),
        "ffn_w_gate": nrm((DEPTH, D_MODEL, D_FF), D_MODEL ** -0.5),
        "ffn_w_up": nrm((DEPTH, D_MODEL, D_FF), D_MODEL ** -0.5),
        "ffn_w_down": nrm((DEPTH, D_FF, D_MODEL), D_FF ** -0.5),
        "final_norm_g": 1.0 + nrm((D_MODEL,), 0.02),
        "ev_w_in": nrm((N_EVEN, D_MODEL, EVEN_IN), D_MODEL ** -0.5),
        "ev_w_out": nrm((N_EVEN, MIX_EVEN, D_MODEL), MIX_EVEN ** -0.5),
        "ssd_conv_w": nrm((N_EVEN, SSD_CONV, SSD_XBC), SSD_CONV ** -0.5),
        "ssd_conv_b": nrm((N_EVEN, SSD_XBC), 0.02),
        "ssd_dt_bias": dt0 + jnp.log(-jnp.expm1(-dt0)),
        "ssd_a_log": jnp.log(unif((N_EVEN, 2, SSD_HEADS), 1.0, 16.0)),
        "ssd_d": 1.0 + nrm((N_EVEN, SSD_HEADS), 0.02),
        "ssd_norm_g": 1.0 + nrm((N_EVEN, SSD_WIDTH), 0.02),
        "hg_lb_logits": nrm((N_EVEN + 1, HG_WIDTH), 0.1),
        "hg_norm_g": 1.0 + nrm((N_EVEN, HG_HEAD_DIM), 0.02),
        "od_w_in": nrm((N_ODD, D_MODEL, S5_WIDTH), D_MODEL ** -0.5),
        "s5_a_re": -0.5 + nrm((N_ODD, 2, S5_GROUPS, S5_STATE), 0.01),
        "s5_a_im": math.pi * jnp.arange(S5_STATE, dtype=F32) + nrm((N_ODD, 2, S5_GROUPS, S5_STATE), 0.01),
        "s5_log_dt": unif((N_ODD, 2, S5_GROUPS), math.log(1e-3), math.log(1e-1)),
        "s5_b_re": nrm((N_ODD, 2, S5_GROUPS, S5_STATE, S5_GROUP), S5_GROUP ** -0.5),
        "s5_b_im": nrm((N_ODD, 2, S5_GROUPS, S5_STATE, S5_GROUP), S5_GROUP ** -0.5),
        "s5_c_re": nrm((N_ODD, 2, S5_GROUPS, S5_GROUP, S5_STATE), S5_STATE ** -0.5),
        "s5_c_im": nrm((N_ODD, 2, S5_GROUPS, S5_GROUP, S5_STATE), S5_STATE ** -0.5),
        "s5_d": 1.0 + nrm((N_ODD, S5_WIDTH), 0.1),
        "od_w_val": nrm((N_ODD, S5_WIDTH, D_MODEL), S5_WIDTH ** -0.5),
        "od_w_gate": nrm((N_ODD, S5_WIDTH, D_MODEL), S5_WIDTH ** -0.5),
    }


def reference(x, c, ctx, c_ctx, ada_w, ada_b, norm_mix_g, norm_ffn_g, ffn_w_gate, ffn_w_up, ffn_w_down,
              final_norm_g, ev_w_in, ev_w_out, ssd_conv_w, ssd_conv_b, ssd_dt_bias, ssd_a_log, ssd_d, ssd_norm_g,
              hg_lb_logits, hg_norm_g, od_w_in, s5_a_re, s5_a_im, s5_log_dt, s5_b_re, s5_b_im, s5_c_re, s5_c_im,
              s5_d, od_w_val, od_w_gate):
    rows = x.shape[1] // GRID_W
    lower_bounds = jnp.cumsum(jax.nn.softmax(hg_lb_logits.astype(F32), axis=0), axis=0)
    h = x.astype(F32)
    hc = ctx.astype(F32)
    for layer in range(DEPTH):
        ctx_out = layer < DEPTH - 1
        j = layer // 2
        sm, scm, gm, sf, scf, gf = ada(c, ada_w[layer], ada_b[layer])
        csm, cscm, cgm, csf, cscf, cgf = ada(c_ctx, ada_w[layer], ada_b[layer])
        a_lat = modulate(h, norm_mix_g[layer], sm[:, None], scm[:, None])
        a_ctx = modulate(hc, norm_mix_g[layer], csm, cscm)
        if layer % 2 == 0:
            y_lat, y_ctx = even_mixer(a_lat, a_ctx, lower_bounds[j], ev_w_in[j], ev_w_out[j], ssd_conv_w[j],
                                      ssd_conv_b[j], ssd_dt_bias[j], ssd_a_log[j], ssd_d[j], ssd_norm_g[j],
                                      hg_norm_g[j], ctx_out)
        else:
            y_lat, y_ctx = odd_mixer(a_lat, a_ctx, rows, od_w_in[j], s5_a_re[j], s5_a_im[j], s5_log_dt[j],
                                     s5_b_re[j], s5_b_im[j], s5_c_re[j], s5_c_im[j], s5_d[j], od_w_val[j],
                                     od_w_gate[j], ctx_out)
        h = h + gm[:, None] * y_lat
        h = h + gf[:, None] * swiglu(modulate(h, norm_ffn_g[layer], sf[:, None], scf[:, None]),
                                     ffn_w_gate[layer], ffn_w_up[layer], ffn_w_down[layer])
        if ctx_out:
            hc = hc + cgm * y_ctx
            hc = hc + cgf * swiglu(modulate(hc, norm_ffn_g[layer], csf, cscf),
                                   ffn_w_gate[layer], ffn_w_up[layer], ffn_w_down[layer])
    return (rms(h) * final_norm_g).astype(x.dtype)
```

```cpp
#include <hip/hip_runtime.h>
#include <cstdio>
#include <cstdint>

#ifndef MK_N_LAUNCHES
#define MK_N_LAUNCHES 1
#endif
namespace pg8 {
#define PG8_LAS __attribute__((address_space(3)))
typedef unsigned short bf16_t;
typedef short bf16x8 __attribute__((ext_vector_type(8)));
typedef float f32x4 __attribute__((ext_vector_type(4)));
typedef unsigned u32x4 __attribute__((ext_vector_type(4)));
constexpr int BM = 256, BK = 64, HALF = 128, HTB = HALF * BK * 2  , STAGE_BYTES = 8 * HTB, NXCD = 8, WGM = 8;

__host__ __device__ __forceinline__ int lds_byte(int r, int c) { const int st = (r >> 4) * 2 + (c >> 5), rr = r & 15, cc = c & 31, ob = rr * 64 + cc * 2; return st * 1024 + (ob ^ (((ob >> 9) & 1) << 5)); }
__host__ __device__ __forceinline__ void stage_rc(int b, int& R, int& C) { const int st = b / 1024, sb = b % 1024, swz = sb ^ (((sb >> 9) & 1) << 5); R = (st >> 1) * 16 + swz / 64; C = (st & 1) * 32 + (swz % 64) / 2; }
__host__ __device__ __forceinline__ int perm32(int rho) { const int n = rho >> 4, i = rho & 15; return 8 * (i >> 2) + 4 * n + (i & 3); }

struct Unit { int pm, pn; };
struct Gemm { const bf16_t* A; const bf16_t* Bt; int M, N, K; };

struct StaticOrder {
    int nM, nN, nwg, G, c;
    __host__ __device__ void init(int M, int N, int G_, int c_) { nM = M / BM; nN = N / BM; nwg = nM * nN; G = G_; c = c_; }
    __host__ __device__ bool next(int i, Unit& u) const {
        const long L = (long)i * G + c; if (L >= nwg) return false;
        int wgid = (int)L; { const int q = nwg / NXCD, r = nwg % NXCD, xcd = wgid % NXCD, off = wgid / NXCD; wgid = (xcd < r ? xcd * (q + 1) : r * (q + 1) + (xcd - r) * q) + off; }
        const int nig = WGM * nN, gid = wgid / nig, fm = gid * WGM, gsz = (nM - fm) < WGM ? (nM - fm) : WGM;
        u.pm = fm + ((wgid % nig) % gsz); u.pn = (wgid % nig) / gsz; return true;
    }
    __device__ __forceinline__ void a_ready(const Unit&) const {}
    __device__ __forceinline__ void done(const Unit&) const {}
};

__device__ __forceinline__ unsigned cvt_pk_bf16(float lo, float hi) { unsigned r; asm volatile("v_cvt_pk_bf16_f32 %0, %1, %2" : "=v"(r) : "v"(lo), "v"(hi)); return r; }
typedef float f32x2 __attribute__((ext_vector_type(2)));
typedef _Float16 f16x8 __attribute__((ext_vector_type(8)));
__device__ __forceinline__ float siluf(float x) { return x / (1.f + __expf(-x)); }
__device__ __forceinline__ float sigmf(float x) { return 1.f / (1.f + __expf(-x)); }
__device__ __forceinline__ u32x4 pack8_bf16(const float (&x)[8]) { u32x4 w; w.x = cvt_pk_bf16(x[0], x[1]); w.y = cvt_pk_bf16(x[2], x[3]); w.z = cvt_pk_bf16(x[4], x[5]); w.w = cvt_pk_bf16(x[6], x[7]); return w; }
constexpr int EP_ML = 16384;

struct EpiMix1 {
    static constexpr bool PERM = true, AFTER_DRAIN = false;
    bf16_t* ZQ; bf16_t* XBC; bf16_t* V; bf16_t* G; _Float16* Flat; _Float16* Fctx; float* DT; const float* lb; const float* dt_bias; const float* a_log;
    template <int KIND> __device__ __forceinline__ void tile(const f32x4 (&acc)[2][2][4][2], const Unit& u, int wr, int wc, int fr, int fq, int seg_tile) const {
        const int row0 = u.pm * BM + wr * 64 + fr, cw = wc * 32 + 8 * fq;
#pragma unroll
        for (int ai = 0; ai < 2; ++ai)
#pragma unroll
            for (int m = 0; m < 4; ++m) { const int row = row0 + ai * HALF + m * 16;
#pragma unroll
                for (int bj = 0; bj < 2; ++bj) { const f32x4 v0 = acc[ai][bj][m][0], v1 = acc[ai][bj][m][1]; const int c = seg_tile * 256 + bj * HALF + cw;
                    float x[8] = {v0[0], v0[1], v0[2], v0[3], v1[0], v1[1], v1[2], v1[3]};
                    if constexpr (KIND == 0) {
#pragma unroll
                        for (int i = 0; i < 8; ++i) x[i] = siluf(x[i]);
                        *(u32x4*)(ZQ + (size_t)row * 2048 + c) = pack8_bf16(x);
                    } else if constexpr (KIND == 1) {
                        *(u32x4*)(XBC + (size_t)row * 1536 + c) = pack8_bf16(x);
                    } else if constexpr (KIND == 2) {
#pragma unroll
                        for (int i = 0; i < 8; ++i) x[i] = siluf(x[i]);
                        *(u32x4*)(ZQ + (size_t)row * 2048 + 1024 + c) = pack8_bf16(x);
                    } else if constexpr (KIND == 3) {
                        f16x8 h;
#pragma unroll
                        for (int i = 0; i < 8; ++i) { const float l = lb[(c + i) & 1023]; const float f = l + (1.f - l) * sigmf(x[i]); h[i] = (_Float16)__logf(f); }
                        _Float16* dst = (row < EP_ML) ? Flat + (size_t)row * 2048 : Fctx + (size_t)(row - EP_ML) * 2048;
                        *(f16x8*)(dst + c) = h;
                    } else if constexpr (KIND == 4) {
                        *(u32x4*)(V + (size_t)row * 1024 + c) = pack8_bf16(x);
                    } else if constexpr (KIND == 5) {
#pragma unroll
                        for (int i = 0; i < 8; ++i) x[i] = siluf(x[i]);
                        *(u32x4*)(G + (size_t)row * 1024 + c) = pack8_bf16(x);
                    } else {
                        if (bj == 0 && wc == 0) {
                            float dtv[8], la[8];
#pragma unroll
                            for (int i = 0; i < 8; ++i) { const int j = 8 * fq + i; const float r = x[i] + dt_bias[j]; dtv[i] = r > 20.f ? r : log1pf(__expf(r)); la[i] = -dtv[i] * __expf(a_log[j]); }
                            float* d = DT + (size_t)row * 64 + 8 * fq;
                            *(f32x4*)(d) = (f32x4){dtv[0], dtv[1], dtv[2], dtv[3]}; *(f32x4*)(d + 4) = (f32x4){dtv[4], dtv[5], dtv[6], dtv[7]};
                            *(f32x4*)(d + 32) = (f32x4){la[0], la[1], la[2], la[3]}; *(f32x4*)(d + 36) = (f32x4){la[4], la[5], la[6], la[7]};
                        }
                    } } }
    }
    __device__ __forceinline__ void operator()(const f32x4 (&acc)[2][2][4][2], const Unit& u, int wr, int wc, int fr, int fq) const {
        const int pn = u.pn;
        if (pn < 4) tile<0>(acc, u, wr, wc, fr, fq, pn);
        else if (pn < 10) tile<1>(acc, u, wr, wc, fr, fq, pn - 4);
        else if (pn < 14) tile<2>(acc, u, wr, wc, fr, fq, pn - 10);
        else if (pn < 22) tile<3>(acc, u, wr, wc, fr, fq, pn - 14);
        else if (pn < 26) tile<4>(acc, u, wr, wc, fr, fq, pn - 22);
        else if (pn < 30) tile<5>(acc, u, wr, wc, fr, fq, pn - 26);
        else tile<6>(acc, u, wr, wc, fr, fq, 0);
    }
};
struct EpiResid {
    static constexpr bool PERM = false, AFTER_DRAIN = false;
    const float* base_lat; const float* base_ctx; float* out_lat; float* out_ctx; const float* gate_lat; const float* gate_ctx;
    __device__ __forceinline__ void operator()(const f32x4 (&acc)[2][2][4][2], const Unit& u, int wr, int wc, int fr, int fq) const {
        const bool isc = u.pm >= 64; const float* base = isc ? base_ctx : base_lat; float* out = isc ? out_ctx : out_lat; const float* gate = isc ? gate_ctx : gate_lat;
        const int row0 = (isc ? 0 : u.pm * BM) + wr * 64 + fr, col0 = u.pn * BM + wc * 32 + 4 * fq;
        f32x4 gv[2][2];
#pragma unroll
        for (int bj = 0; bj < 2; ++bj)
#pragma unroll
            for (int n = 0; n < 2; ++n) gv[bj][n] = *(const f32x4*)(gate + col0 + bj * HALF + n * 16);
#pragma unroll
        for (int ai = 0; ai < 2; ++ai)
#pragma unroll
            for (int m = 0; m < 4; ++m) { const size_t off = (size_t)(row0 + ai * HALF + m * 16) * 1024 + col0;
#pragma unroll
                for (int bj = 0; bj < 2; ++bj)
#pragma unroll
                    for (int n = 0; n < 2; ++n) { const f32x4 b = *(const f32x4*)(base + off + bj * HALF + n * 16); *(f32x4*)(out + off + bj * HALF + n * 16) = b + gv[bj][n] * acc[ai][bj][m][n]; } }
    }
};
struct EpiSwiglu {
    static constexpr bool PERM = true, AFTER_DRAIN = false;
    bf16_t* HID;
    __device__ __forceinline__ void operator()(const f32x4 (&acc)[2][2][4][2], const Unit& u, int wr, int wc, int fr, int fq) const {
        const int row0 = u.pm * BM + wr * 64 + fr, c = u.pn * HALF + wc * 32 + 8 * fq;
#pragma unroll
        for (int ai = 0; ai < 2; ++ai)
#pragma unroll
            for (int m = 0; m < 4; ++m) { const f32x4 g0 = acc[ai][0][m][0], g1 = acc[ai][0][m][1], u0 = acc[ai][1][m][0], u1 = acc[ai][1][m][1];
                float x[8] = {siluf(g0[0]) * u0[0], siluf(g0[1]) * u0[1], siluf(g0[2]) * u0[2], siluf(g0[3]) * u0[3], siluf(g1[0]) * u1[0], siluf(g1[1]) * u1[1], siluf(g1[2]) * u1[2], siluf(g1[3]) * u1[3]};
                *(u32x4*)(HID + (size_t)(row0 + ai * HALF + m * 16) * 2816 + c) = pack8_bf16(x); }
    }
};
struct EpiU {
    static constexpr bool PERM = false, AFTER_DRAIN = false;
    float* U;
    __device__ __forceinline__ void operator()(const f32x4 (&acc)[2][2][4][2], const Unit& u, int wr, int wc, int fr, int fq) const {
        const int row0 = u.pm * BM + wr * 64 + fr, col0 = u.pn * BM + wc * 32 + 4 * fq;
#pragma unroll
        for (int ai = 0; ai < 2; ++ai)
#pragma unroll
            for (int m = 0; m < 4; ++m) { const int row = row0 + ai * HALF + m * 16; const int srow = row < EP_ML ? (row & 63) * 256 + (row >> 6) : row;
#pragma unroll
                for (int bj = 0; bj < 2; ++bj)
#pragma unroll
                    for (int n = 0; n < 2; ++n) *(f32x4*)(U + (size_t)srow * 512 + col0 + bj * HALF + n * 16) = acc[ai][bj][m][n]; }
    }
};
struct EpiValGate {
    static constexpr bool PERM = false, AFTER_DRAIN = false;
    float* H; const float* gate;
    __device__ __forceinline__ void operator()(const f32x4 (&acc)[2][2][4][2], const Unit& u, int wr, int wc, int fr, int fq) const {
        const int row0 = u.pm * BM + wr * 64 + fr, col0 = u.pn * HALF + wc * 32 + 4 * fq;
#pragma unroll
        for (int ai = 0; ai < 2; ++ai)
#pragma unroll
            for (int m = 0; m < 4; ++m) { float* hp = H + (size_t)(row0 + ai * HALF + m * 16) * 1024 + col0;
#pragma unroll
                for (int n = 0; n < 2; ++n) { const f32x4 v = acc[ai][0][m][n], g = acc[ai][1][m][n]; const f32x4 gm = *(const f32x4*)(gate + col0 + n * 16); f32x4 h = *(const f32x4*)(hp + n * 16);
                    h[0] += gm[0] * v[0] * sigmf(g[0]); h[1] += gm[1] * v[1] * sigmf(g[1]); h[2] += gm[2] * v[2] * sigmf(g[2]); h[3] += gm[3] * v[3] * sigmf(g[3]); *(f32x4*)(hp + n * 16) = h; } }
    }
};
template <class Epi, class Sched, bool ALIGN_EPI = false, bool SP2 = false>
__device__ __forceinline__ void gemm_phase(PG8_LAS unsigned char* lds, const Gemm g, const Sched& S, const Epi& E) {
    const int tid = threadIdx.x, wid = __builtin_amdgcn_readfirstlane(tid >> 6), lane = tid & 63, wr = wid >> 2, wc = wid & 3, fr = lane & 15, fq = lane >> 4;
    const int K = g.K, nt = K / BK;
    unsigned voffA[2], voffB[2];
#pragma unroll
    for (int i = 0; i < 2; ++i) { int R, C; stage_rc(tid * 16 + i * 8192, R, C); const int Rb = Epi::PERM ? ((R & ~31) + perm32(R & 31)) : R;
        voffA[i] = (unsigned)(R * K + C) * 2u; voffB[i] = (unsigned)(Rb * K + C) * 2u; }
    const size_t kstep = (size_t)(BK * 2);
    const size_t hstep = (size_t)HALF * K * 2;
    const size_t tstep = 2 * hstep;
    const unsigned ldsw = (unsigned)wid * 1024u;
    const int aoff = lds_byte(wr * 64 + fr, fq * 8), boff = lds_byte(wc * 32 + fr, fq * 8);
#define PG8_SA(b, h) (((b) * 2 + (h)) * HTB)
#define PG8_SB(b, h) ((4 + (b) * 2 + (h)) * HTB)
#define PG8_STAGE(bufoff, gbase, voff) do { _Pragma("unroll") for (int _i = 0; _i < 2; ++_i) \
        __builtin_amdgcn_global_load_lds((const unsigned*)((const char*)(gbase) + (voff)[_i]), (PG8_LAS unsigned*)(lds + (bufoff) + ldsw + _i * 8192), 16, 0, 0); } while (0)
#define PG8_LDA(dst, b, h) do { _Pragma("unroll") for (int m = 0; m < 4; ++m) _Pragma("unroll") for (int k = 0; k < 2; ++k) dst[m][k] = *(const PG8_LAS bf16x8*)(lds + PG8_SA(b, h) + aoff + m * 2048 + k * 1024); } while (0)
#define PG8_LDB(dst, b, h) do { _Pragma("unroll") for (int n = 0; n < 2; ++n) _Pragma("unroll") for (int k = 0; k < 2; ++k) dst[n][k] = *(const PG8_LAS bf16x8*)(lds + PG8_SB(b, h) + boff + n * 2048 + k * 1024); } while (0)
#define PG8_MMA(ai, bj, At, Bt) do { __builtin_amdgcn_s_setprio(1); _Pragma("unroll") for (int m = 0; m < 4; ++m) _Pragma("unroll") for (int n = 0; n < 2; ++n) _Pragma("unroll") for (int k = 0; k < 2; ++k) \
        acc[ai][bj][m][n] = __builtin_amdgcn_mfma_f32_16x16x32_bf16(Bt[n][k], At[m][k], acc[ai][bj][m][n], 0, 0, 0); __builtin_amdgcn_s_setprio(0); } while (0)
#define PG8_WAIT_V(n) asm volatile("s_waitcnt vmcnt(" #n ")" ::: "memory")
#define PG8_WAIT_L(n) asm volatile("s_waitcnt lgkmcnt(" #n ")" ::: "memory")
#define PG8_BAR __builtin_amdgcn_s_barrier()
#define PG8_SCHED __builtin_amdgcn_sched_barrier(0)
    Unit cur, nxt; int ui = 0;
    if (!S.next(0, cur)) return;
    f32x4 acc[2][2][4][2];
#pragma unroll
    for (int a = 0; a < 2; ++a)
#pragma unroll
        for (int b = 0; b < 2; ++b)
#pragma unroll
            for (int m = 0; m < 4; ++m)
#pragma unroll
                for (int n = 0; n < 2; ++n) acc[a][b][m][n] = (f32x4){0.f, 0.f, 0.f, 0.f};
    bf16x8 At[4][2], B0[2][2], B1[2][2];
    const char* cA = (const char*)g.A + (size_t)cur.pm * tstep; const char* cB = (const char*)g.Bt + (size_t)cur.pn * tstep;
    S.a_ready(cur);
    if constexpr (SP2) {
        PG8_STAGE(PG8_SB(0, 0), cB, voffB); PG8_STAGE(PG8_SB(0, 1), cB + hstep, voffB); PG8_STAGE(PG8_SA(0, 0), cA, voffA); PG8_STAGE(PG8_SA(0, 1), cA + hstep, voffA);
        if (wr == 1) PG8_BAR;
        PG8_WAIT_V(2); PG8_BAR;
        PG8_STAGE(PG8_SB(1, 0), cB + kstep, voffB); PG8_STAGE(PG8_SA(1, 0), cA + kstep, voffA); PG8_STAGE(PG8_SB(1, 1), cB + hstep + kstep, voffB);
        PG8_WAIT_V(6); PG8_BAR;
    } else {
        PG8_STAGE(PG8_SB(0, 0), cB, voffB); PG8_STAGE(PG8_SA(0, 0), cA, voffA); PG8_STAGE(PG8_SB(0, 1), cB + hstep, voffB); PG8_STAGE(PG8_SA(0, 1), cA + hstep, voffA);
        if (wr == 1) PG8_BAR;
        PG8_WAIT_V(4); PG8_BAR;
        PG8_STAGE(PG8_SB(1, 0), cB + kstep, voffB); PG8_STAGE(PG8_SA(1, 0), cA + kstep, voffA); PG8_STAGE(PG8_SB(1, 1), cB + hstep + kstep, voffB);
        PG8_WAIT_V(6); PG8_BAR;
    }
    for (;;) {
        const bool has_next = S.next(ui + 1, nxt);
        const char* nA = has_next ? (const char*)g.A + (size_t)nxt.pm * tstep : cA; const char* nB = has_next ? (const char*)g.Bt + (size_t)nxt.pn * tstep : cB;
        for (int t = 0; t < nt; t += 2) {
            const bool last = (t == nt - 2);
            const char* a1 = cA + (size_t)(t + 1) * kstep;
            const char* a2 = last ? nA : cA + (size_t)(t + 2) * kstep; const char* b2 = last ? nB : cB + (size_t)(t + 2) * kstep;
            const char* a3 = a2 + kstep; const char* b3 = b2 + kstep;
            if (last && has_next) S.a_ready(nxt);
            if constexpr (SP2) {
            PG8_LDB(B0, 0, 0); PG8_LDB(B1, 0, 1); PG8_SCHED; PG8_LDA(At, 0, 0); PG8_STAGE(PG8_SA(1, 1), a1 + hstep, voffA);
            PG8_WAIT_V(8); PG8_WAIT_L(0); PG8_BAR; PG8_MMA(0, 0, At, B0); PG8_MMA(0, 1, At, B1); PG8_BAR; PG8_SCHED;
            PG8_LDA(At, 0, 1); PG8_STAGE(PG8_SB(0, 0), b2, voffB); PG8_STAGE(PG8_SB(0, 1), b2 + hstep, voffB); PG8_STAGE(PG8_SA(0, 0), a2, voffA);
            PG8_WAIT_V(8); PG8_WAIT_L(0); PG8_BAR; PG8_MMA(1, 0, At, B0); PG8_MMA(1, 1, At, B1); PG8_BAR; PG8_SCHED;
            PG8_LDB(B0, 1, 0); PG8_LDB(B1, 1, 1); PG8_SCHED; PG8_LDA(At, 1, 0); PG8_STAGE(PG8_SA(0, 1), a2 + hstep, voffA);
            PG8_WAIT_V(8); PG8_WAIT_L(0); PG8_BAR; PG8_MMA(0, 0, At, B0); PG8_MMA(0, 1, At, B1); PG8_BAR; PG8_SCHED;
            PG8_LDA(At, 1, 1); PG8_STAGE(PG8_SB(1, 0), b3, voffB); PG8_STAGE(PG8_SB(1, 1), b3 + hstep, voffB); PG8_STAGE(PG8_SA(1, 0), a3, voffA);
            PG8_WAIT_V(8); PG8_WAIT_L(0); PG8_BAR; PG8_MMA(1, 0, At, B0); PG8_MMA(1, 1, At, B1); PG8_BAR; PG8_SCHED;
            } else {
            PG8_LDB(B0, 0, 0); PG8_SCHED; PG8_LDA(At, 0, 0); PG8_STAGE(PG8_SA(1, 1), a1 + hstep, voffA);
            PG8_WAIT_L(8); PG8_BAR; PG8_WAIT_L(0); PG8_MMA(0, 0, At, B0); PG8_BAR; PG8_SCHED;
            PG8_LDB(B1, 0, 1); PG8_STAGE(PG8_SB(0, 0), b2, voffB);
            PG8_BAR; PG8_WAIT_L(0); PG8_MMA(0, 1, At, B1); PG8_BAR;
            PG8_LDA(At, 0, 1); PG8_STAGE(PG8_SA(0, 0), a2, voffA);
            PG8_BAR; PG8_WAIT_L(0); PG8_MMA(1, 0, At, B0); PG8_BAR; PG8_SCHED;
            PG8_STAGE(PG8_SB(0, 1), b2 + hstep, voffB);
            PG8_WAIT_V(6); PG8_BAR; PG8_MMA(1, 1, At, B1); PG8_BAR;
            PG8_LDB(B0, 1, 0); PG8_SCHED; PG8_LDA(At, 1, 0); PG8_STAGE(PG8_SA(0, 1), a2 + hstep, voffA);
            PG8_WAIT_L(8); PG8_BAR; PG8_WAIT_L(0); PG8_MMA(0, 0, At, B0); PG8_BAR; PG8_SCHED;
            PG8_LDB(B1, 1, 1); PG8_STAGE(PG8_SB(1, 0), b3, voffB);
            PG8_BAR; PG8_WAIT_L(0); PG8_MMA(0, 1, At, B1); PG8_BAR;
            PG8_LDA(At, 1, 1); PG8_STAGE(PG8_SA(1, 0), a3, voffA);
            PG8_BAR; PG8_WAIT_L(0); PG8_MMA(1, 0, At, B0); PG8_BAR; PG8_SCHED;
            PG8_STAGE(PG8_SB(1, 1), b3 + hstep, voffB);
            PG8_WAIT_V(6); PG8_BAR; PG8_MMA(1, 1, At, B1); PG8_BAR;
            }
        }
        if constexpr (ALIGN_EPI) { if (wr == 0) PG8_BAR; }
        if constexpr (!Epi::AFTER_DRAIN) { E(acc, cur, wr, wc, fr, fq); S.done(cur); }
        if (!has_next) break;
#pragma unroll
        for (int a = 0; a < 2; ++a)
#pragma unroll
            for (int b = 0; b < 2; ++b)
#pragma unroll
                for (int m = 0; m < 4; ++m)
#pragma unroll
                    for (int n = 0; n < 2; ++n) acc[a][b][m][n] = (f32x4){0.f, 0.f, 0.f, 0.f};
        cur = nxt; cA = nA; cB = nB; ++ui;
        if constexpr (ALIGN_EPI) { if (wr == 1) PG8_BAR; }
    }
    PG8_WAIT_V(0);
    if constexpr (!ALIGN_EPI) { if (wr == 0) PG8_BAR; }
    PG8_BAR;
    if constexpr (Epi::AFTER_DRAIN) { E.fused(acc, cur, wr, wc, fr, fq, lds, wid, lane); S.done(cur); }
#undef PG8_SA
#undef PG8_SB
#undef PG8_STAGE
#undef PG8_LDA
#undef PG8_LDB
#undef PG8_MMA
#undef PG8_WAIT_V
#undef PG8_WAIT_L
#undef PG8_BAR
#undef PG8_SCHED
}
}
#define GAS __attribute__((address_space(1)))
#define LAS __attribute__((address_space(3)))
typedef unsigned short bf16;
typedef unsigned v4u __attribute__((ext_vector_type(4)));
typedef float f32x4 __attribute__((ext_vector_type(4)));
typedef short bf16x8 __attribute__((ext_vector_type(8)));
typedef GAS unsigned gu32;
typedef GAS unsigned long long gu64;
#define RLX_AGENT __ATOMIC_RELAXED, __HIP_MEMORY_SCOPE_AGENT
#define LDS_WAIT() asm volatile("s_waitcnt lgkmcnt(0)" ::: "memory")
#define VM_WAIT() asm volatile("s_waitcnt vmcnt(0)" ::: "memory")
__device__ __forceinline__ unsigned long long rt() { return __builtin_amdgcn_s_memrealtime(); }
__device__ __forceinline__ unsigned f2bf(float f) { unsigned u = __builtin_bit_cast(unsigned, f); return (u + 0x7fffu + ((u >> 16) & 1u)) >> 16; }
__device__ __forceinline__ unsigned pk2(float lo, float hi) { return f2bf(lo) | (f2bf(hi) << 16); }

#define XB_TMO      128
#define XB_XCNT(j)  (256  + 64 * (j))
#define XB_XSUB(j)  (1280 + 64 * (j))
#define XB_XGEN(j)  (2304 + 64 * (j))
#define XB_TOP      3328
#define XB_TOPGEN   3392
#define XCD_BAR_WORDS 3456
#define XB_SPIN_CAP (1u << 18)

__device__ __forceinline__ unsigned xb_ld(unsigned* p)              { return __hip_atomic_load(p, __ATOMIC_RELAXED, __HIP_MEMORY_SCOPE_AGENT); }
__device__ __forceinline__ unsigned xb_add(unsigned* p, unsigned v) { return __hip_atomic_fetch_add(p, v, __ATOMIC_RELAXED, __HIP_MEMORY_SCOPE_AGENT); }
__device__ __forceinline__ unsigned xb_xcc_id() { return (unsigned)__builtin_amdgcn_s_getreg((3 << 11) | 20) & 0xFu; }
#define XB_SPIN(cond, bar) do { unsigned _sp = 0; while (cond) { __builtin_amdgcn_s_sleep(1); \
    if ((++_sp & 255u) == 0u) { if (xb_ld(&(bar)[XB_TMO])) break; if (_sp > XB_SPIN_CAP) { atomicAdd(&(bar)[XB_TMO], 1u); break; } } } } while (0)

struct XcdBarrier {
    unsigned* bar; unsigned x;
    volatile LAS unsigned* st;
};

__device__ __forceinline__ XcdBarrier xcd_barrier_post(unsigned* bar, volatile LAS unsigned* st) {
    XcdBarrier b; b.bar = bar; b.x = xb_xcc_id(); b.st = st;
    if (threadIdx.x == 0) (void)xb_add(&bar[XB_XCNT(b.x)], 1u);
    return b;
}
__device__ __forceinline__ void xcd_barrier_complete(unsigned* bar, unsigned x, unsigned& nloc, unsigned& nx) {
    const unsigned G = gridDim.x * gridDim.y * gridDim.z;
    unsigned sum, cnt, mine, sp = 0u;
    for (;;) {
        sum = 0u; cnt = 0u; mine = 0u;
#pragma unroll
        for (unsigned j = 0; j < 16; ++j) { const unsigned c = xb_ld(&bar[XB_XCNT(j)]); sum += c; cnt += (c > 0u) ? 1u : 0u; mine = (j == x) ? c : mine; }
        if (sum == G) break;
        __builtin_amdgcn_s_sleep(1);
        if ((++sp & 255u) == 0u) { if (xb_ld(&bar[XB_TMO])) break; if (sp > XB_SPIN_CAP) { atomicAdd(&bar[XB_TMO], 1u); break; } }
    }
    nloc = mine > 0u ? mine : 1u; nx = cnt > 0u ? cnt : 1u;
}

__device__ __forceinline__ void xcd_barrier(const XcdBarrier& b) {
    asm volatile("s_waitcnt vmcnt(0)" ::: "memory");
    __syncthreads();
    if (threadIdx.x == 0) {
        unsigned* bar = b.bar;
        __builtin_amdgcn_s_waitcnt(0);
        unsigned nloc = b.st[0], nx = b.st[1];
        if (nloc == 0u) { xcd_barrier_complete(bar, b.x, nloc, nx); b.st[0] = nloc; b.st[1] = nx; }
        const unsigned old = xb_add(&bar[XB_XSUB(b.x)], 1u);
        const unsigned gen = old / nloc;
        if (old + 1u == (gen + 1u) * nloc) {
            __builtin_amdgcn_fence(__ATOMIC_RELEASE, "agent");
            asm volatile("s_waitcnt vmcnt(0)" ::: "memory");
            const unsigned og = xb_add(&bar[XB_TOP], 1u);
            const unsigned tg = og / nx;
            if (og + 1u == (tg + 1u) * nx) xb_add(&bar[XB_TOPGEN], 1u);
            else XB_SPIN(xb_ld(&bar[XB_TOPGEN]) == tg, bar);
            __builtin_amdgcn_fence(__ATOMIC_ACQUIRE, "agent");
            xb_add(&bar[XB_XGEN(b.x)], 1u);
            asm volatile("s_waitcnt vmcnt(0)" ::: "memory");
        } else {
            XB_SPIN(xb_ld(&bar[XB_XGEN(b.x)]) == gen, bar);
            __builtin_amdgcn_fence(__ATOMIC_ACQUIRE, "agent");
            asm volatile("s_waitcnt vmcnt(0)" ::: "memory");
        }
    }
    __syncthreads();
}


constexpr int NWAVES = 8;
constexpr int D = 1024, ML = 16384, MC = 256, M = ML + MC, DFF = 2816;
constexpr int NIN = 7712, NINP = 7936;
constexpr int NSC = 32, SCL = 512;
constexpr float EPS = 1e-6f;
static_assert(pg8::EP_ML == ML, "epilogue constant");

constexpr size_t MiB = 1u << 20, KiB = 1024;
constexpr size_t WS_CTL = 0, CTL_ZERO_BYTES = 1 * MiB;
constexpr size_t WS_SMALL = 1 * MiB;
constexpr size_t WS_HCTX = 9 * MiB;
constexpr size_t WS_FCTX = 10 * MiB;
constexpr size_t WS_RX = 11 * MiB;
constexpr size_t WS_ZQ = 44 * MiB;
constexpr size_t WS_XBC = 109 * MiB;
constexpr size_t WS_V = WS_XBC + (size_t)M * 1536 * 2;
constexpr size_t WS_G = WS_V + (size_t)M * 1024 * 2;
constexpr size_t WS_DT = WS_G + (size_t)M * 1024 * 2;
constexpr size_t WS_WIN = 227 * MiB;
static_assert(WS_DT + (size_t)M * 64 * 4 <= WS_WIN && WS_WIN + (size_t)NINP * 1024 * 2 <= 256 * MiB, "ws map (mixer phase)");
constexpr size_t WS_WREST = 216 * MiB;
constexpr size_t WO_OUT = 0, WO_UP0 = 4 * MiB, WO_DOWN0 = 15 * MiB, WO_OD = WO_DOWN0 + (size_t)DFF * 1024 * 2, WO_VG = WO_OD + 1 * MiB, WO_UP1 = WO_VG + 2 * MiB, WO_DOWN1 = WO_UP1 + 11 * MiB;
static_assert(WO_DOWN1 + (size_t)DFF * 1024 * 2 <= 40 * MiB, "weights overlay");
constexpr size_t WS_HID = WS_XBC;
static_assert(WS_HID + (size_t)M * DFF * 2 <= WS_WREST, "hidden overlay");
constexpr size_t WS_U = WS_ZQ;
constexpr size_t WS_A2 = WS_U + (size_t)M * 512 * 4;
static_assert(WS_A2 + (size_t)ML * 512 * 2 <= WS_XBC, "layer-1 overlay");
constexpr size_t WS_YS = WS_XBC;
constexpr size_t SM_ADAP = 0;
constexpr size_t SM_MODS = SM_ADAP + 2 * 2 * 8 * 6144 * 4;
constexpr size_t SM_LB = SM_MODS + 2 * 2 * 6144 * 4;
constexpr size_t SM_LAM = SM_LB + 4096;
constexpr size_t SM_LAMP = SM_LAM + 2 * 2048 * 2 * 4;
constexpr size_t SM_BB = SM_LAMP + 2 * 2048 * 2 * 4;
constexpr size_t SM_STATS = SM_BB + 2 * 2048 * 16 * 2 * 4;
constexpr size_t SM_SSDDEC = SM_STATS + (size_t)M * 16 * 4;
constexpr size_t SM_HGDEC = SM_SSDDEC + 33 * 32 * 4 + 128;
constexpr size_t SM_S5ST = ((SM_HGDEC + 33 * 16 * 128 * 4 + 255) / 256) * 256;
static_assert(SM_S5ST + 65 * 2 * 2048 * 2 * 4 <= 8 * MiB, "small tables");
constexpr size_t SSD_ST_BYTES = (size_t)33 * 32 * 8192 * 2;
static_assert(2 * SSD_ST_BYTES <= 33 * MiB && (size_t)M * 1024 * 2 <= 33 * MiB, "RX region");
constexpr int CW_BAR = 4096;

constexpr int RING_OFF = 0, RING_BYTES = 131072;
constexpr int LDSCTL_OFF = RING_BYTES, MISC_OFF = LDSCTL_OFF + 320;
constexpr int LDS_BYTES = 147456;


struct Params { const float* in[33]; float* out; unsigned char* ws; int ph_lo, ph_hi, use_bar, pad; };
enum { I_X = 0, I_C, I_CTX, I_CCTX, I_ADAW, I_ADAB, I_NMIX, I_NFFN, I_WGATE, I_WUP, I_WDOWN, I_FNORM, I_EVIN, I_EVOUT, I_CONVW, I_CONVB, I_DTB, I_ALOG, I_SSDD, I_SSDN, I_LBL, I_HGN,
       I_ODIN, I_ARE, I_AIM, I_LOGDT, I_BRE, I_BIM, I_CRE, I_CIM, I_S5D, I_WVAL, I_WGATE2 };
typedef _Float16 f16x8 __attribute__((ext_vector_type(8)));
typedef _Float16 f16;
typedef float f32x2 __attribute__((ext_vector_type(2)));
__device__ __forceinline__ float bf2f(unsigned b) { return __uint_as_float(b << 16); }
__device__ __forceinline__ float siluf(float x) { return x / (1.f + __expf(-x)); }
__device__ __forceinline__ float wave_sum(float v) {
#pragma unroll
    for (int o = 1; o < 64; o <<= 1) v += __shfl_xor(v, o);
    return v;
}
__device__ __forceinline__ void unpack8(const v4u r, float (&x)[8]) {
    x[0] = bf2f(r.x & 0xffffu); x[1] = bf2f(r.x >> 16); x[2] = bf2f(r.y & 0xffffu); x[3] = bf2f(r.y >> 16);
    x[4] = bf2f(r.z & 0xffffu); x[5] = bf2f(r.z >> 16); x[6] = bf2f(r.w & 0xffffu); x[7] = bf2f(r.w >> 16);
}
__device__ __forceinline__ void tr_item(const float* W, int ldw, int col0, int K, bf16* WT, int dst_row0, LAS float* scr, int kb, int lane) {
    const int k0 = 64 * kb;
#pragma unroll 8
    for (int i = 0; i < 32; ++i) { const int kk = 2 * i + (lane >> 5); scr[kk * 33 + (lane & 31)] = W[(size_t)(k0 + kk) * ldw + col0 + (lane & 31)]; }
    LDS_WAIT(); asm volatile("" ::: "memory");
    const int c = lane & 7;
#pragma unroll
    for (int j = 0; j < 4; ++j) { const int n = (lane >> 3) + 8 * j; const LAS float* s = scr + (8 * c) * 33 + n;
        v4u o; o.x = pk2(s[0 * 33], s[1 * 33]); o.y = pk2(s[2 * 33], s[3 * 33]); o.z = pk2(s[4 * 33], s[5 * 33]); o.w = pk2(s[6 * 33], s[7 * 33]);
        *(GAS v4u*)(WT + (size_t)(dst_row0 + n) * K + k0 + 8 * c) = o; }
    LDS_WAIT(); asm volatile("" ::: "memory");
}
__device__ __forceinline__ int dst_row_of(int mode, int c0) {
    if (mode == 0) return c0 < 2560 ? c0 : (c0 < 2592 ? 7680 + (c0 - 2560) : c0 - 32);
    if (mode == 1) return c0;
    return (c0 >> 7) * 256 + (mode == 3 ? 128 : 0) + (c0 & 127);
}
__device__ __forceinline__ void tr_job(const float* W, int K, int N, int mode, bf16* WT, LAS float* scr, int gw, int ngw, int lane) {
    const int nblk = N / 32, nit = (K / 64) * nblk;
    for (int it = gw; it < nit; it += ngw) { const int kb = it / nblk, nb = it % nblk; tr_item(W, N, 32 * nb, K, WT, dst_row_of(mode, 32 * nb), scr, kb, lane); }
}

__device__ __forceinline__ void phase_prologue(const Params& p, LAS unsigned char* lds, int bid, int G, int tid, int wave, int lane) {
    unsigned char* ws = p.ws; float* sm_adap = (float*)(ws + WS_SMALL + SM_ADAP);
    for (int it = bid; it < 192; it += G) {
        const int layer = it / 96, rem = it % 96, cb = rem / 8, ks = rem % 8;
        LAS float* sl = (LAS float*)lds; LAS float* sc = sl + 128;
        if (tid < 128) { sl[tid] = siluf(p.in[I_C][ks * 128 + tid]); sc[tid] = siluf(p.in[I_CCTX][ks * 128 + tid]); }
        __syncthreads();
        const int col = cb * 512 + tid; const float* W = p.in[I_ADAW] + (size_t)layer * 1024 * 6144 + (size_t)(ks * 128) * 6144 + col;
        float a0 = 0.f, a1 = 0.f;
#pragma unroll 8
        for (int k = 0; k < 128; ++k) { const float w = W[(size_t)k * 6144]; a0 += sl[k] * w; a1 += sc[k] * w; }
        sm_adap[((layer * 2 + 0) * 8 + ks) * 6144 + col] = a0; sm_adap[((layer * 2 + 1) * 8 + ks) * 6144 + col] = a1;
        __syncthreads();
    }
    const int gw = bid * NWAVES + wave, ngw = G * NWAVES;
    LAS float* scr = (LAS float*)(lds + wave * 16384);
    bf16* win = (bf16*)(ws + WS_WIN);
    tr_job(p.in[I_EVIN], 1024, NIN, 0, win, scr, gw, ngw, lane);
    { const int gt = bid * 512 + tid, nt = G * 512; v4u z = {0u, 0u, 0u, 0u};
      for (int i = gt; i < (NINP - NIN) * 1024 / 8; i += nt) *(GAS v4u*)(win + (size_t)NIN * 1024 + (size_t)i * 8) = z; }
    const int gt = bid * 512 + tid;
    if (gt < 1024) { const float l0 = p.in[I_LBL][gt], l1 = p.in[I_LBL][1024 + gt]; const float mx = fmaxf(l0, l1), e0 = __expf(l0 - mx), e1 = __expf(l1 - mx); ((float*)(ws + WS_SMALL + SM_LB))[gt] = e0 / (e0 + e1); }
    if (gt >= 4096 && gt < 8192) {
        const int s = gt - 4096, dg = s >> 6;
        const float dt = expf(p.in[I_LOGDT][dg]), are = p.in[I_ARE][s], aim = p.in[I_AIM][s];
        const float mag = expf(are * dt); float sn, cs; sincosf(aim * dt, &sn, &cs);
        const float lr = mag * cs, li = mag * sn, den = are * are + aim * aim;
        const float cr = ((lr - 1.f) * are + li * aim) / den, ci = (li * are - (lr - 1.f) * aim) / den;
        float* lam = (float*)(ws + WS_SMALL + SM_LAM); lam[2 * s] = lr; lam[2 * s + 1] = li;
        float pr = lr, pi = li;
#pragma unroll
        for (int q = 0; q < 8; ++q) { const float nr = pr * pr - pi * pi, ni = 2.f * pr * pi; pr = nr; pi = ni; }
        float* lamp = (float*)(ws + WS_SMALL + SM_LAMP); lamp[2 * s] = pr; lamp[2 * s + 1] = pi;
        float* bb = (float*)(ws + WS_SMALL + SM_BB) + (size_t)s * 32;
#pragma unroll
        for (int c = 0; c < 16; ++c) { const float br = p.in[I_BRE][(size_t)s * 16 + c], bi = p.in[I_BIM][(size_t)s * 16 + c]; bb[2 * c] = cr * br - ci * bi; bb[2 * c + 1] = cr * bi + ci * br; }
    }
}

__device__ __forceinline__ void phase_rownorm(const Params& p, LAS unsigned char* lds, int bid, int G, int tid, int wave, int lane, int layer, int kind  , int nrows,
                                              const float* src_lat, const float* src_ctx, bool from_partials) {
    unsigned char* ws = p.ws; const float* adap = (const float*)(ws + WS_SMALL + SM_ADAP); float* mods = (float*)(ws + WS_SMALL + SM_MODS);
    LAS float* Gt = (LAS float*)lds; LAS float* St = Gt + 2048;
    const float* ng = p.in[kind == 0 ? I_NMIX : I_NFFN] + layer * 1024;
    for (int idx = tid; idx < 4096; idx += 512) {
        const int vec = idx >> 11, which = (idx >> 10) & 1, col = idx & 1023, j = (kind * 3 + which) * 1024 + col;
        float v;
        if (from_partials) { v = p.in[I_ADAB][layer * 6144 + j];
#pragma unroll
            for (int ks = 0; ks < 8; ++ks) v += adap[((layer * 2 + vec) * 8 + ks) * 6144 + j]; }
        else v = mods[(layer * 2 + vec) * 6144 + j];
        if (which == 0) St[vec * 1024 + col] = v; else Gt[vec * 1024 + col] = ng[col] * (1.f + v);
    }
    if (from_partials && bid < 48) {
        const int idx = bid * 512 + tid, lv = idx / 6144, j = idx % 6144, ly = lv >> 1;
        float v = p.in[I_ADAB][ly * 6144 + j];
#pragma unroll
        for (int ks = 0; ks < 8; ++ks) v += adap[(lv * 8 + ks) * 6144 + j];
        mods[idx] = v;
    }
    __syncthreads();
    bf16* XN = (bf16*)(ws + WS_RX);
    const int gw = bid * NWAVES + wave, ngw = G * NWAVES;
    for (int row = gw; row < nrows; row += ngw) {
        const int vec = row >= ML ? 1 : 0; const float* xr = vec ? src_ctx + (size_t)(row - ML) * 1024 : src_lat + (size_t)row * 1024;
        f32x4 v[4]; float ss = 0.f;
#pragma unroll
        for (int j = 0; j < 4; ++j) { v[j] = *(const GAS f32x4*)(xr + 4 * lane + 256 * j); ss += (v[j].x * v[j].x + v[j].y * v[j].y) + (v[j].z * v[j].z + v[j].w * v[j].w); }
        const float r = rsqrtf(wave_sum(ss) * (1.f / 1024.f) + EPS);
#pragma unroll
        for (int j = 0; j < 4; ++j) { const int c = 4 * lane + 256 * j; const LAS float* g4 = Gt + vec * 1024 + c; const LAS float* s4 = St + vec * 1024 + c;
            const unsigned lo = pk2(v[j].x * r * g4[0] + s4[0], v[j].y * r * g4[1] + s4[1]), hi = pk2(v[j].z * r * g4[2] + s4[2], v[j].w * r * g4[3] + s4[3]);
            *(GAS unsigned long long*)(XN + (size_t)row * 1024 + c) = (unsigned long long)lo | ((unsigned long long)hi << 32); }
    }
}

struct ScanPtrs { const bf16* XBC; const float* DT; bf16* ZQ; const bf16* V; const bf16* G; f16* Flat; f16* Fctx; float* STATS; const float* convw; const float* convb; const float* ssdd; const float* hgn;
                  bf16* SSD_ST; bf16* HG_ST; float* SSD_DEC; float* HG_DEC; };
template <int MODE>
__device__ __forceinline__ void ssd_dir(const ScanPtrs& sp, LAS unsigned char* lds, int row_begin, int nrows, int seq_lo, int seq_hi, int h, int d, float (&st)[16], float& logsum, int tid) {
    LAS float* xs = (LAS float*)lds; LAS float* Bs = (LAS float*)(lds + 8192); LAS float* Cs = (LAS float*)(lds + 24576);
    LAS float* av = (LAS float*)(lds + 40960); LAS float* dtv = (LAS float*)(lds + 41088); LAS float* yb = (LAS float*)(lds + 41472);
    LAS unsigned short* YF = (LAS unsigned short*)(lds + 65536);
    const int p = tid >> 3, nq = tid & 7, g = h >> 3, nblk = nrows >> 5;
    const float dsk = sp.ssdd[h];
    for (int blk = 0; blk < nblk; ++blk) {
        const int r0 = d == 0 ? row_begin + 32 * blk : row_begin + nrows - 32 * (blk + 1);
        for (int w = tid; w < 1280; w += 512) {
            int t, col; LAS float* dst;
            if (w < 256) { t = w >> 3; const int o = w & 7; col = h * 64 + o * 8; dst = xs + t * 64 + o * 8; }
            else if (w < 768) { const int w2 = w - 256; t = w2 >> 4; const int o = w2 & 15; col = 1024 + g * 128 + o * 8; dst = Bs + t * 128 + o * 8; }
            else { const int w2 = w - 768; t = w2 >> 4; const int o = w2 & 15; col = 1280 + g * 128 + o * 8; dst = Cs + t * 128 + o * 8; }
            float a8[8];
            { const f32x4 b0 = *(const GAS f32x4*)(sp.convb + col), b1 = *(const GAS f32x4*)(sp.convb + col + 4); a8[0] = b0.x; a8[1] = b0.y; a8[2] = b0.z; a8[3] = b0.w; a8[4] = b1.x; a8[5] = b1.y; a8[6] = b1.z; a8[7] = b1.w; }
#pragma unroll
            for (int j = 0; j < 5; ++j) { const int rr = r0 + t + j - 2;
                if (rr >= seq_lo && rr < seq_hi) { float x8[8]; unpack8(*(const GAS v4u*)(sp.XBC + (size_t)rr * 1536 + col), x8);
                    const f32x4 w0 = *(const GAS f32x4*)(sp.convw + j * 1536 + col), w1 = *(const GAS f32x4*)(sp.convw + j * 1536 + col + 4);
                    a8[0] += w0.x * x8[0]; a8[1] += w0.y * x8[1]; a8[2] += w0.z * x8[2]; a8[3] += w0.w * x8[3]; a8[4] += w1.x * x8[4]; a8[5] += w1.y * x8[5]; a8[6] += w1.z * x8[6]; a8[7] += w1.w * x8[7]; } }
            *(LAS f32x4*)(dst) = (f32x4){siluf(a8[0]), siluf(a8[1]), siluf(a8[2]), siluf(a8[3])}; *(LAS f32x4*)(dst + 4) = (f32x4){siluf(a8[4]), siluf(a8[5]), siluf(a8[6]), siluf(a8[7])};
        }
        if (tid < 32) { const int row = r0 + tid; const float la = sp.DT[(size_t)row * 64 + 32 + d * 16 + h]; dtv[tid] = sp.DT[(size_t)row * 64 + d * 16 + h]; av[tid] = __expf(la);
            float s = la; s += __shfl_xor(s, 1); s += __shfl_xor(s, 2); s += __shfl_xor(s, 4); s += __shfl_xor(s, 8); s += __shfl_xor(s, 16); logsum += s; }
        __syncthreads();
        for (int jj = 0; jj < 32; ++jj) { const int t = d == 0 ? jj : 31 - jj;
            const float a = av[t], xd = xs[t * 64 + p] * dtv[t];
            const LAS float* bp = Bs + t * 128 + nq * 16; const LAS float* cp = Cs + t * 128 + nq * 16;
            float acc = 0.f;
#pragma unroll
            for (int i4 = 0; i4 < 4; ++i4) { const f32x4 b4 = *(const LAS f32x4*)(bp + 4 * i4);
                st[4 * i4 + 0] = a * st[4 * i4 + 0] + xd * b4.x; st[4 * i4 + 1] = a * st[4 * i4 + 1] + xd * b4.y; st[4 * i4 + 2] = a * st[4 * i4 + 2] + xd * b4.z; st[4 * i4 + 3] = a * st[4 * i4 + 3] + xd * b4.w;
                if (MODE != 0) { const f32x4 c4 = *(const LAS f32x4*)(cp + 4 * i4); acc += (c4.x * st[4 * i4 + 0] + c4.y * st[4 * i4 + 1]) + (c4.z * st[4 * i4 + 2] + c4.w * st[4 * i4 + 3]); } }
            if (MODE != 0) { acc += __shfl_xor(acc, 1); acc += __shfl_xor(acc, 2); acc += __shfl_xor(acc, 4); if (nq == 0) yb[t * 64 + p] = acc; }
        }
        if (MODE != 0) {
            __syncthreads();
            const int t = tid >> 4, p4 = (tid & 15) * 4, row = r0 + t, lrow = row - row_begin;
            const f32x4 y = *(const LAS f32x4*)(yb + t * 64 + p4);
            if (MODE == 1) { *(LAS unsigned long long*)(YF + lrow * 64 + p4) = (unsigned long long)pk2(y.x, y.y) | ((unsigned long long)pk2(y.z, y.w) << 32); }
            else {
                const unsigned long long yfw = *(const LAS unsigned long long*)(YF + lrow * 64 + p4); const f32x4 xv = *(const LAS f32x4*)(xs + t * 64 + p4);
                GAS unsigned long long* zp = (GAS unsigned long long*)(sp.ZQ + (size_t)row * 2048 + h * 64 + p4); const unsigned long long zw = *zp;
                const float o0 = (y.x + bf2f((unsigned)yfw & 0xffffu) + dsk * xv.x) * bf2f((unsigned)zw & 0xffffu), o1 = (y.y + bf2f(((unsigned)yfw >> 16) & 0xffffu) + dsk * xv.y) * bf2f(((unsigned)zw >> 16) & 0xffffu);
                const float o2 = (y.z + bf2f((unsigned)(yfw >> 32) & 0xffffu) + dsk * xv.z) * bf2f((unsigned)(zw >> 32) & 0xffffu), o3 = (y.w + bf2f((unsigned)(yfw >> 48) & 0xffffu) + dsk * xv.w) * bf2f((unsigned)(zw >> 48) & 0xffffu);
                *zp = (unsigned long long)pk2(o0, o1) | ((unsigned long long)pk2(o2, o3) << 32);
                float ss = (o0 * o0 + o1 * o1) + (o2 * o2 + o3 * o3);
                ss += __shfl_xor(ss, 1); ss += __shfl_xor(ss, 2); ss += __shfl_xor(ss, 4); ss += __shfl_xor(ss, 8);
                if ((tid & 15) == 0) sp.STATS[(size_t)row * 16 + h] = ss;
            }
        }
        __syncthreads();
    }
}
__device__ __forceinline__ void ssd_load_state(const bf16* S, float (&st)[16], int tid) {
    float a[8], b[8]; const GAS v4u* sp = (const GAS v4u*)(S + (tid >> 3) * 128 + (tid & 7) * 16); unpack8(sp[0], a); unpack8(sp[1], b);
#pragma unroll
    for (int i = 0; i < 8; ++i) { st[i] = a[i]; st[8 + i] = b[i]; }
}
__device__ __forceinline__ void ssd_save_state(bf16* S, const float (&st)[16], int tid) {
    GAS v4u* sp = (GAS v4u*)(S + (tid >> 3) * 128 + (tid & 7) * 16);
    v4u o; o.x = pk2(st[0], st[1]); o.y = pk2(st[2], st[3]); o.z = pk2(st[4], st[5]); o.w = pk2(st[6], st[7]); sp[0] = o;
    o.x = pk2(st[8], st[9]); o.y = pk2(st[10], st[11]); o.z = pk2(st[12], st[13]); o.w = pk2(st[14], st[15]); sp[1] = o;
}

template <int MODE>
__device__ __forceinline__ void hg_dir(const ScanPtrs& sp, LAS unsigned char* lds, int row_begin, int nrows, int hh, int d, float (&st)[32], float& lsum, int tid) {
    LAS float* qs = (LAS float*)lds; LAS float* fk = (LAS float*)(lds + 8192); LAS float* kk = (LAS float*)(lds + 16384); LAS float* vv = (LAS float*)(lds + 24576);
    LAS float* lfs = (LAS float*)(lds + 32768); LAS float* PO = (LAS float*)(lds + 40960); LAS float* red = (LAS float*)(lds + 73728);
    const int v = tid & 127, kq = tid >> 7, nblk = nrows >> 4, lane = tid & 63, wave = tid >> 6;
    const float hgnv = sp.hgn[v];
    for (int blk = 0; blk < nblk; ++blk) {
        const int r0 = d == 0 ? row_begin + 16 * blk : row_begin + nrows - 16 * (blk + 1);
        { const int wu = tid & 255, t = wu >> 4, o = wu & 15, row = r0 + t;
          if (tid < 256) { float x8[8]; unpack8(*(const GAS v4u*)(sp.ZQ + (size_t)row * 2048 + 1024 + hh * 128 + o * 8), x8);
              *(LAS f32x4*)(qs + t * 128 + o * 8) = (f32x4){x8[0], x8[1], x8[2], x8[3]}; *(LAS f32x4*)(qs + t * 128 + o * 8 + 4) = (f32x4){x8[4], x8[5], x8[6], x8[7]};
              unpack8(*(const GAS v4u*)(sp.V + (size_t)row * 1024 + hh * 128 + o * 8), x8);
              *(LAS f32x4*)(vv + t * 128 + o * 8) = (f32x4){x8[0], x8[1], x8[2], x8[3]}; *(LAS f32x4*)(vv + t * 128 + o * 8 + 4) = (f32x4){x8[4], x8[5], x8[6], x8[7]}; }
          else { const f16* fr = (row < ML ? sp.Flat + (size_t)row * 2048 : sp.Fctx + (size_t)(row - ML) * 2048) + d * 1024 + hh * 128 + o * 8; const f16x8 h8 = *(const GAS f16x8*)fr;
#pragma unroll
              for (int i = 0; i < 8; ++i) { const float lf = (float)h8[i], f = __expf(lf); lfs[t * 128 + o * 8 + i] = lf; fk[t * 128 + o * 8 + i] = f; kk[t * 128 + o * 8 + i] = 1.f - f; } } }
        __syncthreads();
        if (MODE == 0 && tid < 128) {
#pragma unroll
            for (int t = 0; t < 16; ++t) lsum += lfs[t * 128 + tid]; }
        for (int jj = 0; jj < 16; ++jj) { const int t = d == 0 ? jj : 15 - jj;
            const float vvv = vv[t * 128 + v]; float acc = 0.f;
            const LAS float* fp = fk + t * 128 + kq * 32; const LAS float* kp = kk + t * 128 + kq * 32; const LAS float* qp = qs + t * 128 + kq * 32;
#pragma unroll
            for (int i4 = 0; i4 < 8; ++i4) { const f32x4 f4 = *(const LAS f32x4*)(fp + 4 * i4), k4 = *(const LAS f32x4*)(kp + 4 * i4);
                st[4 * i4 + 0] = f4.x * st[4 * i4 + 0] + k4.x * vvv; st[4 * i4 + 1] = f4.y * st[4 * i4 + 1] + k4.y * vvv; st[4 * i4 + 2] = f4.z * st[4 * i4 + 2] + k4.z * vvv; st[4 * i4 + 3] = f4.w * st[4 * i4 + 3] + k4.w * vvv;
                if (MODE != 0) { const f32x4 q4 = *(const LAS f32x4*)(qp + 4 * i4); acc += (q4.x * st[4 * i4 + 0] + q4.y * st[4 * i4 + 1]) + (q4.z * st[4 * i4 + 2] + q4.w * st[4 * i4 + 3]); } }
            if (MODE != 0) PO[(t * 4 + kq) * 128 + v] = acc;
        }
        if (MODE != 0) {
            __syncthreads();
            float oo[4];
#pragma unroll
            for (int i4 = 0; i4 < 4; ++i4) { const int t = i4 * 4 + kq, row = r0 + t;
                float o = (PO[(t * 4 + 0) * 128 + v] + PO[(t * 4 + 1) * 128 + v]) + (PO[(t * 4 + 2) * 128 + v] + PO[(t * 4 + 3) * 128 + v]);
                f16* fr = (row < ML ? sp.Flat + (size_t)row * 2048 : sp.Fctx + (size_t)(row - ML) * 2048) + hh * 128 + v;
                if (MODE == 1) { *(GAS f16*)fr = (f16)o; }
                else { o += (float)*(const GAS f16*)fr; oo[i4] = o; const float ss = wave_sum(o * o); if (lane == 0) red[t * 2 + (wave & 1)] = ss; } }
            if (MODE == 2) {
                __syncthreads();
#pragma unroll
                for (int i4 = 0; i4 < 4; ++i4) { const int t = i4 * 4 + kq, row = r0 + t;
                    const float r = rsqrtf((red[t * 2] + red[t * 2 + 1]) * (1.f / 128.f) + EPS);
                    const float gv = bf2f(*(const GAS unsigned short*)(sp.G + (size_t)row * 1024 + hh * 128 + v));
                    *(GAS unsigned short*)(sp.ZQ + (size_t)row * 2048 + 1024 + hh * 128 + v) = (unsigned short)f2bf(oo[i4] * r * hgnv * gv); }
            }
        }
        __syncthreads();
    }
}
__device__ __forceinline__ void hg_load_state(const bf16* S, float (&st)[32], int tid) {
    const int v = tid & 127, kq = tid >> 7;
#pragma unroll
    for (int i = 0; i < 32; ++i) st[i] = bf2f(*(const GAS unsigned short*)(S + (kq * 32 + i) * 128 + v));
}
__device__ __forceinline__ void hg_save_state(bf16* S, const float (&st)[32], int tid) {
    const int v = tid & 127, kq = tid >> 7;
#pragma unroll
    for (int i = 0; i < 32; ++i) *(GAS unsigned short*)(S + (kq * 32 + i) * 128 + v) = (unsigned short)f2bf(st[i]);
}
__device__ __forceinline__ void wg_fence() { __threadfence(); __syncthreads(); }

__device__ __forceinline__ void phase_scanA(const ScanPtrs& sp, LAS unsigned char* lds, int bid, int G, int tid) {
    const int NI = NSC * 16 + NSC * 32 + 8 + 16;
    for (int it = bid; it < NI; it += G) {
        if (it < NSC * 16) { const int sc = it >> 4, chain = it & 15, hh = chain >> 1, d = chain & 1;
            float st[32]; float lsum = 0.f;
#pragma unroll
            for (int i = 0; i < 32; ++i) st[i] = 0.f;
            hg_dir<0>(sp, lds, sc * SCL, SCL, hh, d, st, lsum, tid);
            hg_save_state(sp.HG_ST + ((size_t)sc * 16 + chain) * 16384, st, tid);
            if (tid < 128) sp.HG_DEC[(sc * 16 + chain) * 128 + tid] = __expf(lsum);
        } else if (it < NSC * 16 + NSC * 32) { const int i2 = it - NSC * 16, sc = i2 >> 5, chain = i2 & 31, h = chain >> 1, d = chain & 1;
            float st[16]; float logsum = 0.f;
#pragma unroll
            for (int i = 0; i < 16; ++i) st[i] = 0.f;
            ssd_dir<0>(sp, lds, sc * SCL, SCL, 0, ML, h, d, st, logsum, tid);
            ssd_save_state(sp.SSD_ST + ((size_t)sc * 32 + chain) * 8192, st, tid);
            if (tid == 0) sp.SSD_DEC[sc * 32 + chain] = __expf(logsum);
        } else if (it < NSC * 16 + NSC * 32 + 8) { const int hh = it - (NSC * 16 + NSC * 32);
            float st[32]; float lsum = 0.f;
#pragma unroll
            for (int i = 0; i < 32; ++i) st[i] = 0.f;
            hg_dir<1>(sp, lds, ML, MC, hh, 0, st, lsum, tid);
            hg_save_state(sp.HG_ST + ((size_t)NSC * 16 + hh * 2 + 0) * 16384, st, tid);
            wg_fence();
#pragma unroll
            for (int i = 0; i < 32; ++i) st[i] = 0.f;
            hg_dir<2>(sp, lds, ML, MC, hh, 1, st, lsum, tid);
            hg_save_state(sp.HG_ST + ((size_t)NSC * 16 + hh * 2 + 1) * 16384, st, tid);
        } else { const int h = it - (NSC * 16 + NSC * 32 + 8);
            float st[16]; float logsum = 0.f;
#pragma unroll
            for (int i = 0; i < 16; ++i) st[i] = 0.f;
            ssd_dir<1>(sp, lds, ML, MC, ML, M, h, 0, st, logsum, tid);
            ssd_save_state(sp.SSD_ST + ((size_t)NSC * 32 + h * 2 + 0) * 8192, st, tid);
#pragma unroll
            for (int i = 0; i < 16; ++i) st[i] = 0.f;
            ssd_dir<2>(sp, lds, ML, MC, ML, M, h, 1, st, logsum, tid);
            ssd_save_state(sp.SSD_ST + ((size_t)NSC * 32 + h * 2 + 1) * 8192, st, tid);
        }
        __syncthreads();
    }
}
__device__ __forceinline__ void phase_scanB(const ScanPtrs& sp, int bid, int G, int tid) {
    const int gt = bid * 512 + tid, nt = G * 512;
    for (int e = gt; e < 2 * 131072; e += nt) {
        const bool hg = e >= 131072; const int e2 = hg ? e - 131072 : e;
        const int chain = hg ? (e2 >> 13) : (e2 >> 12), pr = hg ? (e2 & 8191) : (e2 & 4095), d = chain & 1;
        const int nch = hg ? 16 : 32, ppc = hg ? 8192 : 4096;
        GAS unsigned* base = (GAS unsigned*)(hg ? sp.HG_ST : sp.SSD_ST);
        const unsigned w0 = base[((size_t)NSC * nch + chain) * ppc + pr];
        float r0 = bf2f(w0 & 0xffffu), r1 = bf2f(w0 >> 16);
        for (int i0 = 0; i0 < NSC; i0 += 8) {
            unsigned loc[8]; float dec[8];
#pragma unroll
            for (int j = 0; j < 8; ++j) { const int sc = d == 0 ? i0 + j : NSC - 1 - (i0 + j); loc[j] = base[((size_t)sc * nch + chain) * ppc + pr];
                dec[j] = hg ? sp.HG_DEC[(sc * 16 + chain) * 128 + (pr >> 6)] : sp.SSD_DEC[sc * 32 + chain]; }
#pragma unroll
            for (int j = 0; j < 8; ++j) { const int sc = d == 0 ? i0 + j : NSC - 1 - (i0 + j); base[((size_t)sc * nch + chain) * ppc + pr] = pk2(r0, r1);
                r0 = r0 * dec[j] + bf2f(loc[j] & 0xffffu); r1 = r1 * dec[j] + bf2f(loc[j] >> 16); }
        }
    }
}
__device__ __forceinline__ void phase_scanC(const ScanPtrs& sp, LAS unsigned char* lds, int bid, int G, int tid) {
    const int NI = NSC * 8 + NSC * 16;
    for (int it = bid; it < NI; it += G) {
        if (it < NSC * 8) { const int sc = it >> 3, hh = it & 7;
            float st[32]; float lsum = 0.f;
            hg_load_state(sp.HG_ST + ((size_t)sc * 16 + hh * 2 + 0) * 16384, st, tid);
            hg_dir<1>(sp, lds, sc * SCL, SCL, hh, 0, st, lsum, tid);
            wg_fence();
            hg_load_state(sp.HG_ST + ((size_t)sc * 16 + hh * 2 + 1) * 16384, st, tid);
            hg_dir<2>(sp, lds, sc * SCL, SCL, hh, 1, st, lsum, tid);
        } else { const int i2 = it - NSC * 8, sc = i2 >> 4, h = i2 & 15;
            float st[16]; float logsum = 0.f;
            ssd_load_state(sp.SSD_ST + ((size_t)sc * 32 + h * 2 + 0) * 8192, st, tid);
            ssd_dir<1>(sp, lds, sc * SCL, SCL, 0, ML, h, 0, st, logsum, tid);
            ssd_load_state(sp.SSD_ST + ((size_t)sc * 32 + h * 2 + 1) * 8192, st, tid);
            ssd_dir<2>(sp, lds, sc * SCL, SCL, 0, ML, h, 1, st, logsum, tid);
        }
        __syncthreads();
    }
}
__device__ __forceinline__ void phase_finish(const Params& p, LAS unsigned char* lds, int bid, int G, int tid, int wave, int lane) {
    unsigned char* ws = p.ws; bf16* ZQ = (bf16*)(ws + WS_ZQ); const float* stats = (const float*)(ws + WS_SMALL + SM_STATS); const float* sng = p.in[I_SSDN];
    const int gw = bid * NWAVES + wave, ngw = G * NWAVES;
    for (int row = gw; row < M; row += ngw) {
        const int grp = lane >> 5; const float* s8 = stats + (size_t)row * 16 + grp * 8;
        const float ss = ((s8[0] + s8[1]) + (s8[2] + s8[3])) + ((s8[4] + s8[5]) + (s8[6] + s8[7]));
        const float r = rsqrtf(ss * (1.f / 512.f) + EPS);
        GAS v4u* zp = (GAS v4u*)(ZQ + (size_t)row * 2048 + lane * 16);
#pragma unroll
        for (int q = 0; q < 2; ++q) { float x8[8]; unpack8(zp[q], x8); const float* g8 = sng + lane * 16 + q * 8;
            v4u o; o.x = pk2(x8[0] * r * g8[0], x8[1] * r * g8[1]); o.y = pk2(x8[2] * r * g8[2], x8[3] * r * g8[3]); o.z = pk2(x8[4] * r * g8[4], x8[5] * r * g8[5]); o.w = pk2(x8[6] * r * g8[6], x8[7] * r * g8[7]); zp[q] = o; }
    }
    LAS float* scr = (LAS float*)(lds + wave * 16384); unsigned char* wr = ws + WS_WREST;
    tr_job(p.in[I_EVOUT], 2048, 1024, 1, (bf16*)(wr + WO_OUT), scr, gw, ngw, lane);
    tr_job(p.in[I_WGATE], 1024, DFF, 2, (bf16*)(wr + WO_UP0), scr, gw, ngw, lane);
    tr_job(p.in[I_WUP], 1024, DFF, 3, (bf16*)(wr + WO_UP0), scr, gw, ngw, lane);
    tr_job(p.in[I_WDOWN], DFF, 1024, 1, (bf16*)(wr + WO_DOWN0), scr, gw, ngw, lane);
    tr_job(p.in[I_ODIN], 1024, 512, 1, (bf16*)(wr + WO_OD), scr, gw, ngw, lane);
    tr_job(p.in[I_WVAL], 512, 1024, 2, (bf16*)(wr + WO_VG), scr, gw, ngw, lane);
    tr_job(p.in[I_WGATE2], 512, 1024, 3, (bf16*)(wr + WO_VG), scr, gw, ngw, lane);
    tr_job(p.in[I_WGATE] + (size_t)1024 * DFF, 1024, DFF, 2, (bf16*)(wr + WO_UP1), scr, gw, ngw, lane);
    tr_job(p.in[I_WUP] + (size_t)1024 * DFF, 1024, DFF, 3, (bf16*)(wr + WO_UP1), scr, gw, ngw, lane);
    tr_job(p.in[I_WDOWN] + (size_t)DFF * 1024, DFF, 1024, 1, (bf16*)(wr + WO_DOWN1), scr, gw, ngw, lane);
}

struct S5Ptrs { const float* U; float* YS; bf16* A2; const float* LAM; const float* LAMP; const float* BB; const float* CRE; const float* CIM; const float* S5D; float* ST; };
template <int MODE>
__device__ __forceinline__ void s5_dir(const S5Ptrs& sp, LAS unsigned char* lds, int row_begin, int gb, int d, float& hr, float& hi, int tid) {
    LAS float* ub = (LAS float*)lds; LAS float* hsr = (LAS float*)(lds + 4096); LAS float* hsi = (LAS float*)(lds + 4096 + 16384);
    const int gl = tid >> 6, s = (d * 32 + gb * 8 + gl) * 64 + (tid & 63);
    float bbr[16], bbi[16];
#pragma unroll
    for (int c = 0; c < 16; ++c) { bbr[c] = sp.BB[(size_t)s * 32 + 2 * c]; bbi[c] = sp.BB[(size_t)s * 32 + 2 * c + 1]; }
    const float lr = sp.LAM[2 * s], li = sp.LAM[2 * s + 1];
    for (int blk = 0; blk < 32; ++blk) {
        const int r0 = d == 0 ? row_begin + 8 * blk : row_begin + 256 - 8 * (blk + 1);
        if (tid < 256) { const int t = tid >> 5, c4 = (tid & 31) * 4; *(LAS f32x4*)(ub + t * 128 + c4) = *(const GAS f32x4*)(sp.U + (size_t)(r0 + t) * 512 + gb * 128 + c4); }
        __syncthreads();
        for (int jj = 0; jj < 8; ++jj) { const int t = d == 0 ? jj : 7 - jj; const LAS float* up = ub + t * 128 + gl * 16;
            float br = 0.f, bi = 0.f;
#pragma unroll
            for (int c4 = 0; c4 < 4; ++c4) { const f32x4 u4 = *(const LAS f32x4*)(up + 4 * c4);
                br += (bbr[4 * c4] * u4.x + bbr[4 * c4 + 1] * u4.y) + (bbr[4 * c4 + 2] * u4.z + bbr[4 * c4 + 3] * u4.w); bi += (bbi[4 * c4] * u4.x + bbi[4 * c4 + 1] * u4.y) + (bbi[4 * c4 + 2] * u4.z + bbi[4 * c4 + 3] * u4.w); }
            const float nr = lr * hr - li * hi + br, ni = lr * hi + li * hr + bi; hr = nr; hi = ni;
            if (MODE != 0) { hsr[t * 512 + tid] = hr; hsi[t * 512 + tid] = hi; }
        }
        if (MODE != 0) {
            __syncthreads();
            const int t = tid >> 6, g2 = (tid >> 3) & 7, c0 = (tid & 7) * 2, gg = gb * 8 + g2;
            float y[2];
#pragma unroll
            for (int q = 0; q < 2; ++q) { const float* cr = sp.CRE + ((size_t)(d * 32 + gg) * 16 + c0 + q) * 64; const float* ci = sp.CIM + ((size_t)(d * 32 + gg) * 16 + c0 + q) * 64;
                const LAS float* pr = hsr + t * 512 + g2 * 64; const LAS float* pi = hsi + t * 512 + g2 * 64; float a = 0.f;
#pragma unroll 4
                for (int p4 = 0; p4 < 16; ++p4) { const f32x4 r4 = *(const LAS f32x4*)(pr + 4 * p4), i4 = *(const LAS f32x4*)(pi + 4 * p4), cr4 = *(const GAS f32x4*)(cr + 4 * p4), ci4 = *(const GAS f32x4*)(ci + 4 * p4);
                    a += (cr4.x * r4.x - ci4.x * i4.x) + (cr4.y * r4.y - ci4.y * i4.y) + (cr4.z * r4.z - ci4.z * i4.z) + (cr4.w * r4.w - ci4.w * i4.w); }
                y[q] = a; }
            const int row = r0 + t, col = gb * 128 + g2 * 16 + c0;
            if (MODE == 1) { *(GAS f32x2*)(sp.YS + (size_t)row * 512 + col) = (f32x2){y[0], y[1]}; }
            else { const f32x2 yf = *(const GAS f32x2*)(sp.YS + (size_t)row * 512 + col);
                const float v0 = y[0] + yf.x + sp.S5D[col] * ub[t * 128 + g2 * 16 + c0], v1 = y[1] + yf.y + sp.S5D[col + 1] * ub[t * 128 + g2 * 16 + c0 + 1];
                const float t0 = 0.7978845608f * (v0 + 0.044715f * v0 * v0 * v0), t1 = 0.7978845608f * (v1 + 0.044715f * v1 * v1 * v1);
                const float g0 = 0.5f * v0 * (2.f - 2.f / (__expf(2.f * t0) + 1.f)), g1 = 0.5f * v1 * (2.f - 2.f / (__expf(2.f * t1) + 1.f));
                const int token = (row & 255) * 64 + (row >> 8);
                *(GAS unsigned*)(sp.A2 + (size_t)token * 512 + col) = pk2(g0, g1); }
        }
        __syncthreads();
    }
}
__device__ __forceinline__ void phase_s5A(const S5Ptrs& sp, LAS unsigned char* lds, int bid, int G, int tid) {
    for (int it = bid; it < 64 * 8 + 8; it += G) {
        const bool isc = it >= 512; const int i2 = isc ? it - 512 : it, c = isc ? 64 : (i2 >> 3), d = (i2 >> 2) & 1, gb = i2 & 3;
        float hr = 0.f, hi = 0.f;
        s5_dir<0>(sp, lds, isc ? ML : c * 256, gb, d, hr, hi, tid);
        *(GAS f32x2*)(sp.ST + ((size_t)(c * 2 + d) * 2048 + gb * 512 + tid) * 2) = (f32x2){hr, hi};
    }
}
__device__ __forceinline__ void phase_s5B(const S5Ptrs& sp, int bid, int G, int tid) {
    const int gt = bid * 512 + tid;
    if (gt < 4096) { const int d = gt >> 11, gp = gt & 2047, s = d * 2048 + gp; const float pr = sp.LAMP[2 * s], pi = sp.LAMP[2 * s + 1];
        GAS f32x2* st = (GAS f32x2*)sp.ST; f32x2 run = st[(size_t)(64 * 2 + d) * 2048 + gp];
        for (int i0 = 0; i0 < 64; i0 += 8) { f32x2 loc[8];
#pragma unroll
            for (int j = 0; j < 8; ++j) { const int c = d == 0 ? i0 + j : 63 - (i0 + j); loc[j] = st[(size_t)(c * 2 + d) * 2048 + gp]; }
#pragma unroll
            for (int j = 0; j < 8; ++j) { const int c = d == 0 ? i0 + j : 63 - (i0 + j); st[(size_t)(c * 2 + d) * 2048 + gp] = run;
                const float nr = pr * run.x - pi * run.y + loc[j].x, ni = pr * run.y + pi * run.x + loc[j].y; run.x = nr; run.y = ni; } }
    }
}
__device__ __forceinline__ void phase_s5C(const S5Ptrs& sp, LAS unsigned char* lds, int bid, int G, int tid) {
    for (int it = bid; it < 256; it += G) { const int c = it >> 2, gb = it & 3;
        f32x2 h0 = *(const GAS f32x2*)(sp.ST + ((size_t)(c * 2 + 0) * 2048 + gb * 512 + tid) * 2); float hr = h0.x, hi = h0.y;
        s5_dir<1>(sp, lds, c * 256, gb, 0, hr, hi, tid);
        wg_fence();
        h0 = *(const GAS f32x2*)(sp.ST + ((size_t)(c * 2 + 1) * 2048 + gb * 512 + tid) * 2); hr = h0.x; hi = h0.y;
        s5_dir<2>(sp, lds, c * 256, gb, 1, hr, hi, tid);
    }
}
__device__ __forceinline__ void phase_final(const Params& p, int bid, int G, int wave, int lane) {
    const int gw = bid * NWAVES + wave, ngw = G * NWAVES; const float* fg = p.in[I_FNORM];
    for (int row = gw; row < ML; row += ngw) { float* xr = p.out + (size_t)row * 1024;
        f32x4 v[4]; float ss = 0.f;
#pragma unroll
        for (int j = 0; j < 4; ++j) { v[j] = *(const GAS f32x4*)(xr + 4 * lane + 256 * j); ss += (v[j].x * v[j].x + v[j].y * v[j].y) + (v[j].z * v[j].z + v[j].w * v[j].w); }
        const float r = rsqrtf(wave_sum(ss) * (1.f / 1024.f) + EPS);
#pragma unroll
        for (int j = 0; j < 4; ++j) { const f32x4 g4 = *(const GAS f32x4*)(fg + 4 * lane + 256 * j); *(GAS f32x4*)(xr + 4 * lane + 256 * j) = (f32x4){v[j].x * r * g4.x, v[j].y * r * g4.y, v[j].z * r * g4.z, v[j].w * r * g4.w}; }
    }
}

constexpr int N_PHASES = 21;
__device__ __forceinline__ void run_gmix(const Params& p, LAS unsigned char* lds, int bid, int G) {
    unsigned char* ws = p.ws;
    pg8::Gemm g{(const bf16*)(ws + WS_RX), (const bf16*)(ws + WS_WIN), M, NINP, 1024}; pg8::StaticOrder S; S.init(M, NINP, G, bid);
    pg8::EpiMix1 E{(bf16*)(ws + WS_ZQ), (bf16*)(ws + WS_XBC), (bf16*)(ws + WS_V), (bf16*)(ws + WS_G), (f16*)p.out, (f16*)(ws + WS_FCTX), (float*)(ws + WS_DT), (const float*)(ws + WS_SMALL + SM_LB), p.in[I_DTB], p.in[I_ALOG]};
    pg8::gemm_phase<pg8::EpiMix1, pg8::StaticOrder, true, true>(lds + RING_OFF, g, S, E);
}
__device__ __forceinline__ void run_gout(const Params& p, LAS unsigned char* lds, int bid, int G) {
    unsigned char* ws = p.ws; const float* mods = (const float*)(ws + WS_SMALL + SM_MODS);
    pg8::Gemm g{(const bf16*)(ws + WS_ZQ), (const bf16*)(ws + WS_WREST + WO_OUT), M, 1024, 2048}; pg8::StaticOrder S; S.init(M, 1024, G, bid);
    pg8::EpiResid E{p.in[I_X], p.in[I_CTX], p.out, (float*)(ws + WS_HCTX), mods + (0 * 2 + 0) * 6144 + 2 * 1024, mods + (0 * 2 + 1) * 6144 + 2 * 1024};
    pg8::gemm_phase<pg8::EpiResid, pg8::StaticOrder, true, true>(lds + RING_OFF, g, S, E);
}
__device__ __forceinline__ void run_gup(const Params& p, LAS unsigned char* lds, int bid, int G, int layer) {
    unsigned char* ws = p.ws; const int rows = layer ? ML : M;
    pg8::Gemm g{(const bf16*)(ws + WS_RX), (const bf16*)(ws + WS_WREST + (layer ? WO_UP1 : WO_UP0)), rows, 2 * DFF, 1024}; pg8::StaticOrder S; S.init(rows, 2 * DFF, G, bid);
    pg8::EpiSwiglu E{(bf16*)(ws + WS_HID)};
    pg8::gemm_phase<pg8::EpiSwiglu, pg8::StaticOrder, true, true>(lds + RING_OFF, g, S, E);
}
__device__ __forceinline__ void run_gdown(const Params& p, LAS unsigned char* lds, int bid, int G, int layer) {
    unsigned char* ws = p.ws; const int rows = layer ? ML : M; const float* mods = (const float*)(ws + WS_SMALL + SM_MODS); float* Hctx = (float*)(ws + WS_HCTX);
    pg8::Gemm g{(const bf16*)(ws + WS_HID), (const bf16*)(ws + WS_WREST + (layer ? WO_DOWN1 : WO_DOWN0)), rows, 1024, DFF}; pg8::StaticOrder S; S.init(rows, 1024, G, bid);
    pg8::EpiResid E{p.out, Hctx, p.out, Hctx, mods + (layer * 2 + 0) * 6144 + 5 * 1024, mods + (layer * 2 + 1) * 6144 + 5 * 1024};
    pg8::gemm_phase<pg8::EpiResid, pg8::StaticOrder, true, true>(lds + RING_OFF, g, S, E);
}
__device__ __forceinline__ void run_god(const Params& p, LAS unsigned char* lds, int bid, int G) {
    unsigned char* ws = p.ws;
    pg8::Gemm g{(const bf16*)(ws + WS_RX), (const bf16*)(ws + WS_WREST + WO_OD), M, 512, 1024}; pg8::StaticOrder S; S.init(M, 512, G, bid);
    pg8::EpiU E{(float*)(ws + WS_U)};
    pg8::gemm_phase<pg8::EpiU, pg8::StaticOrder, true, true>(lds + RING_OFF, g, S, E);
}
__device__ __forceinline__ void run_gvg(const Params& p, LAS unsigned char* lds, int bid, int G) {
    unsigned char* ws = p.ws; const float* mods = (const float*)(ws + WS_SMALL + SM_MODS);
    pg8::Gemm g{(const bf16*)(ws + WS_A2), (const bf16*)(ws + WS_WREST + WO_VG), ML, 2048, 512}; pg8::StaticOrder S; S.init(ML, 2048, G, bid);
    pg8::EpiValGate E{p.out, mods + (1 * 2 + 0) * 6144 + 2 * 1024};
    pg8::gemm_phase<pg8::EpiValGate, pg8::StaticOrder, true, true>(lds + RING_OFF, g, S, E);
}
__device__ __forceinline__ ScanPtrs make_scanptrs(const Params& p) {
    unsigned char* ws = p.ws; ScanPtrs sp; sp.XBC = (const bf16*)(ws + WS_XBC); sp.DT = (const float*)(ws + WS_DT); sp.ZQ = (bf16*)(ws + WS_ZQ); sp.V = (const bf16*)(ws + WS_V); sp.G = (const bf16*)(ws + WS_G); sp.Flat = (f16*)p.out; sp.Fctx = (f16*)(ws + WS_FCTX);
    sp.STATS = (float*)(ws + WS_SMALL + SM_STATS); sp.convw = p.in[I_CONVW]; sp.convb = p.in[I_CONVB]; sp.ssdd = p.in[I_SSDD]; sp.hgn = p.in[I_HGN];
    sp.SSD_ST = (bf16*)(ws + WS_RX); sp.HG_ST = (bf16*)(ws + WS_RX + SSD_ST_BYTES); sp.SSD_DEC = (float*)(ws + WS_SMALL + SM_SSDDEC); sp.HG_DEC = (float*)(ws + WS_SMALL + SM_HGDEC); return sp;
}
__device__ __forceinline__ S5Ptrs make_s5ptrs(const Params& p) {
    unsigned char* ws = p.ws; S5Ptrs s5; s5.U = (const float*)(ws + WS_U); s5.YS = (float*)(ws + WS_YS); s5.A2 = (bf16*)(ws + WS_A2); s5.LAM = (const float*)(ws + WS_SMALL + SM_LAM); s5.LAMP = (const float*)(ws + WS_SMALL + SM_LAMP);
    s5.BB = (const float*)(ws + WS_SMALL + SM_BB); s5.CRE = p.in[I_CRE]; s5.CIM = p.in[I_CIM]; s5.S5D = p.in[I_S5D]; s5.ST = (float*)(ws + WS_SMALL + SM_S5ST); return s5;
}
__global__ void __launch_bounds__(NWAVES * 64, 2) mk_fwd(Params p) {
    extern __shared__ __attribute__((aligned(16))) unsigned char lds_raw[];
    LAS unsigned char* lds = (LAS unsigned char*)lds_raw;
    volatile LAS unsigned* MISC = (volatile LAS unsigned*)(lds + MISC_OFF);
    const int tid = threadIdx.x, lane = tid & 63, wave = __builtin_amdgcn_readfirstlane(tid >> 6), G = gridDim.x, bid = blockIdx.x;
    gu32* ctl = (gu32*)(p.ws + WS_CTL);
    for (int u = tid; u < (LDS_BYTES - LDSCTL_OFF) / 4; u += NWAVES * 64) ((LAS unsigned*)(lds + LDSCTL_OFF))[u] = 0u;
    __syncthreads();
    XcdBarrier bar; bar.bar = (unsigned*)(ctl + CW_BAR); bar.x = 0; bar.st = nullptr;
    if (p.use_bar) bar = xcd_barrier_post((unsigned*)(ctl + CW_BAR), MISC + 8);
    const int lo = p.ph_lo, hi = p.ph_hi;
#define IN(k) (lo <= (k) && (k) < hi)
#define SEAM(k) do { if ((k) + 1 < hi) xcd_barrier(bar); } while (0)
    if (IN(0)) { phase_prologue(p, lds, bid, G, tid, wave, lane); SEAM(0); }
    if (IN(1)) { phase_rownorm(p, lds, bid, G, tid, wave, lane, 0, 0, M, p.in[I_X], p.in[I_CTX], true); SEAM(1); }
    if (IN(2)) { run_gmix(p, lds, bid, G); SEAM(2); }
    if (IN(3)) { const ScanPtrs sp = make_scanptrs(p); phase_scanA(sp, lds, bid, G, tid); SEAM(3); }
    if (IN(4)) { const ScanPtrs sp = make_scanptrs(p); phase_scanB(sp, bid, G, tid); SEAM(4); }
    if (IN(5)) { const ScanPtrs sp = make_scanptrs(p); phase_scanC(sp, lds, bid, G, tid); SEAM(5); }
    if (IN(6)) { phase_finish(p, lds, bid, G, tid, wave, lane); SEAM(6); }
    if (IN(7)) { run_gout(p, lds, bid, G); SEAM(7); }
    if (IN(8)) { phase_rownorm(p, lds, bid, G, tid, wave, lane, 0, 1, M, p.out, (const float*)(p.ws + WS_HCTX), false); SEAM(8); }
    if (IN(9)) { run_gup(p, lds, bid, G, 0); SEAM(9); }
    if (IN(10)) { run_gdown(p, lds, bid, G, 0); SEAM(10); }
    if (IN(11)) { phase_rownorm(p, lds, bid, G, tid, wave, lane, 1, 0, M, p.out, (const float*)(p.ws + WS_HCTX), false); SEAM(11); }
    if (IN(12)) { run_god(p, lds, bid, G); SEAM(12); }
    if (IN(13)) { const S5Ptrs s5 = make_s5ptrs(p); phase_s5A(s5, lds, bid, G, tid); SEAM(13); }
    if (IN(14)) { const S5Ptrs s5 = make_s5ptrs(p); phase_s5B(s5, bid, G, tid); SEAM(14); }
    if (IN(15)) { const S5Ptrs s5 = make_s5ptrs(p); phase_s5C(s5, lds, bid, G, tid); SEAM(15); }
    if (IN(16)) { run_gvg(p, lds, bid, G); SEAM(16); }
    if (IN(17)) { phase_rownorm(p, lds, bid, G, tid, wave, lane, 1, 1, ML, p.out, (const float*)(p.ws + WS_HCTX), false); SEAM(17); }
    if (IN(18)) { run_gup(p, lds, bid, G, 1); SEAM(18); }
    if (IN(19)) { run_gdown(p, lds, bid, G, 1); SEAM(19); }
    if (IN(20)) { phase_final(p, bid, G, wave, lane); }
#undef IN
#undef SEAM
}

extern "C" void kernel_launch(void* const* d_in, const int* in_sizes, int n_in, void* d_out, int out_size, void* d_ws, size_t ws_size, hipStream_t stream) {
    static int grid = 0;
    if (grid == 0) {
        if (n_in != 33 || out_size != ML * D || ws_size < 256 * MiB) { fprintf(stderr, "kernel_launch: unexpected shapes (n_in %d, out %d, ws %zu); nothing launched\n", n_in, out_size, ws_size); grid = -1; return; }
        int dev = 0, cus = 0, per_cu = 0;
        if (hipGetDevice(&dev) != hipSuccess || hipDeviceGetAttribute(&cus, hipDeviceAttributeMultiprocessorCount, dev) != hipSuccess) { grid = -1; return; }
        if (hipFuncSetAttribute((const void*)mk_fwd, hipFuncAttributeMaxDynamicSharedMemorySize, LDS_BYTES) != hipSuccess) { fprintf(stderr, "kernel_launch: hipFuncSetAttribute failed\n"); grid = -1; return; }
        if (hipOccupancyMaxActiveBlocksPerMultiprocessor(&per_cu, (const void*)mk_fwd, NWAVES * 64, LDS_BYTES) != hipSuccess || per_cu < 1) fprintf(stderr, "kernel_launch: occupancy query reports %d\n", per_cu);
        (void)hipGetLastError();
        grid = cus;
    }
    if (grid < 0) return;
    (void)hipMemsetAsync((char*)d_ws + WS_CTL, 0, CTL_ZERO_BYTES, stream);
    Params a{};
    for (int i = 0; i < 33; ++i) a.in[i] = (const float*)d_in[i];
    a.out = (float*)d_out; a.ws = (unsigned char*)d_ws;
#if MK_N_LAUNCHES == 1
    a.ph_lo = 0; a.ph_hi = N_PHASES; a.use_bar = 1;
    hipLaunchKernelGGL(mk_fwd, dim3(grid), dim3(NWAVES * 64), LDS_BYTES, stream, a);
#else
    for (int ph = 0; ph < N_PHASES; ++ph) { a.ph_lo = ph; a.ph_hi = ph + 1; a.use_bar = 0; hipLaunchKernelGGL(mk_fwd, dim3(grid), dim3(NWAVES * 64), LDS_BYTES, stream, a); }
#endif
}
```

```cpp
#include <hip/hip_runtime.h>
#include <cstdio>
#include <cstdint>

#ifndef MK_N_LAUNCHES
#define MK_N_LAUNCHES 1
#endif
namespace pg8 {
#define PG8_LAS __attribute__((address_space(3)))
typedef unsigned short bf16_t;
typedef short bf16x8 __attribute__((ext_vector_type(8)));
typedef float f32x4 __attribute__((ext_vector_type(4)));
typedef unsigned u32x4 __attribute__((ext_vector_type(4)));
constexpr int BM = 256, BK = 64, HALF = 128, HTB = HALF * BK * 2  , STAGE_BYTES = 8 * HTB, NXCD = 8, WGM = 8;

__host__ __device__ __forceinline__ int lds_byte(int r, int c) { const int st = (r >> 4) * 2 + (c >> 5), rr = r & 15, cc = c & 31, ob = rr * 64 + cc * 2; return st * 1024 + (ob ^ (((ob >> 9) & 1) << 5)); }
__host__ __device__ __forceinline__ void stage_rc(int b, int& R, int& C) { const int st = b / 1024, sb = b % 1024, swz = sb ^ (((sb >> 9) & 1) << 5); R = (st >> 1) * 16 + swz / 64; C = (st & 1) * 32 + (swz % 64) / 2; }
__host__ __device__ __forceinline__ int perm32(int rho) { const int n = rho >> 4, i = rho & 15; return 8 * (i >> 2) + 4 * n + (i & 3); }

struct Unit { int pm, pn; };
struct Gemm { const bf16_t* A; const bf16_t* Bt; int M, N, K; };

struct StaticOrder {
    int nM, nN, nwg, G, c;
    __host__ __device__ void init(int M, int N, int G_, int c_) { nM = M / BM; nN = N / BM; nwg = nM * nN; G = G_; c = c_; }
    __host__ __device__ bool next(int i, Unit& u) const {
        const long L = (long)i * G + c; if (L >= nwg) return false;
        int wgid = (int)L; { const int q = nwg / NXCD, r = nwg % NXCD, xcd = wgid % NXCD, off = wgid / NXCD; wgid = (xcd < r ? xcd * (q + 1) : r * (q + 1) + (xcd - r) * q) + off; }
        const int nig = WGM * nN, gid = wgid / nig, fm = gid * WGM, gsz = (nM - fm) < WGM ? (nM - fm) : WGM;
        u.pm = fm + ((wgid % nig) % gsz); u.pn = (wgid % nig) / gsz; return true;
    }
    __device__ __forceinline__ void a_ready(const Unit&) const {}
    __device__ __forceinline__ void done(const Unit&) const {}
};

__device__ __forceinline__ unsigned cvt_pk_bf16(float lo, float hi) { unsigned r; asm volatile("v_cvt_pk_bf16_f32 %0, %1, %2" : "=v"(r) : "v"(lo), "v"(hi)); return r; }
typedef float f32x2 __attribute__((ext_vector_type(2)));
typedef _Float16 f16x8 __attribute__((ext_vector_type(8)));
__device__ __forceinline__ float siluf(float x) { return x / (1.f + __expf(-x)); }
__device__ __forceinline__ float sigmf(float x) { return 1.f / (1.f + __expf(-x)); }
__device__ __forceinline__ u32x4 pack8_bf16(const float (&x)[8]) { u32x4 w; w.x = cvt_pk_bf16(x[0], x[1]); w.y = cvt_pk_bf16(x[2], x[3]); w.z = cvt_pk_bf16(x[4], x[5]); w.w = cvt_pk_bf16(x[6], x[7]); return w; }
constexpr int EP_ML = 16384;

struct EpiMix1 {
    static constexpr bool PERM = true, AFTER_DRAIN = false;
    bf16_t* ZQ; bf16_t* XBC; bf16_t* V; bf16_t* G; _Float16* Flat; _Float16* Fctx; float* DT; const float* lb; const float* dt_bias; const float* a_log;
    template <int KIND> __device__ __forceinline__ void tile(const f32x4 (&acc)[2][2][4][2], const Unit& u, int wr, int wc, int fr, int fq, int seg_tile) const {
        const int row0 = u.pm * BM + wr * 64 + fr, cw = wc * 32 + 8 * fq;
#pragma unroll
        for (int ai = 0; ai < 2; ++ai)
#pragma unroll
            for (int m = 0; m < 4; ++m) { const int row = row0 + ai * HALF + m * 16;
#pragma unroll
                for (int bj = 0; bj < 2; ++bj) { const f32x4 v0 = acc[ai][bj][m][0], v1 = acc[ai][bj][m][1]; const int c = seg_tile * 256 + bj * HALF + cw;
                    float x[8] = {v0[0], v0[1], v0[2], v0[3], v1[0], v1[1], v1[2], v1[3]};
                    if constexpr (KIND == 0) {
#pragma unroll
                        for (int i = 0; i < 8; ++i) x[i] = siluf(x[i]);
                        *(u32x4*)(ZQ + (size_t)row * 2048 + c) = pack8_bf16(x);
                    } else if constexpr (KIND == 1) {
                        *(u32x4*)(XBC + (size_t)row * 1536 + c) = pack8_bf16(x);
                    } else if constexpr (KIND == 2) {
#pragma unroll
                        for (int i = 0; i < 8; ++i) x[i] = siluf(x[i]);
                        *(u32x4*)(ZQ + (size_t)row * 2048 + 1024 + c) = pack8_bf16(x);
                    } else if constexpr (KIND == 3) {
                        f16x8 h;
#pragma unroll
                        for (int i = 0; i < 8; ++i) { const float l = lb[(c + i) & 1023]; const float f = l + (1.f - l) * sigmf(x[i]); h[i] = (_Float16)__logf(f); }
                        _Float16* dst = (row < EP_ML) ? Flat + (size_t)row * 2048 : Fctx + (size_t)(row - EP_ML) * 2048;
                        *(f16x8*)(dst + c) = h;
                    } else if constexpr (KIND == 4) {
                        *(u32x4*)(V + (size_t)row * 1024 + c) = pack8_bf16(x);
                    } else if constexpr (KIND == 5) {
#pragma unroll
                        for (int i = 0; i < 8; ++i) x[i] = siluf(x[i]);
                        *(u32x4*)(G + (size_t)row * 1024 + c) = pack8_bf16(x);
                    } else {
                        if (bj == 0 && wc == 0) {
                            float dtv[8], la[8];
#pragma unroll
                            for (int i = 0; i < 8; ++i) { const int j = 8 * fq + i; const float r = x[i] + dt_bias[j]; dtv[i] = r > 20.f ? r : log1pf(__expf(r)); la[i] = -dtv[i] * __expf(a_log[j]); }
                            float* d = DT + (size_t)row * 64 + 8 * fq;
                            *(f32x4*)(d) = (f32x4){dtv[0], dtv[1], dtv[2], dtv[3]}; *(f32x4*)(d + 4) = (f32x4){dtv[4], dtv[5], dtv[6], dtv[7]};
                            *(f32x4*)(d + 32) = (f32x4){la[0], la[1], la[2], la[3]}; *(f32x4*)(d + 36) = (f32x4){la[4], la[5], la[6], la[7]};
                        }
                    } } }
    }
    __device__ __forceinline__ void operator()(const f32x4 (&acc)[2][2][4][2], const Unit& u, int wr, int wc, int fr, int fq) const {
        const int pn = u.pn;
        if (pn < 4) tile<0>(acc, u, wr, wc, fr, fq, pn);
        else if (pn < 10) tile<1>(acc, u, wr, wc, fr, fq, pn - 4);
        else if (pn < 14) tile<2>(acc, u, wr, wc, fr, fq, pn - 10);
        else if (pn < 22) tile<3>(acc, u, wr, wc, fr, fq, pn - 14);
        else if (pn < 26) tile<4>(acc, u, wr, wc, fr, fq, pn - 22);
        else if (pn < 30) tile<5>(acc, u, wr, wc, fr, fq, pn - 26);
        else tile<6>(acc, u, wr, wc, fr, fq, 0);
    }
};
struct EpiResid {
    static constexpr bool PERM = false, AFTER_DRAIN = false;
    const float* base_lat; const float* base_ctx; float* out_lat; float* out_ctx; const float* gate_lat; const float* gate_ctx;
    __device__ __forceinline__ void operator()(const f32x4 (&acc)[2][2][4][2], const Unit& u, int wr, int wc, int fr, int fq) const {
        const bool isc = u.pm >= 64; const float* base = isc ? base_ctx : base_lat; float* out = isc ? out_ctx : out_lat; const float* gate = isc ? gate_ctx : gate_lat;
        const int row0 = (isc ? 0 : u.pm * BM) + wr * 64 + fr, col0 = u.pn * BM + wc * 32 + 4 * fq;
        f32x4 gv[2][2];
#pragma unroll
        for (int bj = 0; bj < 2; ++bj)
#pragma unroll
            for (int n = 0; n < 2; ++n) gv[bj][n] = *(const f32x4*)(gate + col0 + bj * HALF + n * 16);
#pragma unroll
        for (int ai = 0; ai < 2; ++ai)
#pragma unroll
            for (int m = 0; m < 4; ++m) { const size_t off = (size_t)(row0 + ai * HALF + m * 16) * 1024 + col0;
#pragma unroll
                for (int bj = 0; bj < 2; ++bj)
#pragma unroll
                    for (int n = 0; n < 2; ++n) { const f32x4 b = *(const f32x4*)(base + off + bj * HALF + n * 16); *(f32x4*)(out + off + bj * HALF + n * 16) = b + gv[bj][n] * acc[ai][bj][m][n]; } }
    }
};
struct EpiSwiglu {
    static constexpr bool PERM = true, AFTER_DRAIN = false;
    bf16_t* HID;
    __device__ __forceinline__ void operator()(const f32x4 (&acc)[2][2][4][2], const Unit& u, int wr, int wc, int fr, int fq) const {
        const int row0 = u.pm * BM + wr * 64 + fr, c = u.pn * HALF + wc * 32 + 8 * fq;
#pragma unroll
        for (int ai = 0; ai < 2; ++ai)
#pragma unroll
            for (int m = 0; m < 4; ++m) { const f32x4 g0 = acc[ai][0][m][0], g1 = acc[ai][0][m][1], u0 = acc[ai][1][m][0], u1 = acc[ai][1][m][1];
                float x[8] = {siluf(g0[0]) * u0[0], siluf(g0[1]) * u0[1], siluf(g0[2]) * u0[2], siluf(g0[3]) * u0[3], siluf(g1[0]) * u1[0], siluf(g1[1]) * u1[1], siluf(g1[2]) * u1[2], siluf(g1[3]) * u1[3]};
                *(u32x4*)(HID + (size_t)(row0 + ai * HALF + m * 16) * 2816 + c) = pack8_bf16(x); }
    }
};
struct EpiU {
    static constexpr bool PERM = false, AFTER_DRAIN = false;
    float* U;
    __device__ __forceinline__ void operator()(const f32x4 (&acc)[2][2][4][2], const Unit& u, int wr, int wc, int fr, int fq) const {
        const int row0 = u.pm * BM + wr * 64 + fr, col0 = u.pn * BM + wc * 32 + 4 * fq;
#pragma unroll
        for (int ai = 0; ai < 2; ++ai)
#pragma unroll
            for (int m = 0; m < 4; ++m) { const int row = row0 + ai * HALF + m * 16; const int srow = row < EP_ML ? (row & 63) * 256 + (row >> 6) : row;
#pragma unroll
                for (int bj = 0; bj < 2; ++bj)
#pragma unroll
                    for (int n = 0; n < 2; ++n) *(f32x4*)(U + (size_t)srow * 512 + col0 + bj * HALF + n * 16) = acc[ai][bj][m][n]; }
    }
};
struct EpiValGate {
    static constexpr bool PERM = false, AFTER_DRAIN = false;
    float* H; const float* gate;
    __device__ __forceinline__ void operator()(const f32x4 (&acc)[2][2][4][2], const Unit& u, int wr, int wc, int fr, int fq) const {
        const int row0 = u.pm * BM + wr * 64 + fr, col0 = u.pn * HALF + wc * 32 + 4 * fq;
#pragma unroll
        for (int ai = 0; ai < 2; ++ai)
#pragma unroll
            for (int m = 0; m < 4; ++m) { float* hp = H + (size_t)(row0 + ai * HALF + m * 16) * 1024 + col0;
#pragma unroll
                for (int n = 0; n < 2; ++n) { const f32x4 v = acc[ai][0][m][n], g = acc[ai][1][m][n]; const f32x4 gm = *(const f32x4*)(gate + col0 + n * 16); f32x4 h = *(const f32x4*)(hp + n * 16);
                    h[0] += gm[0] * v[0] * sigmf(g[0]); h[1] += gm[1] * v[1] * sigmf(g[1]); h[2] += gm[2] * v[2] * sigmf(g[2]); h[3] += gm[3] * v[3] * sigmf(g[3]); *(f32x4*)(hp + n * 16) = h; } }
    }
};
template <class Epi, class Sched, bool ALIGN_EPI = false, bool SP2 = false>
__device__ __forceinline__ void gemm_phase(PG8_LAS unsigned char* lds, const Gemm g, const Sched& S, const Epi& E) {
    const int tid = threadIdx.x, wid = __builtin_amdgcn_readfirstlane(tid >> 6), lane = tid & 63, wr = wid >> 2, wc = wid & 3, fr = lane & 15, fq = lane >> 4;
    const int K = g.K, nt = K / BK;
    unsigned voffA[2], voffB[2];
#pragma unroll
    for (int i = 0; i < 2; ++i) { int R, C; stage_rc(tid * 16 + i * 8192, R, C); const int Rb = Epi::PERM ? ((R & ~31) + perm32(R & 31)) : R;
        voffA[i] = (unsigned)(R * K + C) * 2u; voffB[i] = (unsigned)(Rb * K + C) * 2u; }
    const size_t kstep = (size_t)(BK * 2);
    const size_t hstep = (size_t)HALF * K * 2;
    const size_t tstep = 2 * hstep;
    const unsigned ldsw = (unsigned)wid * 1024u;
    const int aoff = lds_byte(wr * 64 + fr, fq * 8), boff = lds_byte(wc * 32 + fr, fq * 8);
#define PG8_SA(b, h) (((b) * 2 + (h)) * HTB)
#define PG8_SB(b, h) ((4 + (b) * 2 + (h)) * HTB)
#define PG8_STAGE(bufoff, gbase, voff) do { _Pragma("unroll") for (int _i = 0; _i < 2; ++_i) \
        __builtin_amdgcn_global_load_lds((const unsigned*)((const char*)(gbase) + (voff)[_i]), (PG8_LAS unsigned*)(lds + (bufoff) + ldsw + _i * 8192), 16, 0, 0); } while (0)
#define PG8_LDA(dst, b, h) do { _Pragma("unroll") for (int m = 0; m < 4; ++m) _Pragma("unroll") for (int k = 0; k < 2; ++k) dst[m][k] = *(const PG8_LAS bf16x8*)(lds + PG8_SA(b, h) + aoff + m * 2048 + k * 1024); } while (0)
#define PG8_LDB(dst, b, h) do { _Pragma("unroll") for (int n = 0; n < 2; ++n) _Pragma("unroll") for (int k = 0; k < 2; ++k) dst[n][k] = *(const PG8_LAS bf16x8*)(lds + PG8_SB(b, h) + boff + n * 2048 + k * 1024); } while (0)
#define PG8_MMA(ai, bj, At, Bt) do { __builtin_amdgcn_s_setprio(1); _Pragma("unroll") for (int m = 0; m < 4; ++m) _Pragma("unroll") for (int n = 0; n < 2; ++n) _Pragma("unroll") for (int k = 0; k < 2; ++k) \
        acc[ai][bj][m][n] = __builtin_amdgcn_mfma_f32_16x16x32_bf16(Bt[n][k], At[m][k], acc[ai][bj][m][n], 0, 0, 0); __builtin_amdgcn_s_setprio(0); } while (0)
#define PG8_WAIT_V(n) asm volatile("s_waitcnt vmcnt(" #n ")" ::: "memory")
#define PG8_WAIT_L(n) asm volatile("s_waitcnt lgkmcnt(" #n ")" ::: "memory")
#define PG8_BAR __builtin_amdgcn_s_barrier()
#define PG8_SCHED __builtin_amdgcn_sched_barrier(0)
    Unit cur, nxt; int ui = 0;
    if (!S.next(0, cur)) return;
    f32x4 acc[2][2][4][2];
#pragma unroll
    for (int a = 0; a < 2; ++a)
#pragma unroll
        for (int b = 0; b < 2; ++b)
#pragma unroll
            for (int m = 0; m < 4; ++m)
#pragma unroll
                for (int n = 0; n < 2; ++n) acc[a][b][m][n] = (f32x4){0.f, 0.f, 0.f, 0.f};
    bf16x8 At[4][2], B0[2][2], B1[2][2];
    const char* cA = (const char*)g.A + (size_t)cur.pm * tstep; const char* cB = (const char*)g.Bt + (size_t)cur.pn * tstep;
    S.a_ready(cur);
    if constexpr (SP2) {
        PG8_STAGE(PG8_SB(0, 0), cB, voffB); PG8_STAGE(PG8_SB(0, 1), cB + hstep, voffB); PG8_STAGE(PG8_SA(0, 0), cA, voffA); PG8_STAGE(PG8_SA(0, 1), cA + hstep, voffA);
        if (wr == 1) PG8_BAR;
        PG8_WAIT_V(2); PG8_BAR;
        PG8_STAGE(PG8_SB(1, 0), cB + kstep, voffB); PG8_STAGE(PG8_SA(1, 0), cA + kstep, voffA); PG8_STAGE(PG8_SB(1, 1), cB + hstep + kstep, voffB);
        PG8_WAIT_V(6); PG8_BAR;
    } else {
        PG8_STAGE(PG8_SB(0, 0), cB, voffB); PG8_STAGE(PG8_SA(0, 0), cA, voffA); PG8_STAGE(PG8_SB(0, 1), cB + hstep, voffB); PG8_STAGE(PG8_SA(0, 1), cA + hstep, voffA);
        if (wr == 1) PG8_BAR;
        PG8_WAIT_V(4); PG8_BAR;
        PG8_STAGE(PG8_SB(1, 0), cB + kstep, voffB); PG8_STAGE(PG8_SA(1, 0), cA + kstep, voffA); PG8_STAGE(PG8_SB(1, 1), cB + hstep + kstep, voffB);
        PG8_WAIT_V(6); PG8_BAR;
    }
    for (;;) {
        const bool has_next = S.next(ui + 1, nxt);
        const char* nA = has_next ? (const char*)g.A + (size_t)nxt.pm * tstep : cA; const char* nB = has_next ? (const char*)g.Bt + (size_t)nxt.pn * tstep : cB;
        for (int t = 0; t < nt; t += 2) {
            const bool last = (t == nt - 2);
            const char* a1 = cA + (size_t)(t + 1) * kstep;
            const char* a2 = last ? nA : cA + (size_t)(t + 2) * kstep; const char* b2 = last ? nB : cB + (size_t)(t + 2) * kstep;
            const char* a3 = a2 + kstep; const char* b3 = b2 + kstep;
            if (last && has_next) S.a_ready(nxt);
            if constexpr (SP2) {
            PG8_LDB(B0, 0, 0); PG8_LDB(B1, 0, 1); PG8_SCHED; PG8_LDA(At, 0, 0); PG8_STAGE(PG8_SA(1, 1), a1 + hstep, voffA);
            PG8_WAIT_V(8); PG8_WAIT_L(0); PG8_BAR; PG8_MMA(0, 0, At, B0); PG8_MMA(0, 1, At, B1); PG8_BAR; PG8_SCHED;
            PG8_LDA(At, 0, 1); PG8_STAGE(PG8_SB(0, 0), b2, voffB); PG8_STAGE(PG8_SB(0, 1), b2 + hstep, voffB); PG8_STAGE(PG8_SA(0, 0), a2, voffA);
            PG8_WAIT_V(8); PG8_WAIT_L(0); PG8_BAR; PG8_MMA(1, 0, At, B0); PG8_MMA(1, 1, At, B1); PG8_BAR; PG8_SCHED;
            PG8_LDB(B0, 1, 0); PG8_LDB(B1, 1, 1); PG8_SCHED; PG8_LDA(At, 1, 0); PG8_STAGE(PG8_SA(0, 1), a2 + hstep, voffA);
            PG8_WAIT_V(8); PG8_WAIT_L(0); PG8_BAR; PG8_MMA(0, 0, At, B0); PG8_MMA(0, 1, At, B1); PG8_BAR; PG8_SCHED;
            PG8_LDA(At, 1, 1); PG8_STAGE(PG8_SB(1, 0), b3, voffB); PG8_STAGE(PG8_SB(1, 1), b3 + hstep, voffB); PG8_STAGE(PG8_SA(1, 0), a3, voffA);
            PG8_WAIT_V(8); PG8_WAIT_L(0); PG8_BAR; PG8_MMA(1, 0, At, B0); PG8_MMA(1, 1, At, B1); PG8_BAR; PG8_SCHED;
            } else {
            PG8_LDB(B0, 0, 0); PG8_SCHED; PG8_LDA(At, 0, 0); PG8_STAGE(PG8_SA(1, 1), a1 + hstep, voffA);
            PG8_WAIT_L(8); PG8_BAR; PG8_WAIT_L(0); PG8_MMA(0, 0, At, B0); PG8_BAR; PG8_SCHED;
            PG8_LDB(B1, 0, 1); PG8_STAGE(PG8_SB(0, 0), b2, voffB);
            PG8_BAR; PG8_WAIT_L(0); PG8_MMA(0, 1, At, B1); PG8_BAR;
            PG8_LDA(At, 0, 1); PG8_STAGE(PG8_SA(0, 0), a2, voffA);
            PG8_BAR; PG8_WAIT_L(0); PG8_MMA(1, 0, At, B0); PG8_BAR; PG8_SCHED;
            PG8_STAGE(PG8_SB(0, 1), b2 + hstep, voffB);
            PG8_WAIT_V(6); PG8_BAR; PG8_MMA(1, 1, At, B1); PG8_BAR;
            PG8_LDB(B0, 1, 0); PG8_SCHED; PG8_LDA(At, 1, 0); PG8_STAGE(PG8_SA(0, 1), a2 + hstep, voffA);
            PG8_WAIT_L(8); PG8_BAR; PG8_WAIT_L(0); PG8_MMA(0, 0, At, B0); PG8_BAR; PG8_SCHED;
            PG8_LDB(B1, 1, 1); PG8_STAGE(PG8_SB(1, 0), b3, voffB);
            PG8_BAR; PG8_WAIT_L(0); PG8_MMA(0, 1, At, B1); PG8_BAR;
            PG8_LDA(At, 1, 1); PG8_STAGE(PG8_SA(1, 0), a3, voffA);
            PG8_BAR; PG8_WAIT_L(0); PG8_MMA(1, 0, At, B0); PG8_BAR; PG8_SCHED;
            PG8_STAGE(PG8_SB(1, 1), b3 + hstep, voffB);
            PG8_WAIT_V(6); PG8_BAR; PG8_MMA(1, 1, At, B1); PG8_BAR;
            }
        }
        if constexpr (ALIGN_EPI) { if (wr == 0) PG8_BAR; }
        if constexpr (!Epi::AFTER_DRAIN) { E(acc, cur, wr, wc, fr, fq); S.done(cur); }
        if (!has_next) break;
#pragma unroll
        for (int a = 0; a < 2; ++a)
#pragma unroll
            for (int b = 0; b < 2; ++b)
#pragma unroll
                for (int m = 0; m < 4; ++m)
#pragma unroll
                    for (int n = 0; n < 2; ++n) acc[a][b][m][n] = (f32x4){0.f, 0.f, 0.f, 0.f};
        cur = nxt; cA = nA; cB = nB; ++ui;
        if constexpr (ALIGN_EPI) { if (wr == 1) PG8_BAR; }
    }
    PG8_WAIT_V(0);
    if constexpr (!ALIGN_EPI) { if (wr == 0) PG8_BAR; }
    PG8_BAR;
    if constexpr (Epi::AFTER_DRAIN) { E.fused(acc, cur, wr, wc, fr, fq, lds, wid, lane); S.done(cur); }
#undef PG8_SA
#undef PG8_SB
#undef PG8_STAGE
#undef PG8_LDA
#undef PG8_LDB
#undef PG8_MMA
#undef PG8_WAIT_V
#undef PG8_WAIT_L
#undef PG8_BAR
#undef PG8_SCHED
}
}
#define GAS __attribute__((address_space(1)))
#define LAS __attribute__((address_space(3)))
typedef unsigned short bf16;
typedef unsigned v4u __attribute__((ext_vector_type(4)));
typedef float f32x4 __attribute__((ext_vector_type(4)));
typedef short bf16x8 __attribute__((ext_vector_type(8)));
typedef GAS unsigned gu32;
typedef GAS unsigned long long gu64;
#define RLX_AGENT __ATOMIC_RELAXED, __HIP_MEMORY_SCOPE_AGENT
#define LDS_WAIT() asm volatile("s_waitcnt lgkmcnt(0)" ::: "memory")
#define VM_WAIT() asm volatile("s_waitcnt vmcnt(0)" ::: "memory")
__device__ __forceinline__ unsigned long long rt() { return __builtin_amdgcn_s_memrealtime(); }
__device__ __forceinline__ unsigned f2bf(float f) { unsigned u = __builtin_bit_cast(unsigned, f); return (u + 0x7fffu + ((u >> 16) & 1u)) >> 16; }
__device__ __forceinline__ unsigned pk2(float lo, float hi) { return f2bf(lo) | (f2bf(hi) << 16); }

#define XB_TMO      128
#define XB_XCNT(j)  (256  + 64 * (j))
#define XB_XSUB(j)  (1280 + 64 * (j))
#define XB_XGEN(j)  (2304 + 64 * (j))
#define XB_TOP      3328
#define XB_TOPGEN   3392
#define XCD_BAR_WORDS 3456
#define XB_SPIN_CAP (1u << 18)

__device__ __forceinline__ unsigned xb_ld(unsigned* p)              { return __hip_atomic_load(p, __ATOMIC_RELAXED, __HIP_MEMORY_SCOPE_AGENT); }
__device__ __forceinline__ unsigned xb_add(unsigned* p, unsigned v) { return __hip_atomic_fetch_add(p, v, __ATOMIC_RELAXED, __HIP_MEMORY_SCOPE_AGENT); }
__device__ __forceinline__ unsigned xb_xcc_id() { return (unsigned)__builtin_amdgcn_s_getreg((3 << 11) | 20) & 0xFu; }
#define XB_SPIN(cond, bar) do { unsigned _sp = 0; while (cond) { __builtin_amdgcn_s_sleep(1); \
    if ((++_sp & 255u) == 0u) { if (xb_ld(&(bar)[XB_TMO])) break; if (_sp > XB_SPIN_CAP) { atomicAdd(&(bar)[XB_TMO], 1u); break; } } } } while (0)

struct XcdBarrier {
    unsigned* bar; unsigned x;
    volatile LAS unsigned* st;
};

__device__ __forceinline__ XcdBarrier xcd_barrier_post(unsigned* bar, volatile LAS unsigned* st) {
    XcdBarrier b; b.bar = bar; b.x = xb_xcc_id(); b.st = st;
    if (threadIdx.x == 0) (void)xb_add(&bar[XB_XCNT(b.x)], 1u);
    return b;
}
__device__ __forceinline__ void xcd_barrier_complete(unsigned* bar, unsigned x, unsigned& nloc, unsigned& nx) {
    const unsigned G = gridDim.x * gridDim.y * gridDim.z;
    unsigned sum, cnt, mine, sp = 0u;
    for (;;) {
        sum = 0u; cnt = 0u; mine = 0u;
#pragma unroll
        for (unsigned j = 0; j < 16; ++j) { const unsigned c = xb_ld(&bar[XB_XCNT(j)]); sum += c; cnt += (c > 0u) ? 1u : 0u; mine = (j == x) ? c : mine; }
        if (sum == G) break;
        __builtin_amdgcn_s_sleep(1);
        if ((++sp & 255u) == 0u) { if (xb_ld(&bar[XB_TMO])) break; if (sp > XB_SPIN_CAP) { atomicAdd(&bar[XB_TMO], 1u); break; } }
    }
    nloc = mine > 0u ? mine : 1u; nx = cnt > 0u ? cnt : 1u;
}

__device__ __forceinline__ void xcd_barrier(const XcdBarrier& b) {
    asm volatile("s_waitcnt vmcnt(0)" ::: "memory");
    __syncthreads();
    if (threadIdx.x == 0) {
        unsigned* bar = b.bar;
        __builtin_amdgcn_s_waitcnt(0);
        unsigned nloc = b.st[0], nx = b.st[1];
        if (nloc == 0u) { xcd_barrier_complete(bar, b.x, nloc, nx); b.st[0] = nloc; b.st[1] = nx; }
        const unsigned old = xb_add(&bar[XB_XSUB(b.x)], 1u);
        const unsigned gen = old / nloc;
        if (old + 1u == (gen + 1u) * nloc) {
            __builtin_amdgcn_fence(__ATOMIC_RELEASE, "agent");
            asm volatile("s_waitcnt vmcnt(0)" ::: "memory");
            const unsigned og = xb_add(&bar[XB_TOP], 1u);
            const unsigned tg = og / nx;
            if (og + 1u == (tg + 1u) * nx) xb_add(&bar[XB_TOPGEN], 1u);
            else XB_SPIN(xb_ld(&bar[XB_TOPGEN]) == tg, bar);
            __builtin_amdgcn_fence(__ATOMIC_ACQUIRE, "agent");
            xb_add(&bar[XB_XGEN(b.x)], 1u);
            asm volatile("s_waitcnt vmcnt(0)" ::: "memory");
        } else {
            XB_SPIN(xb_ld(&bar[XB_XGEN(b.x)]) == gen, bar);
            __builtin_amdgcn_fence(__ATOMIC_ACQUIRE, "agent");
            asm volatile("s_waitcnt vmcnt(0)" ::: "memory");
        }
    }
    __syncthreads();
}


constexpr int NWAVES = 8;
constexpr int D = 1024, ML = 16384, MC = 256, M = ML + MC, DFF = 2816;
constexpr int NIN = 7712, NINP = 7936;
constexpr int NSC = 32, SCL = 512;
constexpr float EPS = 1e-6f;
static_assert(pg8::EP_ML == ML, "epilogue constant");

constexpr size_t MiB = 1u << 20, KiB = 1024;
constexpr size_t WS_CTL = 0, CTL_ZERO_BYTES = 1 * MiB;
constexpr size_t WS_SMALL = 1 * MiB;
constexpr size_t WS_HCTX = 9 * MiB;
constexpr size_t WS_FCTX = 10 * MiB;
constexpr size_t WS_RX = 11 * MiB;
constexpr size_t WS_ZQ = 44 * MiB;
constexpr size_t WS_XBC = 109 * MiB;
constexpr size_t WS_V = WS_XBC + (size_t)M * 1536 * 2;
constexpr size_t WS_G = WS_V + (size_t)M * 1024 * 2;
constexpr size_t WS_DT = WS_G + (size_t)M * 1024 * 2;
constexpr size_t WS_WIN = 227 * MiB;
static_assert(WS_DT + (size_t)M * 64 * 4 <= WS_WIN && WS_WIN + (size_t)NINP * 1024 * 2 <= 256 * MiB, "ws map (mixer phase)");
constexpr size_t WS_WREST = 216 * MiB;
constexpr size_t WO_OUT = 0, WO_UP0 = 4 * MiB, WO_DOWN0 = 15 * MiB, WO_OD = WO_DOWN0 + (size_t)DFF * 1024 * 2, WO_VG = WO_OD + 1 * MiB, WO_UP1 = WO_VG + 2 * MiB, WO_DOWN1 = WO_UP1 + 11 * MiB;
static_assert(WO_DOWN1 + (size_t)DFF * 1024 * 2 <= 40 * MiB, "weights overlay");
constexpr size_t WS_HID = WS_XBC;
static_assert(WS_HID + (size_t)M * DFF * 2 <= WS_WREST, "hidden overlay");
constexpr size_t WS_U = WS_ZQ;
constexpr size_t WS_A2 = WS_U + (size_t)M * 512 * 4;
static_assert(WS_A2 + (size_t)ML * 512 * 2 <= WS_XBC, "layer-1 overlay");
constexpr size_t WS_YS = WS_XBC;
constexpr size_t SM_ADAP = 0;
constexpr size_t SM_MODS = SM_ADAP + 2 * 2 * 8 * 6144 * 4;
constexpr size_t SM_LB = SM_MODS + 2 * 2 * 6144 * 4;
constexpr size_t SM_LAM = SM_LB + 4096;
constexpr size_t SM_LAMP = SM_LAM + 2 * 2048 * 2 * 4;
constexpr size_t SM_BB = SM_LAMP + 2 * 2048 * 2 * 4;
constexpr size_t SM_STATS = SM_BB + 2 * 2048 * 16 * 2 * 4;
constexpr size_t SM_SSDDEC = SM_STATS + (size_t)M * 16 * 4;
constexpr size_t SM_HGDEC = SM_SSDDEC + 33 * 32 * 4 + 128;
constexpr size_t SM_S5ST = ((SM_HGDEC + 33 * 16 * 128 * 4 + 255) / 256) * 256;
static_assert(SM_S5ST + 65 * 2 * 2048 * 2 * 4 <= 8 * MiB, "small tables");
constexpr size_t SSD_ST_BYTES = (size_t)33 * 32 * 8192 * 2;
static_assert(2 * SSD_ST_BYTES <= 33 * MiB && (size_t)M * 1024 * 2 <= 33 * MiB, "RX region");
constexpr int CW_BAR = 4096;

constexpr int RING_OFF = 0, RING_BYTES = 131072;
constexpr int LDSCTL_OFF = RING_BYTES, MISC_OFF = LDSCTL_OFF + 320;
constexpr int LDS_BYTES = 147456;


struct Params { const float* in[33]; float* out; unsigned char* ws; int ph_lo, ph_hi, use_bar, pad; };
enum { I_X = 0, I_C, I_CTX, I_CCTX, I_ADAW, I_ADAB, I_NMIX, I_NFFN, I_WGATE, I_WUP, I_WDOWN, I_FNORM, I_EVIN, I_EVOUT, I_CONVW, I_CONVB, I_DTB, I_ALOG, I_SSDD, I_SSDN, I_LBL, I_HGN,
       I_ODIN, I_ARE, I_AIM, I_LOGDT, I_BRE, I_BIM, I_CRE, I_CIM, I_S5D, I_WVAL, I_WGATE2 };
typedef _Float16 f16x8 __attribute__((ext_vector_type(8)));
typedef _Float16 f16;
typedef _Float16 f16x2 __attribute__((ext_vector_type(2)));
typedef float f32x2 __attribute__((ext_vector_type(2)));
__device__ __forceinline__ float bf2f(unsigned b) { return __uint_as_float(b << 16); }
__device__ __forceinline__ float siluf(float x) { return x / (1.f + __expf(-x)); }
__device__ __forceinline__ float wave_sum(float v) {
#pragma unroll
    for (int o = 1; o < 64; o <<= 1) v += __shfl_xor(v, o);
    return v;
}
__device__ __forceinline__ void unpack8(const v4u r, float (&x)[8]) {
    x[0] = bf2f(r.x & 0xffffu); x[1] = bf2f(r.x >> 16); x[2] = bf2f(r.y & 0xffffu); x[3] = bf2f(r.y >> 16);
    x[4] = bf2f(r.z & 0xffffu); x[5] = bf2f(r.z >> 16); x[6] = bf2f(r.w & 0xffffu); x[7] = bf2f(r.w >> 16);
}
__device__ __forceinline__ void tr_item(const float* W, int ldw, int col0, int K, bf16* WT, int dst_row0, LAS float* scr, int kb, int lane) {
    const int k0 = 64 * kb;
#pragma unroll 8
    for (int i = 0; i < 32; ++i) { const int kk = 2 * i + (lane >> 5); scr[kk * 33 + (lane & 31)] = W[(size_t)(k0 + kk) * ldw + col0 + (lane & 31)]; }
    LDS_WAIT(); asm volatile("" ::: "memory");
    const int c = lane & 7;
#pragma unroll
    for (int j = 0; j < 4; ++j) { const int n = (lane >> 3) + 8 * j; const LAS float* s = scr + (8 * c) * 33 + n;
        v4u o; o.x = pk2(s[0 * 33], s[1 * 33]); o.y = pk2(s[2 * 33], s[3 * 33]); o.z = pk2(s[4 * 33], s[5 * 33]); o.w = pk2(s[6 * 33], s[7 * 33]);
        *(GAS v4u*)(WT + (size_t)(dst_row0 + n) * K + k0 + 8 * c) = o; }
    LDS_WAIT(); asm volatile("" ::: "memory");
}
__device__ __forceinline__ int dst_row_of(int mode, int c0) {
    if (mode == 0) return c0 < 2560 ? c0 : (c0 < 2592 ? 7680 + (c0 - 2560) : c0 - 32);
    if (mode == 1) return c0;
    return (c0 >> 7) * 256 + (mode == 3 ? 128 : 0) + (c0 & 127);
}
__device__ __forceinline__ void tr_job(const float* W, int K, int N, int mode, bf16* WT, LAS float* scr, int gw, int ngw, int lane) {
    const int nblk = N / 32, nit = (K / 64) * nblk;
    for (int it = gw; it < nit; it += ngw) { const int kb = it / nblk, nb = it % nblk; tr_item(W, N, 32 * nb, K, WT, dst_row_of(mode, 32 * nb), scr, kb, lane); }
}

__device__ __forceinline__ void phase_prologue(const Params& p, LAS unsigned char* lds, int bid, int G, int tid, int wave, int lane) {
    unsigned char* ws = p.ws; float* sm_adap = (float*)(ws + WS_SMALL + SM_ADAP);
    for (int it = bid; it < 192; it += G) {
        const int layer = it / 96, rem = it % 96, cb = rem / 8, ks = rem % 8;
        LAS float* sl = (LAS float*)lds; LAS float* sc = sl + 128;
        if (tid < 128) { sl[tid] = siluf(p.in[I_C][ks * 128 + tid]); sc[tid] = siluf(p.in[I_CCTX][ks * 128 + tid]); }
        __syncthreads();
        const int col = cb * 512 + tid; const float* W = p.in[I_ADAW] + (size_t)layer * 1024 * 6144 + (size_t)(ks * 128) * 6144 + col;
        float a0 = 0.f, a1 = 0.f;
#pragma unroll 8
        for (int k = 0; k < 128; ++k) { const float w = W[(size_t)k * 6144]; a0 += sl[k] * w; a1 += sc[k] * w; }
        sm_adap[((layer * 2 + 0) * 8 + ks) * 6144 + col] = a0; sm_adap[((layer * 2 + 1) * 8 + ks) * 6144 + col] = a1;
        __syncthreads();
    }
    const int gw = bid * NWAVES + wave, ngw = G * NWAVES;
    LAS float* scr = (LAS float*)(lds + wave * 16384);
    bf16* win = (bf16*)(ws + WS_WIN);
    tr_job(p.in[I_EVIN], 1024, NIN, 0, win, scr, gw, ngw, lane);
    { const int gt = bid * 512 + tid, nt = G * 512; v4u z = {0u, 0u, 0u, 0u};
      for (int i = gt; i < (NINP - NIN) * 1024 / 8; i += nt) *(GAS v4u*)(win + (size_t)NIN * 1024 + (size_t)i * 8) = z; }
    const int gt = bid * 512 + tid;
    if (gt < 1024) { const float l0 = p.in[I_LBL][gt], l1 = p.in[I_LBL][1024 + gt]; const float mx = fmaxf(l0, l1), e0 = __expf(l0 - mx), e1 = __expf(l1 - mx); ((float*)(ws + WS_SMALL + SM_LB))[gt] = e0 / (e0 + e1); }
    if (gt >= 4096 && gt < 8192) {
        const int s = gt - 4096, dg = s >> 6;
        const float dt = expf(p.in[I_LOGDT][dg]), are = p.in[I_ARE][s], aim = p.in[I_AIM][s];
        const float mag = expf(are * dt); float sn, cs; sincosf(aim * dt, &sn, &cs);
        const float lr = mag * cs, li = mag * sn, den = are * are + aim * aim;
        const float cr = ((lr - 1.f) * are + li * aim) / den, ci = (li * are - (lr - 1.f) * aim) / den;
        float* lam = (float*)(ws + WS_SMALL + SM_LAM); lam[2 * s] = lr; lam[2 * s + 1] = li;
        float pr = lr, pi = li;
#pragma unroll
        for (int q = 0; q < 8; ++q) { const float nr = pr * pr - pi * pi, ni = 2.f * pr * pi; pr = nr; pi = ni; }
        float* lamp = (float*)(ws + WS_SMALL + SM_LAMP); lamp[2 * s] = pr; lamp[2 * s + 1] = pi;
        float* bb = (float*)(ws + WS_SMALL + SM_BB) + (size_t)s * 32;
#pragma unroll
        for (int c = 0; c < 16; ++c) { const float br = p.in[I_BRE][(size_t)s * 16 + c], bi = p.in[I_BIM][(size_t)s * 16 + c]; bb[2 * c] = cr * br - ci * bi; bb[2 * c + 1] = cr * bi + ci * br; }
    }
}

__device__ __forceinline__ void phase_rownorm(const Params& p, LAS unsigned char* lds, int bid, int G, int tid, int wave, int lane, int layer, int kind  , int nrows,
                                              const float* src_lat, const float* src_ctx, bool from_partials) {
    unsigned char* ws = p.ws; const float* adap = (const float*)(ws + WS_SMALL + SM_ADAP); float* mods = (float*)(ws + WS_SMALL + SM_MODS);
    LAS float* Gt = (LAS float*)lds; LAS float* St = Gt + 2048;
    const float* ng = p.in[kind == 0 ? I_NMIX : I_NFFN] + layer * 1024;
    for (int idx = tid; idx < 4096; idx += 512) {
        const int vec = idx >> 11, which = (idx >> 10) & 1, col = idx & 1023, j = (kind * 3 + which) * 1024 + col;
        float v;
        if (from_partials) { v = p.in[I_ADAB][layer * 6144 + j];
#pragma unroll
            for (int ks = 0; ks < 8; ++ks) v += adap[((layer * 2 + vec) * 8 + ks) * 6144 + j]; }
        else v = mods[(layer * 2 + vec) * 6144 + j];
        if (which == 0) St[vec * 1024 + col] = v; else Gt[vec * 1024 + col] = ng[col] * (1.f + v);
    }
    if (from_partials && bid < 48) {
        const int idx = bid * 512 + tid, lv = idx / 6144, j = idx % 6144, ly = lv >> 1;
        float v = p.in[I_ADAB][ly * 6144 + j];
#pragma unroll
        for (int ks = 0; ks < 8; ++ks) v += adap[(lv * 8 + ks) * 6144 + j];
        mods[idx] = v;
    }
    __syncthreads();
    bf16* XN = (bf16*)(ws + WS_RX);
    const int gw = bid * NWAVES + wave, ngw = G * NWAVES;
    for (int row = gw; row < nrows; row += ngw) {
        const int vec = row >= ML ? 1 : 0; const float* xr = vec ? src_ctx + (size_t)(row - ML) * 1024 : src_lat + (size_t)row * 1024;
        f32x4 v[4]; float ss = 0.f;
#pragma unroll
        for (int j = 0; j < 4; ++j) { v[j] = *(const GAS f32x4*)(xr + 4 * lane + 256 * j); ss += (v[j].x * v[j].x + v[j].y * v[j].y) + (v[j].z * v[j].z + v[j].w * v[j].w); }
        const float r = rsqrtf(wave_sum(ss) * (1.f / 1024.f) + EPS);
#pragma unroll
        for (int j = 0; j < 4; ++j) { const int c = 4 * lane + 256 * j; const LAS float* g4 = Gt + vec * 1024 + c; const LAS float* s4 = St + vec * 1024 + c;
            const unsigned lo = pk2(v[j].x * r * g4[0] + s4[0], v[j].y * r * g4[1] + s4[1]), hi = pk2(v[j].z * r * g4[2] + s4[2], v[j].w * r * g4[3] + s4[3]);
            *(GAS unsigned long long*)(XN + (size_t)row * 1024 + c) = (unsigned long long)lo | ((unsigned long long)hi << 32); }
    }
}

struct ScanPtrs { const bf16* XBC; const float* DT; bf16* ZQ; const bf16* V; const bf16* G; f16* Flat; f16* Fctx; float* STATS; const float* convw; const float* convb; const float* ssdd; const float* hgn;
                  bf16* SSD_ST; bf16* HG_ST; float* SSD_DEC; float* HG_DEC; };
template <int MODE>
__device__ __forceinline__ void ssd_dir(const ScanPtrs& sp, LAS unsigned char* lds, int row_begin, int nrows, int seq_lo, int seq_hi, int h, int d, float (&st)[16], float& logsum, int tid) {
    LAS float* xs = (LAS float*)lds; LAS float* Bs = (LAS float*)(lds + 8192); LAS float* Cs = (LAS float*)(lds + 24576);
    LAS float* av = (LAS float*)(lds + 40960); LAS float* dtv = (LAS float*)(lds + 41088); LAS float* yb = (LAS float*)(lds + 41472);
    LAS unsigned short* YF = (LAS unsigned short*)(lds + 65536);
    const int p = tid >> 3, nq = tid & 7, g = h >> 3, nblk = nrows >> 5;
    const float dsk = sp.ssdd[h];
    for (int blk = 0; blk < nblk; ++blk) {
        const int r0 = d == 0 ? row_begin + 32 * blk : row_begin + nrows - 32 * (blk + 1);
        for (int w = tid; w < 1280; w += 512) {
            int t, col; LAS float* dst;
            if (w < 256) { t = w >> 3; const int o = w & 7; col = h * 64 + o * 8; dst = xs + t * 64 + o * 8; }
            else if (w < 768) { const int w2 = w - 256; t = w2 >> 4; const int o = w2 & 15; col = 1024 + g * 128 + o * 8; dst = Bs + t * 128 + o * 8; }
            else { const int w2 = w - 768; t = w2 >> 4; const int o = w2 & 15; col = 1280 + g * 128 + o * 8; dst = Cs + t * 128 + o * 8; }
            float a8[8];
            { const f32x4 b0 = *(const GAS f32x4*)(sp.convb + col), b1 = *(const GAS f32x4*)(sp.convb + col + 4); a8[0] = b0.x; a8[1] = b0.y; a8[2] = b0.z; a8[3] = b0.w; a8[4] = b1.x; a8[5] = b1.y; a8[6] = b1.z; a8[7] = b1.w; }
#pragma unroll
            for (int j = 0; j < 5; ++j) { const int rr = r0 + t + j - 2;
                if (rr >= seq_lo && rr < seq_hi) { float x8[8]; unpack8(*(const GAS v4u*)(sp.XBC + (size_t)rr * 1536 + col), x8);
                    const f32x4 w0 = *(const GAS f32x4*)(sp.convw + j * 1536 + col), w1 = *(const GAS f32x4*)(sp.convw + j * 1536 + col + 4);
                    a8[0] += w0.x * x8[0]; a8[1] += w0.y * x8[1]; a8[2] += w0.z * x8[2]; a8[3] += w0.w * x8[3]; a8[4] += w1.x * x8[4]; a8[5] += w1.y * x8[5]; a8[6] += w1.z * x8[6]; a8[7] += w1.w * x8[7]; } }
            *(LAS f32x4*)(dst) = (f32x4){siluf(a8[0]), siluf(a8[1]), siluf(a8[2]), siluf(a8[3])}; *(LAS f32x4*)(dst + 4) = (f32x4){siluf(a8[4]), siluf(a8[5]), siluf(a8[6]), siluf(a8[7])};
        }
        if (tid < 32) { const int row = r0 + tid; const float la = sp.DT[(size_t)row * 64 + 32 + d * 16 + h]; dtv[tid] = sp.DT[(size_t)row * 64 + d * 16 + h]; av[tid] = __expf(la);
            float s = la; s += __shfl_xor(s, 1); s += __shfl_xor(s, 2); s += __shfl_xor(s, 4); s += __shfl_xor(s, 8); s += __shfl_xor(s, 16); logsum += s; }
        __syncthreads();
        for (int jj = 0; jj < 32; ++jj) { const int t = d == 0 ? jj : 31 - jj;
            const float a = av[t], xd = xs[t * 64 + p] * dtv[t];
            const LAS float* bp = Bs + t * 128 + nq * 16; const LAS float* cp = Cs + t * 128 + nq * 16;
            float acc = 0.f;
#pragma unroll
            for (int i4 = 0; i4 < 4; ++i4) { const f32x4 b4 = *(const LAS f32x4*)(bp + 4 * i4);
                st[4 * i4 + 0] = a * st[4 * i4 + 0] + xd * b4.x; st[4 * i4 + 1] = a * st[4 * i4 + 1] + xd * b4.y; st[4 * i4 + 2] = a * st[4 * i4 + 2] + xd * b4.z; st[4 * i4 + 3] = a * st[4 * i4 + 3] + xd * b4.w;
                if (MODE != 0) { const f32x4 c4 = *(const LAS f32x4*)(cp + 4 * i4); acc += (c4.x * st[4 * i4 + 0] + c4.y * st[4 * i4 + 1]) + (c4.z * st[4 * i4 + 2] + c4.w * st[4 * i4 + 3]); } }
            if (MODE != 0) { acc += __shfl_xor(acc, 1); acc += __shfl_xor(acc, 2); acc += __shfl_xor(acc, 4); if (nq == 0) yb[t * 64 + p] = acc; }
        }
        if (MODE != 0) {
            __syncthreads();
            const int t = tid >> 4, p4 = (tid & 15) * 4, row = r0 + t, lrow = row - row_begin;
            const f32x4 y = *(const LAS f32x4*)(yb + t * 64 + p4);
            if (MODE == 1) { *(LAS unsigned long long*)(YF + lrow * 64 + p4) = (unsigned long long)pk2(y.x, y.y) | ((unsigned long long)pk2(y.z, y.w) << 32); }
            else {
                const unsigned long long yfw = *(const LAS unsigned long long*)(YF + lrow * 64 + p4); const f32x4 xv = *(const LAS f32x4*)(xs + t * 64 + p4);
                GAS unsigned long long* zp = (GAS unsigned long long*)(sp.ZQ + (size_t)row * 2048 + h * 64 + p4); const unsigned long long zw = *zp;
                const float o0 = (y.x + bf2f((unsigned)yfw & 0xffffu) + dsk * xv.x) * bf2f((unsigned)zw & 0xffffu), o1 = (y.y + bf2f(((unsigned)yfw >> 16) & 0xffffu) + dsk * xv.y) * bf2f(((unsigned)zw >> 16) & 0xffffu);
                const float o2 = (y.z + bf2f((unsigned)(yfw >> 32) & 0xffffu) + dsk * xv.z) * bf2f((unsigned)(zw >> 32) & 0xffffu), o3 = (y.w + bf2f((unsigned)(yfw >> 48) & 0xffffu) + dsk * xv.w) * bf2f((unsigned)(zw >> 48) & 0xffffu);
                *zp = (unsigned long long)pk2(o0, o1) | ((unsigned long long)pk2(o2, o3) << 32);
                float ss = (o0 * o0 + o1 * o1) + (o2 * o2 + o3 * o3);
                ss += __shfl_xor(ss, 1); ss += __shfl_xor(ss, 2); ss += __shfl_xor(ss, 4); ss += __shfl_xor(ss, 8);
                if ((tid & 15) == 0) sp.STATS[(size_t)row * 16 + h] = ss;
            }
        }
        __syncthreads();
    }
}
__device__ __forceinline__ void ssd_load_state(const bf16* S, float (&st)[16], int tid) {
    float a[8], b[8]; const GAS v4u* sp = (const GAS v4u*)(S + (tid >> 3) * 128 + (tid & 7) * 16); unpack8(sp[0], a); unpack8(sp[1], b);
#pragma unroll
    for (int i = 0; i < 8; ++i) { st[i] = a[i]; st[8 + i] = b[i]; }
}
__device__ __forceinline__ void ssd_save_state(bf16* S, const float (&st)[16], int tid) {
    GAS v4u* sp = (GAS v4u*)(S + (tid >> 3) * 128 + (tid & 7) * 16);
    v4u o; o.x = pk2(st[0], st[1]); o.y = pk2(st[2], st[3]); o.z = pk2(st[4], st[5]); o.w = pk2(st[6], st[7]); sp[0] = o;
    o.x = pk2(st[8], st[9]); o.y = pk2(st[10], st[11]); o.z = pk2(st[12], st[13]); o.w = pk2(st[14], st[15]); sp[1] = o;
}

typedef float f32x16 __attribute__((ext_vector_type(16)));
typedef short s16x4 __attribute__((ext_vector_type(4)));
#define MFMA32(a, b, c) __builtin_amdgcn_mfma_f32_32x32x16_bf16((a), (b), (c), 0, 0, 0)
__device__ __forceinline__ bf16x8 frag_rows(LAS const unsigned char* img, int RS, int row0, int kbyte, int lane) { return *(const LAS bf16x8*)(img + (row0 + (lane & 31)) * RS + kbyte + (lane >> 5) * 16); }
__device__ __forceinline__ bf16x8 frag_tr(LAS const unsigned char* img, int RS, int k0, int col0, int lane) {
    const int h = lane >> 5, blk = (lane >> 4) & 1, q = (lane & 15) >> 2, p = lane & 3;
    LAS const unsigned char* a = img + (k0 + 8 * h + q) * RS + (col0 + 16 * blk + 4 * p) * 2;
    const s16x4 lo = __builtin_amdgcn_ds_read_tr16_b64_v4i16((LAS s16x4*)a), hi = __builtin_amdgcn_ds_read_tr16_b64_v4i16((LAS s16x4*)(a + 4 * RS));
    return (bf16x8){lo[0], lo[1], lo[2], lo[3], hi[0], hi[1], hi[2], hi[3]};
}
__device__ __forceinline__ int arow(int reg, int h) { return (reg & 3) + 8 * (reg >> 2) + 4 * h; }
__device__ __forceinline__ void store_acc_nat(const f32x16& acc, LAS unsigned char* img, int RS, int n0, int m0, int lane) {
    LAS unsigned char* base = img + (n0 + (lane & 31)) * RS + (m0 + 4 * (lane >> 5)) * 2;
#pragma unroll
    for (int g = 0; g < 4; ++g) *(LAS unsigned long long*)(base + 16 * g) = (unsigned long long)pk2(acc[4 * g], acc[4 * g + 1]) | ((unsigned long long)pk2(acc[4 * g + 2], acc[4 * g + 3]) << 32);
}

template <int MODE, int D>
__device__ __forceinline__ void hg_scan(const ScanPtrs& sp, LAS unsigned char* lds, int row_begin, int nchunks, int hh, const bf16* st_in, bf16* st_out, float* dec_out, int tid) {
    const int lane = tid & 63, wave = __builtin_amdgcn_readfirstlane(tid >> 6), h = lane >> 5;
    LAS unsigned char* QP = lds; LAS unsigned char* KP = lds + 17408; LAS unsigned char* VI = lds + 34816; LAS unsigned char* ATT = lds + 52224; LAS unsigned char* STI = lds + 61440;
    LAS float* OB = (LAS float*)(lds + 96256); LAS float* PAR = (LAS float*)(lds + 132096); LAS float* EL = (LAS float*)(lds + 136192);
    f16* Fit = (row_begin < ML) ? sp.Flat + (size_t)row_begin * 2048 : sp.Fctx + (size_t)(row_begin - ML) * 2048;
    const int k0 = (tid & 63) * 2, tg = wave, kb = wave >> 1, vb0 = (wave & 1) * 2;
    asm volatile("" : "+s"(nchunks));
    f32x16 accS[2];
#pragma unroll
    for (int i = 0; i < 2; ++i)
#pragma unroll
        for (int r = 0; r < 16; ++r) accS[i][r] = st_in ? bf2f(*(const GAS unsigned short*)(st_in + (32 * kb + arow(r, h)) * 128 + 32 * (vb0 + i) + (lane & 31))) : 0.f;
    if (MODE != 0) { store_acc_nat(accS[0], STI, 272, 32 * vb0, 32 * kb, lane); store_acc_nat(accS[1], STI, 272, 32 * (vb0 + 1), 32 * kb, lane); }
    float ltot0 = 0.f, ltot1 = 0.f;
    unsigned plf[8], pq[8]; v4u pv0, pv1;
    const int vr = tid >> 3, vc = (tid & 7) * 16;
#define HG_LOAD(c_) do { const int rr_ = 64 * (c_); \
        _Pragma("unroll") for (int i = 0; i < 8; ++i) { plf[i] = *(const GAS unsigned*)(Fit + (size_t)(rr_ + 8 * tg + i) * 2048 + D * 1024 + hh * 128 + k0); \
            if (MODE != 0) pq[i] = *(const GAS unsigned*)(sp.ZQ + (size_t)(row_begin + rr_ + 8 * tg + i) * 2048 + 1024 + hh * 128 + k0); } \
        const GAS v4u* vp_ = (const GAS v4u*)(sp.V + (size_t)(row_begin + rr_ + vr) * 1024 + hh * 128 + vc); pv0 = vp_[0]; pv1 = vp_[1]; } while (0)
    HG_LOAD(D == 0 ? 0 : nchunks - 1);
#pragma unroll 1
    for (int ci = 0; ci < nchunks; ++ci) {
        const int c = D == 0 ? ci : nchunks - 1 - ci, r0 = 64 * c;
        float lf0[8], lf1[8], cs0[8], cs1[8]; float run0 = 0.f, run1 = 0.f;
#pragma unroll
        for (int i = 0; i < 8; ++i) { const f16x2 hr = __builtin_bit_cast(f16x2, plf[i]); lf0[i] = (float)hr.x; lf1[i] = (float)hr.y; }
#pragma unroll
        for (int ii = 0; ii < 8; ++ii) { const int i = D == 0 ? ii : 7 - ii; run0 += lf0[i]; run1 += lf1[i]; cs0[i] = run0; cs1[i] = run1; }
        *(LAS f32x2*)(PAR + tg * 128 + k0) = (f32x2){run0, run1};
        __syncthreads();
        float off0 = 0.f, off1 = 0.f, tot0 = 0.f, tot1 = 0.f;
#pragma unroll
        for (int j = 0; j < 8; ++j) { const f32x2 pj = *(const LAS f32x2*)(PAR + j * 128 + k0); tot0 += pj.x; tot1 += pj.y; if (D == 0 ? (j < tg) : (j > tg)) { off0 += pj.x; off1 += pj.y; } }
#pragma unroll
        for (int i = 0; i < 8; ++i) { const float bc0 = off0 + cs0[i], bc1 = off1 + cs1[i], kk0 = 1.f - __expf(lf0[i]), kk1 = 1.f - __expf(lf1[i]); const int t = 8 * tg + i;
            if (MODE != 0) *(LAS unsigned*)(QP + t * 272 + k0 * 2) = pk2(bf2f(pq[i] & 0xffffu) * __expf(bc0), bf2f(pq[i] >> 16) * __expf(bc1));
            *(LAS unsigned*)(KP + t * 272 + k0 * 2) = pk2(kk0 * __expf(-bc0), kk1 * __expf(-bc1)); }
        if (tg == 0) { *(LAS f32x2*)(EL + k0) = (f32x2){__expf(tot0), __expf(tot1)}; ltot0 += tot0; ltot1 += tot1; }
        *(LAS v4u*)(VI + vr * 272 + vc * 2) = pv0; *(LAS v4u*)(VI + vr * 272 + vc * 2 + 16) = pv1;
        if (ci + 1 < nchunks) HG_LOAD(D == 0 ? ci + 1 : nchunks - 2 - ci);
        __syncthreads();
        f32x16 accO;
        if (MODE != 0) {
            if (wave < 4) { const int sb = wave >> 1, tb = wave & 1; f32x16 a;
#pragma unroll
                for (int r = 0; r < 16; ++r) a[r] = 0.f;
#pragma unroll
                for (int ks = 0; ks < 8; ++ks) a = MFMA32(frag_rows(KP, 272, 32 * sb, 32 * ks, lane), frag_rows(QP, 272, 32 * tb, 32 * ks, lane), a);
                const int t = 32 * tb + (lane & 31);
#pragma unroll
                for (int r = 0; r < 16; ++r) { const int s = 32 * sb + arow(r, h); if (D == 0 ? (s > t) : (s < t)) a[r] = 0.f; }
                store_acc_nat(a, ATT, 144, 32 * tb, 32 * sb, lane); }
            const int tb = wave >> 2, vb = wave & 3;
#pragma unroll
            for (int r = 0; r < 16; ++r) accO[r] = 0.f;
#pragma unroll
            for (int ks = 0; ks < 8; ++ks) accO = MFMA32(frag_rows(QP, 272, 32 * tb, 32 * ks, lane), frag_rows(STI, 272, 32 * vb, 32 * ks, lane), accO);
            __syncthreads();
#pragma unroll
            for (int ks = 0; ks < 4; ++ks) accO = MFMA32(frag_rows(ATT, 144, 32 * tb, 32 * ks, lane), frag_tr(VI, 272, 16 * ks, 32 * vb, lane), accO);
#pragma unroll
            for (int r = 0; r < 16; ++r) OB[(32 * tb + arow(r, h)) * 132 + 32 * vb + (lane & 31)] = accO[r];
        }
#pragma unroll
        for (int ks = 0; ks < 4; ++ks) { const bf16x8 a = frag_tr(KP, 272, 16 * ks, 32 * kb, lane);
            accS[0] = MFMA32(a, frag_tr(VI, 272, 16 * ks, 32 * vb0, lane), accS[0]); accS[1] = MFMA32(a, frag_tr(VI, 272, 16 * ks, 32 * (vb0 + 1), lane), accS[1]); }
#pragma unroll
        for (int r = 0; r < 16; ++r) { const float e = EL[32 * kb + arow(r, h)]; accS[0][r] *= e; accS[1][r] *= e; }
        if (MODE != 0) { store_acc_nat(accS[0], STI, 272, 32 * vb0, 32 * kb, lane); store_acc_nat(accS[1], STI, 272, 32 * (vb0 + 1), 32 * kb, lane); }
        __syncthreads();
        if (MODE != 0) {
            const int t = tid >> 3, c16 = (tid & 7) * 16, row = row_begin + r0 + t;
            float o[16];
#pragma unroll
            for (int j = 0; j < 4; ++j) { const f32x4 x = *(const LAS f32x4*)(OB + t * 132 + c16 + 4 * j); o[4 * j] = x.x; o[4 * j + 1] = x.y; o[4 * j + 2] = x.z; o[4 * j + 3] = x.w; }
            f16* fp = Fit + (size_t)(r0 + t) * 2048 + hh * 128 + c16;
            if (MODE == 1) { f16x8 a, b;
#pragma unroll
                for (int j = 0; j < 8; ++j) { a[j] = (f16)o[j]; b[j] = (f16)o[8 + j]; }
                *(GAS f16x8*)fp = a; *(GAS f16x8*)(fp + 8) = b; }
            else { const f16x8 a = *(const GAS f16x8*)fp, b = *(const GAS f16x8*)(fp + 8); float ss = 0.f;
#pragma unroll
                for (int j = 0; j < 8; ++j) { o[j] += (float)a[j]; o[8 + j] += (float)b[j]; }
#pragma unroll
                for (int j = 0; j < 16; ++j) ss += o[j] * o[j];
                ss += __shfl_xor(ss, 1); ss += __shfl_xor(ss, 2); ss += __shfl_xor(ss, 4);
                const float rn = rsqrtf(ss * (1.f / 128.f) + EPS);
                float g8[8], g9[8]; unpack8(*(const GAS v4u*)(sp.G + (size_t)row * 1024 + hh * 128 + c16), g8); unpack8(*(const GAS v4u*)(sp.G + (size_t)row * 1024 + hh * 128 + c16 + 8), g9);
                const float* hn = sp.hgn + c16;
                v4u w0, w1;
                w0.x = pk2(o[0] * rn * hn[0] * g8[0], o[1] * rn * hn[1] * g8[1]); w0.y = pk2(o[2] * rn * hn[2] * g8[2], o[3] * rn * hn[3] * g8[3]); w0.z = pk2(o[4] * rn * hn[4] * g8[4], o[5] * rn * hn[5] * g8[5]); w0.w = pk2(o[6] * rn * hn[6] * g8[6], o[7] * rn * hn[7] * g8[7]);
                w1.x = pk2(o[8] * rn * hn[8] * g9[0], o[9] * rn * hn[9] * g9[1]); w1.y = pk2(o[10] * rn * hn[10] * g9[2], o[11] * rn * hn[11] * g9[3]); w1.z = pk2(o[12] * rn * hn[12] * g9[4], o[13] * rn * hn[13] * g9[5]); w1.w = pk2(o[14] * rn * hn[14] * g9[6], o[15] * rn * hn[15] * g9[7]);
                GAS v4u* zp = (GAS v4u*)(sp.ZQ + (size_t)row * 2048 + 1024 + hh * 128 + c16); zp[0] = w0; zp[1] = w1; }
        }
    }
#undef HG_LOAD
    if (st_out) {
#pragma unroll
        for (int i = 0; i < 2; ++i)
#pragma unroll
            for (int r = 0; r < 16; ++r) *(GAS unsigned short*)(st_out + (32 * kb + arow(r, h)) * 128 + 32 * (vb0 + i) + (lane & 31)) = (unsigned short)f2bf(accS[i][r]); }
    if (dec_out && tg == 0) { dec_out[k0] = __expf(ltot0); dec_out[k0 + 1] = __expf(ltot1); }
    __syncthreads();
}
__device__ __forceinline__ void wg_fence() { __threadfence(); __syncthreads(); }

__device__ __forceinline__ void phase_scanA(const ScanPtrs& sp, LAS unsigned char* lds, int bid, int G, int tid) {
    const int NI = NSC * 16 + NSC * 32 + 8 + 16;
    for (int it = bid; it < NI; it += G) {
        if (it < NSC * 16) { const int sc = it >> 4, chain = it & 15, hh = chain >> 1, d = chain & 1;
            bf16* so = sp.HG_ST + ((size_t)sc * 16 + chain) * 16384; float* dc = sp.HG_DEC + (sc * 16 + chain) * 128;
            if (d == 0) hg_scan<0, 0>(sp, lds, sc * SCL, SCL / 64, hh, nullptr, so, dc, tid); else hg_scan<0, 1>(sp, lds, sc * SCL, SCL / 64, hh, nullptr, so, dc, tid);
        } else if (it < NSC * 16 + NSC * 32) { const int i2 = it - NSC * 16, sc = i2 >> 5, chain = i2 & 31, h = chain >> 1, d = chain & 1;
            float st[16]; float logsum = 0.f;
#pragma unroll
            for (int i = 0; i < 16; ++i) st[i] = 0.f;
            ssd_dir<0>(sp, lds, sc * SCL, SCL, 0, ML, h, d, st, logsum, tid);
            ssd_save_state(sp.SSD_ST + ((size_t)sc * 32 + chain) * 8192, st, tid);
            if (tid == 0) sp.SSD_DEC[sc * 32 + chain] = __expf(logsum);
        } else if (it < NSC * 16 + NSC * 32 + 8) { const int hh = it - (NSC * 16 + NSC * 32);
            hg_scan<1, 0>(sp, lds, ML, MC / 64, hh, nullptr, sp.HG_ST + ((size_t)NSC * 16 + hh * 2 + 0) * 16384, nullptr, tid);
            wg_fence();
            hg_scan<2, 1>(sp, lds, ML, MC / 64, hh, nullptr, sp.HG_ST + ((size_t)NSC * 16 + hh * 2 + 1) * 16384, nullptr, tid);
        } else { const int h = it - (NSC * 16 + NSC * 32 + 8);
            float st[16]; float logsum = 0.f;
#pragma unroll
            for (int i = 0; i < 16; ++i) st[i] = 0.f;
            ssd_dir<1>(sp, lds, ML, MC, ML, M, h, 0, st, logsum, tid);
            ssd_save_state(sp.SSD_ST + ((size_t)NSC * 32 + h * 2 + 0) * 8192, st, tid);
#pragma unroll
            for (int i = 0; i < 16; ++i) st[i] = 0.f;
            ssd_dir<2>(sp, lds, ML, MC, ML, M, h, 1, st, logsum, tid);
            ssd_save_state(sp.SSD_ST + ((size_t)NSC * 32 + h * 2 + 1) * 8192, st, tid);
        }
        __syncthreads();
    }
}
__device__ __forceinline__ void phase_scanB(const ScanPtrs& sp, int bid, int G, int tid) {
    const int gt = bid * 512 + tid, nt = G * 512;
    for (int e = gt; e < 2 * 131072; e += nt) {
        const bool hg = e >= 131072; const int e2 = hg ? e - 131072 : e;
        const int chain = hg ? (e2 >> 13) : (e2 >> 12), pr = hg ? (e2 & 8191) : (e2 & 4095), d = chain & 1;
        const int nch = hg ? 16 : 32, ppc = hg ? 8192 : 4096;
        GAS unsigned* base = (GAS unsigned*)(hg ? sp.HG_ST : sp.SSD_ST);
        const unsigned w0 = base[((size_t)NSC * nch + chain) * ppc + pr];
        float r0 = bf2f(w0 & 0xffffu), r1 = bf2f(w0 >> 16);
        for (int i0 = 0; i0 < NSC; i0 += 8) {
            unsigned loc[8]; float dec[8];
#pragma unroll
            for (int j = 0; j < 8; ++j) { const int sc = d == 0 ? i0 + j : NSC - 1 - (i0 + j); loc[j] = base[((size_t)sc * nch + chain) * ppc + pr];
                dec[j] = hg ? sp.HG_DEC[(sc * 16 + chain) * 128 + (pr >> 6)] : sp.SSD_DEC[sc * 32 + chain]; }
#pragma unroll
            for (int j = 0; j < 8; ++j) { const int sc = d == 0 ? i0 + j : NSC - 1 - (i0 + j); base[((size_t)sc * nch + chain) * ppc + pr] = pk2(r0, r1);
                r0 = r0 * dec[j] + bf2f(loc[j] & 0xffffu); r1 = r1 * dec[j] + bf2f(loc[j] >> 16); }
        }
    }
}
__device__ __forceinline__ void phase_scanC(const ScanPtrs& sp, LAS unsigned char* lds, int bid, int G, int tid) {
    const int NI = NSC * 8 + NSC * 16;
    for (int it = bid; it < NI; it += G) {
        if (it < NSC * 8) { const int sc = it >> 3, hh = it & 7;
            hg_scan<1, 0>(sp, lds, sc * SCL, SCL / 64, hh, sp.HG_ST + ((size_t)sc * 16 + hh * 2 + 0) * 16384, nullptr, nullptr, tid);
            wg_fence();
            hg_scan<2, 1>(sp, lds, sc * SCL, SCL / 64, hh, sp.HG_ST + ((size_t)sc * 16 + hh * 2 + 1) * 16384, nullptr, nullptr, tid);
        } else { const int i2 = it - NSC * 8, sc = i2 >> 4, h = i2 & 15;
            float st[16]; float logsum = 0.f;
            ssd_load_state(sp.SSD_ST + ((size_t)sc * 32 + h * 2 + 0) * 8192, st, tid);
            ssd_dir<1>(sp, lds, sc * SCL, SCL, 0, ML, h, 0, st, logsum, tid);
            ssd_load_state(sp.SSD_ST + ((size_t)sc * 32 + h * 2 + 1) * 8192, st, tid);
            ssd_dir<2>(sp, lds, sc * SCL, SCL, 0, ML, h, 1, st, logsum, tid);
        }
        __syncthreads();
    }
}
__device__ __forceinline__ void phase_finish(const Params& p, LAS unsigned char* lds, int bid, int G, int tid, int wave, int lane) {
    unsigned char* ws = p.ws; bf16* ZQ = (bf16*)(ws + WS_ZQ); const float* stats = (const float*)(ws + WS_SMALL + SM_STATS); const float* sng = p.in[I_SSDN];
    const int gw = bid * NWAVES + wave, ngw = G * NWAVES;
    for (int row = gw; row < M; row += ngw) {
        const int grp = lane >> 5; const float* s8 = stats + (size_t)row * 16 + grp * 8;
        const float ss = ((s8[0] + s8[1]) + (s8[2] + s8[3])) + ((s8[4] + s8[5]) + (s8[6] + s8[7]));
        const float r = rsqrtf(ss * (1.f / 512.f) + EPS);
        GAS v4u* zp = (GAS v4u*)(ZQ + (size_t)row * 2048 + lane * 16);
#pragma unroll
        for (int q = 0; q < 2; ++q) { float x8[8]; unpack8(zp[q], x8); const float* g8 = sng + lane * 16 + q * 8;
            v4u o; o.x = pk2(x8[0] * r * g8[0], x8[1] * r * g8[1]); o.y = pk2(x8[2] * r * g8[2], x8[3] * r * g8[3]); o.z = pk2(x8[4] * r * g8[4], x8[5] * r * g8[5]); o.w = pk2(x8[6] * r * g8[6], x8[7] * r * g8[7]); zp[q] = o; }
    }
    LAS float* scr = (LAS float*)(lds + wave * 16384); unsigned char* wr = ws + WS_WREST;
    tr_job(p.in[I_EVOUT], 2048, 1024, 1, (bf16*)(wr + WO_OUT), scr, gw, ngw, lane);
    tr_job(p.in[I_WGATE], 1024, DFF, 2, (bf16*)(wr + WO_UP0), scr, gw, ngw, lane);
    tr_job(p.in[I_WUP], 1024, DFF, 3, (bf16*)(wr + WO_UP0), scr, gw, ngw, lane);
    tr_job(p.in[I_WDOWN], DFF, 1024, 1, (bf16*)(wr + WO_DOWN0), scr, gw, ngw, lane);
    tr_job(p.in[I_ODIN], 1024, 512, 1, (bf16*)(wr + WO_OD), scr, gw, ngw, lane);
    tr_job(p.in[I_WVAL], 512, 1024, 2, (bf16*)(wr + WO_VG), scr, gw, ngw, lane);
    tr_job(p.in[I_WGATE2], 512, 1024, 3, (bf16*)(wr + WO_VG), scr, gw, ngw, lane);
    tr_job(p.in[I_WGATE] + (size_t)1024 * DFF, 1024, DFF, 2, (bf16*)(wr + WO_UP1), scr, gw, ngw, lane);
    tr_job(p.in[I_WUP] + (size_t)1024 * DFF, 1024, DFF, 3, (bf16*)(wr + WO_UP1), scr, gw, ngw, lane);
    tr_job(p.in[I_WDOWN] + (size_t)DFF * 1024, DFF, 1024, 1, (bf16*)(wr + WO_DOWN1), scr, gw, ngw, lane);
}

struct S5Ptrs { const float* U; float* YS; bf16* A2; const float* LAM; const float* LAMP; const float* BB; const float* CRE; const float* CIM; const float* S5D; float* ST; };
template <int MODE>
__device__ __forceinline__ void s5_dir(const S5Ptrs& sp, LAS unsigned char* lds, int row_begin, int gb, int d, float& hr, float& hi, int tid) {
    LAS float* ub = (LAS float*)lds; LAS float* hsr = (LAS float*)(lds + 4096); LAS float* hsi = (LAS float*)(lds + 4096 + 16384);
    const int gl = tid >> 6, s = (d * 32 + gb * 8 + gl) * 64 + (tid & 63);
    float bbr[16], bbi[16];
#pragma unroll
    for (int c = 0; c < 16; ++c) { bbr[c] = sp.BB[(size_t)s * 32 + 2 * c]; bbi[c] = sp.BB[(size_t)s * 32 + 2 * c + 1]; }
    const float lr = sp.LAM[2 * s], li = sp.LAM[2 * s + 1];
    for (int blk = 0; blk < 32; ++blk) {
        const int r0 = d == 0 ? row_begin + 8 * blk : row_begin + 256 - 8 * (blk + 1);
        if (tid < 256) { const int t = tid >> 5, c4 = (tid & 31) * 4; *(LAS f32x4*)(ub + t * 128 + c4) = *(const GAS f32x4*)(sp.U + (size_t)(r0 + t) * 512 + gb * 128 + c4); }
        __syncthreads();
        for (int jj = 0; jj < 8; ++jj) { const int t = d == 0 ? jj : 7 - jj; const LAS float* up = ub + t * 128 + gl * 16;
            float br = 0.f, bi = 0.f;
#pragma unroll
            for (int c4 = 0; c4 < 4; ++c4) { const f32x4 u4 = *(const LAS f32x4*)(up + 4 * c4);
                br += (bbr[4 * c4] * u4.x + bbr[4 * c4 + 1] * u4.y) + (bbr[4 * c4 + 2] * u4.z + bbr[4 * c4 + 3] * u4.w); bi += (bbi[4 * c4] * u4.x + bbi[4 * c4 + 1] * u4.y) + (bbi[4 * c4 + 2] * u4.z + bbi[4 * c4 + 3] * u4.w); }
            const float nr = lr * hr - li * hi + br, ni = lr * hi + li * hr + bi; hr = nr; hi = ni;
            if (MODE != 0) { hsr[t * 512 + tid] = hr; hsi[t * 512 + tid] = hi; }
        }
        if (MODE != 0) {
            __syncthreads();
            const int t = tid >> 6, g2 = (tid >> 3) & 7, c0 = (tid & 7) * 2, gg = gb * 8 + g2;
            float y[2];
#pragma unroll
            for (int q = 0; q < 2; ++q) { const float* cr = sp.CRE + ((size_t)(d * 32 + gg) * 16 + c0 + q) * 64; const float* ci = sp.CIM + ((size_t)(d * 32 + gg) * 16 + c0 + q) * 64;
                const LAS float* pr = hsr + t * 512 + g2 * 64; const LAS float* pi = hsi + t * 512 + g2 * 64; float a = 0.f;
#pragma unroll 4
                for (int p4 = 0; p4 < 16; ++p4) { const f32x4 r4 = *(const LAS f32x4*)(pr + 4 * p4), i4 = *(const LAS f32x4*)(pi + 4 * p4), cr4 = *(const GAS f32x4*)(cr + 4 * p4), ci4 = *(const GAS f32x4*)(ci + 4 * p4);
                    a += (cr4.x * r4.x - ci4.x * i4.x) + (cr4.y * r4.y - ci4.y * i4.y) + (cr4.z * r4.z - ci4.z * i4.z) + (cr4.w * r4.w - ci4.w * i4.w); }
                y[q] = a; }
            const int row = r0 + t, col = gb * 128 + g2 * 16 + c0;
            if (MODE == 1) { *(GAS f32x2*)(sp.YS + (size_t)row * 512 + col) = (f32x2){y[0], y[1]}; }
            else { const f32x2 yf = *(const GAS f32x2*)(sp.YS + (size_t)row * 512 + col);
                const float v0 = y[0] + yf.x + sp.S5D[col] * ub[t * 128 + g2 * 16 + c0], v1 = y[1] + yf.y + sp.S5D[col + 1] * ub[t * 128 + g2 * 16 + c0 + 1];
                const float t0 = 0.7978845608f * (v0 + 0.044715f * v0 * v0 * v0), t1 = 0.7978845608f * (v1 + 0.044715f * v1 * v1 * v1);
                const float g0 = 0.5f * v0 * (2.f - 2.f / (__expf(2.f * t0) + 1.f)), g1 = 0.5f * v1 * (2.f - 2.f / (__expf(2.f * t1) + 1.f));
                const int token = (row & 255) * 64 + (row >> 8);
                *(GAS unsigned*)(sp.A2 + (size_t)token * 512 + col) = pk2(g0, g1); }
        }
        __syncthreads();
    }
}
__device__ __forceinline__ void phase_s5A(const S5Ptrs& sp, LAS unsigned char* lds, int bid, int G, int tid) {
    for (int it = bid; it < 64 * 8 + 8; it += G) {
        const bool isc = it >= 512; const int i2 = isc ? it - 512 : it, c = isc ? 64 : (i2 >> 3), d = (i2 >> 2) & 1, gb = i2 & 3;
        float hr = 0.f, hi = 0.f;
        s5_dir<0>(sp, lds, isc ? ML : c * 256, gb, d, hr, hi, tid);
        *(GAS f32x2*)(sp.ST + ((size_t)(c * 2 + d) * 2048 + gb * 512 + tid) * 2) = (f32x2){hr, hi};
    }
}
__device__ __forceinline__ void phase_s5B(const S5Ptrs& sp, int bid, int G, int tid) {
    const int gt = bid * 512 + tid;
    if (gt < 4096) { const int d = gt >> 11, gp = gt & 2047, s = d * 2048 + gp; const float pr = sp.LAMP[2 * s], pi = sp.LAMP[2 * s + 1];
        GAS f32x2* st = (GAS f32x2*)sp.ST; f32x2 run = st[(size_t)(64 * 2 + d) * 2048 + gp];
        for (int i0 = 0; i0 < 64; i0 += 8) { f32x2 loc[8];
#pragma unroll
            for (int j = 0; j < 8; ++j) { const int c = d == 0 ? i0 + j : 63 - (i0 + j); loc[j] = st[(size_t)(c * 2 + d) * 2048 + gp]; }
#pragma unroll
            for (int j = 0; j < 8; ++j) { const int c = d == 0 ? i0 + j : 63 - (i0 + j); st[(size_t)(c * 2 + d) * 2048 + gp] = run;
                const float nr = pr * run.x - pi * run.y + loc[j].x, ni = pr * run.y + pi * run.x + loc[j].y; run.x = nr; run.y = ni; } }
    }
}
__device__ __forceinline__ void phase_s5C(const S5Ptrs& sp, LAS unsigned char* lds, int bid, int G, int tid) {
    for (int it = bid; it < 256; it += G) { const int c = it >> 2, gb = it & 3;
        f32x2 h0 = *(const GAS f32x2*)(sp.ST + ((size_t)(c * 2 + 0) * 2048 + gb * 512 + tid) * 2); float hr = h0.x, hi = h0.y;
        s5_dir<1>(sp, lds, c * 256, gb, 0, hr, hi, tid);
        wg_fence();
        h0 = *(const GAS f32x2*)(sp.ST + ((size_t)(c * 2 + 1) * 2048 + gb * 512 + tid) * 2); hr = h0.x; hi = h0.y;
        s5_dir<2>(sp, lds, c * 256, gb, 1, hr, hi, tid);
    }
}
__device__ __forceinline__ void phase_final(const Params& p, int bid, int G, int wave, int lane) {
    const int gw = bid * NWAVES + wave, ngw = G * NWAVES; const float* fg = p.in[I_FNORM];
    for (int row = gw; row < ML; row += ngw) { float* xr = p.out + (size_t)row * 1024;
        f32x4 v[4]; float ss = 0.f;
#pragma unroll
        for (int j = 0; j < 4; ++j) { v[j] = *(const GAS f32x4*)(xr + 4 * lane + 256 * j); ss += (v[j].x * v[j].x + v[j].y * v[j].y) + (v[j].z * v[j].z + v[j].w * v[j].w); }
        const float r = rsqrtf(wave_sum(ss) * (1.f / 1024.f) + EPS);
#pragma unroll
        for (int j = 0; j < 4; ++j) { const f32x4 g4 = *(const GAS f32x4*)(fg + 4 * lane + 256 * j); *(GAS f32x4*)(xr + 4 * lane + 256 * j) = (f32x4){v[j].x * r * g4.x, v[j].y * r * g4.y, v[j].z * r * g4.z, v[j].w * r * g4.w}; }
    }
}

constexpr int N_PHASES = 21;
__device__ __forceinline__ void run_gmix(const Params& p, LAS unsigned char* lds, int bid, int G) {
    unsigned char* ws = p.ws;
    pg8::Gemm g{(const bf16*)(ws + WS_RX), (const bf16*)(ws + WS_WIN), M, NINP, 1024}; pg8::StaticOrder S; S.init(M, NINP, G, bid);
    pg8::EpiMix1 E{(bf16*)(ws + WS_ZQ), (bf16*)(ws + WS_XBC), (bf16*)(ws + WS_V), (bf16*)(ws + WS_G), (f16*)p.out, (f16*)(ws + WS_FCTX), (float*)(ws + WS_DT), (const float*)(ws + WS_SMALL + SM_LB), p.in[I_DTB], p.in[I_ALOG]};
    pg8::gemm_phase<pg8::EpiMix1, pg8::StaticOrder, true, true>(lds + RING_OFF, g, S, E);
}
__device__ __forceinline__ void run_gout(const Params& p, LAS unsigned char* lds, int bid, int G) {
    unsigned char* ws = p.ws; const float* mods = (const float*)(ws + WS_SMALL + SM_MODS);
    pg8::Gemm g{(const bf16*)(ws + WS_ZQ), (const bf16*)(ws + WS_WREST + WO_OUT), M, 1024, 2048}; pg8::StaticOrder S; S.init(M, 1024, G, bid);
    pg8::EpiResid E{p.in[I_X], p.in[I_CTX], p.out, (float*)(ws + WS_HCTX), mods + (0 * 2 + 0) * 6144 + 2 * 1024, mods + (0 * 2 + 1) * 6144 + 2 * 1024};
    pg8::gemm_phase<pg8::EpiResid, pg8::StaticOrder, true, true>(lds + RING_OFF, g, S, E);
}
__device__ __forceinline__ void run_gup(const Params& p, LAS unsigned char* lds, int bid, int G, int layer) {
    unsigned char* ws = p.ws; const int rows = layer ? ML : M;
    pg8::Gemm g{(const bf16*)(ws + WS_RX), (const bf16*)(ws + WS_WREST + (layer ? WO_UP1 : WO_UP0)), rows, 2 * DFF, 1024}; pg8::StaticOrder S; S.init(rows, 2 * DFF, G, bid);
    pg8::EpiSwiglu E{(bf16*)(ws + WS_HID)};
    pg8::gemm_phase<pg8::EpiSwiglu, pg8::StaticOrder, true, true>(lds + RING_OFF, g, S, E);
}
__device__ __forceinline__ void run_gdown(const Params& p, LAS unsigned char* lds, int bid, int G, int layer) {
    unsigned char* ws = p.ws; const int rows = layer ? ML : M; const float* mods = (const float*)(ws + WS_SMALL + SM_MODS); float* Hctx = (float*)(ws + WS_HCTX);
    pg8::Gemm g{(const bf16*)(ws + WS_HID), (const bf16*)(ws + WS_WREST + (layer ? WO_DOWN1 : WO_DOWN0)), rows, 1024, DFF}; pg8::StaticOrder S; S.init(rows, 1024, G, bid);
    pg8::EpiResid E{p.out, Hctx, p.out, Hctx, mods + (layer * 2 + 0) * 6144 + 5 * 1024, mods + (layer * 2 + 1) * 6144 + 5 * 1024};
    pg8::gemm_phase<pg8::EpiResid, pg8::StaticOrder, true, true>(lds + RING_OFF, g, S, E);
}
__device__ __forceinline__ void run_god(const Params& p, LAS unsigned char* lds, int bid, int G) {
    unsigned char* ws = p.ws;
    pg8::Gemm g{(const bf16*)(ws + WS_RX), (const bf16*)(ws + WS_WREST + WO_OD), M, 512, 1024}; pg8::StaticOrder S; S.init(M, 512, G, bid);
    pg8::EpiU E{(float*)(ws + WS_U)};
    pg8::gemm_phase<pg8::EpiU, pg8::StaticOrder, true, true>(lds + RING_OFF, g, S, E);
}
__device__ __forceinline__ void run_gvg(const Params& p, LAS unsigned char* lds, int bid, int G) {
    unsigned char* ws = p.ws; const float* mods = (const float*)(ws + WS_SMALL + SM_MODS);
    pg8::Gemm g{(const bf16*)(ws + WS_A2), (const bf16*)(ws + WS_WREST + WO_VG), ML, 2048, 512}; pg8::StaticOrder S; S.init(ML, 2048, G, bid);
    pg8::EpiValGate E{p.out, mods + (1 * 2 + 0) * 6144 + 2 * 1024};
    pg8::gemm_phase<pg8::EpiValGate, pg8::StaticOrder, true, true>(lds + RING_OFF, g, S, E);
}
__device__ __forceinline__ ScanPtrs make_scanptrs(const Params& p) {
    unsigned char* ws = p.ws; ScanPtrs sp; sp.XBC = (const bf16*)(ws + WS_XBC); sp.DT = (const float*)(ws + WS_DT); sp.ZQ = (bf16*)(ws + WS_ZQ); sp.V = (const bf16*)(ws + WS_V); sp.G = (const bf16*)(ws + WS_G); sp.Flat = (f16*)p.out; sp.Fctx = (f16*)(ws + WS_FCTX);
    sp.STATS = (float*)(ws + WS_SMALL + SM_STATS); sp.convw = p.in[I_CONVW]; sp.convb = p.in[I_CONVB]; sp.ssdd = p.in[I_SSDD]; sp.hgn = p.in[I_HGN];
    sp.SSD_ST = (bf16*)(ws + WS_RX); sp.HG_ST = (bf16*)(ws + WS_RX + SSD_ST_BYTES); sp.SSD_DEC = (float*)(ws + WS_SMALL + SM_SSDDEC); sp.HG_DEC = (float*)(ws + WS_SMALL + SM_HGDEC); return sp;
}
__device__ __forceinline__ S5Ptrs make_s5ptrs(const Params& p) {
    unsigned char* ws = p.ws; S5Ptrs s5; s5.U = (const float*)(ws + WS_U); s5.YS = (float*)(ws + WS_YS); s5.A2 = (bf16*)(ws + WS_A2); s5.LAM = (const float*)(ws + WS_SMALL + SM_LAM); s5.LAMP = (const float*)(ws + WS_SMALL + SM_LAMP);
    s5.BB = (const float*)(ws + WS_SMALL + SM_BB); s5.CRE = p.in[I_CRE]; s5.CIM = p.in[I_CIM]; s5.S5D = p.in[I_S5D]; s5.ST = (float*)(ws + WS_SMALL + SM_S5ST); return s5;
}
__global__ void __launch_bounds__(NWAVES * 64, 2) mk_fwd(Params p) {
    extern __shared__ __attribute__((aligned(16))) unsigned char lds_raw[];
    LAS unsigned char* lds = (LAS unsigned char*)lds_raw;
    volatile LAS unsigned* MISC = (volatile LAS unsigned*)(lds + MISC_OFF);
    const int tid = threadIdx.x, lane = tid & 63, wave = __builtin_amdgcn_readfirstlane(tid >> 6), G = gridDim.x, bid = blockIdx.x;
    gu32* ctl = (gu32*)(p.ws + WS_CTL);
    for (int u = tid; u < (LDS_BYTES - LDSCTL_OFF) / 4; u += NWAVES * 64) ((LAS unsigned*)(lds + LDSCTL_OFF))[u] = 0u;
    __syncthreads();
    XcdBarrier bar; bar.bar = (unsigned*)(ctl + CW_BAR); bar.x = 0; bar.st = nullptr;
    if (p.use_bar) bar = xcd_barrier_post((unsigned*)(ctl + CW_BAR), MISC + 8);
    const int lo = p.ph_lo, hi = p.ph_hi;
#ifndef MK_ONLYPH
#define MK_ONLYPH -1
#endif
#define IN(k) ((MK_ONLYPH < 0 || MK_ONLYPH == (k)) && lo <= (k) && (k) < hi)
#define SEAM(k) do { if ((k) + 1 < hi) xcd_barrier(bar); } while (0)
    if (IN(0)) { phase_prologue(p, lds, bid, G, tid, wave, lane); SEAM(0); }
    if (IN(1)) { phase_rownorm(p, lds, bid, G, tid, wave, lane, 0, 0, M, p.in[I_X], p.in[I_CTX], true); SEAM(1); }
    if (IN(2)) { run_gmix(p, lds, bid, G); SEAM(2); }
    if (IN(3)) { const ScanPtrs sp = make_scanptrs(p); phase_scanA(sp, lds, bid, G, tid); SEAM(3); }
    if (IN(4)) { const ScanPtrs sp = make_scanptrs(p); phase_scanB(sp, bid, G, tid); SEAM(4); }
    if (IN(5)) { const ScanPtrs sp = make_scanptrs(p); phase_scanC(sp, lds, bid, G, tid); SEAM(5); }
    if (IN(6)) { phase_finish(p, lds, bid, G, tid, wave, lane); SEAM(6); }
    if (IN(7)) { run_gout(p, lds, bid, G); SEAM(7); }
    if (IN(8)) { phase_rownorm(p, lds, bid, G, tid, wave, lane, 0, 1, M, p.out, (const float*)(p.ws + WS_HCTX), false); SEAM(8); }
    if (IN(9)) { run_gup(p, lds, bid, G, 0); SEAM(9); }
    if (IN(10)) { run_gdown(p, lds, bid, G, 0); SEAM(10); }
    if (IN(11)) { phase_rownorm(p, lds, bid, G, tid, wave, lane, 1, 0, M, p.out, (const float*)(p.ws + WS_HCTX), false); SEAM(11); }
    if (IN(12)) { run_god(p, lds, bid, G); SEAM(12); }
    if (IN(13)) { const S5Ptrs s5 = make_s5ptrs(p); phase_s5A(s5, lds, bid, G, tid); SEAM(13); }
    if (IN(14)) { const S5Ptrs s5 = make_s5ptrs(p); phase_s5B(s5, bid, G, tid); SEAM(14); }
    if (IN(15)) { const S5Ptrs s5 = make_s5ptrs(p); phase_s5C(s5, lds, bid, G, tid); SEAM(15); }
    if (IN(16)) { run_gvg(p, lds, bid, G); SEAM(16); }
    if (IN(17)) { phase_rownorm(p, lds, bid, G, tid, wave, lane, 1, 1, ML, p.out, (const float*)(p.ws + WS_HCTX), false); SEAM(17); }
    if (IN(18)) { run_gup(p, lds, bid, G, 1); SEAM(18); }
    if (IN(19)) { run_gdown(p, lds, bid, G, 1); SEAM(19); }
    if (IN(20)) { phase_final(p, bid, G, wave, lane); }
#undef IN
#undef SEAM
}

extern "C" void kernel_launch(void* const* d_in, const int* in_sizes, int n_in, void* d_out, int out_size, void* d_ws, size_t ws_size, hipStream_t stream) {
    static int grid = 0;
    if (grid == 0) {
        if (n_in != 33 || out_size != ML * D || ws_size < 256 * MiB) { fprintf(stderr, "kernel_launch: unexpected shapes (n_in %d, out %d, ws %zu); nothing launched\n", n_in, out_size, ws_size); grid = -1; return; }
        int dev = 0, cus = 0, per_cu = 0;
        if (hipGetDevice(&dev) != hipSuccess || hipDeviceGetAttribute(&cus, hipDeviceAttributeMultiprocessorCount, dev) != hipSuccess) { grid = -1; return; }
        if (hipFuncSetAttribute((const void*)mk_fwd, hipFuncAttributeMaxDynamicSharedMemorySize, LDS_BYTES) != hipSuccess) { fprintf(stderr, "kernel_launch: hipFuncSetAttribute failed\n"); grid = -1; return; }
        if (hipOccupancyMaxActiveBlocksPerMultiprocessor(&per_cu, (const void*)mk_fwd, NWAVES * 64, LDS_BYTES) != hipSuccess || per_cu < 1) fprintf(stderr, "kernel_launch: occupancy query reports %d\n", per_cu);
        (void)hipGetLastError();
        grid = cus;
    }
    if (grid < 0) return;
    (void)hipMemsetAsync((char*)d_ws + WS_CTL, 0, CTL_ZERO_BYTES, stream);
    Params a{};
    for (int i = 0; i < 33; ++i) a.in[i] = (const float*)d_in[i];
    a.out = (float*)d_out; a.ws = (unsigned char*)d_ws;
#if MK_N_LAUNCHES == 1
    a.ph_lo = 0; a.ph_hi = N_PHASES; a.use_bar = 1;
    hipLaunchKernelGGL(mk_fwd, dim3(grid), dim3(NWAVES * 64), LDS_BYTES, stream, a);
#else
    for (int ph = 0; ph < N_PHASES; ++ph) { a.ph_lo = ph; a.ph_hi = ph + 1; a.use_bar = 0; hipLaunchKernelGGL(mk_fwd, dim3(grid), dim3(NWAVES * 64), LDS_BYTES, stream, a); }
#endif
}
```

```cpp
#include <hip/hip_runtime.h>
#include <cstdio>
#include <cstdint>

#ifndef MK_N_LAUNCHES
#define MK_N_LAUNCHES 1
#endif
namespace pg8 {
#define PG8_LAS __attribute__((address_space(3)))
typedef unsigned short bf16_t;
typedef short bf16x8 __attribute__((ext_vector_type(8)));
typedef float f32x4 __attribute__((ext_vector_type(4)));
typedef unsigned u32x4 __attribute__((ext_vector_type(4)));
constexpr int BM = 256, BK = 64, HALF = 128, HTB = HALF * BK * 2  , STAGE_BYTES = 8 * HTB, NXCD = 8, WGM = 8;

__host__ __device__ __forceinline__ int lds_byte(int r, int c) { const int st = (r >> 4) * 2 + (c >> 5), rr = r & 15, cc = c & 31, ob = rr * 64 + cc * 2; return st * 1024 + (ob ^ (((ob >> 9) & 1) << 5)); }
__host__ __device__ __forceinline__ void stage_rc(int b, int& R, int& C) { const int st = b / 1024, sb = b % 1024, swz = sb ^ (((sb >> 9) & 1) << 5); R = (st >> 1) * 16 + swz / 64; C = (st & 1) * 32 + (swz % 64) / 2; }
__host__ __device__ __forceinline__ int perm32(int rho) { const int n = rho >> 4, i = rho & 15; return 8 * (i >> 2) + 4 * n + (i & 3); }

struct Unit { int pm, pn; };
struct Gemm { const bf16_t* A; const bf16_t* Bt; int M, N, K; };

struct StaticOrder {
    int nM, nN, nwg, G, c;
    __host__ __device__ void init(int M, int N, int G_, int c_) { nM = M / BM; nN = N / BM; nwg = nM * nN; G = G_; c = c_; }
    __host__ __device__ bool next(int i, Unit& u) const {
        const long L = (long)i * G + c; if (L >= nwg) return false;
        int wgid = (int)L; { const int q = nwg / NXCD, r = nwg % NXCD, xcd = wgid % NXCD, off = wgid / NXCD; wgid = (xcd < r ? xcd * (q + 1) : r * (q + 1) + (xcd - r) * q) + off; }
        const int nig = WGM * nN, gid = wgid / nig, fm = gid * WGM, gsz = (nM - fm) < WGM ? (nM - fm) : WGM;
        u.pm = fm + ((wgid % nig) % gsz); u.pn = (wgid % nig) / gsz; return true;
    }
    __device__ __forceinline__ void a_ready(const Unit&) const {}
    __device__ __forceinline__ void done(const Unit&) const {}
};

__device__ __forceinline__ unsigned cvt_pk_bf16(float lo, float hi) { unsigned r; asm volatile("v_cvt_pk_bf16_f32 %0, %1, %2" : "=v"(r) : "v"(lo), "v"(hi)); return r; }
typedef float f32x2 __attribute__((ext_vector_type(2)));
typedef _Float16 f16x8 __attribute__((ext_vector_type(8)));
__device__ __forceinline__ float siluf(float x) { return x / (1.f + __expf(-x)); }
__device__ __forceinline__ float sigmf(float x) { return 1.f / (1.f + __expf(-x)); }
__device__ __forceinline__ u32x4 pack8_bf16(const float (&x)[8]) { u32x4 w; w.x = cvt_pk_bf16(x[0], x[1]); w.y = cvt_pk_bf16(x[2], x[3]); w.z = cvt_pk_bf16(x[4], x[5]); w.w = cvt_pk_bf16(x[6], x[7]); return w; }
constexpr int EP_ML = 16384;

struct EpiMix1 {
    static constexpr bool PERM = true, AFTER_DRAIN = false;
    bf16_t* ZQ; bf16_t* XBC; bf16_t* V; bf16_t* G; _Float16* Flat; _Float16* Fctx; float* DT; const float* lb; const float* dt_bias; const float* a_log;
    template <int KIND> __device__ __forceinline__ void tile(const f32x4 (&acc)[2][2][4][2], const Unit& u, int wr, int wc, int fr, int fq, int seg_tile) const {
        const int row0 = u.pm * BM + wr * 64 + fr, cw = wc * 32 + 8 * fq;
#pragma unroll
        for (int ai = 0; ai < 2; ++ai)
#pragma unroll
            for (int m = 0; m < 4; ++m) { const int row = row0 + ai * HALF + m * 16;
#pragma unroll
                for (int bj = 0; bj < 2; ++bj) { const f32x4 v0 = acc[ai][bj][m][0], v1 = acc[ai][bj][m][1]; const int c = seg_tile * 256 + bj * HALF + cw;
                    float x[8] = {v0[0], v0[1], v0[2], v0[3], v1[0], v1[1], v1[2], v1[3]};
                    if constexpr (KIND == 0) {
#pragma unroll
                        for (int i = 0; i < 8; ++i) x[i] = siluf(x[i]);
                        *(u32x4*)(ZQ + (size_t)row * 2048 + c) = pack8_bf16(x);
                    } else if constexpr (KIND == 1) {
                        *(u32x4*)(XBC + (size_t)row * 1536 + c) = pack8_bf16(x);
                    } else if constexpr (KIND == 2) {
#pragma unroll
                        for (int i = 0; i < 8; ++i) x[i] = siluf(x[i]);
                        *(u32x4*)(ZQ + (size_t)row * 2048 + 1024 + c) = pack8_bf16(x);
                    } else if constexpr (KIND == 3) {
                        f16x8 h;
#pragma unroll
                        for (int i = 0; i < 8; ++i) { const float l = lb[(c + i) & 1023]; const float f = l + (1.f - l) * sigmf(x[i]); h[i] = (_Float16)__logf(f); }
                        _Float16* dst = (row < EP_ML) ? Flat + (size_t)row * 2048 : Fctx + (size_t)(row - EP_ML) * 2048;
                        *(f16x8*)(dst + c) = h;
                    } else if constexpr (KIND == 4) {
                        *(u32x4*)(V + (size_t)row * 1024 + c) = pack8_bf16(x);
                    } else if constexpr (KIND == 5) {
#pragma unroll
                        for (int i = 0; i < 8; ++i) x[i] = siluf(x[i]);
                        *(u32x4*)(G + (size_t)row * 1024 + c) = pack8_bf16(x);
                    } else {
                        if (bj == 0 && wc == 0) {
                            float dtv[8], la[8];
#pragma unroll
                            for (int i = 0; i < 8; ++i) { const int j = 8 * fq + i; const float r = x[i] + dt_bias[j]; dtv[i] = r > 20.f ? r : log1pf(__expf(r)); la[i] = -dtv[i] * __expf(a_log[j]); }
                            float* d = DT + (size_t)row * 64 + 8 * fq;
                            *(f32x4*)(d) = (f32x4){dtv[0], dtv[1], dtv[2], dtv[3]}; *(f32x4*)(d + 4) = (f32x4){dtv[4], dtv[5], dtv[6], dtv[7]};
                            *(f32x4*)(d + 32) = (f32x4){la[0], la[1], la[2], la[3]}; *(f32x4*)(d + 36) = (f32x4){la[4], la[5], la[6], la[7]};
                        }
                    } } }
    }
    __device__ __forceinline__ void operator()(const f32x4 (&acc)[2][2][4][2], const Unit& u, int wr, int wc, int fr, int fq) const {
        const int pn = u.pn;
        if (pn < 4) tile<0>(acc, u, wr, wc, fr, fq, pn);
        else if (pn < 10) tile<1>(acc, u, wr, wc, fr, fq, pn - 4);
        else if (pn < 14) tile<2>(acc, u, wr, wc, fr, fq, pn - 10);
        else if (pn < 22) tile<3>(acc, u, wr, wc, fr, fq, pn - 14);
        else if (pn < 26) tile<4>(acc, u, wr, wc, fr, fq, pn - 22);
        else if (pn < 30) tile<5>(acc, u, wr, wc, fr, fq, pn - 26);
        else tile<6>(acc, u, wr, wc, fr, fq, 0);
    }
};
struct EpiResid {
    static constexpr bool PERM = false, AFTER_DRAIN = false;
    const float* base_lat; const float* base_ctx; float* out_lat; float* out_ctx; const float* gate_lat; const float* gate_ctx;
    __device__ __forceinline__ void operator()(const f32x4 (&acc)[2][2][4][2], const Unit& u, int wr, int wc, int fr, int fq) const {
        const bool isc = u.pm >= 64; const float* base = isc ? base_ctx : base_lat; float* out = isc ? out_ctx : out_lat; const float* gate = isc ? gate_ctx : gate_lat;
        const int row0 = (isc ? 0 : u.pm * BM) + wr * 64 + fr, col0 = u.pn * BM + wc * 32 + 4 * fq;
        f32x4 gv[2][2];
#pragma unroll
        for (int bj = 0; bj < 2; ++bj)
#pragma unroll
            for (int n = 0; n < 2; ++n) gv[bj][n] = *(const f32x4*)(gate + col0 + bj * HALF + n * 16);
#pragma unroll
        for (int ai = 0; ai < 2; ++ai)
#pragma unroll
            for (int m = 0; m < 4; ++m) { const size_t off = (size_t)(row0 + ai * HALF + m * 16) * 1024 + col0;
#pragma unroll
                for (int bj = 0; bj < 2; ++bj)
#pragma unroll
                    for (int n = 0; n < 2; ++n) { const f32x4 b = *(const f32x4*)(base + off + bj * HALF + n * 16); *(f32x4*)(out + off + bj * HALF + n * 16) = b + gv[bj][n] * acc[ai][bj][m][n]; } }
    }
};
struct EpiSwiglu {
    static constexpr bool PERM = true, AFTER_DRAIN = false;
    bf16_t* HID;
    __device__ __forceinline__ void operator()(const f32x4 (&acc)[2][2][4][2], const Unit& u, int wr, int wc, int fr, int fq) const {
        const int row0 = u.pm * BM + wr * 64 + fr, c = u.pn * HALF + wc * 32 + 8 * fq;
#pragma unroll
        for (int ai = 0; ai < 2; ++ai)
#pragma unroll
            for (int m = 0; m < 4; ++m) { const f32x4 g0 = acc[ai][0][m][0], g1 = acc[ai][0][m][1], u0 = acc[ai][1][m][0], u1 = acc[ai][1][m][1];
                float x[8] = {siluf(g0[0]) * u0[0], siluf(g0[1]) * u0[1], siluf(g0[2]) * u0[2], siluf(g0[3]) * u0[3], siluf(g1[0]) * u1[0], siluf(g1[1]) * u1[1], siluf(g1[2]) * u1[2], siluf(g1[3]) * u1[3]};
                *(u32x4*)(HID + (size_t)(row0 + ai * HALF + m * 16) * 2816 + c) = pack8_bf16(x); }
    }
};
struct EpiU {
    static constexpr bool PERM = false, AFTER_DRAIN = false;
    float* U;
    __device__ __forceinline__ void operator()(const f32x4 (&acc)[2][2][4][2], const Unit& u, int wr, int wc, int fr, int fq) const {
        const int row0 = u.pm * BM + wr * 64 + fr, col0 = u.pn * BM + wc * 32 + 4 * fq;
#pragma unroll
        for (int ai = 0; ai < 2; ++ai)
#pragma unroll
            for (int m = 0; m < 4; ++m) { const int row = row0 + ai * HALF + m * 16; const int srow = row < EP_ML ? (row & 63) * 256 + (row >> 6) : row;
#pragma unroll
                for (int bj = 0; bj < 2; ++bj)
#pragma unroll
                    for (int n = 0; n < 2; ++n) *(f32x4*)(U + (size_t)srow * 512 + col0 + bj * HALF + n * 16) = acc[ai][bj][m][n]; }
    }
};
struct EpiValGate {
    static constexpr bool PERM = false, AFTER_DRAIN = false;
    float* H; const float* gate;
    __device__ __forceinline__ void operator()(const f32x4 (&acc)[2][2][4][2], const Unit& u, int wr, int wc, int fr, int fq) const {
        const int row0 = u.pm * BM + wr * 64 + fr, col0 = u.pn * HALF + wc * 32 + 4 * fq;
#pragma unroll
        for (int ai = 0; ai < 2; ++ai)
#pragma unroll
            for (int m = 0; m < 4; ++m) { float* hp = H + (size_t)(row0 + ai * HALF + m * 16) * 1024 + col0;
#pragma unroll
                for (int n = 0; n < 2; ++n) { const f32x4 v = acc[ai][0][m][n], g = acc[ai][1][m][n]; const f32x4 gm = *(const f32x4*)(gate + col0 + n * 16); f32x4 h = *(const f32x4*)(hp + n * 16);
                    h[0] += gm[0] * v[0] * sigmf(g[0]); h[1] += gm[1] * v[1] * sigmf(g[1]); h[2] += gm[2] * v[2] * sigmf(g[2]); h[3] += gm[3] * v[3] * sigmf(g[3]); *(f32x4*)(hp + n * 16) = h; } }
    }
};
template <class Epi, class Sched, bool ALIGN_EPI = false, bool SP2 = false>
__device__ __forceinline__ void gemm_phase(PG8_LAS unsigned char* lds, const Gemm g, const Sched& S, const Epi& E) {
    const int tid = threadIdx.x, wid = __builtin_amdgcn_readfirstlane(tid >> 6), lane = tid & 63, wr = wid >> 2, wc = wid & 3, fr = lane & 15, fq = lane >> 4;
    const int K = g.K, nt = K / BK;
    unsigned voffA[2], voffB[2];
#pragma unroll
    for (int i = 0; i < 2; ++i) { int R, C; stage_rc(tid * 16 + i * 8192, R, C); const int Rb = Epi::PERM ? ((R & ~31) + perm32(R & 31)) : R;
        voffA[i] = (unsigned)(R * K + C) * 2u; voffB[i] = (unsigned)(Rb * K + C) * 2u; }
    const size_t kstep = (size_t)(BK * 2);
    const size_t hstep = (size_t)HALF * K * 2;
    const size_t tstep = 2 * hstep;
    const unsigned ldsw = (unsigned)wid * 1024u;
    const int aoff = lds_byte(wr * 64 + fr, fq * 8), boff = lds_byte(wc * 32 + fr, fq * 8);
#define PG8_SA(b, h) (((b) * 2 + (h)) * HTB)
#define PG8_SB(b, h) ((4 + (b) * 2 + (h)) * HTB)
#define PG8_STAGE(bufoff, gbase, voff) do { _Pragma("unroll") for (int _i = 0; _i < 2; ++_i) \
        __builtin_amdgcn_global_load_lds((const unsigned*)((const char*)(gbase) + (voff)[_i]), (PG8_LAS unsigned*)(lds + (bufoff) + ldsw + _i * 8192), 16, 0, 0); } while (0)
#define PG8_LDA(dst, b, h) do { _Pragma("unroll") for (int m = 0; m < 4; ++m) _Pragma("unroll") for (int k = 0; k < 2; ++k) dst[m][k] = *(const PG8_LAS bf16x8*)(lds + PG8_SA(b, h) + aoff + m * 2048 + k * 1024); } while (0)
#define PG8_LDB(dst, b, h) do { _Pragma("unroll") for (int n = 0; n < 2; ++n) _Pragma("unroll") for (int k = 0; k < 2; ++k) dst[n][k] = *(const PG8_LAS bf16x8*)(lds + PG8_SB(b, h) + boff + n * 2048 + k * 1024); } while (0)
#define PG8_MMA(ai, bj, At, Bt) do { __builtin_amdgcn_s_setprio(1); _Pragma("unroll") for (int m = 0; m < 4; ++m) _Pragma("unroll") for (int n = 0; n < 2; ++n) _Pragma("unroll") for (int k = 0; k < 2; ++k) \
        acc[ai][bj][m][n] = __builtin_amdgcn_mfma_f32_16x16x32_bf16(Bt[n][k], At[m][k], acc[ai][bj][m][n], 0, 0, 0); __builtin_amdgcn_s_setprio(0); } while (0)
#define PG8_WAIT_V(n) asm volatile("s_waitcnt vmcnt(" #n ")" ::: "memory")
#define PG8_WAIT_L(n) asm volatile("s_waitcnt lgkmcnt(" #n ")" ::: "memory")
#define PG8_BAR __builtin_amdgcn_s_barrier()
#define PG8_SCHED __builtin_amdgcn_sched_barrier(0)
    Unit cur, nxt; int ui = 0;
    if (!S.next(0, cur)) return;
    f32x4 acc[2][2][4][2];
#pragma unroll
    for (int a = 0; a < 2; ++a)
#pragma unroll
        for (int b = 0; b < 2; ++b)
#pragma unroll
            for (int m = 0; m < 4; ++m)
#pragma unroll
                for (int n = 0; n < 2; ++n) acc[a][b][m][n] = (f32x4){0.f, 0.f, 0.f, 0.f};
    bf16x8 At[4][2], B0[2][2], B1[2][2];
    const char* cA = (const char*)g.A + (size_t)cur.pm * tstep; const char* cB = (const char*)g.Bt + (size_t)cur.pn * tstep;
    S.a_ready(cur);
    if constexpr (SP2) {
        PG8_STAGE(PG8_SB(0, 0), cB, voffB); PG8_STAGE(PG8_SB(0, 1), cB + hstep, voffB); PG8_STAGE(PG8_SA(0, 0), cA, voffA); PG8_STAGE(PG8_SA(0, 1), cA + hstep, voffA);
        if (wr == 1) PG8_BAR;
        PG8_WAIT_V(2); PG8_BAR;
        PG8_STAGE(PG8_SB(1, 0), cB + kstep, voffB); PG8_STAGE(PG8_SA(1, 0), cA + kstep, voffA); PG8_STAGE(PG8_SB(1, 1), cB + hstep + kstep, voffB);
        PG8_WAIT_V(6); PG8_BAR;
    } else {
        PG8_STAGE(PG8_SB(0, 0), cB, voffB); PG8_STAGE(PG8_SA(0, 0), cA, voffA); PG8_STAGE(PG8_SB(0, 1), cB + hstep, voffB); PG8_STAGE(PG8_SA(0, 1), cA + hstep, voffA);
        if (wr == 1) PG8_BAR;
        PG8_WAIT_V(4); PG8_BAR;
        PG8_STAGE(PG8_SB(1, 0), cB + kstep, voffB); PG8_STAGE(PG8_SA(1, 0), cA + kstep, voffA); PG8_STAGE(PG8_SB(1, 1), cB + hstep + kstep, voffB);
        PG8_WAIT_V(6); PG8_BAR;
    }
    for (;;) {
        const bool has_next = S.next(ui + 1, nxt);
        const char* nA = has_next ? (const char*)g.A + (size_t)nxt.pm * tstep : cA; const char* nB = has_next ? (const char*)g.Bt + (size_t)nxt.pn * tstep : cB;
        for (int t = 0; t < nt; t += 2) {
            const bool last = (t == nt - 2);
            const char* a1 = cA + (size_t)(t + 1) * kstep;
            const char* a2 = last ? nA : cA + (size_t)(t + 2) * kstep; const char* b2 = last ? nB : cB + (size_t)(t + 2) * kstep;
            const char* a3 = a2 + kstep; const char* b3 = b2 + kstep;
            if (last && has_next) S.a_ready(nxt);
            if constexpr (SP2) {
            PG8_LDB(B0, 0, 0); PG8_LDB(B1, 0, 1); PG8_SCHED; PG8_LDA(At, 0, 0); PG8_STAGE(PG8_SA(1, 1), a1 + hstep, voffA);
            PG8_WAIT_V(8); PG8_WAIT_L(0); PG8_BAR; PG8_MMA(0, 0, At, B0); PG8_MMA(0, 1, At, B1); PG8_BAR; PG8_SCHED;
            PG8_LDA(At, 0, 1); PG8_STAGE(PG8_SB(0, 0), b2, voffB); PG8_STAGE(PG8_SB(0, 1), b2 + hstep, voffB); PG8_STAGE(PG8_SA(0, 0), a2, voffA);
            PG8_WAIT_V(8); PG8_WAIT_L(0); PG8_BAR; PG8_MMA(1, 0, At, B0); PG8_MMA(1, 1, At, B1); PG8_BAR; PG8_SCHED;
            PG8_LDB(B0, 1, 0); PG8_LDB(B1, 1, 1); PG8_SCHED; PG8_LDA(At, 1, 0); PG8_STAGE(PG8_SA(0, 1), a2 + hstep, voffA);
            PG8_WAIT_V(8); PG8_WAIT_L(0); PG8_BAR; PG8_MMA(0, 0, At, B0); PG8_MMA(0, 1, At, B1); PG8_BAR; PG8_SCHED;
            PG8_LDA(At, 1, 1); PG8_STAGE(PG8_SB(1, 0), b3, voffB); PG8_STAGE(PG8_SB(1, 1), b3 + hstep, voffB); PG8_STAGE(PG8_SA(1, 0), a3, voffA);
            PG8_WAIT_V(8); PG8_WAIT_L(0); PG8_BAR; PG8_MMA(1, 0, At, B0); PG8_MMA(1, 1, At, B1); PG8_BAR; PG8_SCHED;
            } else {
            PG8_LDB(B0, 0, 0); PG8_SCHED; PG8_LDA(At, 0, 0); PG8_STAGE(PG8_SA(1, 1), a1 + hstep, voffA);
            PG8_WAIT_L(8); PG8_BAR; PG8_WAIT_L(0); PG8_MMA(0, 0, At, B0); PG8_BAR; PG8_SCHED;
            PG8_LDB(B1, 0, 1); PG8_STAGE(PG8_SB(0, 0), b2, voffB);
            PG8_BAR; PG8_WAIT_L(0); PG8_MMA(0, 1, At, B1); PG8_BAR;
            PG8_LDA(At, 0, 1); PG8_STAGE(PG8_SA(0, 0), a2, voffA);
            PG8_BAR; PG8_WAIT_L(0); PG8_MMA(1, 0, At, B0); PG8_BAR; PG8_SCHED;
            PG8_STAGE(PG8_SB(0, 1), b2 + hstep, voffB);
            PG8_WAIT_V(6); PG8_BAR; PG8_MMA(1, 1, At, B1); PG8_BAR;
            PG8_LDB(B0, 1, 0); PG8_SCHED; PG8_LDA(At, 1, 0); PG8_STAGE(PG8_SA(0, 1), a2 + hstep, voffA);
            PG8_WAIT_L(8); PG8_BAR; PG8_WAIT_L(0); PG8_MMA(0, 0, At, B0); PG8_BAR; PG8_SCHED;
            PG8_LDB(B1, 1, 1); PG8_STAGE(PG8_SB(1, 0), b3, voffB);
            PG8_BAR; PG8_WAIT_L(0); PG8_MMA(0, 1, At, B1); PG8_BAR;
            PG8_LDA(At, 1, 1); PG8_STAGE(PG8_SA(1, 0), a3, voffA);
            PG8_BAR; PG8_WAIT_L(0); PG8_MMA(1, 0, At, B0); PG8_BAR; PG8_SCHED;
            PG8_STAGE(PG8_SB(1, 1), b3 + hstep, voffB);
            PG8_WAIT_V(6); PG8_BAR; PG8_MMA(1, 1, At, B1); PG8_BAR;
            }
        }
        if constexpr (ALIGN_EPI) { if (wr == 0) PG8_BAR; }
        if constexpr (!Epi::AFTER_DRAIN) { E(acc, cur, wr, wc, fr, fq); S.done(cur); }
        if (!has_next) break;
#pragma unroll
        for (int a = 0; a < 2; ++a)
#pragma unroll
            for (int b = 0; b < 2; ++b)
#pragma unroll
                for (int m = 0; m < 4; ++m)
#pragma unroll
                    for (int n = 0; n < 2; ++n) acc[a][b][m][n] = (f32x4){0.f, 0.f, 0.f, 0.f};
        cur = nxt; cA = nA; cB = nB; ++ui;
        if constexpr (ALIGN_EPI) { if (wr == 1) PG8_BAR; }
    }
    PG8_WAIT_V(0);
    if constexpr (!ALIGN_EPI) { if (wr == 0) PG8_BAR; }
    PG8_BAR;
    if constexpr (Epi::AFTER_DRAIN) { E.fused(acc, cur, wr, wc, fr, fq, lds, wid, lane); S.done(cur); }
#undef PG8_SA
#undef PG8_SB
#undef PG8_STAGE
#undef PG8_LDA
#undef PG8_LDB
#undef PG8_MMA
#undef PG8_WAIT_V
#undef PG8_WAIT_L
#undef PG8_BAR
#undef PG8_SCHED
}
}
#define GAS __attribute__((address_space(1)))
#define LAS __attribute__((address_space(3)))
typedef unsigned short bf16;
typedef unsigned v4u __attribute__((ext_vector_type(4)));
typedef float f32x4 __attribute__((ext_vector_type(4)));
typedef short bf16x8 __attribute__((ext_vector_type(8)));
typedef GAS unsigned gu32;
typedef GAS unsigned long long gu64;
#define RLX_AGENT __ATOMIC_RELAXED, __HIP_MEMORY_SCOPE_AGENT
#define LDS_WAIT() asm volatile("s_waitcnt lgkmcnt(0)" ::: "memory")
#define VM_WAIT() asm volatile("s_waitcnt vmcnt(0)" ::: "memory")
__device__ __forceinline__ unsigned long long rt() { return __builtin_amdgcn_s_memrealtime(); }
__device__ __forceinline__ unsigned f2bf(float f) { unsigned u = __builtin_bit_cast(unsigned, f); return (u + 0x7fffu + ((u >> 16) & 1u)) >> 16; }
__device__ __forceinline__ unsigned pk2(float lo, float hi) { return f2bf(lo) | (f2bf(hi) << 16); }

#define XB_TMO      128
#define XB_XCNT(j)  (256  + 64 * (j))
#define XB_XSUB(j)  (1280 + 64 * (j))
#define XB_XGEN(j)  (2304 + 64 * (j))
#define XB_TOP      3328
#define XB_TOPGEN   3392
#define XCD_BAR_WORDS 3456
#define XB_SPIN_CAP (1u << 18)

__device__ __forceinline__ unsigned xb_ld(unsigned* p)              { return __hip_atomic_load(p, __ATOMIC_RELAXED, __HIP_MEMORY_SCOPE_AGENT); }
__device__ __forceinline__ unsigned xb_add(unsigned* p, unsigned v) { return __hip_atomic_fetch_add(p, v, __ATOMIC_RELAXED, __HIP_MEMORY_SCOPE_AGENT); }
__device__ __forceinline__ unsigned xb_xcc_id() { return (unsigned)__builtin_amdgcn_s_getreg((3 << 11) | 20) & 0xFu; }
#define XB_SPIN(cond, bar) do { unsigned _sp = 0; while (cond) { __builtin_amdgcn_s_sleep(1); \
    if ((++_sp & 255u) == 0u) { if (xb_ld(&(bar)[XB_TMO])) break; if (_sp > XB_SPIN_CAP) { atomicAdd(&(bar)[XB_TMO], 1u); break; } } } } while (0)

struct XcdBarrier {
    unsigned* bar; unsigned x;
    volatile LAS unsigned* st;
};

__device__ __forceinline__ XcdBarrier xcd_barrier_post(unsigned* bar, volatile LAS unsigned* st) {
    XcdBarrier b; b.bar = bar; b.x = xb_xcc_id(); b.st = st;
    if (threadIdx.x == 0) (void)xb_add(&bar[XB_XCNT(b.x)], 1u);
    return b;
}
__device__ __forceinline__ void xcd_barrier_complete(unsigned* bar, unsigned x, unsigned& nloc, unsigned& nx) {
    const unsigned G = gridDim.x * gridDim.y * gridDim.z;
    unsigned sum, cnt, mine, sp = 0u;
    for (;;) {
        sum = 0u; cnt = 0u; mine = 0u;
#pragma unroll
        for (unsigned j = 0; j < 16; ++j) { const unsigned c = xb_ld(&bar[XB_XCNT(j)]); sum += c; cnt += (c > 0u) ? 1u : 0u; mine = (j == x) ? c : mine; }
        if (sum == G) break;
        __builtin_amdgcn_s_sleep(1);
        if ((++sp & 255u) == 0u) { if (xb_ld(&bar[XB_TMO])) break; if (sp > XB_SPIN_CAP) { atomicAdd(&bar[XB_TMO], 1u); break; } }
    }
    nloc = mine > 0u ? mine : 1u; nx = cnt > 0u ? cnt : 1u;
}

__device__ __forceinline__ void xcd_barrier(const XcdBarrier& b) {
    asm volatile("s_waitcnt vmcnt(0)" ::: "memory");
    __syncthreads();
    if (threadIdx.x == 0) {
        unsigned* bar = b.bar;
        __builtin_amdgcn_s_waitcnt(0);
        unsigned nloc = b.st[0], nx = b.st[1];
        if (nloc == 0u) { xcd_barrier_complete(bar, b.x, nloc, nx); b.st[0] = nloc; b.st[1] = nx; }
        const unsigned old = xb_add(&bar[XB_XSUB(b.x)], 1u);
        const unsigned gen = old / nloc;
        if (old + 1u == (gen + 1u) * nloc) {
            __builtin_amdgcn_fence(__ATOMIC_RELEASE, "agent");
            asm volatile("s_waitcnt vmcnt(0)" ::: "memory");
            const unsigned og = xb_add(&bar[XB_TOP], 1u);
            const unsigned tg = og / nx;
            if (og + 1u == (tg + 1u) * nx) xb_add(&bar[XB_TOPGEN], 1u);
            else XB_SPIN(xb_ld(&bar[XB_TOPGEN]) == tg, bar);
            __builtin_amdgcn_fence(__ATOMIC_ACQUIRE, "agent");
            xb_add(&bar[XB_XGEN(b.x)], 1u);
            asm volatile("s_waitcnt vmcnt(0)" ::: "memory");
        } else {
            XB_SPIN(xb_ld(&bar[XB_XGEN(b.x)]) == gen, bar);
            __builtin_amdgcn_fence(__ATOMIC_ACQUIRE, "agent");
            asm volatile("s_waitcnt vmcnt(0)" ::: "memory");
        }
    }
    __syncthreads();
}


constexpr int NWAVES = 8;
constexpr int D = 1024, ML = 16384, MC = 256, M = ML + MC, DFF = 2816;
constexpr int NIN = 7712, NINP = 7936;
constexpr int NSC = 32, SCL = 512;
constexpr float EPS = 1e-6f;
static_assert(pg8::EP_ML == ML, "epilogue constant");

constexpr size_t MiB = 1u << 20, KiB = 1024;
constexpr size_t WS_CTL = 0, CTL_ZERO_BYTES = 1 * MiB;
constexpr size_t WS_SMALL = 1 * MiB;
constexpr size_t WS_HCTX = 9 * MiB;
constexpr size_t WS_FCTX = 10 * MiB;
constexpr size_t WS_RX = 11 * MiB;
constexpr size_t WS_ZQ = 44 * MiB;
constexpr size_t WS_XBC = 109 * MiB;
constexpr size_t WS_V = WS_XBC + (size_t)M * 1536 * 2;
constexpr size_t WS_G = WS_V + (size_t)M * 1024 * 2;
constexpr size_t WS_DT = WS_G + (size_t)M * 1024 * 2;
constexpr size_t WS_WIN = 227 * MiB;
static_assert(WS_DT + (size_t)M * 64 * 4 <= WS_WIN && WS_WIN + (size_t)NINP * 1024 * 2 <= 256 * MiB, "ws map (mixer phase)");
constexpr size_t WS_WREST = 216 * MiB;
constexpr size_t WO_OUT = 0, WO_UP0 = 4 * MiB, WO_DOWN0 = 15 * MiB, WO_OD = WO_DOWN0 + (size_t)DFF * 1024 * 2, WO_VG = WO_OD + 1 * MiB, WO_UP1 = WO_VG + 2 * MiB, WO_DOWN1 = WO_UP1 + 11 * MiB;
static_assert(WO_DOWN1 + (size_t)DFF * 1024 * 2 <= 40 * MiB, "weights overlay");
constexpr size_t WS_HID = WS_XBC;
static_assert(WS_HID + (size_t)M * DFF * 2 <= WS_WREST, "hidden overlay");
constexpr size_t WS_U = WS_ZQ;
constexpr size_t WS_A2 = WS_U + (size_t)M * 512 * 4;
static_assert(WS_A2 + (size_t)ML * 512 * 2 <= WS_XBC, "layer-1 overlay");
constexpr size_t WS_YS = WS_XBC;
constexpr size_t SM_ADAP = 0;
constexpr size_t SM_MODS = SM_ADAP + 2 * 2 * 8 * 6144 * 4;
constexpr size_t SM_LB = SM_MODS + 2 * 2 * 6144 * 4;
constexpr size_t SM_LAM = SM_LB + 4096;
constexpr size_t SM_LAMP = SM_LAM + 2 * 2048 * 2 * 4;
constexpr size_t SM_BB = SM_LAMP + 2 * 2048 * 2 * 4;
constexpr size_t SM_STATS = SM_BB + 2 * 2048 * 16 * 2 * 4;
constexpr size_t SM_SSDDEC = SM_STATS + (size_t)M * 16 * 4;
constexpr size_t SM_HGDEC = SM_SSDDEC + 33 * 32 * 4 + 128;
constexpr size_t SM_S5ST = ((SM_HGDEC + 33 * 16 * 128 * 4 + 255) / 256) * 256;
static_assert(SM_S5ST + 65 * 2 * 2048 * 2 * 4 <= 8 * MiB, "small tables");
constexpr size_t SSD_ST_BYTES = (size_t)33 * 32 * 8192 * 2;
static_assert(2 * SSD_ST_BYTES <= 33 * MiB && (size_t)M * 1024 * 2 <= 33 * MiB, "RX region");
constexpr int CW_BAR = 4096;

constexpr int RING_OFF = 0, RING_BYTES = 131072;
constexpr int LDSCTL_OFF = RING_BYTES, MISC_OFF = LDSCTL_OFF + 320;
constexpr int LDS_BYTES = 163840;


struct Params { const float* in[33]; float* out; unsigned char* ws; int ph_lo, ph_hi, use_bar, pad; };
enum { I_X = 0, I_C, I_CTX, I_CCTX, I_ADAW, I_ADAB, I_NMIX, I_NFFN, I_WGATE, I_WUP, I_WDOWN, I_FNORM, I_EVIN, I_EVOUT, I_CONVW, I_CONVB, I_DTB, I_ALOG, I_SSDD, I_SSDN, I_LBL, I_HGN,
       I_ODIN, I_ARE, I_AIM, I_LOGDT, I_BRE, I_BIM, I_CRE, I_CIM, I_S5D, I_WVAL, I_WGATE2 };
typedef _Float16 f16x8 __attribute__((ext_vector_type(8)));
typedef _Float16 f16;
typedef _Float16 f16x2 __attribute__((ext_vector_type(2)));
typedef float f32x2 __attribute__((ext_vector_type(2)));
__device__ __forceinline__ float bf2f(unsigned b) { return __uint_as_float(b << 16); }
__device__ __forceinline__ float siluf(float x) { return x / (1.f + __expf(-x)); }
__device__ __forceinline__ float wave_sum(float v) {
#pragma unroll
    for (int o = 1; o < 64; o <<= 1) v += __shfl_xor(v, o);
    return v;
}
__device__ __forceinline__ void unpack8(const v4u r, float (&x)[8]) {
    x[0] = bf2f(r.x & 0xffffu); x[1] = bf2f(r.x >> 16); x[2] = bf2f(r.y & 0xffffu); x[3] = bf2f(r.y >> 16);
    x[4] = bf2f(r.z & 0xffffu); x[5] = bf2f(r.z >> 16); x[6] = bf2f(r.w & 0xffffu); x[7] = bf2f(r.w >> 16);
}
__device__ __forceinline__ void tr_item(const float* W, int ldw, int col0, int K, bf16* WT, int dst_row0, LAS float* scr, int kb, int lane) {
    const int k0 = 64 * kb;
#pragma unroll 8
    for (int i = 0; i < 32; ++i) { const int kk = 2 * i + (lane >> 5); scr[kk * 33 + (lane & 31)] = W[(size_t)(k0 + kk) * ldw + col0 + (lane & 31)]; }
    LDS_WAIT(); asm volatile("" ::: "memory");
    const int c = lane & 7;
#pragma unroll
    for (int j = 0; j < 4; ++j) { const int n = (lane >> 3) + 8 * j; const LAS float* s = scr + (8 * c) * 33 + n;
        v4u o; o.x = pk2(s[0 * 33], s[1 * 33]); o.y = pk2(s[2 * 33], s[3 * 33]); o.z = pk2(s[4 * 33], s[5 * 33]); o.w = pk2(s[6 * 33], s[7 * 33]);
        *(GAS v4u*)(WT + (size_t)(dst_row0 + n) * K + k0 + 8 * c) = o; }
    LDS_WAIT(); asm volatile("" ::: "memory");
}
__device__ __forceinline__ int dst_row_of(int mode, int c0) {
    if (mode == 0) return c0 < 2560 ? c0 : (c0 < 2592 ? 7680 + (c0 - 2560) : c0 - 32);
    if (mode == 1) return c0;
    return (c0 >> 7) * 256 + (mode == 3 ? 128 : 0) + (c0 & 127);
}
__device__ __forceinline__ void tr_job(const float* W, int K, int N, int mode, bf16* WT, LAS float* scr, int gw, int ngw, int lane) {
    const int nblk = N / 32, nit = (K / 64) * nblk;
    for (int it = gw; it < nit; it += ngw) { const int kb = it / nblk, nb = it % nblk; tr_item(W, N, 32 * nb, K, WT, dst_row_of(mode, 32 * nb), scr, kb, lane); }
}

__device__ __forceinline__ void phase_prologue(const Params& p, LAS unsigned char* lds, int bid, int G, int tid, int wave, int lane) {
    unsigned char* ws = p.ws; float* sm_adap = (float*)(ws + WS_SMALL + SM_ADAP);
    for (int it = bid; it < 192; it += G) {
        const int layer = it / 96, rem = it % 96, cb = rem / 8, ks = rem % 8;
        LAS float* sl = (LAS float*)lds; LAS float* sc = sl + 128;
        if (tid < 128) { sl[tid] = siluf(p.in[I_C][ks * 128 + tid]); sc[tid] = siluf(p.in[I_CCTX][ks * 128 + tid]); }
        __syncthreads();
        const int col = cb * 512 + tid; const float* W = p.in[I_ADAW] + (size_t)layer * 1024 * 6144 + (size_t)(ks * 128) * 6144 + col;
        float a0 = 0.f, a1 = 0.f;
#pragma unroll 8
        for (int k = 0; k < 128; ++k) { const float w = W[(size_t)k * 6144]; a0 += sl[k] * w; a1 += sc[k] * w; }
        sm_adap[((layer * 2 + 0) * 8 + ks) * 6144 + col] = a0; sm_adap[((layer * 2 + 1) * 8 + ks) * 6144 + col] = a1;
        __syncthreads();
    }
    const int gw = bid * NWAVES + wave, ngw = G * NWAVES;
    LAS float* scr = (LAS float*)(lds + wave * 16384);
    bf16* win = (bf16*)(ws + WS_WIN);
    tr_job(p.in[I_EVIN], 1024, NIN, 0, win, scr, gw, ngw, lane);
    { const int gt = bid * 512 + tid, nt = G * 512; v4u z = {0u, 0u, 0u, 0u};
      for (int i = gt; i < (NINP - NIN) * 1024 / 8; i += nt) *(GAS v4u*)(win + (size_t)NIN * 1024 + (size_t)i * 8) = z; }
    const int gt = bid * 512 + tid;
    if (gt < 1024) { const float l0 = p.in[I_LBL][gt], l1 = p.in[I_LBL][1024 + gt]; const float mx = fmaxf(l0, l1), e0 = __expf(l0 - mx), e1 = __expf(l1 - mx); ((float*)(ws + WS_SMALL + SM_LB))[gt] = e0 / (e0 + e1); }
    if (gt >= 4096 && gt < 8192) {
        const int s = gt - 4096, dg = s >> 6;
        const float dt = expf(p.in[I_LOGDT][dg]), are = p.in[I_ARE][s], aim = p.in[I_AIM][s];
        const float mag = expf(are * dt); float sn, cs; sincosf(aim * dt, &sn, &cs);
        const float lr = mag * cs, li = mag * sn, den = are * are + aim * aim;
        const float cr = ((lr - 1.f) * are + li * aim) / den, ci = (li * are - (lr - 1.f) * aim) / den;
        float* lam = (float*)(ws + WS_SMALL + SM_LAM); lam[2 * s] = lr; lam[2 * s + 1] = li;
        float pr = lr, pi = li;
#pragma unroll
        for (int q = 0; q < 8; ++q) { const float nr = pr * pr - pi * pi, ni = 2.f * pr * pi; pr = nr; pi = ni; }
        float* lamp = (float*)(ws + WS_SMALL + SM_LAMP); lamp[2 * s] = pr; lamp[2 * s + 1] = pi;
        float* bb = (float*)(ws + WS_SMALL + SM_BB) + (size_t)s * 32;
#pragma unroll
        for (int c = 0; c < 16; ++c) { const float br = p.in[I_BRE][(size_t)s * 16 + c], bi = p.in[I_BIM][(size_t)s * 16 + c]; bb[2 * c] = cr * br - ci * bi; bb[2 * c + 1] = cr * bi + ci * br; }
    }
}

__device__ __forceinline__ void phase_rownorm(const Params& p, LAS unsigned char* lds, int bid, int G, int tid, int wave, int lane, int layer, int kind  , int nrows,
                                              const float* src_lat, const float* src_ctx, bool from_partials) {
    unsigned char* ws = p.ws; const float* adap = (const float*)(ws + WS_SMALL + SM_ADAP); float* mods = (float*)(ws + WS_SMALL + SM_MODS);
    LAS float* Gt = (LAS float*)lds; LAS float* St = Gt + 2048;
    const float* ng = p.in[kind == 0 ? I_NMIX : I_NFFN] + layer * 1024;
    for (int idx = tid; idx < 4096; idx += 512) {
        const int vec = idx >> 11, which = (idx >> 10) & 1, col = idx & 1023, j = (kind * 3 + which) * 1024 + col;
        float v;
        if (from_partials) { v = p.in[I_ADAB][layer * 6144 + j];
#pragma unroll
            for (int ks = 0; ks < 8; ++ks) v += adap[((layer * 2 + vec) * 8 + ks) * 6144 + j]; }
        else v = mods[(layer * 2 + vec) * 6144 + j];
        if (which == 0) St[vec * 1024 + col] = v; else Gt[vec * 1024 + col] = ng[col] * (1.f + v);
    }
    if (from_partials && bid < 48) {
        const int idx = bid * 512 + tid, lv = idx / 6144, j = idx % 6144, ly = lv >> 1;
        float v = p.in[I_ADAB][ly * 6144 + j];
#pragma unroll
        for (int ks = 0; ks < 8; ++ks) v += adap[(lv * 8 + ks) * 6144 + j];
        mods[idx] = v;
    }
    __syncthreads();
    bf16* XN = (bf16*)(ws + WS_RX);
    const int gw = bid * NWAVES + wave, ngw = G * NWAVES;
    for (int row = gw; row < nrows; row += ngw) {
        const int vec = row >= ML ? 1 : 0; const float* xr = vec ? src_ctx + (size_t)(row - ML) * 1024 : src_lat + (size_t)row * 1024;
        f32x4 v[4]; float ss = 0.f;
#pragma unroll
        for (int j = 0; j < 4; ++j) { v[j] = *(const GAS f32x4*)(xr + 4 * lane + 256 * j); ss += (v[j].x * v[j].x + v[j].y * v[j].y) + (v[j].z * v[j].z + v[j].w * v[j].w); }
        const float r = rsqrtf(wave_sum(ss) * (1.f / 1024.f) + EPS);
#pragma unroll
        for (int j = 0; j < 4; ++j) { const int c = 4 * lane + 256 * j; const LAS float* g4 = Gt + vec * 1024 + c; const LAS float* s4 = St + vec * 1024 + c;
            const unsigned lo = pk2(v[j].x * r * g4[0] + s4[0], v[j].y * r * g4[1] + s4[1]), hi = pk2(v[j].z * r * g4[2] + s4[2], v[j].w * r * g4[3] + s4[3]);
            *(GAS unsigned long long*)(XN + (size_t)row * 1024 + c) = (unsigned long long)lo | ((unsigned long long)hi << 32); }
    }
}

typedef float f32x16 __attribute__((ext_vector_type(16)));
typedef short s16x4 __attribute__((ext_vector_type(4)));
#define MFMA32(a, b, c) __builtin_amdgcn_mfma_f32_32x32x16_bf16((a), (b), (c), 0, 0, 0)
__device__ __forceinline__ bf16x8 frag_rows(LAS const unsigned char* img, int RS, int row0, int kbyte, int lane) { return *(const LAS bf16x8*)(img + (row0 + (lane & 31)) * RS + kbyte + (lane >> 5) * 16); }
__device__ __forceinline__ bf16x8 frag_tr(LAS const unsigned char* img, int RS, int k0, int col0, int lane) {
    const int h = lane >> 5, blk = (lane >> 4) & 1, q = (lane & 15) >> 2, p = lane & 3;
    LAS const unsigned char* a = img + (k0 + 8 * h + q) * RS + (col0 + 16 * blk + 4 * p) * 2;
    const s16x4 lo = __builtin_amdgcn_ds_read_tr16_b64_v4i16((LAS s16x4*)a), hi = __builtin_amdgcn_ds_read_tr16_b64_v4i16((LAS s16x4*)(a + 4 * RS));
    return (bf16x8){lo[0], lo[1], lo[2], lo[3], hi[0], hi[1], hi[2], hi[3]};
}
__device__ __forceinline__ int arow(int reg, int h) { return (reg & 3) + 8 * (reg >> 2) + 4 * h; }
__device__ __forceinline__ void store_acc_nat(const f32x16& acc, LAS unsigned char* img, int RS, int n0, int m0, int lane) {
    LAS unsigned char* base = img + (n0 + (lane & 31)) * RS + (m0 + 4 * (lane >> 5)) * 2;
#pragma unroll
    for (int g = 0; g < 4; ++g) *(LAS unsigned long long*)(base + 16 * g) = (unsigned long long)pk2(acc[4 * g], acc[4 * g + 1]) | ((unsigned long long)pk2(acc[4 * g + 2], acc[4 * g + 3]) << 32);
}

struct ScanPtrs { const bf16* XBC; const float* DT; bf16* ZQ; const bf16* V; const bf16* G; f16* Flat; f16* Fctx; float* STATS; const float* convw; const float* convb; const float* ssdd; const float* hgn;
                  bf16* SSD_ST; bf16* HG_ST; float* SSD_DEC; float* HG_DEC; bf16* YFS; };
template <int MODE, int D>
__device__ __forceinline__ void ssd_scan(const ScanPtrs& sp, LAS unsigned char* lds, int row_begin, int nchunks, int seq_lo, int seq_hi, int h, const bf16* st_in, bf16* st_out, float* dec_out, bf16* yfs, int tid) {
    const int lane = tid & 63, wave = __builtin_amdgcn_readfirstlane(tid >> 6), hf = lane >> 5, g = h >> 3;
    LAS unsigned char* XI = lds; LAS unsigned char* XE = lds + 9216; LAS unsigned char* BI = lds + 18432; LAS unsigned char* CI = lds + 35840; LAS unsigned char* MI = lds + 53248; LAS unsigned char* SPI = lds + 62464;
    LAS float* YB = (LAS float*)(lds + 79872); LAS unsigned char* XR = lds + 97280; LAS unsigned char* BR = lds + 105984; LAS float* WT = (LAS float*)(lds + 123392); LAS unsigned char* CR = lds + 132096;
    LAS float* AC = (LAS float*)(lds + 149504); LAS float* EA = AC + 64; LAS float* ES = AC + 128; LAS float* DTS = AC + 192;
    asm volatile("" : "+s"(nchunks));
    for (int i = tid; i < 1920; i += 512) { int col, j;
        if (i < 384) { j = i >> 6; col = h * 64 + (i & 63); } else if (i < 1152) { const int i2 = i - 384; j = i2 >> 7; col = 1024 + g * 128 + (i2 & 127); } else { const int i2 = i - 1152; j = i2 >> 7; col = 1280 + g * 128 + (i2 & 127); }
        WT[i] = j < 5 ? sp.convw[j * 1536 + col] : sp.convb[col]; }
    const int nb = wave >> 1, pb = wave & 1;
    f32x16 accS;
#pragma unroll
    for (int r = 0; r < 16; ++r) accS[r] = st_in ? bf2f(*(const GAS unsigned short*)(st_in + (32 * nb + arow(r, hf)) * 64 + 32 * pb + (lane & 31))) : 0.f;
    if (MODE != 0) store_acc_nat(accS, SPI, 272, 32 * pb, 32 * nb, lane);
    float ltot = 0.f; const float dsk = sp.ssdd[h];
    constexpr int NU = MODE != 0 ? 2720 : 1632, NPF = MODE != 0 ? 6 : 4;
    v4u pf[NPF]; float pdt = 0.f, pla = 0.f;
    const v4u zero4 = {0u, 0u, 0u, 0u};
#define SSD_LOAD(c_, tid) do { const int rb_ = row_begin + 64 * (c_) - 2; \
        _Pragma("unroll") for (int i_ = 0; i_ < NPF; ++i_) { const int u_ = tid + 512 * i_; int rr_, cc_; \
            if (u_ < 544) { rr_ = u_ >> 3; cc_ = h * 64 + (u_ & 7) * 8; } else if (u_ < 1632) { rr_ = (u_ - 544) >> 4; cc_ = 1024 + g * 128 + ((u_ - 544) & 15) * 8; } else { rr_ = (u_ - 1632) >> 4; cc_ = 1280 + g * 128 + ((u_ - 1632) & 15) * 8; } \
            rr_ += rb_; pf[i_] = (u_ < NU && rr_ >= seq_lo && rr_ < seq_hi) ? *(const GAS v4u*)(sp.XBC + (size_t)rr_ * 1536 + cc_) : zero4; } \
        if (tid < 64) { pdt = sp.DT[(size_t)(rb_ + 2 + tid) * 64 + D * 16 + h]; pla = sp.DT[(size_t)(rb_ + 2 + tid) * 64 + 32 + D * 16 + h]; } } while (0)
    SSD_LOAD(D == 0 ? 0 : nchunks - 1, tid);
#pragma unroll 1
    for (int ci = 0; ci < nchunks; ++ci) {
        const int c = D == 0 ? ci : nchunks - 1 - ci, r0 = row_begin + 64 * c;
        int tl = tid; asm volatile("" : "+v"(tl));
#pragma unroll
        for (int i = 0; i < NPF; ++i) { const int u = tl + 512 * i; if (u < NU) { if (u < 1632) *(LAS v4u*)(XR + u * 16) = pf[i]; else *(LAS v4u*)(CR + (u - 1632) * 16) = pf[i]; } }
        if (wave == 0) {
            float x = pla;
#pragma unroll
            for (int o = 1; o < 64; o <<= 1) { const float v = D == 0 ? __shfl_up(x, o) : __shfl_down(x, o); if (D == 0 ? (lane >= o) : (lane + o < 64)) x += v; }
            const float last = __shfl(x, D == 0 ? 63 : 0);
            AC[lane] = x; EA[lane] = __expf(x); ES[lane] = pdt * __expf(last - x); DTS[lane] = pdt;
            if (lane == 0) AC[256] = __expf(last);
            ltot += last;
        }
        __syncthreads();
        { const int t = tl >> 3, o8 = (tl & 7) * 8; float a8[8];
#pragma unroll
          for (int i = 0; i < 8; ++i) a8[i] = WT[320 + o8 + i];
#pragma unroll
          for (int j = 0; j < 5; ++j) { float x8[8]; unpack8(*(const LAS v4u*)(XR + (t + j) * 128 + o8 * 2), x8);
#pragma unroll
              for (int i = 0; i < 8; ++i) a8[i] += WT[j * 64 + o8 + i] * x8[i]; }
          const float es = ES[t]; v4u w, we;
#pragma unroll
          for (int i = 0; i < 8; ++i) a8[i] = siluf(a8[i]);
          w.x = pk2(a8[0], a8[1]); w.y = pk2(a8[2], a8[3]); w.z = pk2(a8[4], a8[5]); w.w = pk2(a8[6], a8[7]);
          we.x = pk2(a8[0] * es, a8[1] * es); we.y = pk2(a8[2] * es, a8[3] * es); we.z = pk2(a8[4] * es, a8[5] * es); we.w = pk2(a8[6] * es, a8[7] * es);
          *(LAS v4u*)(XI + t * 144 + o8 * 2) = w; *(LAS v4u*)(XE + t * 144 + o8 * 2) = we; }
        __builtin_amdgcn_sched_barrier(0);
#pragma unroll
        for (int u2 = 0; u2 < 2; ++u2) { const int u = tl + 512 * u2, t = u >> 4, o8 = (u & 15) * 8;
            { float a8[8];
#pragma unroll
              for (int i = 0; i < 8; ++i) a8[i] = WT[384 + 640 + o8 + i];
#pragma unroll
              for (int j = 0; j < 5; ++j) { float x8[8]; unpack8(*(const LAS v4u*)(BR + (t + j) * 256 + o8 * 2), x8);
#pragma unroll
                  for (int i = 0; i < 8; ++i) a8[i] += WT[384 + j * 128 + o8 + i] * x8[i]; }
              v4u w; w.x = pk2(siluf(a8[0]), siluf(a8[1])); w.y = pk2(siluf(a8[2]), siluf(a8[3])); w.z = pk2(siluf(a8[4]), siluf(a8[5])); w.w = pk2(siluf(a8[6]), siluf(a8[7]));
              *(LAS v4u*)(BI + t * 272 + o8 * 2) = w; }
            __builtin_amdgcn_sched_barrier(0);
            if (MODE != 0) { float a8[8];
#pragma unroll
              for (int i = 0; i < 8; ++i) a8[i] = WT[1152 + 640 + o8 + i];
#pragma unroll
              for (int j = 0; j < 5; ++j) { float x8[8]; unpack8(*(const LAS v4u*)(CR + (t + j) * 256 + o8 * 2), x8);
#pragma unroll
                  for (int i = 0; i < 8; ++i) a8[i] += WT[1152 + j * 128 + o8 + i] * x8[i]; }
              v4u w; w.x = pk2(siluf(a8[0]), siluf(a8[1])); w.y = pk2(siluf(a8[2]), siluf(a8[3])); w.z = pk2(siluf(a8[4]), siluf(a8[5])); w.w = pk2(siluf(a8[6]), siluf(a8[7]));
              *(LAS v4u*)(CI + t * 272 + o8 * 2) = w; }
            __builtin_amdgcn_sched_barrier(0); }
        if (ci + 1 < nchunks) SSD_LOAD(D == 0 ? ci + 1 : nchunks - 2 - ci, tl);
        __syncthreads();
        f32x16 accY;
        const int tb = (wave & 3) >> 1, qb = wave & 1;
        if (MODE != 0) {
            if (wave >= 4) { const int sb = tb; f32x16 a;
#pragma unroll
                for (int r = 0; r < 16; ++r) a[r] = 0.f;
#pragma unroll
                for (int ks = 0; ks < 8; ++ks) a = MFMA32(frag_rows(BI, 272, 32 * sb, 32 * ks, lane), frag_rows(CI, 272, 32 * qb, 32 * ks, lane), a);
                const int t = 32 * qb + (lane & 31); const float act = AC[t];
#pragma unroll
                for (int r = 0; r < 16; ++r) { const int s2 = 32 * sb + arow(r, hf); const bool keep = D == 0 ? (s2 <= t) : (s2 >= t); a[r] = keep ? a[r] * __expf(act - AC[s2]) * DTS[s2] : 0.f; }
                store_acc_nat(a, MI, 144, 32 * qb, 32 * sb, lane);
            } else {
#pragma unroll
                for (int r = 0; r < 16; ++r) accY[r] = 0.f;
#pragma unroll
                for (int ks = 0; ks < 8; ++ks) accY = MFMA32(frag_rows(CI, 272, 32 * tb, 32 * ks, lane), frag_rows(SPI, 272, 32 * qb, 32 * ks, lane), accY);
#pragma unroll
                for (int r = 0; r < 16; ++r) accY[r] *= EA[32 * tb + arow(r, hf)];
            }
            __syncthreads();
            if (wave < 4) {
#pragma unroll
                for (int ks = 0; ks < 4; ++ks) accY = MFMA32(frag_rows(MI, 144, 32 * tb, 32 * ks, lane), frag_tr(XI, 144, 16 * ks, 32 * qb, lane), accY);
#pragma unroll
                for (int r = 0; r < 16; ++r) YB[(32 * tb + arow(r, hf)) * 68 + 32 * qb + (lane & 31)] = accY[r];
            }
        }
        { const float el = AC[256];
#pragma unroll
          for (int r = 0; r < 16; ++r) accS[r] *= el;
#pragma unroll
          for (int ks = 0; ks < 4; ++ks) accS = MFMA32(frag_tr(BI, 272, 16 * ks, 32 * nb, lane), frag_tr(XE, 144, 16 * ks, 32 * pb, lane), accS);
          if (MODE != 0) store_acc_nat(accS, SPI, 272, 32 * pb, 32 * nb, lane); }
        __syncthreads();
        if (MODE != 0) {
            int t3 = tid; asm volatile("" : "+v"(t3)); const int t = t3 >> 3, p8 = (t3 & 7) * 8, row = r0 + t;
            const f32x4 y0 = *(const LAS f32x4*)(YB + t * 68 + p8), y1 = *(const LAS f32x4*)(YB + t * 68 + p8 + 4);
            GAS v4u* yp = (GAS v4u*)(yfs + (size_t)(row - row_begin) * 64 + p8);
            if (MODE == 1) { v4u w; w.x = pk2(y0.x, y0.y); w.y = pk2(y0.z, y0.w); w.z = pk2(y1.x, y1.y); w.w = pk2(y1.z, y1.w); *yp = w; }
            else { float yf[8], x8[8], z8[8]; unpack8(*yp, yf); unpack8(*(const LAS v4u*)(XI + t * 144 + p8 * 2), x8);
                GAS v4u* zp = (GAS v4u*)(sp.ZQ + (size_t)row * 2048 + h * 64 + p8); unpack8(*zp, z8);
                float o[8] = {y0.x, y0.y, y0.z, y0.w, y1.x, y1.y, y1.z, y1.w}; float ss = 0.f;
#pragma unroll
                for (int i = 0; i < 8; ++i) { o[i] = (o[i] + yf[i] + dsk * x8[i]) * z8[i]; ss += o[i] * o[i]; }
                v4u w; w.x = pk2(o[0], o[1]); w.y = pk2(o[2], o[3]); w.z = pk2(o[4], o[5]); w.w = pk2(o[6], o[7]); *zp = w;
                ss += __shfl_xor(ss, 1); ss += __shfl_xor(ss, 2); ss += __shfl_xor(ss, 4);
                if ((t3 & 7) == 0) sp.STATS[(size_t)row * 16 + h] = ss; }
        }
    }
#undef SSD_LOAD
    if (st_out) {
#pragma unroll
        for (int r = 0; r < 16; ++r) *(GAS unsigned short*)(st_out + (32 * nb + arow(r, hf)) * 64 + 32 * pb + (lane & 31)) = (unsigned short)f2bf(accS[r]); }
    if (dec_out && tid == 0) *dec_out = __expf(ltot);
    __syncthreads();
}
template <int MODE, int D>
__device__ __forceinline__ void hg_scan(const ScanPtrs& sp, LAS unsigned char* lds, int row_begin, int nchunks, int hh, const bf16* st_in, bf16* st_out, float* dec_out, int tid) {
    const int lane = tid & 63, wave = __builtin_amdgcn_readfirstlane(tid >> 6), h = lane >> 5;
    LAS unsigned char* QP = lds; LAS unsigned char* KP = lds + 17408; LAS unsigned char* VI = lds + 34816; LAS unsigned char* ATT = lds + 52224; LAS unsigned char* STI = lds + 61440;
    LAS float* OB = (LAS float*)(lds + 96256); LAS float* PAR = (LAS float*)(lds + 132096); LAS float* EL = (LAS float*)(lds + 136192);
    f16* Fit = (row_begin < ML) ? sp.Flat + (size_t)row_begin * 2048 : sp.Fctx + (size_t)(row_begin - ML) * 2048;
    const int k0 = (tid & 63) * 2, tg = wave, kb = wave >> 1, vb0 = (wave & 1) * 2;
    asm volatile("" : "+s"(nchunks));
    f32x16 accS[2];
#pragma unroll
    for (int i = 0; i < 2; ++i)
#pragma unroll
        for (int r = 0; r < 16; ++r) accS[i][r] = st_in ? bf2f(*(const GAS unsigned short*)(st_in + (32 * kb + arow(r, h)) * 128 + 32 * (vb0 + i) + (lane & 31))) : 0.f;
    if (MODE != 0) { store_acc_nat(accS[0], STI, 272, 32 * vb0, 32 * kb, lane); store_acc_nat(accS[1], STI, 272, 32 * (vb0 + 1), 32 * kb, lane); }
    float ltot0 = 0.f, ltot1 = 0.f;
    unsigned plf[8], pq[8]; v4u pv0, pv1;
    const int vr = tid >> 3, vc = (tid & 7) * 16;
#define HG_LOAD(c_) do { const int rr_ = 64 * (c_); \
        _Pragma("unroll") for (int i = 0; i < 8; ++i) { plf[i] = *(const GAS unsigned*)(Fit + (size_t)(rr_ + 8 * tg + i) * 2048 + D * 1024 + hh * 128 + k0); \
            if (MODE != 0) pq[i] = *(const GAS unsigned*)(sp.ZQ + (size_t)(row_begin + rr_ + 8 * tg + i) * 2048 + 1024 + hh * 128 + k0); } \
        const GAS v4u* vp_ = (const GAS v4u*)(sp.V + (size_t)(row_begin + rr_ + vr) * 1024 + hh * 128 + vc); pv0 = vp_[0]; pv1 = vp_[1]; } while (0)
    HG_LOAD(D == 0 ? 0 : nchunks - 1);
#pragma unroll 1
    for (int ci = 0; ci < nchunks; ++ci) {
        const int c = D == 0 ? ci : nchunks - 1 - ci, r0 = 64 * c;
        float lf0[8], lf1[8], cs0[8], cs1[8]; float run0 = 0.f, run1 = 0.f;
#pragma unroll
        for (int i = 0; i < 8; ++i) { const f16x2 hr = __builtin_bit_cast(f16x2, plf[i]); lf0[i] = (float)hr.x; lf1[i] = (float)hr.y; }
#pragma unroll
        for (int ii = 0; ii < 8; ++ii) { const int i = D == 0 ? ii : 7 - ii; run0 += lf0[i]; run1 += lf1[i]; cs0[i] = run0; cs1[i] = run1; }
        *(LAS f32x2*)(PAR + tg * 128 + k0) = (f32x2){run0, run1};
        __syncthreads();
        float off0 = 0.f, off1 = 0.f, tot0 = 0.f, tot1 = 0.f;
#pragma unroll
        for (int j = 0; j < 8; ++j) { const f32x2 pj = *(const LAS f32x2*)(PAR + j * 128 + k0); tot0 += pj.x; tot1 += pj.y; if (D == 0 ? (j < tg) : (j > tg)) { off0 += pj.x; off1 += pj.y; } }
#pragma unroll
        for (int i = 0; i < 8; ++i) { const float bc0 = off0 + cs0[i], bc1 = off1 + cs1[i], kk0 = 1.f - __expf(lf0[i]), kk1 = 1.f - __expf(lf1[i]); const int t = 8 * tg + i;
            if (MODE != 0) *(LAS unsigned*)(QP + t * 272 + k0 * 2) = pk2(bf2f(pq[i] & 0xffffu) * __expf(bc0), bf2f(pq[i] >> 16) * __expf(bc1));
            *(LAS unsigned*)(KP + t * 272 + k0 * 2) = pk2(kk0 * __expf(-bc0), kk1 * __expf(-bc1)); }
        if (tg == 0) { *(LAS f32x2*)(EL + k0) = (f32x2){__expf(tot0), __expf(tot1)}; ltot0 += tot0; ltot1 += tot1; }
        *(LAS v4u*)(VI + vr * 272 + vc * 2) = pv0; *(LAS v4u*)(VI + vr * 272 + vc * 2 + 16) = pv1;
        if (ci + 1 < nchunks) HG_LOAD(D == 0 ? ci + 1 : nchunks - 2 - ci);
        __syncthreads();
        f32x16 accO;
        if (MODE != 0) {
            if (wave < 4) { const int sb = wave >> 1, tb = wave & 1; f32x16 a;
#pragma unroll
                for (int r = 0; r < 16; ++r) a[r] = 0.f;
#pragma unroll
                for (int ks = 0; ks < 8; ++ks) a = MFMA32(frag_rows(KP, 272, 32 * sb, 32 * ks, lane), frag_rows(QP, 272, 32 * tb, 32 * ks, lane), a);
                const int t = 32 * tb + (lane & 31);
#pragma unroll
                for (int r = 0; r < 16; ++r) { const int s = 32 * sb + arow(r, h); if (D == 0 ? (s > t) : (s < t)) a[r] = 0.f; }
                store_acc_nat(a, ATT, 144, 32 * tb, 32 * sb, lane); }
            const int tb = wave >> 2, vb = wave & 3;
#pragma unroll
            for (int r = 0; r < 16; ++r) accO[r] = 0.f;
#pragma unroll
            for (int ks = 0; ks < 8; ++ks) accO = MFMA32(frag_rows(QP, 272, 32 * tb, 32 * ks, lane), frag_rows(STI, 272, 32 * vb, 32 * ks, lane), accO);
            __syncthreads();
#pragma unroll
            for (int ks = 0; ks < 4; ++ks) accO = MFMA32(frag_rows(ATT, 144, 32 * tb, 32 * ks, lane), frag_tr(VI, 272, 16 * ks, 32 * vb, lane), accO);
#pragma unroll
            for (int r = 0; r < 16; ++r) OB[(32 * tb + arow(r, h)) * 132 + 32 * vb + (lane & 31)] = accO[r];
        }
#pragma unroll
        for (int ks = 0; ks < 4; ++ks) { const bf16x8 a = frag_tr(KP, 272, 16 * ks, 32 * kb, lane);
            accS[0] = MFMA32(a, frag_tr(VI, 272, 16 * ks, 32 * vb0, lane), accS[0]); accS[1] = MFMA32(a, frag_tr(VI, 272, 16 * ks, 32 * (vb0 + 1), lane), accS[1]); }
#pragma unroll
        for (int r = 0; r < 16; ++r) { const float e = EL[32 * kb + arow(r, h)]; accS[0][r] *= e; accS[1][r] *= e; }
        if (MODE != 0) { store_acc_nat(accS[0], STI, 272, 32 * vb0, 32 * kb, lane); store_acc_nat(accS[1], STI, 272, 32 * (vb0 + 1), 32 * kb, lane); }
        __syncthreads();
        if (MODE != 0) {
            const int t = tid >> 3, c16 = (tid & 7) * 16, row = row_begin + r0 + t;
            float o[16];
#pragma unroll
            for (int j = 0; j < 4; ++j) { const f32x4 x = *(const LAS f32x4*)(OB + t * 132 + c16 + 4 * j); o[4 * j] = x.x; o[4 * j + 1] = x.y; o[4 * j + 2] = x.z; o[4 * j + 3] = x.w; }
            f16* fp = Fit + (size_t)(r0 + t) * 2048 + hh * 128 + c16;
            if (MODE == 1) { f16x8 a, b;
#pragma unroll
                for (int j = 0; j < 8; ++j) { a[j] = (f16)o[j]; b[j] = (f16)o[8 + j]; }
                *(GAS f16x8*)fp = a; *(GAS f16x8*)(fp + 8) = b; }
            else { const f16x8 a = *(const GAS f16x8*)fp, b = *(const GAS f16x8*)(fp + 8); float ss = 0.f;
#pragma unroll
                for (int j = 0; j < 8; ++j) { o[j] += (float)a[j]; o[8 + j] += (float)b[j]; }
#pragma unroll
                for (int j = 0; j < 16; ++j) ss += o[j] * o[j];
                ss += __shfl_xor(ss, 1); ss += __shfl_xor(ss, 2); ss += __shfl_xor(ss, 4);
                const float rn = rsqrtf(ss * (1.f / 128.f) + EPS);
                float g8[8], g9[8]; unpack8(*(const GAS v4u*)(sp.G + (size_t)row * 1024 + hh * 128 + c16), g8); unpack8(*(const GAS v4u*)(sp.G + (size_t)row * 1024 + hh * 128 + c16 + 8), g9);
                const float* hn = sp.hgn + c16;
                v4u w0, w1;
                w0.x = pk2(o[0] * rn * hn[0] * g8[0], o[1] * rn * hn[1] * g8[1]); w0.y = pk2(o[2] * rn * hn[2] * g8[2], o[3] * rn * hn[3] * g8[3]); w0.z = pk2(o[4] * rn * hn[4] * g8[4], o[5] * rn * hn[5] * g8[5]); w0.w = pk2(o[6] * rn * hn[6] * g8[6], o[7] * rn * hn[7] * g8[7]);
                w1.x = pk2(o[8] * rn * hn[8] * g9[0], o[9] * rn * hn[9] * g9[1]); w1.y = pk2(o[10] * rn * hn[10] * g9[2], o[11] * rn * hn[11] * g9[3]); w1.z = pk2(o[12] * rn * hn[12] * g9[4], o[13] * rn * hn[13] * g9[5]); w1.w = pk2(o[14] * rn * hn[14] * g9[6], o[15] * rn * hn[15] * g9[7]);
                GAS v4u* zp = (GAS v4u*)(sp.ZQ + (size_t)row * 2048 + 1024 + hh * 128 + c16); zp[0] = w0; zp[1] = w1; }
        }
    }
#undef HG_LOAD
    if (st_out) {
#pragma unroll
        for (int i = 0; i < 2; ++i)
#pragma unroll
            for (int r = 0; r < 16; ++r) *(GAS unsigned short*)(st_out + (32 * kb + arow(r, h)) * 128 + 32 * (vb0 + i) + (lane & 31)) = (unsigned short)f2bf(accS[i][r]); }
    if (dec_out && tg == 0) { dec_out[k0] = __expf(ltot0); dec_out[k0 + 1] = __expf(ltot1); }
    __syncthreads();
}
__device__ __forceinline__ void wg_fence() { __threadfence(); __syncthreads(); }

__device__ __forceinline__ void phase_scanA(const ScanPtrs& sp, LAS unsigned char* lds, int bid, int G, int tid) {
    for (int it = bid; it < NSC * 16; it += G) { const int sc = it >> 4, chain = it & 15, hh = chain >> 1, d = chain & 1;
        bf16* so = sp.HG_ST + ((size_t)sc * 16 + chain) * 16384; float* dc = sp.HG_DEC + (sc * 16 + chain) * 128;
        if (d == 0) hg_scan<0, 0>(sp, lds, sc * SCL, SCL / 64, hh, nullptr, so, dc, tid); else hg_scan<0, 1>(sp, lds, sc * SCL, SCL / 64, hh, nullptr, so, dc, tid); }
    for (int it = bid; it < NSC * 32; it += G) { const int sc = it >> 5, chain = it & 31, h = chain >> 1, d = chain & 1;
        bf16* so = sp.SSD_ST + ((size_t)sc * 32 + chain) * 8192; float* dc = sp.SSD_DEC + sc * 32 + chain;
        if (d == 0) ssd_scan<0, 0>(sp, lds, sc * SCL, SCL / 64, 0, ML, h, nullptr, so, dc, nullptr, tid); else ssd_scan<0, 1>(sp, lds, sc * SCL, SCL / 64, 0, ML, h, nullptr, so, dc, nullptr, tid); }
    for (int it = bid; it < 8; it += G) { const int hh = it;
        hg_scan<1, 0>(sp, lds, ML, MC / 64, hh, nullptr, sp.HG_ST + ((size_t)NSC * 16 + hh * 2 + 0) * 16384, nullptr, tid);
        wg_fence();
        hg_scan<2, 1>(sp, lds, ML, MC / 64, hh, nullptr, sp.HG_ST + ((size_t)NSC * 16 + hh * 2 + 1) * 16384, nullptr, tid); }
    for (int it = bid; it >= 8 && it < 24; it += G) { const int h = it - 8;
        bf16* yfs = sp.YFS + (size_t)blockIdx.x * 32768;
        ssd_scan<1, 0>(sp, lds, ML, MC / 64, ML, M, h, nullptr, sp.SSD_ST + ((size_t)NSC * 32 + h * 2 + 0) * 8192, nullptr, yfs, tid);
        wg_fence();
        ssd_scan<2, 1>(sp, lds, ML, MC / 64, ML, M, h, nullptr, sp.SSD_ST + ((size_t)NSC * 32 + h * 2 + 1) * 8192, nullptr, yfs, tid); }
}
__device__ __forceinline__ void phase_scanB(const ScanPtrs& sp, int bid, int G, int tid) {
    const int gt = bid * 512 + tid, nt = G * 512;
    for (int e = gt; e < 2 * 131072; e += nt) {
        const bool hg = e >= 131072; const int e2 = hg ? e - 131072 : e;
        const int chain = hg ? (e2 >> 13) : (e2 >> 12), pr = hg ? (e2 & 8191) : (e2 & 4095), d = chain & 1;
        const int nch = hg ? 16 : 32, ppc = hg ? 8192 : 4096;
        GAS unsigned* base = (GAS unsigned*)(hg ? sp.HG_ST : sp.SSD_ST);
        const unsigned w0 = base[((size_t)NSC * nch + chain) * ppc + pr];
        float r0 = bf2f(w0 & 0xffffu), r1 = bf2f(w0 >> 16);
        for (int i0 = 0; i0 < NSC; i0 += 8) {
            unsigned loc[8]; float dec[8];
#pragma unroll
            for (int j = 0; j < 8; ++j) { const int sc = d == 0 ? i0 + j : NSC - 1 - (i0 + j); loc[j] = base[((size_t)sc * nch + chain) * ppc + pr];
                dec[j] = hg ? sp.HG_DEC[(sc * 16 + chain) * 128 + (pr >> 6)] : sp.SSD_DEC[sc * 32 + chain]; }
#pragma unroll
            for (int j = 0; j < 8; ++j) { const int sc = d == 0 ? i0 + j : NSC - 1 - (i0 + j); base[((size_t)sc * nch + chain) * ppc + pr] = pk2(r0, r1);
                r0 = r0 * dec[j] + bf2f(loc[j] & 0xffffu); r1 = r1 * dec[j] + bf2f(loc[j] >> 16); }
        }
    }
}
__device__ __forceinline__ void phase_scanC(const ScanPtrs& sp, LAS unsigned char* lds, int bid, int G, int tid) {
    for (int it = bid; it < NSC * 8; it += G) { const int sc = it >> 3, hh = it & 7;
        hg_scan<1, 0>(sp, lds, sc * SCL, SCL / 64, hh, sp.HG_ST + ((size_t)sc * 16 + hh * 2 + 0) * 16384, nullptr, nullptr, tid);
        wg_fence();
        hg_scan<2, 1>(sp, lds, sc * SCL, SCL / 64, hh, sp.HG_ST + ((size_t)sc * 16 + hh * 2 + 1) * 16384, nullptr, nullptr, tid); }
    for (int it = bid; it < NSC * 16; it += G) { const int sc = it >> 4, h = it & 15;
        bf16* yfs = sp.YFS + (size_t)blockIdx.x * 32768;
        ssd_scan<1, 0>(sp, lds, sc * SCL, SCL / 64, 0, ML, h, sp.SSD_ST + ((size_t)sc * 32 + h * 2 + 0) * 8192, nullptr, nullptr, yfs, tid);
        wg_fence();
        ssd_scan<2, 1>(sp, lds, sc * SCL, SCL / 64, 0, ML, h, sp.SSD_ST + ((size_t)sc * 32 + h * 2 + 1) * 8192, nullptr, nullptr, yfs, tid); }
}
__device__ __forceinline__ void phase_finish(const Params& p, LAS unsigned char* lds, int bid, int G, int tid, int wave, int lane) {
    unsigned char* ws = p.ws; bf16* ZQ = (bf16*)(ws + WS_ZQ); const float* stats = (const float*)(ws + WS_SMALL + SM_STATS); const float* sng = p.in[I_SSDN];
    const int gw = bid * NWAVES + wave, ngw = G * NWAVES;
    for (int row = gw; row < M; row += ngw) {
        const int grp = lane >> 5; const float* s8 = stats + (size_t)row * 16 + grp * 8;
        const float ss = ((s8[0] + s8[1]) + (s8[2] + s8[3])) + ((s8[4] + s8[5]) + (s8[6] + s8[7]));
        const float r = rsqrtf(ss * (1.f / 512.f) + EPS);
        GAS v4u* zp = (GAS v4u*)(ZQ + (size_t)row * 2048 + lane * 16);
#pragma unroll
        for (int q = 0; q < 2; ++q) { float x8[8]; unpack8(zp[q], x8); const float* g8 = sng + lane * 16 + q * 8;
            v4u o; o.x = pk2(x8[0] * r * g8[0], x8[1] * r * g8[1]); o.y = pk2(x8[2] * r * g8[2], x8[3] * r * g8[3]); o.z = pk2(x8[4] * r * g8[4], x8[5] * r * g8[5]); o.w = pk2(x8[6] * r * g8[6], x8[7] * r * g8[7]); zp[q] = o; }
    }
    LAS float* scr = (LAS float*)(lds + wave * 16384); unsigned char* wr = ws + WS_WREST;
    tr_job(p.in[I_EVOUT], 2048, 1024, 1, (bf16*)(wr + WO_OUT), scr, gw, ngw, lane);
    tr_job(p.in[I_WGATE], 1024, DFF, 2, (bf16*)(wr + WO_UP0), scr, gw, ngw, lane);
    tr_job(p.in[I_WUP], 1024, DFF, 3, (bf16*)(wr + WO_UP0), scr, gw, ngw, lane);
    tr_job(p.in[I_WDOWN], DFF, 1024, 1, (bf16*)(wr + WO_DOWN0), scr, gw, ngw, lane);
    tr_job(p.in[I_ODIN], 1024, 512, 1, (bf16*)(wr + WO_OD), scr, gw, ngw, lane);
    tr_job(p.in[I_WVAL], 512, 1024, 2, (bf16*)(wr + WO_VG), scr, gw, ngw, lane);
    tr_job(p.in[I_WGATE2], 512, 1024, 3, (bf16*)(wr + WO_VG), scr, gw, ngw, lane);
    tr_job(p.in[I_WGATE] + (size_t)1024 * DFF, 1024, DFF, 2, (bf16*)(wr + WO_UP1), scr, gw, ngw, lane);
    tr_job(p.in[I_WUP] + (size_t)1024 * DFF, 1024, DFF, 3, (bf16*)(wr + WO_UP1), scr, gw, ngw, lane);
    tr_job(p.in[I_WDOWN] + (size_t)DFF * 1024, DFF, 1024, 1, (bf16*)(wr + WO_DOWN1), scr, gw, ngw, lane);
}

struct S5Ptrs { const float* U; float* YS; bf16* A2; const float* LAM; const float* LAMP; const float* BB; const float* CRE; const float* CIM; const float* S5D; float* ST; };
template <int MODE>
__device__ __forceinline__ void s5_dir(const S5Ptrs& sp, LAS unsigned char* lds, int row_begin, int gb, int d, float& hr, float& hi, int tid) {
    LAS float* ub = (LAS float*)lds; LAS float* hsr = (LAS float*)(lds + 4096); LAS float* hsi = (LAS float*)(lds + 4096 + 16384);
    const int gl = tid >> 6, s = (d * 32 + gb * 8 + gl) * 64 + (tid & 63);
    float bbr[16], bbi[16];
#pragma unroll
    for (int c = 0; c < 16; ++c) { bbr[c] = sp.BB[(size_t)s * 32 + 2 * c]; bbi[c] = sp.BB[(size_t)s * 32 + 2 * c + 1]; }
    const float lr = sp.LAM[2 * s], li = sp.LAM[2 * s + 1];
    for (int blk = 0; blk < 32; ++blk) {
        const int r0 = d == 0 ? row_begin + 8 * blk : row_begin + 256 - 8 * (blk + 1);
        if (tid < 256) { const int t = tid >> 5, c4 = (tid & 31) * 4; *(LAS f32x4*)(ub + t * 128 + c4) = *(const GAS f32x4*)(sp.U + (size_t)(r0 + t) * 512 + gb * 128 + c4); }
        __syncthreads();
        for (int jj = 0; jj < 8; ++jj) { const int t = d == 0 ? jj : 7 - jj; const LAS float* up = ub + t * 128 + gl * 16;
            float br = 0.f, bi = 0.f;
#pragma unroll
            for (int c4 = 0; c4 < 4; ++c4) { const f32x4 u4 = *(const LAS f32x4*)(up + 4 * c4);
                br += (bbr[4 * c4] * u4.x + bbr[4 * c4 + 1] * u4.y) + (bbr[4 * c4 + 2] * u4.z + bbr[4 * c4 + 3] * u4.w); bi += (bbi[4 * c4] * u4.x + bbi[4 * c4 + 1] * u4.y) + (bbi[4 * c4 + 2] * u4.z + bbi[4 * c4 + 3] * u4.w); }
            const float nr = lr * hr - li * hi + br, ni = lr * hi + li * hr + bi; hr = nr; hi = ni;
            if (MODE != 0) { hsr[t * 512 + tid] = hr; hsi[t * 512 + tid] = hi; }
        }
        if (MODE != 0) {
            __syncthreads();
            const int t = tid >> 6, g2 = (tid >> 3) & 7, c0 = (tid & 7) * 2, gg = gb * 8 + g2;
            float y[2];
#pragma unroll
            for (int q = 0; q < 2; ++q) { const float* cr = sp.CRE + ((size_t)(d * 32 + gg) * 16 + c0 + q) * 64; const float* ci = sp.CIM + ((size_t)(d * 32 + gg) * 16 + c0 + q) * 64;
                const LAS float* pr = hsr + t * 512 + g2 * 64; const LAS float* pi = hsi + t * 512 + g2 * 64; float a = 0.f;
#pragma unroll 4
                for (int p4 = 0; p4 < 16; ++p4) { const f32x4 r4 = *(const LAS f32x4*)(pr + 4 * p4), i4 = *(const LAS f32x4*)(pi + 4 * p4), cr4 = *(const GAS f32x4*)(cr + 4 * p4), ci4 = *(const GAS f32x4*)(ci + 4 * p4);
                    a += (cr4.x * r4.x - ci4.x * i4.x) + (cr4.y * r4.y - ci4.y * i4.y) + (cr4.z * r4.z - ci4.z * i4.z) + (cr4.w * r4.w - ci4.w * i4.w); }
                y[q] = a; }
            const int row = r0 + t, col = gb * 128 + g2 * 16 + c0;
            if (MODE == 1) { *(GAS f32x2*)(sp.YS + (size_t)row * 512 + col) = (f32x2){y[0], y[1]}; }
            else { const f32x2 yf = *(const GAS f32x2*)(sp.YS + (size_t)row * 512 + col);
                const float v0 = y[0] + yf.x + sp.S5D[col] * ub[t * 128 + g2 * 16 + c0], v1 = y[1] + yf.y + sp.S5D[col + 1] * ub[t * 128 + g2 * 16 + c0 + 1];
                const float t0 = 0.7978845608f * (v0 + 0.044715f * v0 * v0 * v0), t1 = 0.7978845608f * (v1 + 0.044715f * v1 * v1 * v1);
                const float g0 = 0.5f * v0 * (2.f - 2.f / (__expf(2.f * t0) + 1.f)), g1 = 0.5f * v1 * (2.f - 2.f / (__expf(2.f * t1) + 1.f));
                const int token = (row & 255) * 64 + (row >> 8);
                *(GAS unsigned*)(sp.A2 + (size_t)token * 512 + col) = pk2(g0, g1); }
        }
        __syncthreads();
    }
}
__device__ __forceinline__ void phase_s5A(const S5Ptrs& sp, LAS unsigned char* lds, int bid, int G, int tid) {
    for (int it = bid; it < 64 * 8 + 8; it += G) {
        const bool isc = it >= 512; const int i2 = isc ? it - 512 : it, c = isc ? 64 : (i2 >> 3), d = (i2 >> 2) & 1, gb = i2 & 3;
        float hr = 0.f, hi = 0.f;
        s5_dir<0>(sp, lds, isc ? ML : c * 256, gb, d, hr, hi, tid);
        *(GAS f32x2*)(sp.ST + ((size_t)(c * 2 + d) * 2048 + gb * 512 + tid) * 2) = (f32x2){hr, hi};
    }
}
__device__ __forceinline__ void phase_s5B(const S5Ptrs& sp, int bid, int G, int tid) {
    const int gt = bid * 512 + tid;
    if (gt < 4096) { const int d = gt >> 11, gp = gt & 2047, s = d * 2048 + gp; const float pr = sp.LAMP[2 * s], pi = sp.LAMP[2 * s + 1];
        GAS f32x2* st = (GAS f32x2*)sp.ST; f32x2 run = st[(size_t)(64 * 2 + d) * 2048 + gp];
        for (int i0 = 0; i0 < 64; i0 += 8) { f32x2 loc[8];
#pragma unroll
            for (int j = 0; j < 8; ++j) { const int c = d == 0 ? i0 + j : 63 - (i0 + j); loc[j] = st[(size_t)(c * 2 + d) * 2048 + gp]; }
#pragma unroll
            for (int j = 0; j < 8; ++j) { const int c = d == 0 ? i0 + j : 63 - (i0 + j); st[(size_t)(c * 2 + d) * 2048 + gp] = run;
                const float nr = pr * run.x - pi * run.y + loc[j].x, ni = pr * run.y + pi * run.x + loc[j].y; run.x = nr; run.y = ni; } }
    }
}
__device__ __forceinline__ void phase_s5C(const S5Ptrs& sp, LAS unsigned char* lds, int bid, int G, int tid) {
    for (int it = bid; it < 256; it += G) { const int c = it >> 2, gb = it & 3;
        f32x2 h0 = *(const GAS f32x2*)(sp.ST + ((size_t)(c * 2 + 0) * 2048 + gb * 512 + tid) * 2); float hr = h0.x, hi = h0.y;
        s5_dir<1>(sp, lds, c * 256, gb, 0, hr, hi, tid);
        wg_fence();
        h0 = *(const GAS f32x2*)(sp.ST + ((size_t)(c * 2 + 1) * 2048 + gb * 512 + tid) * 2); hr = h0.x; hi = h0.y;
        s5_dir<2>(sp, lds, c * 256, gb, 1, hr, hi, tid);
    }
}
__device__ __forceinline__ void phase_final(const Params& p, int bid, int G, int wave, int lane) {
    const int gw = bid * NWAVES + wave, ngw = G * NWAVES; const float* fg = p.in[I_FNORM];
    for (int row = gw; row < ML; row += ngw) { float* xr = p.out + (size_t)row * 1024;
        f32x4 v[4]; float ss = 0.f;
#pragma unroll
        for (int j = 0; j < 4; ++j) { v[j] = *(const GAS f32x4*)(xr + 4 * lane + 256 * j); ss += (v[j].x * v[j].x + v[j].y * v[j].y) + (v[j].z * v[j].z + v[j].w * v[j].w); }
        const float r = rsqrtf(wave_sum(ss) * (1.f / 1024.f) + EPS);
#pragma unroll
        for (int j = 0; j < 4; ++j) { const f32x4 g4 = *(const GAS f32x4*)(fg + 4 * lane + 256 * j); *(GAS f32x4*)(xr + 4 * lane + 256 * j) = (f32x4){v[j].x * r * g4.x, v[j].y * r * g4.y, v[j].z * r * g4.z, v[j].w * r * g4.w}; }
    }
}

constexpr int N_PHASES = 21;
__device__ __forceinline__ void run_gmix(const Params& p, LAS unsigned char* lds, int bid, int G) {
    unsigned char* ws = p.ws;
    pg8::Gemm g{(const bf16*)(ws + WS_RX), (const bf16*)(ws + WS_WIN), M, NINP, 1024}; pg8::StaticOrder S; S.init(M, NINP, G, bid);
    pg8::EpiMix1 E{(bf16*)(ws + WS_ZQ), (bf16*)(ws + WS_XBC), (bf16*)(ws + WS_V), (bf16*)(ws + WS_G), (f16*)p.out, (f16*)(ws + WS_FCTX), (float*)(ws + WS_DT), (const float*)(ws + WS_SMALL + SM_LB), p.in[I_DTB], p.in[I_ALOG]};
    pg8::gemm_phase<pg8::EpiMix1, pg8::StaticOrder, true, true>(lds + RING_OFF, g, S, E);
}
__device__ __forceinline__ void run_gout(const Params& p, LAS unsigned char* lds, int bid, int G) {
    unsigned char* ws = p.ws; const float* mods = (const float*)(ws + WS_SMALL + SM_MODS);
    pg8::Gemm g{(const bf16*)(ws + WS_ZQ), (const bf16*)(ws + WS_WREST + WO_OUT), M, 1024, 2048}; pg8::StaticOrder S; S.init(M, 1024, G, bid);
    pg8::EpiResid E{p.in[I_X], p.in[I_CTX], p.out, (float*)(ws + WS_HCTX), mods + (0 * 2 + 0) * 6144 + 2 * 1024, mods + (0 * 2 + 1) * 6144 + 2 * 1024};
    pg8::gemm_phase<pg8::EpiResid, pg8::StaticOrder, true, true>(lds + RING_OFF, g, S, E);
}
__device__ __forceinline__ void run_gup(const Params& p, LAS unsigned char* lds, int bid, int G, int layer) {
    unsigned char* ws = p.ws; const int rows = layer ? ML : M;
    pg8::Gemm g{(const bf16*)(ws + WS_RX), (const bf16*)(ws + WS_WREST + (layer ? WO_UP1 : WO_UP0)), rows, 2 * DFF, 1024}; pg8::StaticOrder S; S.init(rows, 2 * DFF, G, bid);
    pg8::EpiSwiglu E{(bf16*)(ws + WS_HID)};
    pg8::gemm_phase<pg8::EpiSwiglu, pg8::StaticOrder, true, true>(lds + RING_OFF, g, S, E);
}
__device__ __forceinline__ void run_gdown(const Params& p, LAS unsigned char* lds, int bid, int G, int layer) {
    unsigned char* ws = p.ws; const int rows = layer ? ML : M; const float* mods = (const float*)(ws + WS_SMALL + SM_MODS); float* Hctx = (float*)(ws + WS_HCTX);
    pg8::Gemm g{(const bf16*)(ws + WS_HID), (const bf16*)(ws + WS_WREST + (layer ? WO_DOWN1 : WO_DOWN0)), rows, 1024, DFF}; pg8::StaticOrder S; S.init(rows, 1024, G, bid);
    pg8::EpiResid E{p.out, Hctx, p.out, Hctx, mods + (layer * 2 + 0) * 6144 + 5 * 1024, mods + (layer * 2 + 1) * 6144 + 5 * 1024};
    pg8::gemm_phase<pg8::EpiResid, pg8::StaticOrder, true, true>(lds + RING_OFF, g, S, E);
}
__device__ __forceinline__ void run_god(const Params& p, LAS unsigned char* lds, int bid, int G) {
    unsigned char* ws = p.ws;
    pg8::Gemm g{(const bf16*)(ws + WS_RX), (const bf16*)(ws + WS_WREST + WO_OD), M, 512, 1024}; pg8::StaticOrder S; S.init(M, 512, G, bid);
    pg8::EpiU E{(float*)(ws + WS_U)};
    pg8::gemm_phase<pg8::EpiU, pg8::StaticOrder, true, true>(lds + RING_OFF, g, S, E);
}
__device__ __forceinline__ void run_gvg(const Params& p, LAS unsigned char* lds, int bid, int G) {
    unsigned char* ws = p.ws; const float* mods = (const float*)(ws + WS_SMALL + SM_MODS);
    pg8::Gemm g{(const bf16*)(ws + WS_A2), (const bf16*)(ws + WS_WREST + WO_VG), ML, 2048, 512}; pg8::StaticOrder S; S.init(ML, 2048, G, bid);
    pg8::EpiValGate E{p.out, mods + (1 * 2 + 0) * 6144 + 2 * 1024};
    pg8::gemm_phase<pg8::EpiValGate, pg8::StaticOrder, true, true>(lds + RING_OFF, g, S, E);
}
__device__ __forceinline__ ScanPtrs make_scanptrs(const Params& p) {
    unsigned char* ws = p.ws; ScanPtrs sp; sp.XBC = (const bf16*)(ws + WS_XBC); sp.DT = (const float*)(ws + WS_DT); sp.ZQ = (bf16*)(ws + WS_ZQ); sp.V = (const bf16*)(ws + WS_V); sp.G = (const bf16*)(ws + WS_G); sp.Flat = (f16*)p.out; sp.Fctx = (f16*)(ws + WS_FCTX);
    sp.STATS = (float*)(ws + WS_SMALL + SM_STATS); sp.convw = p.in[I_CONVW]; sp.convb = p.in[I_CONVB]; sp.ssdd = p.in[I_SSDD]; sp.hgn = p.in[I_HGN];
    sp.SSD_ST = (bf16*)(ws + WS_RX); sp.HG_ST = (bf16*)(ws + WS_RX + SSD_ST_BYTES); sp.SSD_DEC = (float*)(ws + WS_SMALL + SM_SSDDEC); sp.HG_DEC = (float*)(ws + WS_SMALL + SM_HGDEC); sp.YFS = (bf16*)(ws + WS_WIN); return sp;
}
__device__ __forceinline__ S5Ptrs make_s5ptrs(const Params& p) {
    unsigned char* ws = p.ws; S5Ptrs s5; s5.U = (const float*)(ws + WS_U); s5.YS = (float*)(ws + WS_YS); s5.A2 = (bf16*)(ws + WS_A2); s5.LAM = (const float*)(ws + WS_SMALL + SM_LAM); s5.LAMP = (const float*)(ws + WS_SMALL + SM_LAMP);
    s5.BB = (const float*)(ws + WS_SMALL + SM_BB); s5.CRE = p.in[I_CRE]; s5.CIM = p.in[I_CIM]; s5.S5D = p.in[I_S5D]; s5.ST = (float*)(ws + WS_SMALL + SM_S5ST); return s5;
}
__global__ void __launch_bounds__(NWAVES * 64, 2) mk_fwd(Params p) {
    extern __shared__ __attribute__((aligned(16))) unsigned char lds_raw[];
    LAS unsigned char* lds = (LAS unsigned char*)lds_raw;
    volatile LAS unsigned* MISC = (volatile LAS unsigned*)(lds + MISC_OFF);
    const int tid = threadIdx.x, lane = tid & 63, wave = __builtin_amdgcn_readfirstlane(tid >> 6), G = gridDim.x, bid = blockIdx.x;
    gu32* ctl = (gu32*)(p.ws + WS_CTL);
    for (int u = tid; u < (LDS_BYTES - LDSCTL_OFF) / 4; u += NWAVES * 64) ((LAS unsigned*)(lds + LDSCTL_OFF))[u] = 0u;
    __syncthreads();
    XcdBarrier bar; bar.bar = (unsigned*)(ctl + CW_BAR); bar.x = 0; bar.st = nullptr;
    if (p.use_bar) bar = xcd_barrier_post((unsigned*)(ctl + CW_BAR), MISC + 8);
    const int lo = p.ph_lo, hi = p.ph_hi;
#ifndef MK_ONLYPH
#define MK_ONLYPH -1
#endif
#define IN(k) ((MK_ONLYPH < 0 || MK_ONLYPH == (k)) && lo <= (k) && (k) < hi)
#define SEAM(k) do { if ((k) + 1 < hi) xcd_barrier(bar); } while (0)
    if (IN(0)) { phase_prologue(p, lds, bid, G, tid, wave, lane); SEAM(0); }
    if (IN(1)) { phase_rownorm(p, lds, bid, G, tid, wave, lane, 0, 0, M, p.in[I_X], p.in[I_CTX], true); SEAM(1); }
    if (IN(2)) { run_gmix(p, lds, bid, G); SEAM(2); }
    if (IN(3)) { const ScanPtrs sp = make_scanptrs(p); phase_scanA(sp, lds, bid, G, tid); SEAM(3); }
    if (IN(4)) { const ScanPtrs sp = make_scanptrs(p); phase_scanB(sp, bid, G, tid); SEAM(4); }
    if (IN(5)) { const ScanPtrs sp = make_scanptrs(p); phase_scanC(sp, lds, bid, G, tid); SEAM(5); }
    if (IN(6)) { phase_finish(p, lds, bid, G, tid, wave, lane); SEAM(6); }
    if (IN(7)) { run_gout(p, lds, bid, G); SEAM(7); }
    if (IN(8)) { phase_rownorm(p, lds, bid, G, tid, wave, lane, 0, 1, M, p.out, (const float*)(p.ws + WS_HCTX), false); SEAM(8); }
    if (IN(9)) { run_gup(p, lds, bid, G, 0); SEAM(9); }
    if (IN(10)) { run_gdown(p, lds, bid, G, 0); SEAM(10); }
    if (IN(11)) { phase_rownorm(p, lds, bid, G, tid, wave, lane, 1, 0, M, p.out, (const float*)(p.ws + WS_HCTX), false); SEAM(11); }
    if (IN(12)) { run_god(p, lds, bid, G); SEAM(12); }
    if (IN(13)) { const S5Ptrs s5 = make_s5ptrs(p); phase_s5A(s5, lds, bid, G, tid); SEAM(13); }
    if (IN(14)) { const S5Ptrs s5 = make_s5ptrs(p); phase_s5B(s5, bid, G, tid); SEAM(14); }
    if (IN(15)) { const S5Ptrs s5 = make_s5ptrs(p); phase_s5C(s5, lds, bid, G, tid); SEAM(15); }
    if (IN(16)) { run_gvg(p, lds, bid, G); SEAM(16); }
    if (IN(17)) { phase_rownorm(p, lds, bid, G, tid, wave, lane, 1, 1, ML, p.out, (const float*)(p.ws + WS_HCTX), false); SEAM(17); }
    if (IN(18)) { run_gup(p, lds, bid, G, 1); SEAM(18); }
    if (IN(19)) { run_gdown(p, lds, bid, G, 1); SEAM(19); }
    if (IN(20)) { phase_final(p, bid, G, wave, lane); }
#undef IN
#undef SEAM
}

extern "C" void kernel_launch(void* const* d_in, const int* in_sizes, int n_in, void* d_out, int out_size, void* d_ws, size_t ws_size, hipStream_t stream) {
    static int grid = 0;
    if (grid == 0) {
        if (n_in != 33 || out_size != ML * D || ws_size < 256 * MiB) { fprintf(stderr, "kernel_launch: unexpected shapes (n_in %d, out %d, ws %zu); nothing launched\n", n_in, out_size, ws_size); grid = -1; return; }
        int dev = 0, cus = 0, per_cu = 0;
        if (hipGetDevice(&dev) != hipSuccess || hipDeviceGetAttribute(&cus, hipDeviceAttributeMultiprocessorCount, dev) != hipSuccess) { grid = -1; return; }
        if (hipFuncSetAttribute((const void*)mk_fwd, hipFuncAttributeMaxDynamicSharedMemorySize, LDS_BYTES) != hipSuccess) { fprintf(stderr, "kernel_launch: hipFuncSetAttribute failed\n"); grid = -1; return; }
        if (hipOccupancyMaxActiveBlocksPerMultiprocessor(&per_cu, (const void*)mk_fwd, NWAVES * 64, LDS_BYTES) != hipSuccess || per_cu < 1) fprintf(stderr, "kernel_launch: occupancy query reports %d\n", per_cu);
        (void)hipGetLastError();
        grid = cus;
    }
    if (grid < 0) return;
    (void)hipMemsetAsync((char*)d_ws + WS_CTL, 0, CTL_ZERO_BYTES, stream);
    Params a{};
    for (int i = 0; i < 33; ++i) a.in[i] = (const float*)d_in[i];
    a.out = (float*)d_out; a.ws = (unsigned char*)d_ws;
#if MK_N_LAUNCHES == 1
    a.ph_lo = 0; a.ph_hi = N_PHASES; a.use_bar = 1;
    hipLaunchKernelGGL(mk_fwd, dim3(grid), dim3(NWAVES * 64), LDS_BYTES, stream, a);
#else
    for (int ph = 0; ph < N_PHASES; ++ph) { a.ph_lo = ph; a.ph_hi = ph + 1; a.use_bar = 0; hipLaunchKernelGGL(mk_fwd, dim3(grid), dim3(NWAVES * 64), LDS_BYTES, stream, a); }
#endif
}
```

```cpp
#include <hip/hip_runtime.h>
#include <cstdio>
#include <cstdint>

#ifndef MK_N_LAUNCHES
#define MK_N_LAUNCHES 1
#endif
namespace pg8 {
#define PG8_LAS __attribute__((address_space(3)))
typedef unsigned short bf16_t;
typedef short bf16x8 __attribute__((ext_vector_type(8)));
typedef float f32x4 __attribute__((ext_vector_type(4)));
typedef unsigned u32x4 __attribute__((ext_vector_type(4)));
constexpr int BM = 256, BK = 64, HALF = 128, HTB = HALF * BK * 2  , STAGE_BYTES = 8 * HTB, NXCD = 8, WGM = 8;

__host__ __device__ __forceinline__ int lds_byte(int r, int c) { const int st = (r >> 4) * 2 + (c >> 5), rr = r & 15, cc = c & 31, ob = rr * 64 + cc * 2; return st * 1024 + (ob ^ (((ob >> 9) & 1) << 5)); }
__host__ __device__ __forceinline__ void stage_rc(int b, int& R, int& C) { const int st = b / 1024, sb = b % 1024, swz = sb ^ (((sb >> 9) & 1) << 5); R = (st >> 1) * 16 + swz / 64; C = (st & 1) * 32 + (swz % 64) / 2; }
__host__ __device__ __forceinline__ int perm32(int rho) { const int n = rho >> 4, i = rho & 15; return 8 * (i >> 2) + 4 * n + (i & 3); }

struct Unit { int pm, pn; };
struct Gemm { const bf16_t* A; const bf16_t* Bt; int M, N, K; };

struct StaticOrder {
    int nM, nN, nwg, G, c;
    __host__ __device__ void init(int M, int N, int G_, int c_) { nM = M / BM; nN = N / BM; nwg = nM * nN; G = G_; c = c_; }
    __host__ __device__ bool next(int i, Unit& u) const {
        const long L = (long)i * G + c; if (L >= nwg) return false;
        int wgid = (int)L; { const int q = nwg / NXCD, r = nwg % NXCD, xcd = wgid % NXCD, off = wgid / NXCD; wgid = (xcd < r ? xcd * (q + 1) : r * (q + 1) + (xcd - r) * q) + off; }
        const int nig = WGM * nN, gid = wgid / nig, fm = gid * WGM, gsz = (nM - fm) < WGM ? (nM - fm) : WGM;
        u.pm = fm + ((wgid % nig) % gsz); u.pn = (wgid % nig) / gsz; return true;
    }
    __device__ __forceinline__ void a_ready(const Unit&) const {}
    __device__ __forceinline__ void done(const Unit&) const {}
};

__device__ __forceinline__ unsigned cvt_pk_bf16(float lo, float hi) { unsigned r; asm volatile("v_cvt_pk_bf16_f32 %0, %1, %2" : "=v"(r) : "v"(lo), "v"(hi)); return r; }
typedef float f32x2 __attribute__((ext_vector_type(2)));
typedef _Float16 f16x8 __attribute__((ext_vector_type(8)));
__device__ __forceinline__ float siluf(float x) { return x / (1.f + __expf(-x)); }
__device__ __forceinline__ float sigmf(float x) { return 1.f / (1.f + __expf(-x)); }
__device__ __forceinline__ u32x4 pack8_bf16(const float (&x)[8]) { u32x4 w; w.x = cvt_pk_bf16(x[0], x[1]); w.y = cvt_pk_bf16(x[2], x[3]); w.z = cvt_pk_bf16(x[4], x[5]); w.w = cvt_pk_bf16(x[6], x[7]); return w; }
constexpr int EP_ML = 16384;

struct EpiMix1 {
    static constexpr bool PERM = true, AFTER_DRAIN = false;
    bf16_t* ZQ; bf16_t* XBC; bf16_t* V; bf16_t* G; _Float16* Flat; _Float16* Fctx; float* DT; const float* lb; const float* dt_bias; const float* a_log;
    template <int KIND> __device__ __forceinline__ void tile(const f32x4 (&acc)[2][2][4][2], const Unit& u, int wr, int wc, int fr, int fq, int seg_tile) const {
        const int row0 = u.pm * BM + wr * 64 + fr, cw = wc * 32 + 8 * fq;
#pragma unroll
        for (int ai = 0; ai < 2; ++ai)
#pragma unroll
            for (int m = 0; m < 4; ++m) { const int row = row0 + ai * HALF + m * 16;
#pragma unroll
                for (int bj = 0; bj < 2; ++bj) { const f32x4 v0 = acc[ai][bj][m][0], v1 = acc[ai][bj][m][1]; const int c = seg_tile * 256 + bj * HALF + cw;
                    float x[8] = {v0[0], v0[1], v0[2], v0[3], v1[0], v1[1], v1[2], v1[3]};
                    if constexpr (KIND == 0) {
#pragma unroll
                        for (int i = 0; i < 8; ++i) x[i] = siluf(x[i]);
                        *(u32x4*)(ZQ + (size_t)row * 2048 + c) = pack8_bf16(x);
                    } else if constexpr (KIND == 1) {
                        *(u32x4*)(XBC + (size_t)row * 1536 + c) = pack8_bf16(x);
                    } else if constexpr (KIND == 2) {
#pragma unroll
                        for (int i = 0; i < 8; ++i) x[i] = siluf(x[i]);
                        *(u32x4*)(ZQ + (size_t)row * 2048 + 1024 + c) = pack8_bf16(x);
                    } else if constexpr (KIND == 3) {
                        f16x8 h;
#pragma unroll
                        for (int i = 0; i < 8; ++i) { const float l = lb[(c + i) & 1023]; const float f = l + (1.f - l) * sigmf(x[i]); h[i] = (_Float16)__logf(f); }
                        _Float16* dst = (row < EP_ML) ? Flat + (size_t)row * 2048 : Fctx + (size_t)(row - EP_ML) * 2048;
                        *(f16x8*)(dst + c) = h;
                    } else if constexpr (KIND == 4) {
                        *(u32x4*)(V + (size_t)row * 1024 + c) = pack8_bf16(x);
                    } else if constexpr (KIND == 5) {
#pragma unroll
                        for (int i = 0; i < 8; ++i) x[i] = siluf(x[i]);
                        *(u32x4*)(G + (size_t)row * 1024 + c) = pack8_bf16(x);
                    } else {
                        if (bj == 0 && wc == 0) {
                            float dtv[8], la[8];
#pragma unroll
                            for (int i = 0; i < 8; ++i) { const int j = 8 * fq + i; const float r = x[i] + dt_bias[j]; dtv[i] = r > 20.f ? r : log1pf(__expf(r)); la[i] = -dtv[i] * __expf(a_log[j]); }
                            float* d = DT + (size_t)row * 64 + 8 * fq;
                            *(f32x4*)(d) = (f32x4){dtv[0], dtv[1], dtv[2], dtv[3]}; *(f32x4*)(d + 4) = (f32x4){dtv[4], dtv[5], dtv[6], dtv[7]};
                            *(f32x4*)(d + 32) = (f32x4){la[0], la[1], la[2], la[3]}; *(f32x4*)(d + 36) = (f32x4){la[4], la[5], la[6], la[7]};
                        }
                    } } }
    }
    __device__ __forceinline__ void operator()(const f32x4 (&acc)[2][2][4][2], const Unit& u, int wr, int wc, int fr, int fq) const {
        const int pn = u.pn;
        if (pn < 4) tile<0>(acc, u, wr, wc, fr, fq, pn);
        else if (pn < 10) tile<1>(acc, u, wr, wc, fr, fq, pn - 4);
        else if (pn < 14) tile<2>(acc, u, wr, wc, fr, fq, pn - 10);
        else if (pn < 22) tile<3>(acc, u, wr, wc, fr, fq, pn - 14);
        else if (pn < 26) tile<4>(acc, u, wr, wc, fr, fq, pn - 22);
        else if (pn < 30) tile<5>(acc, u, wr, wc, fr, fq, pn - 26);
        else tile<6>(acc, u, wr, wc, fr, fq, 0);
    }
};
struct EpiResid {
    static constexpr bool PERM = false, AFTER_DRAIN = false;
    const float* base_lat; const float* base_ctx; float* out_lat; float* out_ctx; const float* gate_lat; const float* gate_ctx;
    __device__ __forceinline__ void operator()(const f32x4 (&acc)[2][2][4][2], const Unit& u, int wr, int wc, int fr, int fq) const {
        const bool isc = u.pm >= 64; const float* base = isc ? base_ctx : base_lat; float* out = isc ? out_ctx : out_lat; const float* gate = isc ? gate_ctx : gate_lat;
        const int row0 = (isc ? 0 : u.pm * BM) + wr * 64 + fr, col0 = u.pn * BM + wc * 32 + 4 * fq;
        f32x4 gv[2][2];
#pragma unroll
        for (int bj = 0; bj < 2; ++bj)
#pragma unroll
            for (int n = 0; n < 2; ++n) gv[bj][n] = *(const f32x4*)(gate + col0 + bj * HALF + n * 16);
#pragma unroll
        for (int ai = 0; ai < 2; ++ai)
#pragma unroll
            for (int m = 0; m < 4; ++m) { const size_t off = (size_t)(row0 + ai * HALF + m * 16) * 1024 + col0;
#pragma unroll
                for (int bj = 0; bj < 2; ++bj)
#pragma unroll
                    for (int n = 0; n < 2; ++n) { const f32x4 b = *(const f32x4*)(base + off + bj * HALF + n * 16); *(f32x4*)(out + off + bj * HALF + n * 16) = b + gv[bj][n] * acc[ai][bj][m][n]; } }
    }
};
struct EpiSwiglu {
    static constexpr bool PERM = true, AFTER_DRAIN = false;
    bf16_t* HID;
    __device__ __forceinline__ void operator()(const f32x4 (&acc)[2][2][4][2], const Unit& u, int wr, int wc, int fr, int fq) const {
        const int row0 = u.pm * BM + wr * 64 + fr, c = u.pn * HALF + wc * 32 + 8 * fq;
#pragma unroll
        for (int ai = 0; ai < 2; ++ai)
#pragma unroll
            for (int m = 0; m < 4; ++m) { const f32x4 g0 = acc[ai][0][m][0], g1 = acc[ai][0][m][1], u0 = acc[ai][1][m][0], u1 = acc[ai][1][m][1];
                float x[8] = {siluf(g0[0]) * u0[0], siluf(g0[1]) * u0[1], siluf(g0[2]) * u0[2], siluf(g0[3]) * u0[3], siluf(g1[0]) * u1[0], siluf(g1[1]) * u1[1], siluf(g1[2]) * u1[2], siluf(g1[3]) * u1[3]};
                *(u32x4*)(HID + (size_t)(row0 + ai * HALF + m * 16) * 2816 + c) = pack8_bf16(x); }
    }
};
struct EpiU {
    static constexpr bool PERM = true, AFTER_DRAIN = false;
    bf16_t* U;
    __device__ __forceinline__ void operator()(const f32x4 (&acc)[2][2][4][2], const Unit& u, int wr, int wc, int fr, int fq) const {
        const int row0 = u.pm * BM + wr * 64 + fr, col0 = u.pn * BM + wc * 32 + 8 * fq;
#pragma unroll
        for (int ai = 0; ai < 2; ++ai)
#pragma unroll
            for (int m = 0; m < 4; ++m) { const int row = row0 + ai * HALF + m * 16; const int srow = row < EP_ML ? (row & 63) * 256 + (row >> 6) : row;
#pragma unroll
                for (int bj = 0; bj < 2; ++bj) { const f32x4 v0 = acc[ai][bj][m][0], v1 = acc[ai][bj][m][1]; float x[8] = {v0[0], v0[1], v0[2], v0[3], v1[0], v1[1], v1[2], v1[3]};
                    *(u32x4*)(U + (size_t)srow * 512 + col0 + bj * HALF) = pack8_bf16(x); } }
    }
};
struct EpiValGate {
    static constexpr bool PERM = false, AFTER_DRAIN = false;
    float* H; const float* gate;
    __device__ __forceinline__ void operator()(const f32x4 (&acc)[2][2][4][2], const Unit& u, int wr, int wc, int fr, int fq) const {
        const int row0 = u.pm * BM + wr * 64 + fr, col0 = u.pn * HALF + wc * 32 + 4 * fq;
#pragma unroll
        for (int ai = 0; ai < 2; ++ai)
#pragma unroll
            for (int m = 0; m < 4; ++m) { float* hp = H + (size_t)(row0 + ai * HALF + m * 16) * 1024 + col0;
#pragma unroll
                for (int n = 0; n < 2; ++n) { const f32x4 v = acc[ai][0][m][n], g = acc[ai][1][m][n]; const f32x4 gm = *(const f32x4*)(gate + col0 + n * 16); f32x4 h = *(const f32x4*)(hp + n * 16);
                    h[0] += gm[0] * v[0] * sigmf(g[0]); h[1] += gm[1] * v[1] * sigmf(g[1]); h[2] += gm[2] * v[2] * sigmf(g[2]); h[3] += gm[3] * v[3] * sigmf(g[3]); *(f32x4*)(hp + n * 16) = h; } }
    }
};
template <class Epi, class Sched, bool ALIGN_EPI = false, bool SP2 = false>
__device__ __forceinline__ void gemm_phase(PG8_LAS unsigned char* lds, const Gemm g, const Sched& S, const Epi& E) {
    const int tid = threadIdx.x, wid = __builtin_amdgcn_readfirstlane(tid >> 6), lane = tid & 63, wr = wid >> 2, wc = wid & 3, fr = lane & 15, fq = lane >> 4;
    const int K = g.K, nt = K / BK;
    unsigned voffA[2], voffB[2];
#pragma unroll
    for (int i = 0; i < 2; ++i) { int R, C; stage_rc(tid * 16 + i * 8192, R, C); const int Rb = Epi::PERM ? ((R & ~31) + perm32(R & 31)) : R;
        voffA[i] = (unsigned)(R * K + C) * 2u; voffB[i] = (unsigned)(Rb * K + C) * 2u; }
    const size_t kstep = (size_t)(BK * 2);
    const size_t hstep = (size_t)HALF * K * 2;
    const size_t tstep = 2 * hstep;
    const unsigned ldsw = (unsigned)wid * 1024u;
    const int aoff = lds_byte(wr * 64 + fr, fq * 8), boff = lds_byte(wc * 32 + fr, fq * 8);
#define PG8_SA(b, h) (((b) * 2 + (h)) * HTB)
#define PG8_SB(b, h) ((4 + (b) * 2 + (h)) * HTB)
#define PG8_STAGE(bufoff, gbase, voff) do { _Pragma("unroll") for (int _i = 0; _i < 2; ++_i) \
        __builtin_amdgcn_global_load_lds((const unsigned*)((const char*)(gbase) + (voff)[_i]), (PG8_LAS unsigned*)(lds + (bufoff) + ldsw + _i * 8192), 16, 0, 0); } while (0)
#define PG8_LDA(dst, b, h) do { _Pragma("unroll") for (int m = 0; m < 4; ++m) _Pragma("unroll") for (int k = 0; k < 2; ++k) dst[m][k] = *(const PG8_LAS bf16x8*)(lds + PG8_SA(b, h) + aoff + m * 2048 + k * 1024); } while (0)
#define PG8_LDB(dst, b, h) do { _Pragma("unroll") for (int n = 0; n < 2; ++n) _Pragma("unroll") for (int k = 0; k < 2; ++k) dst[n][k] = *(const PG8_LAS bf16x8*)(lds + PG8_SB(b, h) + boff + n * 2048 + k * 1024); } while (0)
#define PG8_MMA(ai, bj, At, Bt) do { __builtin_amdgcn_s_setprio(1); _Pragma("unroll") for (int m = 0; m < 4; ++m) _Pragma("unroll") for (int n = 0; n < 2; ++n) _Pragma("unroll") for (int k = 0; k < 2; ++k) \
        acc[ai][bj][m][n] = __builtin_amdgcn_mfma_f32_16x16x32_bf16(Bt[n][k], At[m][k], acc[ai][bj][m][n], 0, 0, 0); __builtin_amdgcn_s_setprio(0); } while (0)
#define PG8_WAIT_V(n) asm volatile("s_waitcnt vmcnt(" #n ")" ::: "memory")
#define PG8_WAIT_L(n) asm volatile("s_waitcnt lgkmcnt(" #n ")" ::: "memory")
#define PG8_BAR __builtin_amdgcn_s_barrier()
#define PG8_SCHED __builtin_amdgcn_sched_barrier(0)
    Unit cur, nxt; int ui = 0;
    if (!S.next(0, cur)) return;
    f32x4 acc[2][2][4][2];
#pragma unroll
    for (int a = 0; a < 2; ++a)
#pragma unroll
        for (int b = 0; b < 2; ++b)
#pragma unroll
            for (int m = 0; m < 4; ++m)
#pragma unroll
                for (int n = 0; n < 2; ++n) acc[a][b][m][n] = (f32x4){0.f, 0.f, 0.f, 0.f};
    bf16x8 At[4][2], B0[2][2], B1[2][2];
    const char* cA = (const char*)g.A + (size_t)cur.pm * tstep; const char* cB = (const char*)g.Bt + (size_t)cur.pn * tstep;
    S.a_ready(cur);
    if constexpr (SP2) {
        PG8_STAGE(PG8_SB(0, 0), cB, voffB); PG8_STAGE(PG8_SB(0, 1), cB + hstep, voffB); PG8_STAGE(PG8_SA(0, 0), cA, voffA); PG8_STAGE(PG8_SA(0, 1), cA + hstep, voffA);
        if (wr == 1) PG8_BAR;
        PG8_WAIT_V(2); PG8_BAR;
        PG8_STAGE(PG8_SB(1, 0), cB + kstep, voffB); PG8_STAGE(PG8_SA(1, 0), cA + kstep, voffA); PG8_STAGE(PG8_SB(1, 1), cB + hstep + kstep, voffB);
        PG8_WAIT_V(6); PG8_BAR;
    } else {
        PG8_STAGE(PG8_SB(0, 0), cB, voffB); PG8_STAGE(PG8_SA(0, 0), cA, voffA); PG8_STAGE(PG8_SB(0, 1), cB + hstep, voffB); PG8_STAGE(PG8_SA(0, 1), cA + hstep, voffA);
        if (wr == 1) PG8_BAR;
        PG8_WAIT_V(4); PG8_BAR;
        PG8_STAGE(PG8_SB(1, 0), cB + kstep, voffB); PG8_STAGE(PG8_SA(1, 0), cA + kstep, voffA); PG8_STAGE(PG8_SB(1, 1), cB + hstep + kstep, voffB);
        PG8_WAIT_V(6); PG8_BAR;
    }
    for (;;) {
        const bool has_next = S.next(ui + 1, nxt);
        const char* nA = has_next ? (const char*)g.A + (size_t)nxt.pm * tstep : cA; const char* nB = has_next ? (const char*)g.Bt + (size_t)nxt.pn * tstep : cB;
        for (int t = 0; t < nt; t += 2) {
            const bool last = (t == nt - 2);
            const char* a1 = cA + (size_t)(t + 1) * kstep;
            const char* a2 = last ? nA : cA + (size_t)(t + 2) * kstep; const char* b2 = last ? nB : cB + (size_t)(t + 2) * kstep;
            const char* a3 = a2 + kstep; const char* b3 = b2 + kstep;
            if (last && has_next) S.a_ready(nxt);
            if constexpr (SP2) {
            PG8_LDB(B0, 0, 0); PG8_LDB(B1, 0, 1); PG8_SCHED; PG8_LDA(At, 0, 0); PG8_STAGE(PG8_SA(1, 1), a1 + hstep, voffA);
            PG8_WAIT_V(8); PG8_WAIT_L(0); PG8_BAR; PG8_MMA(0, 0, At, B0); PG8_MMA(0, 1, At, B1); PG8_BAR; PG8_SCHED;
            PG8_LDA(At, 0, 1); PG8_STAGE(PG8_SB(0, 0), b2, voffB); PG8_STAGE(PG8_SB(0, 1), b2 + hstep, voffB); PG8_STAGE(PG8_SA(0, 0), a2, voffA);
            PG8_WAIT_V(8); PG8_WAIT_L(0); PG8_BAR; PG8_MMA(1, 0, At, B0); PG8_MMA(1, 1, At, B1); PG8_BAR; PG8_SCHED;
            PG8_LDB(B0, 1, 0); PG8_LDB(B1, 1, 1); PG8_SCHED; PG8_LDA(At, 1, 0); PG8_STAGE(PG8_SA(0, 1), a2 + hstep, voffA);
            PG8_WAIT_V(8); PG8_WAIT_L(0); PG8_BAR; PG8_MMA(0, 0, At, B0); PG8_MMA(0, 1, At, B1); PG8_BAR; PG8_SCHED;
            PG8_LDA(At, 1, 1); PG8_STAGE(PG8_SB(1, 0), b3, voffB); PG8_STAGE(PG8_SB(1, 1), b3 + hstep, voffB); PG8_STAGE(PG8_SA(1, 0), a3, voffA);
            PG8_WAIT_V(8); PG8_WAIT_L(0); PG8_BAR; PG8_MMA(1, 0, At, B0); PG8_MMA(1, 1, At, B1); PG8_BAR; PG8_SCHED;
            } else {
            PG8_LDB(B0, 0, 0); PG8_SCHED; PG8_LDA(At, 0, 0); PG8_STAGE(PG8_SA(1, 1), a1 + hstep, voffA);
            PG8_WAIT_L(8); PG8_BAR; PG8_WAIT_L(0); PG8_MMA(0, 0, At, B0); PG8_BAR; PG8_SCHED;
            PG8_LDB(B1, 0, 1); PG8_STAGE(PG8_SB(0, 0), b2, voffB);
            PG8_BAR; PG8_WAIT_L(0); PG8_MMA(0, 1, At, B1); PG8_BAR;
            PG8_LDA(At, 0, 1); PG8_STAGE(PG8_SA(0, 0), a2, voffA);
            PG8_BAR; PG8_WAIT_L(0); PG8_MMA(1, 0, At, B0); PG8_BAR; PG8_SCHED;
            PG8_STAGE(PG8_SB(0, 1), b2 + hstep, voffB);
            PG8_WAIT_V(6); PG8_BAR; PG8_MMA(1, 1, At, B1); PG8_BAR;
            PG8_LDB(B0, 1, 0); PG8_SCHED; PG8_LDA(At, 1, 0); PG8_STAGE(PG8_SA(0, 1), a2 + hstep, voffA);
            PG8_WAIT_L(8); PG8_BAR; PG8_WAIT_L(0); PG8_MMA(0, 0, At, B0); PG8_BAR; PG8_SCHED;
            PG8_LDB(B1, 1, 1); PG8_STAGE(PG8_SB(1, 0), b3, voffB);
            PG8_BAR; PG8_WAIT_L(0); PG8_MMA(0, 1, At, B1); PG8_BAR;
            PG8_LDA(At, 1, 1); PG8_STAGE(PG8_SA(1, 0), a3, voffA);
            PG8_BAR; PG8_WAIT_L(0); PG8_MMA(1, 0, At, B0); PG8_BAR; PG8_SCHED;
            PG8_STAGE(PG8_SB(1, 1), b3 + hstep, voffB);
            PG8_WAIT_V(6); PG8_BAR; PG8_MMA(1, 1, At, B1); PG8_BAR;
            }
        }
        if constexpr (ALIGN_EPI) { if (wr == 0) PG8_BAR; }
        if constexpr (!Epi::AFTER_DRAIN) { E(acc, cur, wr, wc, fr, fq); S.done(cur); }
        if (!has_next) break;
#pragma unroll
        for (int a = 0; a < 2; ++a)
#pragma unroll
            for (int b = 0; b < 2; ++b)
#pragma unroll
                for (int m = 0; m < 4; ++m)
#pragma unroll
                    for (int n = 0; n < 2; ++n) acc[a][b][m][n] = (f32x4){0.f, 0.f, 0.f, 0.f};
        cur = nxt; cA = nA; cB = nB; ++ui;
        if constexpr (ALIGN_EPI) { if (wr == 1) PG8_BAR; }
    }
    PG8_WAIT_V(0);
    if constexpr (!ALIGN_EPI) { if (wr == 0) PG8_BAR; }
    PG8_BAR;
    if constexpr (Epi::AFTER_DRAIN) { E.fused(acc, cur, wr, wc, fr, fq, lds, wid, lane); S.done(cur); }
#undef PG8_SA
#undef PG8_SB
#undef PG8_STAGE
#undef PG8_LDA
#undef PG8_LDB
#undef PG8_MMA
#undef PG8_WAIT_V
#undef PG8_WAIT_L
#undef PG8_BAR
#undef PG8_SCHED
}
}
#define GAS __attribute__((address_space(1)))
#define LAS __attribute__((address_space(3)))
typedef unsigned short bf16;
typedef unsigned v4u __attribute__((ext_vector_type(4)));
typedef float f32x4 __attribute__((ext_vector_type(4)));
typedef short bf16x8 __attribute__((ext_vector_type(8)));
typedef GAS unsigned gu32;
typedef GAS unsigned long long gu64;
#define RLX_AGENT __ATOMIC_RELAXED, __HIP_MEMORY_SCOPE_AGENT
#define LDS_WAIT() asm volatile("s_waitcnt lgkmcnt(0)" ::: "memory")
#define VM_WAIT() asm volatile("s_waitcnt vmcnt(0)" ::: "memory")
__device__ __forceinline__ unsigned long long rt() { return __builtin_amdgcn_s_memrealtime(); }
__device__ __forceinline__ unsigned f2bf(float f) { unsigned u = __builtin_bit_cast(unsigned, f); return (u + 0x7fffu + ((u >> 16) & 1u)) >> 16; }
__device__ __forceinline__ unsigned pk2(float lo, float hi) { return f2bf(lo) | (f2bf(hi) << 16); }

#define XB_TMO      128
#define XB_XCNT(j)  (256  + 64 * (j))
#define XB_XSUB(j)  (1280 + 64 * (j))
#define XB_XGEN(j)  (2304 + 64 * (j))
#define XB_TOP      3328
#define XB_TOPGEN   3392
#define XCD_BAR_WORDS 3456
#define XB_SPIN_CAP (1u << 18)

__device__ __forceinline__ unsigned xb_ld(unsigned* p)              { return __hip_atomic_load(p, __ATOMIC_RELAXED, __HIP_MEMORY_SCOPE_AGENT); }
__device__ __forceinline__ unsigned xb_add(unsigned* p, unsigned v) { return __hip_atomic_fetch_add(p, v, __ATOMIC_RELAXED, __HIP_MEMORY_SCOPE_AGENT); }
__device__ __forceinline__ unsigned xb_xcc_id() { return (unsigned)__builtin_amdgcn_s_getreg((3 << 11) | 20) & 0xFu; }
#define XB_SPIN(cond, bar) do { unsigned _sp = 0; while (cond) { __builtin_amdgcn_s_sleep(1); \
    if ((++_sp & 255u) == 0u) { if (xb_ld(&(bar)[XB_TMO])) break; if (_sp > XB_SPIN_CAP) { atomicAdd(&(bar)[XB_TMO], 1u); break; } } } } while (0)

struct XcdBarrier {
    unsigned* bar; unsigned x;
    volatile LAS unsigned* st;
};

__device__ __forceinline__ XcdBarrier xcd_barrier_post(unsigned* bar, volatile LAS unsigned* st) {
    XcdBarrier b; b.bar = bar; b.x = xb_xcc_id(); b.st = st;
    if (threadIdx.x == 0) (void)xb_add(&bar[XB_XCNT(b.x)], 1u);
    return b;
}
__device__ __forceinline__ void xcd_barrier_complete(unsigned* bar, unsigned x, unsigned& nloc, unsigned& nx) {
    const unsigned G = gridDim.x * gridDim.y * gridDim.z;
    unsigned sum, cnt, mine, sp = 0u;
    for (;;) {
        sum = 0u; cnt = 0u; mine = 0u;
#pragma unroll
        for (unsigned j = 0; j < 16; ++j) { const unsigned c = xb_ld(&bar[XB_XCNT(j)]); sum += c; cnt += (c > 0u) ? 1u : 0u; mine = (j == x) ? c : mine; }
        if (sum == G) break;
        __builtin_amdgcn_s_sleep(1);
        if ((++sp & 255u) == 0u) { if (xb_ld(&bar[XB_TMO])) break; if (sp > XB_SPIN_CAP) { atomicAdd(&bar[XB_TMO], 1u); break; } }
    }
    nloc = mine > 0u ? mine : 1u; nx = cnt > 0u ? cnt : 1u;
}

__device__ __forceinline__ void xcd_barrier(const XcdBarrier& b) {
    asm volatile("s_waitcnt vmcnt(0)" ::: "memory");
    __syncthreads();
    if (threadIdx.x == 0) {
        unsigned* bar = b.bar;
        __builtin_amdgcn_s_waitcnt(0);
        unsigned nloc = b.st[0], nx = b.st[1];
        if (nloc == 0u) { xcd_barrier_complete(bar, b.x, nloc, nx); b.st[0] = nloc; b.st[1] = nx; }
        const unsigned old = xb_add(&bar[XB_XSUB(b.x)], 1u);
        const unsigned gen = old / nloc;
        if (old + 1u == (gen + 1u) * nloc) {
            __builtin_amdgcn_fence(__ATOMIC_RELEASE, "agent");
            asm volatile("s_waitcnt vmcnt(0)" ::: "memory");
            const unsigned og = xb_add(&bar[XB_TOP], 1u);
            const unsigned tg = og / nx;
            if (og + 1u == (tg + 1u) * nx) xb_add(&bar[XB_TOPGEN], 1u);
            else XB_SPIN(xb_ld(&bar[XB_TOPGEN]) == tg, bar);
            __builtin_amdgcn_fence(__ATOMIC_ACQUIRE, "agent");
            xb_add(&bar[XB_XGEN(b.x)], 1u);
            asm volatile("s_waitcnt vmcnt(0)" ::: "memory");
        } else {
            XB_SPIN(xb_ld(&bar[XB_XGEN(b.x)]) == gen, bar);
            __builtin_amdgcn_fence(__ATOMIC_ACQUIRE, "agent");
            asm volatile("s_waitcnt vmcnt(0)" ::: "memory");
        }
    }
    __syncthreads();
}


constexpr int NWAVES = 8;
constexpr int D = 1024, ML = 16384, MC = 256, M = ML + MC, DFF = 2816;
constexpr int NIN = 7712, NINP = 7936;
constexpr int NSC = 32, SCL = 512;
constexpr float EPS = 1e-6f;
static_assert(pg8::EP_ML == ML, "epilogue constant");

constexpr size_t MiB = 1u << 20, KiB = 1024;
constexpr size_t WS_CTL = 0, CTL_ZERO_BYTES = 1 * MiB;
constexpr size_t WS_SMALL = 1 * MiB;
constexpr size_t WS_HCTX = 9 * MiB;
constexpr size_t WS_FCTX = 10 * MiB;
constexpr size_t WS_RX = 11 * MiB;
constexpr size_t WS_ZQ = 44 * MiB;
constexpr size_t WS_XBC = 109 * MiB;
constexpr size_t WS_V = WS_XBC + (size_t)M * 1536 * 2;
constexpr size_t WS_G = WS_V + (size_t)M * 1024 * 2;
constexpr size_t WS_DT = WS_G + (size_t)M * 1024 * 2;
constexpr size_t WS_WIN = 227 * MiB;
static_assert(WS_DT + (size_t)M * 64 * 4 <= WS_WIN && WS_WIN + (size_t)NINP * 1024 * 2 <= 256 * MiB, "ws map (mixer phase)");
constexpr size_t WS_WREST = 216 * MiB;
constexpr size_t WO_OUT = 0, WO_UP0 = 4 * MiB, WO_DOWN0 = 15 * MiB, WO_OD = WO_DOWN0 + (size_t)DFF * 1024 * 2, WO_VG = WO_OD + 1 * MiB, WO_UP1 = WO_VG + 2 * MiB, WO_DOWN1 = WO_UP1 + 11 * MiB;
static_assert(WO_DOWN1 + (size_t)DFF * 1024 * 2 <= 40 * MiB, "weights overlay");
constexpr size_t WS_HID = WS_XBC;
static_assert(WS_HID + (size_t)M * DFF * 2 <= WS_WREST, "hidden overlay");
constexpr size_t WS_U = WS_ZQ;
constexpr size_t WS_A2 = WS_U + (size_t)M * 512 * 4;
static_assert(WS_A2 + (size_t)ML * 512 * 2 <= WS_XBC, "layer-1 overlay");
constexpr size_t WS_YS = WS_XBC;
constexpr size_t SM_ADAP = 0;
constexpr size_t SM_MODS = SM_ADAP + 2 * 2 * 8 * 6144 * 4;
constexpr size_t SM_LB = SM_MODS + 2 * 2 * 6144 * 4;
constexpr size_t SM_LAM = SM_LB + 4096;
constexpr size_t SM_LAMP = SM_LAM + 2 * 2048 * 2 * 4;
constexpr size_t SM_BB = SM_LAMP + 2 * 2048 * 2 * 4;
constexpr size_t SM_STATS = SM_BB + 2 * 2048 * 16 * 2 * 4;
constexpr size_t SM_SSDDEC = SM_STATS + (size_t)M * 16 * 4;
constexpr size_t SM_HGDEC = SM_SSDDEC + 33 * 32 * 4 + 128;
constexpr size_t SM_S5ST = ((SM_HGDEC + 33 * 16 * 128 * 4 + 255) / 256) * 256;
static_assert(SM_S5ST + 130 * 2 * 2048 * 2 * 4 <= 8 * MiB, "small tables");
constexpr size_t SSD_ST_BYTES = (size_t)33 * 32 * 8192 * 2;
static_assert(2 * SSD_ST_BYTES <= 33 * MiB && (size_t)M * 1024 * 2 <= 33 * MiB, "RX region");
constexpr int CW_BAR = 4096;

constexpr int RING_OFF = 0, RING_BYTES = 131072;
constexpr int LDSCTL_OFF = RING_BYTES, MISC_OFF = LDSCTL_OFF + 320;
constexpr int LDS_BYTES = 163840;


struct Params { const float* in[33]; float* out; unsigned char* ws; int ph_lo, ph_hi, use_bar, pad; };
enum { I_X = 0, I_C, I_CTX, I_CCTX, I_ADAW, I_ADAB, I_NMIX, I_NFFN, I_WGATE, I_WUP, I_WDOWN, I_FNORM, I_EVIN, I_EVOUT, I_CONVW, I_CONVB, I_DTB, I_ALOG, I_SSDD, I_SSDN, I_LBL, I_HGN,
       I_ODIN, I_ARE, I_AIM, I_LOGDT, I_BRE, I_BIM, I_CRE, I_CIM, I_S5D, I_WVAL, I_WGATE2 };
typedef _Float16 f16x8 __attribute__((ext_vector_type(8)));
typedef _Float16 f16;
typedef _Float16 f16x2 __attribute__((ext_vector_type(2)));
typedef float f32x2 __attribute__((ext_vector_type(2)));
__device__ __forceinline__ float bf2f(unsigned b) { return __uint_as_float(b << 16); }
__device__ __forceinline__ float siluf(float x) { return x / (1.f + __expf(-x)); }
__device__ __forceinline__ float wave_sum(float v) {
#pragma unroll
    for (int o = 1; o < 64; o <<= 1) v += __shfl_xor(v, o);
    return v;
}
__device__ __forceinline__ void unpack8(const v4u r, float (&x)[8]) {
    x[0] = bf2f(r.x & 0xffffu); x[1] = bf2f(r.x >> 16); x[2] = bf2f(r.y & 0xffffu); x[3] = bf2f(r.y >> 16);
    x[4] = bf2f(r.z & 0xffffu); x[5] = bf2f(r.z >> 16); x[6] = bf2f(r.w & 0xffffu); x[7] = bf2f(r.w >> 16);
}
__device__ __forceinline__ void tr_item(const float* W, int ldw, int col0, int K, bf16* WT, int dst_row0, LAS float* scr, int kb, int lane) {
    const int k0 = 64 * kb;
#pragma unroll 8
    for (int i = 0; i < 32; ++i) { const int kk = 2 * i + (lane >> 5); scr[kk * 33 + (lane & 31)] = W[(size_t)(k0 + kk) * ldw + col0 + (lane & 31)]; }
    LDS_WAIT(); asm volatile("" ::: "memory");
    const int c = lane & 7;
#pragma unroll
    for (int j = 0; j < 4; ++j) { const int n = (lane >> 3) + 8 * j; const LAS float* s = scr + (8 * c) * 33 + n;
        v4u o; o.x = pk2(s[0 * 33], s[1 * 33]); o.y = pk2(s[2 * 33], s[3 * 33]); o.z = pk2(s[4 * 33], s[5 * 33]); o.w = pk2(s[6 * 33], s[7 * 33]);
        *(GAS v4u*)(WT + (size_t)(dst_row0 + n) * K + k0 + 8 * c) = o; }
    LDS_WAIT(); asm volatile("" ::: "memory");
}
__device__ __forceinline__ int dst_row_of(int mode, int c0) {
    if (mode == 0) return c0 < 2560 ? c0 : (c0 < 2592 ? 7680 + (c0 - 2560) : c0 - 32);
    if (mode == 1) return c0;
    return (c0 >> 7) * 256 + (mode == 3 ? 128 : 0) + (c0 & 127);
}
__device__ __forceinline__ void tr_job(const float* W, int K, int N, int mode, bf16* WT, LAS float* scr, int gw, int ngw, int lane) {
    const int nblk = N / 32, nit = (K / 64) * nblk;
    for (int it = gw; it < nit; it += ngw) { const int kb = it / nblk, nb = it % nblk; tr_item(W, N, 32 * nb, K, WT, dst_row_of(mode, 32 * nb), scr, kb, lane); }
}

__device__ __forceinline__ void phase_prologue(const Params& p, LAS unsigned char* lds, int bid, int G, int tid, int wave, int lane) {
    unsigned char* ws = p.ws; float* sm_adap = (float*)(ws + WS_SMALL + SM_ADAP);
    for (int it = bid; it < 192; it += G) {
        const int layer = it / 96, rem = it % 96, cb = rem / 8, ks = rem % 8;
        LAS float* sl = (LAS float*)lds; LAS float* sc = sl + 128;
        if (tid < 128) { sl[tid] = siluf(p.in[I_C][ks * 128 + tid]); sc[tid] = siluf(p.in[I_CCTX][ks * 128 + tid]); }
        __syncthreads();
        const int col = cb * 512 + tid; const float* W = p.in[I_ADAW] + (size_t)layer * 1024 * 6144 + (size_t)(ks * 128) * 6144 + col;
        float a0 = 0.f, a1 = 0.f;
#pragma unroll 8
        for (int k = 0; k < 128; ++k) { const float w = W[(size_t)k * 6144]; a0 += sl[k] * w; a1 += sc[k] * w; }
        sm_adap[((layer * 2 + 0) * 8 + ks) * 6144 + col] = a0; sm_adap[((layer * 2 + 1) * 8 + ks) * 6144 + col] = a1;
        __syncthreads();
    }
    const int gw = bid * NWAVES + wave, ngw = G * NWAVES;
    LAS float* scr = (LAS float*)(lds + wave * 16384);
    bf16* win = (bf16*)(ws + WS_WIN);
    tr_job(p.in[I_EVIN], 1024, NIN, 0, win, scr, gw, ngw, lane);
    { const int gt = bid * 512 + tid, nt = G * 512; v4u z = {0u, 0u, 0u, 0u};
      for (int i = gt; i < (NINP - NIN) * 1024 / 8; i += nt) *(GAS v4u*)(win + (size_t)NIN * 1024 + (size_t)i * 8) = z; }
    const int gt = bid * 512 + tid;
    if (gt < 1024) { const float l0 = p.in[I_LBL][gt], l1 = p.in[I_LBL][1024 + gt]; const float mx = fmaxf(l0, l1), e0 = __expf(l0 - mx), e1 = __expf(l1 - mx); ((float*)(ws + WS_SMALL + SM_LB))[gt] = e0 / (e0 + e1); }
    if (gt >= 4096 && gt < 8192) {
        const int s = gt - 4096, dg = s >> 6;
        const float dt = expf(p.in[I_LOGDT][dg]), are = p.in[I_ARE][s], aim = p.in[I_AIM][s];
        const float mag = expf(are * dt); float sn, cs; sincosf(aim * dt, &sn, &cs);
        const float lr = mag * cs, li = mag * sn, den = are * are + aim * aim;
        const float cr = ((lr - 1.f) * are + li * aim) / den, ci = (li * are - (lr - 1.f) * aim) / den;
        float* lam = (float*)(ws + WS_SMALL + SM_LAM); lam[2 * s] = lr; lam[2 * s + 1] = li;
        float pr = lr, pi = li;
#pragma unroll
        for (int q = 0; q < 7; ++q) { const float nr = pr * pr - pi * pi, ni = 2.f * pr * pi; pr = nr; pi = ni; }
        float* lamp = (float*)(ws + WS_SMALL + SM_LAMP); lamp[2 * s] = pr; lamp[2 * s + 1] = pi;
        bf16* bbh = (bf16*)(ws + WS_SMALL + SM_BB) + (size_t)s * 32;
#pragma unroll
        for (int c = 0; c < 16; ++c) { const float br = p.in[I_BRE][(size_t)s * 16 + c], bi = p.in[I_BIM][(size_t)s * 16 + c]; bbh[c] = (bf16)f2bf(cr * br - ci * bi); bbh[16 + c] = (bf16)f2bf(cr * bi + ci * br); }
    }
    { bf16* cmh = (bf16*)(ws + WS_SMALL + SM_BB + 262144); const int nt = G * 512;
      for (int e = gt; e < 2 * 32 * 16 * 128; e += nt) { const int k = e & 127, dgc = e >> 7; cmh[e] = (bf16)f2bf(k < 64 ? p.in[I_CRE][(size_t)dgc * 64 + k] : -p.in[I_CIM][(size_t)dgc * 64 + k - 64]); } }
}

__device__ __forceinline__ void phase_rownorm(const Params& p, LAS unsigned char* lds, int bid, int G, int tid, int wave, int lane, int layer, int kind  , int nrows,
                                              const float* src_lat, const float* src_ctx, bool from_partials) {
    unsigned char* ws = p.ws; const float* adap = (const float*)(ws + WS_SMALL + SM_ADAP); float* mods = (float*)(ws + WS_SMALL + SM_MODS);
    LAS float* Gt = (LAS float*)lds; LAS float* St = Gt + 2048;
    const float* ng = p.in[kind == 0 ? I_NMIX : I_NFFN] + layer * 1024;
    for (int idx = tid; idx < 4096; idx += 512) {
        const int vec = idx >> 11, which = (idx >> 10) & 1, col = idx & 1023, j = (kind * 3 + which) * 1024 + col;
        float v;
        if (from_partials) { v = p.in[I_ADAB][layer * 6144 + j];
#pragma unroll
            for (int ks = 0; ks < 8; ++ks) v += adap[((layer * 2 + vec) * 8 + ks) * 6144 + j]; }
        else v = mods[(layer * 2 + vec) * 6144 + j];
        if (which == 0) St[vec * 1024 + col] = v; else Gt[vec * 1024 + col] = ng[col] * (1.f + v);
    }
    if (from_partials && bid < 48) {
        const int idx = bid * 512 + tid, lv = idx / 6144, j = idx % 6144, ly = lv >> 1;
        float v = p.in[I_ADAB][ly * 6144 + j];
#pragma unroll
        for (int ks = 0; ks < 8; ++ks) v += adap[(lv * 8 + ks) * 6144 + j];
        mods[idx] = v;
    }
    __syncthreads();
    bf16* XN = (bf16*)(ws + WS_RX);
    const int gw = bid * NWAVES + wave, ngw = G * NWAVES;
    for (int row = gw; row < nrows; row += ngw) {
        const int vec = row >= ML ? 1 : 0; const float* xr = vec ? src_ctx + (size_t)(row - ML) * 1024 : src_lat + (size_t)row * 1024;
        f32x4 v[4]; float ss = 0.f;
#pragma unroll
        for (int j = 0; j < 4; ++j) { v[j] = *(const GAS f32x4*)(xr + 4 * lane + 256 * j); ss += (v[j].x * v[j].x + v[j].y * v[j].y) + (v[j].z * v[j].z + v[j].w * v[j].w); }
        const float r = rsqrtf(wave_sum(ss) * (1.f / 1024.f) + EPS);
#pragma unroll
        for (int j = 0; j < 4; ++j) { const int c = 4 * lane + 256 * j; const LAS float* g4 = Gt + vec * 1024 + c; const LAS float* s4 = St + vec * 1024 + c;
            const unsigned lo = pk2(v[j].x * r * g4[0] + s4[0], v[j].y * r * g4[1] + s4[1]), hi = pk2(v[j].z * r * g4[2] + s4[2], v[j].w * r * g4[3] + s4[3]);
            *(GAS unsigned long long*)(XN + (size_t)row * 1024 + c) = (unsigned long long)lo | ((unsigned long long)hi << 32); }
    }
}

typedef float f32x16 __attribute__((ext_vector_type(16)));
typedef short s16x4 __attribute__((ext_vector_type(4)));
#define MFMA32(a, b, c) __builtin_amdgcn_mfma_f32_32x32x16_bf16((a), (b), (c), 0, 0, 0)
__device__ __forceinline__ bf16x8 frag_rows(LAS const unsigned char* img, int RS, int row0, int kbyte, int lane) { return *(const LAS bf16x8*)(img + (row0 + (lane & 31)) * RS + kbyte + (lane >> 5) * 16); }
__device__ __forceinline__ bf16x8 frag_tr(LAS const unsigned char* img, int RS, int k0, int col0, int lane) {
    const int h = lane >> 5, blk = (lane >> 4) & 1, q = (lane & 15) >> 2, p = lane & 3;
    LAS const unsigned char* a = img + (k0 + 8 * h + q) * RS + (col0 + 16 * blk + 4 * p) * 2;
    const s16x4 lo = __builtin_amdgcn_ds_read_tr16_b64_v4i16((LAS s16x4*)a), hi = __builtin_amdgcn_ds_read_tr16_b64_v4i16((LAS s16x4*)(a + 4 * RS));
    return (bf16x8){lo[0], lo[1], lo[2], lo[3], hi[0], hi[1], hi[2], hi[3]};
}
__device__ __forceinline__ int arow(int reg, int h) { return (reg & 3) + 8 * (reg >> 2) + 4 * h; }
__device__ __forceinline__ void store_acc_nat(const f32x16& acc, LAS unsigned char* img, int RS, int n0, int m0, int lane) {
    LAS unsigned char* base = img + (n0 + (lane & 31)) * RS + (m0 + 4 * (lane >> 5)) * 2;
#pragma unroll
    for (int g = 0; g < 4; ++g) *(LAS unsigned long long*)(base + 16 * g) = (unsigned long long)pk2(acc[4 * g], acc[4 * g + 1]) | ((unsigned long long)pk2(acc[4 * g + 2], acc[4 * g + 3]) << 32);
}

struct ScanPtrs { const bf16* XBC; const float* DT; bf16* ZQ; const bf16* V; const bf16* G; f16* Flat; f16* Fctx; float* STATS; const float* convw; const float* convb; const float* ssdd; const float* hgn;
                  bf16* SSD_ST; bf16* HG_ST; float* SSD_DEC; float* HG_DEC; bf16* YFS; };
template <int MODE, int D>
__device__ __forceinline__ void ssd_scan(const ScanPtrs& sp, LAS unsigned char* lds, int row_begin, int nchunks, int seq_lo, int seq_hi, int h, const bf16* st_in, bf16* st_out, float* dec_out, bf16* yfs, int tid) {
    const int lane = tid & 63, wave = __builtin_amdgcn_readfirstlane(tid >> 6), hf = lane >> 5, g = h >> 3;
    LAS unsigned char* XI = lds; LAS unsigned char* XE = lds + 9216; LAS unsigned char* BI = lds + 18432; LAS unsigned char* CI = lds + 35840; LAS unsigned char* MI = lds + 53248; LAS unsigned char* SPI = lds + 62464;
    LAS float* YB = (LAS float*)(lds + 79872); LAS unsigned char* XR = lds + 97280; LAS unsigned char* BR = lds + 105984; LAS float* WT = (LAS float*)(lds + 123392); LAS unsigned char* CR = lds + 132096;
    LAS float* AC = (LAS float*)(lds + 149504); LAS float* EA = AC + 64; LAS float* ES = AC + 128; LAS float* DTS = AC + 192;
    asm volatile("" : "+s"(nchunks));
    for (int i = tid; i < 1920; i += 512) { int col, j;
        if (i < 384) { j = i >> 6; col = h * 64 + (i & 63); } else if (i < 1152) { const int i2 = i - 384; j = i2 >> 7; col = 1024 + g * 128 + (i2 & 127); } else { const int i2 = i - 1152; j = i2 >> 7; col = 1280 + g * 128 + (i2 & 127); }
        WT[i] = j < 5 ? sp.convw[j * 1536 + col] : sp.convb[col]; }
    const int nb = wave >> 1, pb = wave & 1;
    f32x16 accS;
#pragma unroll
    for (int r = 0; r < 16; ++r) accS[r] = st_in ? bf2f(*(const GAS unsigned short*)(st_in + (32 * nb + arow(r, hf)) * 64 + 32 * pb + (lane & 31))) : 0.f;
    if (MODE != 0) store_acc_nat(accS, SPI, 272, 32 * pb, 32 * nb, lane);
    float ltot = 0.f; const float dsk = sp.ssdd[h];
    constexpr int NU = MODE != 0 ? 2720 : 1632, NPF = MODE != 0 ? 6 : 4;
    v4u pf[NPF]; float pdt = 0.f, pla = 0.f;
    const v4u zero4 = {0u, 0u, 0u, 0u};
#define SSD_LOAD(c_, tid) do { const int rb_ = row_begin + 64 * (c_) - 2; \
        _Pragma("unroll") for (int i_ = 0; i_ < NPF; ++i_) { const int u_ = tid + 512 * i_; int rr_, cc_; \
            if (u_ < 544) { rr_ = u_ >> 3; cc_ = h * 64 + (u_ & 7) * 8; } else if (u_ < 1632) { rr_ = (u_ - 544) >> 4; cc_ = 1024 + g * 128 + ((u_ - 544) & 15) * 8; } else { rr_ = (u_ - 1632) >> 4; cc_ = 1280 + g * 128 + ((u_ - 1632) & 15) * 8; } \
            rr_ += rb_; pf[i_] = (u_ < NU && rr_ >= seq_lo && rr_ < seq_hi) ? *(const GAS v4u*)(sp.XBC + (size_t)rr_ * 1536 + cc_) : zero4; } \
        if (tid < 64) { pdt = sp.DT[(size_t)(rb_ + 2 + tid) * 64 + D * 16 + h]; pla = sp.DT[(size_t)(rb_ + 2 + tid) * 64 + 32 + D * 16 + h]; } } while (0)
    SSD_LOAD(D == 0 ? 0 : nchunks - 1, tid);
#pragma unroll 1
    for (int ci = 0; ci < nchunks; ++ci) {
        const int c = D == 0 ? ci : nchunks - 1 - ci, r0 = row_begin + 64 * c;
        int tl = tid; asm volatile("" : "+v"(tl));
#pragma unroll
        for (int i = 0; i < NPF; ++i) { const int u = tl + 512 * i; if (u < NU) { if (u < 1632) *(LAS v4u*)(XR + u * 16) = pf[i]; else *(LAS v4u*)(CR + (u - 1632) * 16) = pf[i]; } }
        if (wave == 0) {
            float x = pla;
#pragma unroll
            for (int o = 1; o < 64; o <<= 1) { const float v = D == 0 ? __shfl_up(x, o) : __shfl_down(x, o); if (D == 0 ? (lane >= o) : (lane + o < 64)) x += v; }
            const float last = __shfl(x, D == 0 ? 63 : 0);
            AC[lane] = x; EA[lane] = __expf(x); ES[lane] = pdt * __expf(last - x); DTS[lane] = pdt;
            if (lane == 0) AC[256] = __expf(last);
            ltot += last;
        }
        __syncthreads();
        { const int t = tl >> 3, o8 = (tl & 7) * 8; float a8[8];
#pragma unroll
          for (int i = 0; i < 8; ++i) a8[i] = WT[320 + o8 + i];
#pragma unroll
          for (int j = 0; j < 5; ++j) { float x8[8]; unpack8(*(const LAS v4u*)(XR + (t + j) * 128 + o8 * 2), x8);
#pragma unroll
              for (int i = 0; i < 8; ++i) a8[i] += WT[j * 64 + o8 + i] * x8[i]; }
          const float es = ES[t]; v4u w, we;
#pragma unroll
          for (int i = 0; i < 8; ++i) a8[i] = siluf(a8[i]);
          w.x = pk2(a8[0], a8[1]); w.y = pk2(a8[2], a8[3]); w.z = pk2(a8[4], a8[5]); w.w = pk2(a8[6], a8[7]);
          we.x = pk2(a8[0] * es, a8[1] * es); we.y = pk2(a8[2] * es, a8[3] * es); we.z = pk2(a8[4] * es, a8[5] * es); we.w = pk2(a8[6] * es, a8[7] * es);
          *(LAS v4u*)(XI + t * 144 + o8 * 2) = w; *(LAS v4u*)(XE + t * 144 + o8 * 2) = we; }
        __builtin_amdgcn_sched_barrier(0);
#pragma unroll
        for (int u2 = 0; u2 < 2; ++u2) { const int u = tl + 512 * u2, t = u >> 4, o8 = (u & 15) * 8;
            { float a8[8];
#pragma unroll
              for (int i = 0; i < 8; ++i) a8[i] = WT[384 + 640 + o8 + i];
#pragma unroll
              for (int j = 0; j < 5; ++j) { float x8[8]; unpack8(*(const LAS v4u*)(BR + (t + j) * 256 + o8 * 2), x8);
#pragma unroll
                  for (int i = 0; i < 8; ++i) a8[i] += WT[384 + j * 128 + o8 + i] * x8[i]; }
              v4u w; w.x = pk2(siluf(a8[0]), siluf(a8[1])); w.y = pk2(siluf(a8[2]), siluf(a8[3])); w.z = pk2(siluf(a8[4]), siluf(a8[5])); w.w = pk2(siluf(a8[6]), siluf(a8[7]));
              *(LAS v4u*)(BI + t * 272 + o8 * 2) = w; }
            __builtin_amdgcn_sched_barrier(0);
            if (MODE != 0) { float a8[8];
#pragma unroll
              for (int i = 0; i < 8; ++i) a8[i] = WT[1152 + 640 + o8 + i];
#pragma unroll
              for (int j = 0; j < 5; ++j) { float x8[8]; unpack8(*(const LAS v4u*)(CR + (t + j) * 256 + o8 * 2), x8);
#pragma unroll
                  for (int i = 0; i < 8; ++i) a8[i] += WT[1152 + j * 128 + o8 + i] * x8[i]; }
              v4u w; w.x = pk2(siluf(a8[0]), siluf(a8[1])); w.y = pk2(siluf(a8[2]), siluf(a8[3])); w.z = pk2(siluf(a8[4]), siluf(a8[5])); w.w = pk2(siluf(a8[6]), siluf(a8[7]));
              *(LAS v4u*)(CI + t * 272 + o8 * 2) = w; }
            __builtin_amdgcn_sched_barrier(0); }
        if (ci + 1 < nchunks) SSD_LOAD(D == 0 ? ci + 1 : nchunks - 2 - ci, tl);
        __syncthreads();
        f32x16 accY;
        const int tb = (wave & 3) >> 1, qb = wave & 1;
        if (MODE != 0) {
            if (wave >= 4) { const int sb = tb; f32x16 a;
#pragma unroll
                for (int r = 0; r < 16; ++r) a[r] = 0.f;
#pragma unroll
                for (int ks = 0; ks < 8; ++ks) a = MFMA32(frag_rows(BI, 272, 32 * sb, 32 * ks, lane), frag_rows(CI, 272, 32 * qb, 32 * ks, lane), a);
                const int t = 32 * qb + (lane & 31); const float act = AC[t];
#pragma unroll
                for (int r = 0; r < 16; ++r) { const int s2 = 32 * sb + arow(r, hf); const bool keep = D == 0 ? (s2 <= t) : (s2 >= t); a[r] = keep ? a[r] * __expf(act - AC[s2]) * DTS[s2] : 0.f; }
                store_acc_nat(a, MI, 144, 32 * qb, 32 * sb, lane);
            } else {
#pragma unroll
                for (int r = 0; r < 16; ++r) accY[r] = 0.f;
#pragma unroll
                for (int ks = 0; ks < 8; ++ks) accY = MFMA32(frag_rows(CI, 272, 32 * tb, 32 * ks, lane), frag_rows(SPI, 272, 32 * qb, 32 * ks, lane), accY);
#pragma unroll
                for (int r = 0; r < 16; ++r) accY[r] *= EA[32 * tb + arow(r, hf)];
            }
            __syncthreads();
            if (wave < 4) {
#pragma unroll
                for (int ks = 0; ks < 4; ++ks) accY = MFMA32(frag_rows(MI, 144, 32 * tb, 32 * ks, lane), frag_tr(XI, 144, 16 * ks, 32 * qb, lane), accY);
#pragma unroll
                for (int r = 0; r < 16; ++r) YB[(32 * tb + arow(r, hf)) * 68 + 32 * qb + (lane & 31)] = accY[r];
            }
        }
        { const float el = AC[256];
#pragma unroll
          for (int r = 0; r < 16; ++r) accS[r] *= el;
#pragma unroll
          for (int ks = 0; ks < 4; ++ks) accS = MFMA32(frag_tr(BI, 272, 16 * ks, 32 * nb, lane), frag_tr(XE, 144, 16 * ks, 32 * pb, lane), accS);
          if (MODE != 0) store_acc_nat(accS, SPI, 272, 32 * pb, 32 * nb, lane); }
        __syncthreads();
        if (MODE != 0) {
            int t3 = tid; asm volatile("" : "+v"(t3)); const int t = t3 >> 3, p8 = (t3 & 7) * 8, row = r0 + t;
            const f32x4 y0 = *(const LAS f32x4*)(YB + t * 68 + p8), y1 = *(const LAS f32x4*)(YB + t * 68 + p8 + 4);
            GAS v4u* yp = (GAS v4u*)(yfs + (size_t)(row - row_begin) * 64 + p8);
            if (MODE == 1) { v4u w; w.x = pk2(y0.x, y0.y); w.y = pk2(y0.z, y0.w); w.z = pk2(y1.x, y1.y); w.w = pk2(y1.z, y1.w); *yp = w; }
            else { float yf[8], x8[8], z8[8]; unpack8(*yp, yf); unpack8(*(const LAS v4u*)(XI + t * 144 + p8 * 2), x8);
                GAS v4u* zp = (GAS v4u*)(sp.ZQ + (size_t)row * 2048 + h * 64 + p8); unpack8(*zp, z8);
                float o[8] = {y0.x, y0.y, y0.z, y0.w, y1.x, y1.y, y1.z, y1.w}; float ss = 0.f;
#pragma unroll
                for (int i = 0; i < 8; ++i) { o[i] = (o[i] + yf[i] + dsk * x8[i]) * z8[i]; ss += o[i] * o[i]; }
                v4u w; w.x = pk2(o[0], o[1]); w.y = pk2(o[2], o[3]); w.z = pk2(o[4], o[5]); w.w = pk2(o[6], o[7]); *zp = w;
                ss += __shfl_xor(ss, 1); ss += __shfl_xor(ss, 2); ss += __shfl_xor(ss, 4);
                if ((t3 & 7) == 0) sp.STATS[(size_t)row * 16 + h] = ss; }
        }
    }
#undef SSD_LOAD
    if (st_out) {
#pragma unroll
        for (int r = 0; r < 16; ++r) *(GAS unsigned short*)(st_out + (32 * nb + arow(r, hf)) * 64 + 32 * pb + (lane & 31)) = (unsigned short)f2bf(accS[r]); }
    if (dec_out && tid == 0) *dec_out = __expf(ltot);
    __syncthreads();
}
template <int MODE, int D>
__device__ __forceinline__ void hg_scan(const ScanPtrs& sp, LAS unsigned char* lds, int row_begin, int nchunks, int hh, const bf16* st_in, bf16* st_out, float* dec_out, int tid) {
    const int lane = tid & 63, wave = __builtin_amdgcn_readfirstlane(tid >> 6), h = lane >> 5;
    LAS unsigned char* QP = lds; LAS unsigned char* KP = lds + 17408; LAS unsigned char* VI = lds + 34816; LAS unsigned char* ATT = lds + 52224; LAS unsigned char* STI = lds + 61440;
    LAS float* OB = (LAS float*)(lds + 96256); LAS float* PAR = (LAS float*)(lds + 132096); LAS float* EL = (LAS float*)(lds + 136192);
    f16* Fit = (row_begin < ML) ? sp.Flat + (size_t)row_begin * 2048 : sp.Fctx + (size_t)(row_begin - ML) * 2048;
    const int k0 = (tid & 63) * 2, tg = wave, kb = wave >> 1, vb0 = (wave & 1) * 2;
    asm volatile("" : "+s"(nchunks));
    f32x16 accS[2];
#pragma unroll
    for (int i = 0; i < 2; ++i)
#pragma unroll
        for (int r = 0; r < 16; ++r) accS[i][r] = st_in ? bf2f(*(const GAS unsigned short*)(st_in + (32 * kb + arow(r, h)) * 128 + 32 * (vb0 + i) + (lane & 31))) : 0.f;
    if (MODE != 0) { store_acc_nat(accS[0], STI, 272, 32 * vb0, 32 * kb, lane); store_acc_nat(accS[1], STI, 272, 32 * (vb0 + 1), 32 * kb, lane); }
    float ltot0 = 0.f, ltot1 = 0.f;
    unsigned plf[8], pq[8]; v4u pv0, pv1;
    const int vr = tid >> 3, vc = (tid & 7) * 16;
#define HG_LOAD(c_) do { const int rr_ = 64 * (c_); \
        _Pragma("unroll") for (int i = 0; i < 8; ++i) { plf[i] = *(const GAS unsigned*)(Fit + (size_t)(rr_ + 8 * tg + i) * 2048 + D * 1024 + hh * 128 + k0); \
            if (MODE != 0) pq[i] = *(const GAS unsigned*)(sp.ZQ + (size_t)(row_begin + rr_ + 8 * tg + i) * 2048 + 1024 + hh * 128 + k0); } \
        const GAS v4u* vp_ = (const GAS v4u*)(sp.V + (size_t)(row_begin + rr_ + vr) * 1024 + hh * 128 + vc); pv0 = vp_[0]; pv1 = vp_[1]; } while (0)
    HG_LOAD(D == 0 ? 0 : nchunks - 1);
#pragma unroll 1
    for (int ci = 0; ci < nchunks; ++ci) {
        const int c = D == 0 ? ci : nchunks - 1 - ci, r0 = 64 * c;
        float lf0[8], lf1[8], cs0[8], cs1[8]; float run0 = 0.f, run1 = 0.f;
#pragma unroll
        for (int i = 0; i < 8; ++i) { const f16x2 hr = __builtin_bit_cast(f16x2, plf[i]); lf0[i] = (float)hr.x; lf1[i] = (float)hr.y; }
#pragma unroll
        for (int ii = 0; ii < 8; ++ii) { const int i = D == 0 ? ii : 7 - ii; run0 += lf0[i]; run1 += lf1[i]; cs0[i] = run0; cs1[i] = run1; }
        *(LAS f32x2*)(PAR + tg * 128 + k0) = (f32x2){run0, run1};
        __syncthreads();
        float off0 = 0.f, off1 = 0.f, tot0 = 0.f, tot1 = 0.f;
#pragma unroll
        for (int j = 0; j < 8; ++j) { const f32x2 pj = *(const LAS f32x2*)(PAR + j * 128 + k0); tot0 += pj.x; tot1 += pj.y; if (D == 0 ? (j < tg) : (j > tg)) { off0 += pj.x; off1 += pj.y; } }
#pragma unroll
        for (int i = 0; i < 8; ++i) { const float bc0 = off0 + cs0[i], bc1 = off1 + cs1[i], kk0 = 1.f - __expf(lf0[i]), kk1 = 1.f - __expf(lf1[i]); const int t = 8 * tg + i;
            if (MODE != 0) *(LAS unsigned*)(QP + t * 272 + k0 * 2) = pk2(bf2f(pq[i] & 0xffffu) * __expf(bc0), bf2f(pq[i] >> 16) * __expf(bc1));
            *(LAS unsigned*)(KP + t * 272 + k0 * 2) = pk2(kk0 * __expf(-bc0), kk1 * __expf(-bc1)); }
        if (tg == 0) { *(LAS f32x2*)(EL + k0) = (f32x2){__expf(tot0), __expf(tot1)}; ltot0 += tot0; ltot1 += tot1; }
        *(LAS v4u*)(VI + vr * 272 + vc * 2) = pv0; *(LAS v4u*)(VI + vr * 272 + vc * 2 + 16) = pv1;
        if (ci + 1 < nchunks) HG_LOAD(D == 0 ? ci + 1 : nchunks - 2 - ci);
        __syncthreads();
        f32x16 accO;
        if (MODE != 0) {
            if (wave < 4) { const int sb = wave >> 1, tb = wave & 1; f32x16 a;
#pragma unroll
                for (int r = 0; r < 16; ++r) a[r] = 0.f;
#pragma unroll
                for (int ks = 0; ks < 8; ++ks) a = MFMA32(frag_rows(KP, 272, 32 * sb, 32 * ks, lane), frag_rows(QP, 272, 32 * tb, 32 * ks, lane), a);
                const int t = 32 * tb + (lane & 31);
#pragma unroll
                for (int r = 0; r < 16; ++r) { const int s = 32 * sb + arow(r, h); if (D == 0 ? (s > t) : (s < t)) a[r] = 0.f; }
                store_acc_nat(a, ATT, 144, 32 * tb, 32 * sb, lane); }
            const int tb = wave >> 2, vb = wave & 3;
#pragma unroll
            for (int r = 0; r < 16; ++r) accO[r] = 0.f;
#pragma unroll
            for (int ks = 0; ks < 8; ++ks) accO = MFMA32(frag_rows(QP, 272, 32 * tb, 32 * ks, lane), frag_rows(STI, 272, 32 * vb, 32 * ks, lane), accO);
            __syncthreads();
#pragma unroll
            for (int ks = 0; ks < 4; ++ks) accO = MFMA32(frag_rows(ATT, 144, 32 * tb, 32 * ks, lane), frag_tr(VI, 272, 16 * ks, 32 * vb, lane), accO);
#pragma unroll
            for (int r = 0; r < 16; ++r) OB[(32 * tb + arow(r, h)) * 132 + 32 * vb + (lane & 31)] = accO[r];
        }
#pragma unroll
        for (int ks = 0; ks < 4; ++ks) { const bf16x8 a = frag_tr(KP, 272, 16 * ks, 32 * kb, lane);
            accS[0] = MFMA32(a, frag_tr(VI, 272, 16 * ks, 32 * vb0, lane), accS[0]); accS[1] = MFMA32(a, frag_tr(VI, 272, 16 * ks, 32 * (vb0 + 1), lane), accS[1]); }
#pragma unroll
        for (int r = 0; r < 16; ++r) { const float e = EL[32 * kb + arow(r, h)]; accS[0][r] *= e; accS[1][r] *= e; }
        if (MODE != 0) { store_acc_nat(accS[0], STI, 272, 32 * vb0, 32 * kb, lane); store_acc_nat(accS[1], STI, 272, 32 * (vb0 + 1), 32 * kb, lane); }
        __syncthreads();
        if (MODE != 0) {
            const int t = tid >> 3, c16 = (tid & 7) * 16, row = row_begin + r0 + t;
            float o[16];
#pragma unroll
            for (int j = 0; j < 4; ++j) { const f32x4 x = *(const LAS f32x4*)(OB + t * 132 + c16 + 4 * j); o[4 * j] = x.x; o[4 * j + 1] = x.y; o[4 * j + 2] = x.z; o[4 * j + 3] = x.w; }
            f16* fp = Fit + (size_t)(r0 + t) * 2048 + hh * 128 + c16;
            if (MODE == 1) { f16x8 a, b;
#pragma unroll
                for (int j = 0; j < 8; ++j) { a[j] = (f16)o[j]; b[j] = (f16)o[8 + j]; }
                *(GAS f16x8*)fp = a; *(GAS f16x8*)(fp + 8) = b; }
            else { const f16x8 a = *(const GAS f16x8*)fp, b = *(const GAS f16x8*)(fp + 8); float ss = 0.f;
#pragma unroll
                for (int j = 0; j < 8; ++j) { o[j] += (float)a[j]; o[8 + j] += (float)b[j]; }
#pragma unroll
                for (int j = 0; j < 16; ++j) ss += o[j] * o[j];
                ss += __shfl_xor(ss, 1); ss += __shfl_xor(ss, 2); ss += __shfl_xor(ss, 4);
                const float rn = rsqrtf(ss * (1.f / 128.f) + EPS);
                float g8[8], g9[8]; unpack8(*(const GAS v4u*)(sp.G + (size_t)row * 1024 + hh * 128 + c16), g8); unpack8(*(const GAS v4u*)(sp.G + (size_t)row * 1024 + hh * 128 + c16 + 8), g9);
                const float* hn = sp.hgn + c16;
                v4u w0, w1;
                w0.x = pk2(o[0] * rn * hn[0] * g8[0], o[1] * rn * hn[1] * g8[1]); w0.y = pk2(o[2] * rn * hn[2] * g8[2], o[3] * rn * hn[3] * g8[3]); w0.z = pk2(o[4] * rn * hn[4] * g8[4], o[5] * rn * hn[5] * g8[5]); w0.w = pk2(o[6] * rn * hn[6] * g8[6], o[7] * rn * hn[7] * g8[7]);
                w1.x = pk2(o[8] * rn * hn[8] * g9[0], o[9] * rn * hn[9] * g9[1]); w1.y = pk2(o[10] * rn * hn[10] * g9[2], o[11] * rn * hn[11] * g9[3]); w1.z = pk2(o[12] * rn * hn[12] * g9[4], o[13] * rn * hn[13] * g9[5]); w1.w = pk2(o[14] * rn * hn[14] * g9[6], o[15] * rn * hn[15] * g9[7]);
                GAS v4u* zp = (GAS v4u*)(sp.ZQ + (size_t)row * 2048 + 1024 + hh * 128 + c16); zp[0] = w0; zp[1] = w1; }
        }
    }
#undef HG_LOAD
    if (st_out) {
#pragma unroll
        for (int i = 0; i < 2; ++i)
#pragma unroll
            for (int r = 0; r < 16; ++r) *(GAS unsigned short*)(st_out + (32 * kb + arow(r, h)) * 128 + 32 * (vb0 + i) + (lane & 31)) = (unsigned short)f2bf(accS[i][r]); }
    if (dec_out && tg == 0) { dec_out[k0] = __expf(ltot0); dec_out[k0 + 1] = __expf(ltot1); }
    __syncthreads();
}
__device__ __forceinline__ void wg_fence() { __threadfence(); __syncthreads(); }

__device__ __forceinline__ void phase_scanA(const ScanPtrs& sp, LAS unsigned char* lds, int bid, int G, int tid) {
    for (int it = bid; it < NSC * 16; it += G) { const int sc = it >> 4, chain = it & 15, hh = chain >> 1, d = chain & 1;
        bf16* so = sp.HG_ST + ((size_t)sc * 16 + chain) * 16384; float* dc = sp.HG_DEC + (sc * 16 + chain) * 128;
        if (d == 0) hg_scan<0, 0>(sp, lds, sc * SCL, SCL / 64, hh, nullptr, so, dc, tid); else hg_scan<0, 1>(sp, lds, sc * SCL, SCL / 64, hh, nullptr, so, dc, tid); }
    for (int it = bid; it < NSC * 32; it += G) { const int sc = it >> 5, chain = it & 31, h = chain >> 1, d = chain & 1;
        bf16* so = sp.SSD_ST + ((size_t)sc * 32 + chain) * 8192; float* dc = sp.SSD_DEC + sc * 32 + chain;
        if (d == 0) ssd_scan<0, 0>(sp, lds, sc * SCL, SCL / 64, 0, ML, h, nullptr, so, dc, nullptr, tid); else ssd_scan<0, 1>(sp, lds, sc * SCL, SCL / 64, 0, ML, h, nullptr, so, dc, nullptr, tid); }
    for (int it = bid; it < 8; it += G) { const int hh = it;
        hg_scan<1, 0>(sp, lds, ML, MC / 64, hh, nullptr, sp.HG_ST + ((size_t)NSC * 16 + hh * 2 + 0) * 16384, nullptr, tid);
        wg_fence();
        hg_scan<2, 1>(sp, lds, ML, MC / 64, hh, nullptr, sp.HG_ST + ((size_t)NSC * 16 + hh * 2 + 1) * 16384, nullptr, tid); }
    for (int it = bid; it >= 8 && it < 24; it += G) { const int h = it - 8;
        bf16* yfs = sp.YFS + (size_t)blockIdx.x * 32768;
        ssd_scan<1, 0>(sp, lds, ML, MC / 64, ML, M, h, nullptr, sp.SSD_ST + ((size_t)NSC * 32 + h * 2 + 0) * 8192, nullptr, yfs, tid);
        wg_fence();
        ssd_scan<2, 1>(sp, lds, ML, MC / 64, ML, M, h, nullptr, sp.SSD_ST + ((size_t)NSC * 32 + h * 2 + 1) * 8192, nullptr, yfs, tid); }
}
__device__ __forceinline__ void phase_scanB(const ScanPtrs& sp, int bid, int G, int tid) {
    const int gt = bid * 512 + tid, nt = G * 512;
    for (int e = gt; e < 2 * 131072; e += nt) {
        const bool hg = e >= 131072; const int e2 = hg ? e - 131072 : e;
        const int chain = hg ? (e2 >> 13) : (e2 >> 12), pr = hg ? (e2 & 8191) : (e2 & 4095), d = chain & 1;
        const int nch = hg ? 16 : 32, ppc = hg ? 8192 : 4096;
        GAS unsigned* base = (GAS unsigned*)(hg ? sp.HG_ST : sp.SSD_ST);
        const unsigned w0 = base[((size_t)NSC * nch + chain) * ppc + pr];
        float r0 = bf2f(w0 & 0xffffu), r1 = bf2f(w0 >> 16);
        for (int i0 = 0; i0 < NSC; i0 += 8) {
            unsigned loc[8]; float dec[8];
#pragma unroll
            for (int j = 0; j < 8; ++j) { const int sc = d == 0 ? i0 + j : NSC - 1 - (i0 + j); loc[j] = base[((size_t)sc * nch + chain) * ppc + pr];
                dec[j] = hg ? sp.HG_DEC[(sc * 16 + chain) * 128 + (pr >> 6)] : sp.SSD_DEC[sc * 32 + chain]; }
#pragma unroll
            for (int j = 0; j < 8; ++j) { const int sc = d == 0 ? i0 + j : NSC - 1 - (i0 + j); base[((size_t)sc * nch + chain) * ppc + pr] = pk2(r0, r1);
                r0 = r0 * dec[j] + bf2f(loc[j] & 0xffffu); r1 = r1 * dec[j] + bf2f(loc[j] >> 16); }
        }
    }
}
__device__ __forceinline__ void phase_scanC(const ScanPtrs& sp, LAS unsigned char* lds, int bid, int G, int tid) {
    for (int it = bid; it < NSC * 8; it += G) { const int sc = it >> 3, hh = it & 7;
        hg_scan<1, 0>(sp, lds, sc * SCL, SCL / 64, hh, sp.HG_ST + ((size_t)sc * 16 + hh * 2 + 0) * 16384, nullptr, nullptr, tid);
        wg_fence();
        hg_scan<2, 1>(sp, lds, sc * SCL, SCL / 64, hh, sp.HG_ST + ((size_t)sc * 16 + hh * 2 + 1) * 16384, nullptr, nullptr, tid); }
    for (int it = bid; it < NSC * 16; it += G) { const int sc = it >> 4, h = it & 15;
        bf16* yfs = sp.YFS + (size_t)blockIdx.x * 32768;
        ssd_scan<1, 0>(sp, lds, sc * SCL, SCL / 64, 0, ML, h, sp.SSD_ST + ((size_t)sc * 32 + h * 2 + 0) * 8192, nullptr, nullptr, yfs, tid);
        wg_fence();
        ssd_scan<2, 1>(sp, lds, sc * SCL, SCL / 64, 0, ML, h, sp.SSD_ST + ((size_t)sc * 32 + h * 2 + 1) * 8192, nullptr, nullptr, yfs, tid); }
}
__device__ __forceinline__ void phase_finish(const Params& p, LAS unsigned char* lds, int bid, int G, int tid, int wave, int lane) {
    unsigned char* ws = p.ws; bf16* ZQ = (bf16*)(ws + WS_ZQ); const float* stats = (const float*)(ws + WS_SMALL + SM_STATS); const float* sng = p.in[I_SSDN];
    const int gw = bid * NWAVES + wave, ngw = G * NWAVES;
    for (int row = gw; row < M; row += ngw) {
        const int grp = lane >> 5; const float* s8 = stats + (size_t)row * 16 + grp * 8;
        const float ss = ((s8[0] + s8[1]) + (s8[2] + s8[3])) + ((s8[4] + s8[5]) + (s8[6] + s8[7]));
        const float r = rsqrtf(ss * (1.f / 512.f) + EPS);
        GAS v4u* zp = (GAS v4u*)(ZQ + (size_t)row * 2048 + lane * 16);
#pragma unroll
        for (int q = 0; q < 2; ++q) { float x8[8]; unpack8(zp[q], x8); const float* g8 = sng + lane * 16 + q * 8;
            v4u o; o.x = pk2(x8[0] * r * g8[0], x8[1] * r * g8[1]); o.y = pk2(x8[2] * r * g8[2], x8[3] * r * g8[3]); o.z = pk2(x8[4] * r * g8[4], x8[5] * r * g8[5]); o.w = pk2(x8[6] * r * g8[6], x8[7] * r * g8[7]); zp[q] = o; }
    }
    LAS float* scr = (LAS float*)(lds + wave * 16384); unsigned char* wr = ws + WS_WREST;
    tr_job(p.in[I_EVOUT], 2048, 1024, 1, (bf16*)(wr + WO_OUT), scr, gw, ngw, lane);
    tr_job(p.in[I_WGATE], 1024, DFF, 2, (bf16*)(wr + WO_UP0), scr, gw, ngw, lane);
    tr_job(p.in[I_WUP], 1024, DFF, 3, (bf16*)(wr + WO_UP0), scr, gw, ngw, lane);
    tr_job(p.in[I_WDOWN], DFF, 1024, 1, (bf16*)(wr + WO_DOWN0), scr, gw, ngw, lane);
    tr_job(p.in[I_ODIN], 1024, 512, 1, (bf16*)(wr + WO_OD), scr, gw, ngw, lane);
    tr_job(p.in[I_WVAL], 512, 1024, 2, (bf16*)(wr + WO_VG), scr, gw, ngw, lane);
    tr_job(p.in[I_WGATE2], 512, 1024, 3, (bf16*)(wr + WO_VG), scr, gw, ngw, lane);
    tr_job(p.in[I_WGATE] + (size_t)1024 * DFF, 1024, DFF, 2, (bf16*)(wr + WO_UP1), scr, gw, ngw, lane);
    tr_job(p.in[I_WUP] + (size_t)1024 * DFF, 1024, DFF, 3, (bf16*)(wr + WO_UP1), scr, gw, ngw, lane);
    tr_job(p.in[I_WDOWN] + (size_t)DFF * 1024, DFF, 1024, 1, (bf16*)(wr + WO_DOWN1), scr, gw, ngw, lane);
}

struct S5Ptrs { const bf16* U; float* YS; bf16* A2; const float* LAM; const float* LAMP; const bf16* BBH; const bf16* CMH; const float* S5D; float* ST; };
template <int MODE, int D>
__device__ __forceinline__ void s5_wave(const S5Ptrs& sp, LAS unsigned char* SI  , int row0  , int g, int slot0, int lane) {
    const int n = lane & 31, hs = lane >> 5, dg = D * 32 + g;
    bf16x8 bq[4];
#pragma unroll
    for (int q = 0; q < 4; ++q) bq[q] = *(const GAS bf16x8*)(sp.BBH + ((size_t)(dg * 64 + (q & 1) * 32 + n) * 2 + (q >> 1)) * 16 + 8 * hs);
    bf16x8 cm[8];
    if (MODE != 0) {
#pragma unroll
        for (int ks = 0; ks < 8; ++ks) cm[ks] = n < 16 ? *(const GAS bf16x8*)(sp.CMH + ((size_t)(dg * 16 + n) * 128 + 16 * ks + 8 * hs)) : (bf16x8){0, 0, 0, 0, 0, 0, 0, 0}; }
    const float lr0 = sp.LAM[2 * (dg * 64 + n)], li0 = sp.LAM[2 * (dg * 64 + n) + 1], lr1 = sp.LAM[2 * (dg * 64 + 32 + n)], li1 = sp.LAM[2 * (dg * 64 + 32 + n) + 1];
    float hr0 = 0.f, hi0 = 0.f, hr1 = 0.f, hi1 = 0.f;
    float* stp = sp.ST + ((size_t)((slot0 + hs) * 2 + D) * 2048 + g * 64 + n) * 2;
    if (MODE != 0) { const f32x2 a = *(const GAS f32x2*)stp, b = *(const GAS f32x2*)(stp + 64); hr0 = a.x; hi0 = a.y; hr1 = b.x; hi1 = b.y; }
    const int astream = (n >> 2) & 1, aidx = 4 * (n >> 3) + (n & 3);
    const bf16* ua = sp.U + (size_t)(row0 + 128 * astream) * 512 + g * 16 + 8 * hs;
    const float dsk = (MODE == 2 && n < 16) ? sp.S5D[g * 16 + n] : 0.f;
    bf16x8 afr = *(const GAS bf16x8*)(ua + (size_t)(D == 0 ? aidx : 127 - aidx) * 512);
#pragma unroll 1
    for (int i = 0; i < 8; ++i) {
        f32x16 acc[4];
#pragma unroll
        for (int q = 0; q < 4; ++q) {
#pragma unroll
            for (int r = 0; r < 16; ++r) acc[q][r] = 0.f;
            acc[q] = MFMA32(afr, bq[q], acc[q]); }
        if (i < 7) afr = *(const GAS bf16x8*)(ua + (size_t)(D == 0 ? 16 * (i + 1) + aidx : 127 - 16 * (i + 1) - aidx) * 512);
#pragma unroll
        for (int j = 0; j < 16; ++j) {
            const float nr0 = lr0 * hr0 - li0 * hi0 + acc[0][j], ni0 = lr0 * hi0 + li0 * hr0 + acc[2][j]; hr0 = nr0; hi0 = ni0; acc[0][j] = nr0; acc[2][j] = ni0;
            const float nr1 = lr1 * hr1 - li1 * hi1 + acc[1][j], ni1 = lr1 * hi1 + li1 * hr1 + acc[3][j]; hr1 = nr1; hi1 = ni1; acc[1][j] = nr1; acc[3][j] = ni1; }
        if (MODE != 0) {
            store_acc_nat(acc[0], SI, 72, 0, 0, lane); store_acc_nat(acc[1], SI, 72, 32, 0, lane); store_acc_nat(acc[2], SI, 72, 64, 0, lane); store_acc_nat(acc[3], SI, 72, 96, 0, lane);
            asm volatile("s_waitcnt lgkmcnt(0)" ::: "memory");
            f32x16 y;
#pragma unroll
            for (int r = 0; r < 16; ++r) y[r] = 0.f;
#pragma unroll
            for (int ks = 0; ks < 8; ++ks) y = MFMA32(frag_tr(SI, 72, 16 * ks, 0, lane), cm[ks], y);
            asm volatile("" ::: "memory");
            if (n < 16) {
#pragma unroll
                for (int j = 0; j < 16; ++j) { const int pos = D == 0 ? 16 * i + j : 127 - 16 * i - j, row = row0 + 128 * hs + pos;
                    float* ysp = sp.YS + (size_t)row * 512 + g * 16 + n;
                    if (MODE == 1) *(GAS float*)ysp = y[j];
                    else { const float v = y[j] + *(const GAS float*)ysp + dsk * bf2f(*(const GAS unsigned short*)(sp.U + (size_t)row * 512 + g * 16 + n));
                        const float tt = 0.7978845608f * (v + 0.044715f * v * v * v), gl = 0.5f * v * (2.f - 2.f / (__expf(2.f * tt) + 1.f));
                        const int token = (row & 255) * 64 + (row >> 8);
                        *(GAS unsigned short*)(sp.A2 + (size_t)token * 512 + g * 16 + n) = (unsigned short)f2bf(gl); } }
            }
        }
    }
    if (MODE == 0) { *(GAS f32x2*)stp = (f32x2){hr0, hi0}; *(GAS f32x2*)(stp + 64) = (f32x2){hr1, hi1}; }
}
__device__ __forceinline__ void phase_s5A(const S5Ptrs& sp, LAS unsigned char* lds, int bid, int G, int wave, int lane) {
    LAS unsigned char* SI = lds + wave * 9216;
    for (int it = bid; it < 65 * 8; it += G) { const int col = it >> 3, gb = (it >> 1) & 3, d = it & 1, g = gb * 8 + wave;
        const int row0 = col < 64 ? col * 256 : ML, slot0 = col < 64 ? 2 * col : 128;
        if (d == 0) s5_wave<0, 0>(sp, SI, row0, g, slot0, lane); else s5_wave<0, 1>(sp, SI, row0, g, slot0, lane); }
}
__device__ __forceinline__ void phase_s5B(const S5Ptrs& sp, int bid, int G, int tid) {
    const int gt = bid * 512 + tid;
    if (gt < 4096) { const int d = gt >> 11, gp = gt & 2047, s = d * 2048 + gp; const float pr = sp.LAMP[2 * s], pi = sp.LAMP[2 * s + 1];
        GAS f32x2* st = (GAS f32x2*)sp.ST; f32x2 run = {0.f, 0.f};
        for (int i0 = 0; i0 < 130; i0 += 10) { f32x2 loc[10];
#pragma unroll
            for (int j = 0; j < 10; ++j) { const int q = i0 + j, slot = d == 0 ? (q < 2 ? 128 + q : q - 2) : (q < 2 ? 129 - q : 129 - q); loc[j] = st[(size_t)(slot * 2 + d) * 2048 + gp]; }
#pragma unroll
            for (int j = 0; j < 10; ++j) { const int q = i0 + j, slot = d == 0 ? (q < 2 ? 128 + q : q - 2) : (q < 2 ? 129 - q : 129 - q); st[(size_t)(slot * 2 + d) * 2048 + gp] = run;
                const float nr = pr * run.x - pi * run.y + loc[j].x, ni = pr * run.y + pi * run.x + loc[j].y; run.x = nr; run.y = ni; } }
    }
}
__device__ __forceinline__ void phase_s5C(const S5Ptrs& sp, LAS unsigned char* lds, int bid, int G, int wave, int lane) {
    LAS unsigned char* SI = lds + wave * 9216;
    for (int it = bid; it < 256; it += G) { const int col = it >> 2, g = (it & 3) * 8 + wave;
        s5_wave<1, 0>(sp, SI, col * 256, g, 2 * col, lane);
        __threadfence();
        s5_wave<2, 1>(sp, SI, col * 256, g, 2 * col, lane); }
}
__device__ __forceinline__ void phase_final(const Params& p, int bid, int G, int wave, int lane) {
    const int gw = bid * NWAVES + wave, ngw = G * NWAVES; const float* fg = p.in[I_FNORM];
    for (int row = gw; row < ML; row += ngw) { float* xr = p.out + (size_t)row * 1024;
        f32x4 v[4]; float ss = 0.f;
#pragma unroll
        for (int j = 0; j < 4; ++j) { v[j] = *(const GAS f32x4*)(xr + 4 * lane + 256 * j); ss += (v[j].x * v[j].x + v[j].y * v[j].y) + (v[j].z * v[j].z + v[j].w * v[j].w); }
        const float r = rsqrtf(wave_sum(ss) * (1.f / 1024.f) + EPS);
#pragma unroll
        for (int j = 0; j < 4; ++j) { const f32x4 g4 = *(const GAS f32x4*)(fg + 4 * lane + 256 * j); *(GAS f32x4*)(xr + 4 * lane + 256 * j) = (f32x4){v[j].x * r * g4.x, v[j].y * r * g4.y, v[j].z * r * g4.z, v[j].w * r * g4.w}; }
    }
}

constexpr int N_PHASES = 21;
__device__ __forceinline__ void run_gmix(const Params& p, LAS unsigned char* lds, int bid, int G) {
    unsigned char* ws = p.ws;
    pg8::Gemm g{(const bf16*)(ws + WS_RX), (const bf16*)(ws + WS_WIN), M, NINP, 1024}; pg8::StaticOrder S; S.init(M, NINP, G, bid);
    pg8::EpiMix1 E{(bf16*)(ws + WS_ZQ), (bf16*)(ws + WS_XBC), (bf16*)(ws + WS_V), (bf16*)(ws + WS_G), (f16*)p.out, (f16*)(ws + WS_FCTX), (float*)(ws + WS_DT), (const float*)(ws + WS_SMALL + SM_LB), p.in[I_DTB], p.in[I_ALOG]};
    pg8::gemm_phase<pg8::EpiMix1, pg8::StaticOrder, true, true>(lds + RING_OFF, g, S, E);
}
__device__ __forceinline__ void run_gout(const Params& p, LAS unsigned char* lds, int bid, int G) {
    unsigned char* ws = p.ws; const float* mods = (const float*)(ws + WS_SMALL + SM_MODS);
    pg8::Gemm g{(const bf16*)(ws + WS_ZQ), (const bf16*)(ws + WS_WREST + WO_OUT), M, 1024, 2048}; pg8::StaticOrder S; S.init(M, 1024, G, bid);
    pg8::EpiResid E{p.in[I_X], p.in[I_CTX], p.out, (float*)(ws + WS_HCTX), mods + (0 * 2 + 0) * 6144 + 2 * 1024, mods + (0 * 2 + 1) * 6144 + 2 * 1024};
    pg8::gemm_phase<pg8::EpiResid, pg8::StaticOrder, true, true>(lds + RING_OFF, g, S, E);
}
__device__ __forceinline__ void run_gup(const Params& p, LAS unsigned char* lds, int bid, int G, int layer) {
    unsigned char* ws = p.ws; const int rows = layer ? ML : M;
    pg8::Gemm g{(const bf16*)(ws + WS_RX), (const bf16*)(ws + WS_WREST + (layer ? WO_UP1 : WO_UP0)), rows, 2 * DFF, 1024}; pg8::StaticOrder S; S.init(rows, 2 * DFF, G, bid);
    pg8::EpiSwiglu E{(bf16*)(ws + WS_HID)};
    pg8::gemm_phase<pg8::EpiSwiglu, pg8::StaticOrder, true, true>(lds + RING_OFF, g, S, E);
}
__device__ __forceinline__ void run_gdown(const Params& p, LAS unsigned char* lds, int bid, int G, int layer) {
    unsigned char* ws = p.ws; const int rows = layer ? ML : M; const float* mods = (const float*)(ws + WS_SMALL + SM_MODS); float* Hctx = (float*)(ws + WS_HCTX);
    pg8::Gemm g{(const bf16*)(ws + WS_HID), (const bf16*)(ws + WS_WREST + (layer ? WO_DOWN1 : WO_DOWN0)), rows, 1024, DFF}; pg8::StaticOrder S; S.init(rows, 1024, G, bid);
    pg8::EpiResid E{p.out, Hctx, p.out, Hctx, mods + (layer * 2 + 0) * 6144 + 5 * 1024, mods + (layer * 2 + 1) * 6144 + 5 * 1024};
    pg8::gemm_phase<pg8::EpiResid, pg8::StaticOrder, true, true>(lds + RING_OFF, g, S, E);
}
__device__ __forceinline__ void run_god(const Params& p, LAS unsigned char* lds, int bid, int G) {
    unsigned char* ws = p.ws;
    pg8::Gemm g{(const bf16*)(ws + WS_RX), (const bf16*)(ws + WS_WREST + WO_OD), M, 512, 1024}; pg8::StaticOrder S; S.init(M, 512, G, bid);
    pg8::EpiU E{(bf16*)(ws + WS_U)};
    pg8::gemm_phase<pg8::EpiU, pg8::StaticOrder, true, true>(lds + RING_OFF, g, S, E);
}
__device__ __forceinline__ void run_gvg(const Params& p, LAS unsigned char* lds, int bid, int G) {
    unsigned char* ws = p.ws; const float* mods = (const float*)(ws + WS_SMALL + SM_MODS);
    pg8::Gemm g{(const bf16*)(ws + WS_A2), (const bf16*)(ws + WS_WREST + WO_VG), ML, 2048, 512}; pg8::StaticOrder S; S.init(ML, 2048, G, bid);
    pg8::EpiValGate E{p.out, mods + (1 * 2 + 0) * 6144 + 2 * 1024};
    pg8::gemm_phase<pg8::EpiValGate, pg8::StaticOrder, true, true>(lds + RING_OFF, g, S, E);
}
__device__ __forceinline__ ScanPtrs make_scanptrs(const Params& p) {
    unsigned char* ws = p.ws; ScanPtrs sp; sp.XBC = (const bf16*)(ws + WS_XBC); sp.DT = (const float*)(ws + WS_DT); sp.ZQ = (bf16*)(ws + WS_ZQ); sp.V = (const bf16*)(ws + WS_V); sp.G = (const bf16*)(ws + WS_G); sp.Flat = (f16*)p.out; sp.Fctx = (f16*)(ws + WS_FCTX);
    sp.STATS = (float*)(ws + WS_SMALL + SM_STATS); sp.convw = p.in[I_CONVW]; sp.convb = p.in[I_CONVB]; sp.ssdd = p.in[I_SSDD]; sp.hgn = p.in[I_HGN];
    sp.SSD_ST = (bf16*)(ws + WS_RX); sp.HG_ST = (bf16*)(ws + WS_RX + SSD_ST_BYTES); sp.SSD_DEC = (float*)(ws + WS_SMALL + SM_SSDDEC); sp.HG_DEC = (float*)(ws + WS_SMALL + SM_HGDEC); sp.YFS = (bf16*)(ws + WS_WIN); return sp;
}
__device__ __forceinline__ S5Ptrs make_s5ptrs(const Params& p) {
    unsigned char* ws = p.ws; S5Ptrs s5; s5.U = (const bf16*)(ws + WS_U); s5.YS = (float*)(ws + WS_YS); s5.A2 = (bf16*)(ws + WS_A2); s5.LAM = (const float*)(ws + WS_SMALL + SM_LAM); s5.LAMP = (const float*)(ws + WS_SMALL + SM_LAMP);
    s5.BBH = (const bf16*)(ws + WS_SMALL + SM_BB); s5.CMH = (const bf16*)(ws + WS_SMALL + SM_BB + 262144); s5.S5D = p.in[I_S5D]; s5.ST = (float*)(ws + WS_SMALL + SM_S5ST); return s5;
}
__global__ void __launch_bounds__(NWAVES * 64, 2) mk_fwd(Params p) {
    extern __shared__ __attribute__((aligned(16))) unsigned char lds_raw[];
    LAS unsigned char* lds = (LAS unsigned char*)lds_raw;
    volatile LAS unsigned* MISC = (volatile LAS unsigned*)(lds + MISC_OFF);
    const int tid = threadIdx.x, lane = tid & 63, wave = __builtin_amdgcn_readfirstlane(tid >> 6), G = gridDim.x, bid = blockIdx.x;
    gu32* ctl = (gu32*)(p.ws + WS_CTL);
    for (int u = tid; u < (LDS_BYTES - LDSCTL_OFF) / 4; u += NWAVES * 64) ((LAS unsigned*)(lds + LDSCTL_OFF))[u] = 0u;
    __syncthreads();
    XcdBarrier bar; bar.bar = (unsigned*)(ctl + CW_BAR); bar.x = 0; bar.st = nullptr;
    if (p.use_bar) bar = xcd_barrier_post((unsigned*)(ctl + CW_BAR), MISC + 8);
    const int lo = p.ph_lo, hi = p.ph_hi;
#ifndef MK_ONLYPH
#define MK_ONLYPH -1
#endif
#define IN(k) ((MK_ONLYPH < 0 || MK_ONLYPH == (k)) && lo <= (k) && (k) < hi)
#define SEAM(k) do { if ((k) + 1 < hi) xcd_barrier(bar); } while (0)
    if (IN(0)) { phase_prologue(p, lds, bid, G, tid, wave, lane); SEAM(0); }
    if (IN(1)) { phase_rownorm(p, lds, bid, G, tid, wave, lane, 0, 0, M, p.in[I_X], p.in[I_CTX], true); SEAM(1); }
    if (IN(2)) { run_gmix(p, lds, bid, G); SEAM(2); }
    if (IN(3)) { const ScanPtrs sp = make_scanptrs(p); phase_scanA(sp, lds, bid, G, tid); SEAM(3); }
    if (IN(4)) { const ScanPtrs sp = make_scanptrs(p); phase_scanB(sp, bid, G, tid); SEAM(4); }
    if (IN(5)) { const ScanPtrs sp = make_scanptrs(p); phase_scanC(sp, lds, bid, G, tid); SEAM(5); }
    if (IN(6)) { phase_finish(p, lds, bid, G, tid, wave, lane); SEAM(6); }
    if (IN(7)) { run_gout(p, lds, bid, G); SEAM(7); }
    if (IN(8)) { phase_rownorm(p, lds, bid, G, tid, wave, lane, 0, 1, M, p.out, (const float*)(p.ws + WS_HCTX), false); SEAM(8); }
    if (IN(9)) { run_gup(p, lds, bid, G, 0); SEAM(9); }
    if (IN(10)) { run_gdown(p, lds, bid, G, 0); SEAM(10); }
    if (IN(11)) { phase_rownorm(p, lds, bid, G, tid, wave, lane, 1, 0, M, p.out, (const float*)(p.ws + WS_HCTX), false); SEAM(11); }
    if (IN(12)) { run_god(p, lds, bid, G); SEAM(12); }
    if (IN(13)) { const S5Ptrs s5 = make_s5ptrs(p); phase_s5A(s5, lds, bid, G, wave, lane); SEAM(13); }
    if (IN(14)) { const S5Ptrs s5 = make_s5ptrs(p); phase_s5B(s5, bid, G, tid); SEAM(14); }
    if (IN(15)) { const S5Ptrs s5 = make_s5ptrs(p); phase_s5C(s5, lds, bid, G, wave, lane); SEAM(15); }
    if (IN(16)) { run_gvg(p, lds, bid, G); SEAM(16); }
    if (IN(17)) { phase_rownorm(p, lds, bid, G, tid, wave, lane, 1, 1, ML, p.out, (const float*)(p.ws + WS_HCTX), false); SEAM(17); }
    if (IN(18)) { run_gup(p, lds, bid, G, 1); SEAM(18); }
    if (IN(19)) { run_gdown(p, lds, bid, G, 1); SEAM(19); }
    if (IN(20)) { phase_final(p, bid, G, wave, lane); }
#undef IN
#undef SEAM
}

extern "C" void kernel_launch(void* const* d_in, const int* in_sizes, int n_in, void* d_out, int out_size, void* d_ws, size_t ws_size, hipStream_t stream) {
    static int grid = 0;
    if (grid == 0) {
        if (n_in != 33 || out_size != ML * D || ws_size < 256 * MiB) { fprintf(stderr, "kernel_launch: unexpected shapes (n_in %d, out %d, ws %zu); nothing launched\n", n_in, out_size, ws_size); grid = -1; return; }
        int dev = 0, cus = 0, per_cu = 0;
        if (hipGetDevice(&dev) != hipSuccess || hipDeviceGetAttribute(&cus, hipDeviceAttributeMultiprocessorCount, dev) != hipSuccess) { grid = -1; return; }
        if (hipFuncSetAttribute((const void*)mk_fwd, hipFuncAttributeMaxDynamicSharedMemorySize, LDS_BYTES) != hipSuccess) { fprintf(stderr, "kernel_launch: hipFuncSetAttribute failed\n"); grid = -1; return; }
        if (hipOccupancyMaxActiveBlocksPerMultiprocessor(&per_cu, (const void*)mk_fwd, NWAVES * 64, LDS_BYTES) != hipSuccess || per_cu < 1) fprintf(stderr, "kernel_launch: occupancy query reports %d\n", per_cu);
        (void)hipGetLastError();
        grid = cus;
    }
    if (grid < 0) return;
    (void)hipMemsetAsync((char*)d_ws + WS_CTL, 0, CTL_ZERO_BYTES, stream);
    Params a{};
    for (int i = 0; i < 33; ++i) a.in[i] = (const float*)d_in[i];
    a.out = (float*)d_out; a.ws = (unsigned char*)d_ws;
#if MK_N_LAUNCHES == 1
    a.ph_lo = 0; a.ph_hi = N_PHASES; a.use_bar = 1;
    hipLaunchKernelGGL(mk_fwd, dim3(grid), dim3(NWAVES * 64), LDS_BYTES, stream, a);
#else
    for (int ph = 0; ph < N_PHASES; ++ph) { a.ph_lo = ph; a.ph_hi = ph + 1; a.use_bar = 0; hipLaunchKernelGGL(mk_fwd, dim3(grid), dim3(NWAVES * 64), LDS_BYTES, stream, a); }
#endif
}
```

```cpp
#include <hip/hip_runtime.h>
#include <cstdio>
#include <cstdint>

#ifndef MK_N_LAUNCHES
#define MK_N_LAUNCHES 1
#endif
namespace pg8 {
#define PG8_LAS __attribute__((address_space(3)))
typedef unsigned short bf16_t;
typedef short bf16x8 __attribute__((ext_vector_type(8)));
typedef float f32x4 __attribute__((ext_vector_type(4)));
typedef unsigned u32x4 __attribute__((ext_vector_type(4)));
constexpr int BM = 256, BK = 64, HALF = 128, HTB = HALF * BK * 2  , STAGE_BYTES = 8 * HTB, NXCD = 8, WGM = 8;

__host__ __device__ __forceinline__ int lds_byte(int r, int c) { const int st = (r >> 4) * 2 + (c >> 5), rr = r & 15, cc = c & 31, ob = rr * 64 + cc * 2; return st * 1024 + (ob ^ (((ob >> 9) & 1) << 5)); }
__host__ __device__ __forceinline__ void stage_rc(int b, int& R, int& C) { const int st = b / 1024, sb = b % 1024, swz = sb ^ (((sb >> 9) & 1) << 5); R = (st >> 1) * 16 + swz / 64; C = (st & 1) * 32 + (swz % 64) / 2; }
__host__ __device__ __forceinline__ int perm32(int rho) { const int n = rho >> 4, i = rho & 15; return 8 * (i >> 2) + 4 * n + (i & 3); }

struct Unit { int pm, pn; };
struct Gemm { const bf16_t* A; const bf16_t* Bt; int M, N, K; };

struct StaticOrder {
    int nM, nN, nwg, G, c;
    __host__ __device__ void init(int M, int N, int G_, int c_) { nM = M / BM; nN = N / BM; nwg = nM * nN; G = G_; c = c_; }
    __host__ __device__ bool next(int i, Unit& u) const {
        const long L = (long)i * G + c; if (L >= nwg) return false;
        int wgid = (int)L; { const int q = nwg / NXCD, r = nwg % NXCD, xcd = wgid % NXCD, off = wgid / NXCD; wgid = (xcd < r ? xcd * (q + 1) : r * (q + 1) + (xcd - r) * q) + off; }
        const int nig = WGM * nN, gid = wgid / nig, fm = gid * WGM, gsz = (nM - fm) < WGM ? (nM - fm) : WGM;
        u.pm = fm + ((wgid % nig) % gsz); u.pn = (wgid % nig) / gsz; return true;
    }
    __device__ __forceinline__ void a_ready(const Unit&) const {}
    __device__ __forceinline__ void done(const Unit&) const {}
};

__device__ __forceinline__ unsigned cvt_pk_bf16(float lo, float hi) { unsigned r; asm volatile("v_cvt_pk_bf16_f32 %0, %1, %2" : "=v"(r) : "v"(lo), "v"(hi)); return r; }
typedef float f32x2 __attribute__((ext_vector_type(2)));
typedef _Float16 f16x8 __attribute__((ext_vector_type(8)));
__device__ __forceinline__ float siluf(float x) { return x * __builtin_amdgcn_rcpf(1.f + __expf(-x)); }
__device__ __forceinline__ float sigmf(float x) { return __builtin_amdgcn_rcpf(1.f + __expf(-x)); }
__device__ __forceinline__ u32x4 pack8_bf16(const float (&x)[8]) { u32x4 w; w.x = cvt_pk_bf16(x[0], x[1]); w.y = cvt_pk_bf16(x[2], x[3]); w.z = cvt_pk_bf16(x[4], x[5]); w.w = cvt_pk_bf16(x[6], x[7]); return w; }
constexpr int EP_ML = 16384;

struct EpiMix1 {
    static constexpr bool PERM = true, AFTER_DRAIN = false;
    bf16_t* ZQ; bf16_t* XBC; bf16_t* V; bf16_t* G; _Float16* Flat; _Float16* Fctx; float* DT; const float* lb; const float* dt_bias; const float* a_log;
    template <int KIND> __device__ __forceinline__ void tile(const f32x4 (&acc)[2][2][4][2], const Unit& u, int wr, int wc, int fr, int fq, int seg_tile) const {
        const int row0 = u.pm * BM + wr * 64 + fr, cw = wc * 32 + 8 * fq;
#pragma unroll
        for (int ai = 0; ai < 2; ++ai)
#pragma unroll
            for (int m = 0; m < 4; ++m) { const int row = row0 + ai * HALF + m * 16;
#pragma unroll
                for (int bj = 0; bj < 2; ++bj) { const f32x4 v0 = acc[ai][bj][m][0], v1 = acc[ai][bj][m][1]; const int c = seg_tile * 256 + bj * HALF + cw;
                    float x[8] = {v0[0], v0[1], v0[2], v0[3], v1[0], v1[1], v1[2], v1[3]};
                    if constexpr (KIND == 0) {
#pragma unroll
                        for (int i = 0; i < 8; ++i) x[i] = siluf(x[i]);
                        *(u32x4*)(ZQ + (size_t)row * 2048 + c) = pack8_bf16(x);
                    } else if constexpr (KIND == 1) {
                        *(u32x4*)(XBC + (size_t)row * 1536 + c) = pack8_bf16(x);
                    } else if constexpr (KIND == 2) {
#pragma unroll
                        for (int i = 0; i < 8; ++i) x[i] = siluf(x[i]);
                        *(u32x4*)(ZQ + (size_t)row * 2048 + 1024 + c) = pack8_bf16(x);
                    } else if constexpr (KIND == 3) {
                        f16x8 h;
#pragma unroll
                        for (int i = 0; i < 8; ++i) { const float l = lb[(c + i) & 1023]; const float f = l + (1.f - l) * sigmf(x[i]); h[i] = (_Float16)__logf(f); }
                        _Float16* dst = (row < EP_ML) ? Flat + (size_t)row * 2048 : Fctx + (size_t)(row - EP_ML) * 2048;
                        *(f16x8*)(dst + c) = h;
                    } else if constexpr (KIND == 4) {
                        *(u32x4*)(V + (size_t)row * 1024 + c) = pack8_bf16(x);
                    } else if constexpr (KIND == 5) {
#pragma unroll
                        for (int i = 0; i < 8; ++i) x[i] = siluf(x[i]);
                        *(u32x4*)(G + (size_t)row * 1024 + c) = pack8_bf16(x);
                    } else {
                        if (bj == 0 && wc == 0) {
                            float dtv[8], la[8];
#pragma unroll
                            for (int i = 0; i < 8; ++i) { const int j = 8 * fq + i; const float r = x[i] + dt_bias[j]; dtv[i] = r > 20.f ? r : log1pf(__expf(r)); la[i] = -dtv[i] * __expf(a_log[j]); }
                            float* d = DT + (size_t)row * 64 + 8 * fq;
                            *(f32x4*)(d) = (f32x4){dtv[0], dtv[1], dtv[2], dtv[3]}; *(f32x4*)(d + 4) = (f32x4){dtv[4], dtv[5], dtv[6], dtv[7]};
                            *(f32x4*)(d + 32) = (f32x4){la[0], la[1], la[2], la[3]}; *(f32x4*)(d + 36) = (f32x4){la[4], la[5], la[6], la[7]};
                        }
                    } } }
    }
    __device__ __forceinline__ void operator()(const f32x4 (&acc)[2][2][4][2], const Unit& u, int wr, int wc, int fr, int fq) const {
        const int pn = u.pn;
        if (pn < 4) tile<0>(acc, u, wr, wc, fr, fq, pn);
        else if (pn < 10) tile<1>(acc, u, wr, wc, fr, fq, pn - 4);
        else if (pn < 14) tile<2>(acc, u, wr, wc, fr, fq, pn - 10);
        else if (pn < 22) tile<3>(acc, u, wr, wc, fr, fq, pn - 14);
        else if (pn < 26) tile<4>(acc, u, wr, wc, fr, fq, pn - 22);
        else if (pn < 30) tile<5>(acc, u, wr, wc, fr, fq, pn - 26);
        else tile<6>(acc, u, wr, wc, fr, fq, 0);
    }
};
struct EpiResid {
    static constexpr bool PERM = false, AFTER_DRAIN = false;
    const float* base_lat; const float* base_ctx; float* out_lat; float* out_ctx; const float* gate_lat; const float* gate_ctx;
    __device__ __forceinline__ void operator()(const f32x4 (&acc)[2][2][4][2], const Unit& u, int wr, int wc, int fr, int fq) const {
        const bool isc = u.pm >= 64; const float* base = isc ? base_ctx : base_lat; float* out = isc ? out_ctx : out_lat; const float* gate = isc ? gate_ctx : gate_lat;
        const int row0 = (isc ? 0 : u.pm * BM) + wr * 64 + fr, col0 = u.pn * BM + wc * 32 + 4 * fq;
        f32x4 gv[2][2];
#pragma unroll
        for (int bj = 0; bj < 2; ++bj)
#pragma unroll
            for (int n = 0; n < 2; ++n) gv[bj][n] = *(const f32x4*)(gate + col0 + bj * HALF + n * 16);
#pragma unroll
        for (int ai = 0; ai < 2; ++ai)
#pragma unroll
            for (int m = 0; m < 4; ++m) { const size_t off = (size_t)(row0 + ai * HALF + m * 16) * 1024 + col0;
#pragma unroll
                for (int bj = 0; bj < 2; ++bj)
#pragma unroll
                    for (int n = 0; n < 2; ++n) { const f32x4 b = *(const f32x4*)(base + off + bj * HALF + n * 16); *(f32x4*)(out + off + bj * HALF + n * 16) = b + gv[bj][n] * acc[ai][bj][m][n]; } }
    }
};
struct EpiSwiglu {
    static constexpr bool PERM = true, AFTER_DRAIN = false;
    bf16_t* HID;
    __device__ __forceinline__ void operator()(const f32x4 (&acc)[2][2][4][2], const Unit& u, int wr, int wc, int fr, int fq) const {
        const int row0 = u.pm * BM + wr * 64 + fr, c = u.pn * HALF + wc * 32 + 8 * fq;
#pragma unroll
        for (int ai = 0; ai < 2; ++ai)
#pragma unroll
            for (int m = 0; m < 4; ++m) { const f32x4 g0 = acc[ai][0][m][0], g1 = acc[ai][0][m][1], u0 = acc[ai][1][m][0], u1 = acc[ai][1][m][1];
                float x[8] = {siluf(g0[0]) * u0[0], siluf(g0[1]) * u0[1], siluf(g0[2]) * u0[2], siluf(g0[3]) * u0[3], siluf(g1[0]) * u1[0], siluf(g1[1]) * u1[1], siluf(g1[2]) * u1[2], siluf(g1[3]) * u1[3]};
                *(u32x4*)(HID + (size_t)(row0 + ai * HALF + m * 16) * 2816 + c) = pack8_bf16(x); }
    }
};
struct EpiU {
    static constexpr bool PERM = true, AFTER_DRAIN = false;
    bf16_t* U;
    __device__ __forceinline__ void operator()(const f32x4 (&acc)[2][2][4][2], const Unit& u, int wr, int wc, int fr, int fq) const {
        const int row0 = u.pm * BM + wr * 64 + fr, col0 = u.pn * BM + wc * 32 + 8 * fq;
#pragma unroll
        for (int ai = 0; ai < 2; ++ai)
#pragma unroll
            for (int m = 0; m < 4; ++m) { const int row = row0 + ai * HALF + m * 16; const int srow = row < EP_ML ? (row & 63) * 256 + (row >> 6) : row;
#pragma unroll
                for (int bj = 0; bj < 2; ++bj) { const f32x4 v0 = acc[ai][bj][m][0], v1 = acc[ai][bj][m][1]; float x[8] = {v0[0], v0[1], v0[2], v0[3], v1[0], v1[1], v1[2], v1[3]};
                    *(u32x4*)(U + (size_t)srow * 512 + col0 + bj * HALF) = pack8_bf16(x); } }
    }
};
struct EpiValGate {
    static constexpr bool PERM = false, AFTER_DRAIN = false;
    float* H; const float* gate;
    __device__ __forceinline__ void operator()(const f32x4 (&acc)[2][2][4][2], const Unit& u, int wr, int wc, int fr, int fq) const {
        const int row0 = u.pm * BM + wr * 64 + fr, col0 = u.pn * HALF + wc * 32 + 4 * fq;
#pragma unroll
        for (int ai = 0; ai < 2; ++ai)
#pragma unroll
            for (int m = 0; m < 4; ++m) { float* hp = H + (size_t)(row0 + ai * HALF + m * 16) * 1024 + col0;
#pragma unroll
                for (int n = 0; n < 2; ++n) { const f32x4 v = acc[ai][0][m][n], g = acc[ai][1][m][n]; const f32x4 gm = *(const f32x4*)(gate + col0 + n * 16); f32x4 h = *(const f32x4*)(hp + n * 16);
                    h[0] += gm[0] * v[0] * sigmf(g[0]); h[1] += gm[1] * v[1] * sigmf(g[1]); h[2] += gm[2] * v[2] * sigmf(g[2]); h[3] += gm[3] * v[3] * sigmf(g[3]); *(f32x4*)(hp + n * 16) = h; } }
    }
};
template <class Epi, class Sched, bool ALIGN_EPI = false, bool SP2 = false>
__device__ __forceinline__ void gemm_phase(PG8_LAS unsigned char* lds, const Gemm g, const Sched& S, const Epi& E) {
    const int tid = threadIdx.x, wid = __builtin_amdgcn_readfirstlane(tid >> 6), lane = tid & 63, wr = wid >> 2, wc = wid & 3, fr = lane & 15, fq = lane >> 4;
    const int K = g.K, nt = K / BK;
    unsigned voffA[2], voffB[2];
#pragma unroll
    for (int i = 0; i < 2; ++i) { int R, C; stage_rc(tid * 16 + i * 8192, R, C); const int Rb = Epi::PERM ? ((R & ~31) + perm32(R & 31)) : R;
        voffA[i] = (unsigned)(R * K + C) * 2u; voffB[i] = (unsigned)(Rb * K + C) * 2u; }
    const size_t kstep = (size_t)(BK * 2);
    const size_t hstep = (size_t)HALF * K * 2;
    const size_t tstep = 2 * hstep;
    const unsigned ldsw = (unsigned)wid * 1024u;
    const int aoff = lds_byte(wr * 64 + fr, fq * 8), boff = lds_byte(wc * 32 + fr, fq * 8);
#define PG8_SA(b, h) (((b) * 2 + (h)) * HTB)
#define PG8_SB(b, h) ((4 + (b) * 2 + (h)) * HTB)
#define PG8_STAGE(bufoff, gbase, voff) do { _Pragma("unroll") for (int _i = 0; _i < 2; ++_i) \
        __builtin_amdgcn_global_load_lds((const unsigned*)((const char*)(gbase) + (voff)[_i]), (PG8_LAS unsigned*)(lds + (bufoff) + ldsw + _i * 8192), 16, 0, 0); } while (0)
#define PG8_LDA(dst, b, h) do { _Pragma("unroll") for (int m = 0; m < 4; ++m) _Pragma("unroll") for (int k = 0; k < 2; ++k) dst[m][k] = *(const PG8_LAS bf16x8*)(lds + PG8_SA(b, h) + aoff + m * 2048 + k * 1024); } while (0)
#define PG8_LDB(dst, b, h) do { _Pragma("unroll") for (int n = 0; n < 2; ++n) _Pragma("unroll") for (int k = 0; k < 2; ++k) dst[n][k] = *(const PG8_LAS bf16x8*)(lds + PG8_SB(b, h) + boff + n * 2048 + k * 1024); } while (0)
#define PG8_MMA(ai, bj, At, Bt) do { __builtin_amdgcn_s_setprio(1); _Pragma("unroll") for (int m = 0; m < 4; ++m) _Pragma("unroll") for (int n = 0; n < 2; ++n) _Pragma("unroll") for (int k = 0; k < 2; ++k) \
        acc[ai][bj][m][n] = __builtin_amdgcn_mfma_f32_16x16x32_bf16(Bt[n][k], At[m][k], acc[ai][bj][m][n], 0, 0, 0); __builtin_amdgcn_s_setprio(0); } while (0)
#define PG8_WAIT_V(n) asm volatile("s_waitcnt vmcnt(" #n ")" ::: "memory")
#define PG8_WAIT_L(n) asm volatile("s_waitcnt lgkmcnt(" #n ")" ::: "memory")
#define PG8_BAR __builtin_amdgcn_s_barrier()
#define PG8_SCHED __builtin_amdgcn_sched_barrier(0)
    Unit cur, nxt; int ui = 0;
    if (!S.next(0, cur)) return;
    f32x4 acc[2][2][4][2];
#pragma unroll
    for (int a = 0; a < 2; ++a)
#pragma unroll
        for (int b = 0; b < 2; ++b)
#pragma unroll
            for (int m = 0; m < 4; ++m)
#pragma unroll
                for (int n = 0; n < 2; ++n) acc[a][b][m][n] = (f32x4){0.f, 0.f, 0.f, 0.f};
    bf16x8 At[4][2], B0[2][2], B1[2][2];
    const char* cA = (const char*)g.A + (size_t)cur.pm * tstep; const char* cB = (const char*)g.Bt + (size_t)cur.pn * tstep;
    S.a_ready(cur);
    if constexpr (SP2) {
        PG8_STAGE(PG8_SB(0, 0), cB, voffB); PG8_STAGE(PG8_SB(0, 1), cB + hstep, voffB); PG8_STAGE(PG8_SA(0, 0), cA, voffA); PG8_STAGE(PG8_SA(0, 1), cA + hstep, voffA);
        if (wr == 1) PG8_BAR;
        PG8_WAIT_V(2); PG8_BAR;
        PG8_STAGE(PG8_SB(1, 0), cB + kstep, voffB); PG8_STAGE(PG8_SA(1, 0), cA + kstep, voffA); PG8_STAGE(PG8_SB(1, 1), cB + hstep + kstep, voffB);
        PG8_WAIT_V(6); PG8_BAR;
    } else {
        PG8_STAGE(PG8_SB(0, 0), cB, voffB); PG8_STAGE(PG8_SA(0, 0), cA, voffA); PG8_STAGE(PG8_SB(0, 1), cB + hstep, voffB); PG8_STAGE(PG8_SA(0, 1), cA + hstep, voffA);
        if (wr == 1) PG8_BAR;
        PG8_WAIT_V(4); PG8_BAR;
        PG8_STAGE(PG8_SB(1, 0), cB + kstep, voffB); PG8_STAGE(PG8_SA(1, 0), cA + kstep, voffA); PG8_STAGE(PG8_SB(1, 1), cB + hstep + kstep, voffB);
        PG8_WAIT_V(6); PG8_BAR;
    }
    for (;;) {
        const bool has_next = S.next(ui + 1, nxt);
        const char* nA = has_next ? (const char*)g.A + (size_t)nxt.pm * tstep : cA; const char* nB = has_next ? (const char*)g.Bt + (size_t)nxt.pn * tstep : cB;
        for (int t = 0; t < nt; t += 2) {
            const bool last = (t == nt - 2);
            const char* a1 = cA + (size_t)(t + 1) * kstep;
            const char* a2 = last ? nA : cA + (size_t)(t + 2) * kstep; const char* b2 = last ? nB : cB + (size_t)(t + 2) * kstep;
            const char* a3 = a2 + kstep; const char* b3 = b2 + kstep;
            if (last && has_next) S.a_ready(nxt);
            if constexpr (SP2) {
            PG8_LDB(B0, 0, 0); PG8_LDB(B1, 0, 1); PG8_SCHED; PG8_LDA(At, 0, 0); PG8_STAGE(PG8_SA(1, 1), a1 + hstep, voffA);
            PG8_WAIT_V(8); PG8_WAIT_L(0); PG8_BAR; PG8_MMA(0, 0, At, B0); PG8_MMA(0, 1, At, B1); PG8_BAR; PG8_SCHED;
            PG8_LDA(At, 0, 1); PG8_STAGE(PG8_SB(0, 0), b2, voffB); PG8_STAGE(PG8_SB(0, 1), b2 + hstep, voffB); PG8_STAGE(PG8_SA(0, 0), a2, voffA);
            PG8_WAIT_V(8); PG8_WAIT_L(0); PG8_BAR; PG8_MMA(1, 0, At, B0); PG8_MMA(1, 1, At, B1); PG8_BAR; PG8_SCHED;
            PG8_LDB(B0, 1, 0); PG8_LDB(B1, 1, 1); PG8_SCHED; PG8_LDA(At, 1, 0); PG8_STAGE(PG8_SA(0, 1), a2 + hstep, voffA);
            PG8_WAIT_V(8); PG8_WAIT_L(0); PG8_BAR; PG8_MMA(0, 0, At, B0); PG8_MMA(0, 1, At, B1); PG8_BAR; PG8_SCHED;
            PG8_LDA(At, 1, 1); PG8_STAGE(PG8_SB(1, 0), b3, voffB); PG8_STAGE(PG8_SB(1, 1), b3 + hstep, voffB); PG8_STAGE(PG8_SA(1, 0), a3, voffA);
            PG8_WAIT_V(8); PG8_WAIT_L(0); PG8_BAR; PG8_MMA(1, 0, At, B0); PG8_MMA(1, 1, At, B1); PG8_BAR; PG8_SCHED;
            } else {
            PG8_LDB(B0, 0, 0); PG8_SCHED; PG8_LDA(At, 0, 0); PG8_STAGE(PG8_SA(1, 1), a1 + hstep, voffA);
            PG8_WAIT_L(8); PG8_BAR; PG8_WAIT_L(0); PG8_MMA(0, 0, At, B0); PG8_BAR; PG8_SCHED;
            PG8_LDB(B1, 0, 1); PG8_STAGE(PG8_SB(0, 0), b2, voffB);
            PG8_BAR; PG8_WAIT_L(0); PG8_MMA(0, 1, At, B1); PG8_BAR;
            PG8_LDA(At, 0, 1); PG8_STAGE(PG8_SA(0, 0), a2, voffA);
            PG8_BAR; PG8_WAIT_L(0); PG8_MMA(1, 0, At, B0); PG8_BAR; PG8_SCHED;
            PG8_STAGE(PG8_SB(0, 1), b2 + hstep, voffB);
            PG8_WAIT_V(6); PG8_BAR; PG8_MMA(1, 1, At, B1); PG8_BAR;
            PG8_LDB(B0, 1, 0); PG8_SCHED; PG8_LDA(At, 1, 0); PG8_STAGE(PG8_SA(0, 1), a2 + hstep, voffA);
            PG8_WAIT_L(8); PG8_BAR; PG8_WAIT_L(0); PG8_MMA(0, 0, At, B0); PG8_BAR; PG8_SCHED;
            PG8_LDB(B1, 1, 1); PG8_STAGE(PG8_SB(1, 0), b3, voffB);
            PG8_BAR; PG8_WAIT_L(0); PG8_MMA(0, 1, At, B1); PG8_BAR;
            PG8_LDA(At, 1, 1); PG8_STAGE(PG8_SA(1, 0), a3, voffA);
            PG8_BAR; PG8_WAIT_L(0); PG8_MMA(1, 0, At, B0); PG8_BAR; PG8_SCHED;
            PG8_STAGE(PG8_SB(1, 1), b3 + hstep, voffB);
            PG8_WAIT_V(6); PG8_BAR; PG8_MMA(1, 1, At, B1); PG8_BAR;
            }
        }
        if constexpr (ALIGN_EPI) { if (wr == 0) PG8_BAR; }
        if constexpr (!Epi::AFTER_DRAIN) { E(acc, cur, wr, wc, fr, fq); S.done(cur); }
        if (!has_next) break;
#pragma unroll
        for (int a = 0; a < 2; ++a)
#pragma unroll
            for (int b = 0; b < 2; ++b)
#pragma unroll
                for (int m = 0; m < 4; ++m)
#pragma unroll
                    for (int n = 0; n < 2; ++n) acc[a][b][m][n] = (f32x4){0.f, 0.f, 0.f, 0.f};
        cur = nxt; cA = nA; cB = nB; ++ui;
        if constexpr (ALIGN_EPI) { if (wr == 1) PG8_BAR; }
    }
    PG8_WAIT_V(0);
    if constexpr (!ALIGN_EPI) { if (wr == 0) PG8_BAR; }
    PG8_BAR;
    if constexpr (Epi::AFTER_DRAIN) { E.fused(acc, cur, wr, wc, fr, fq, lds, wid, lane); S.done(cur); }
#undef PG8_SA
#undef PG8_SB
#undef PG8_STAGE
#undef PG8_LDA
#undef PG8_LDB
#undef PG8_MMA
#undef PG8_WAIT_V
#undef PG8_WAIT_L
#undef PG8_BAR
#undef PG8_SCHED
}
}
#define GAS __attribute__((address_space(1)))
#define LAS __attribute__((address_space(3)))
typedef unsigned short bf16;
typedef unsigned v4u __attribute__((ext_vector_type(4)));
typedef float f32x4 __attribute__((ext_vector_type(4)));
typedef short bf16x8 __attribute__((ext_vector_type(8)));
typedef GAS unsigned gu32;
typedef GAS unsigned long long gu64;
#define RLX_AGENT __ATOMIC_RELAXED, __HIP_MEMORY_SCOPE_AGENT
#define LDS_WAIT() asm volatile("s_waitcnt lgkmcnt(0)" ::: "memory")
#define VM_WAIT() asm volatile("s_waitcnt vmcnt(0)" ::: "memory")
__device__ __forceinline__ unsigned long long rt() { return __builtin_amdgcn_s_memrealtime(); }
typedef __bf16 bf16x2_t __attribute__((ext_vector_type(2)));
__device__ __forceinline__ unsigned f2bf(float f) { return (unsigned)__builtin_bit_cast(unsigned short, (__bf16)f); }
__device__ __forceinline__ unsigned pk2(float lo, float hi) { const bf16x2_t v = {(__bf16)lo, (__bf16)hi}; return __builtin_bit_cast(unsigned, v); }

#define XB_TMO      128
#define XB_XCNT(j)  (256  + 64 * (j))
#define XB_XSUB(j)  (1280 + 64 * (j))
#define XB_XGEN(j)  (2304 + 64 * (j))
#define XB_TOP      3328
#define XB_TOPGEN   3392
#define XCD_BAR_WORDS 3456
#define XB_SPIN_CAP (1u << 18)

__device__ __forceinline__ unsigned xb_ld(unsigned* p)              { return __hip_atomic_load(p, __ATOMIC_RELAXED, __HIP_MEMORY_SCOPE_AGENT); }
__device__ __forceinline__ unsigned xb_add(unsigned* p, unsigned v) { return __hip_atomic_fetch_add(p, v, __ATOMIC_RELAXED, __HIP_MEMORY_SCOPE_AGENT); }
__device__ __forceinline__ unsigned xb_xcc_id() { return (unsigned)__builtin_amdgcn_s_getreg((3 << 11) | 20) & 0xFu; }
#define XB_SPIN(cond, bar) do { unsigned _sp = 0; while (cond) { __builtin_amdgcn_s_sleep(1); \
    if ((++_sp & 255u) == 0u) { if (xb_ld(&(bar)[XB_TMO])) break; if (_sp > XB_SPIN_CAP) { atomicAdd(&(bar)[XB_TMO], 1u); break; } } } } while (0)

struct XcdBarrier {
    unsigned* bar; unsigned x;
    volatile LAS unsigned* st;
};

__device__ __forceinline__ XcdBarrier xcd_barrier_post(unsigned* bar, volatile LAS unsigned* st) {
    XcdBarrier b; b.bar = bar; b.x = xb_xcc_id(); b.st = st;
    if (threadIdx.x == 0) (void)xb_add(&bar[XB_XCNT(b.x)], 1u);
    return b;
}
__device__ __forceinline__ void xcd_barrier_complete(unsigned* bar, unsigned x, unsigned& nloc, unsigned& nx) {
    const unsigned G = gridDim.x * gridDim.y * gridDim.z;
    unsigned sum, cnt, mine, sp = 0u;
    for (;;) {
        sum = 0u; cnt = 0u; mine = 0u;
#pragma unroll
        for (unsigned j = 0; j < 16; ++j) { const unsigned c = xb_ld(&bar[XB_XCNT(j)]); sum += c; cnt += (c > 0u) ? 1u : 0u; mine = (j == x) ? c : mine; }
        if (sum == G) break;
        __builtin_amdgcn_s_sleep(1);
        if ((++sp & 255u) == 0u) { if (xb_ld(&bar[XB_TMO])) break; if (sp > XB_SPIN_CAP) { atomicAdd(&bar[XB_TMO], 1u); break; } }
    }
    nloc = mine > 0u ? mine : 1u; nx = cnt > 0u ? cnt : 1u;
}

__device__ __forceinline__ void xcd_barrier(const XcdBarrier& b) {
    asm volatile("s_waitcnt vmcnt(0)" ::: "memory");
    __syncthreads();
    if (threadIdx.x == 0) {
        unsigned* bar = b.bar;
        __builtin_amdgcn_s_waitcnt(0);
        unsigned nloc = b.st[0], nx = b.st[1];
        if (nloc == 0u) { xcd_barrier_complete(bar, b.x, nloc, nx); b.st[0] = nloc; b.st[1] = nx; }
        const unsigned old = xb_add(&bar[XB_XSUB(b.x)], 1u);
        const unsigned gen = old / nloc;
        if (old + 1u == (gen + 1u) * nloc) {
            __builtin_amdgcn_fence(__ATOMIC_RELEASE, "agent");
            asm volatile("s_waitcnt vmcnt(0)" ::: "memory");
            const unsigned og = xb_add(&bar[XB_TOP], 1u);
            const unsigned tg = og / nx;
            if (og + 1u == (tg + 1u) * nx) xb_add(&bar[XB_TOPGEN], 1u);
            else XB_SPIN(xb_ld(&bar[XB_TOPGEN]) == tg, bar);
            __builtin_amdgcn_fence(__ATOMIC_ACQUIRE, "agent");
            xb_add(&bar[XB_XGEN(b.x)], 1u);
            asm volatile("s_waitcnt vmcnt(0)" ::: "memory");
        } else {
            XB_SPIN(xb_ld(&bar[XB_XGEN(b.x)]) == gen, bar);
            __builtin_amdgcn_fence(__ATOMIC_ACQUIRE, "agent");
            asm volatile("s_waitcnt vmcnt(0)" ::: "memory");
        }
    }
    __syncthreads();
}


constexpr int NWAVES = 8;
constexpr int D = 1024, ML = 16384, MC = 256, M = ML + MC, DFF = 2816;
constexpr int NIN = 7712, NINP = 7936;
constexpr int NSC = 32, SCL = 512;
constexpr float EPS = 1e-6f;
static_assert(pg8::EP_ML == ML, "epilogue constant");

constexpr size_t MiB = 1u << 20, KiB = 1024;
constexpr size_t WS_CTL = 0, CTL_ZERO_BYTES = 1 * MiB;
constexpr size_t WS_SMALL = 1 * MiB;
constexpr size_t WS_HCTX = 9 * MiB;
constexpr size_t WS_FCTX = 10 * MiB;
constexpr size_t WS_RX = 11 * MiB;
constexpr size_t WS_ZQ = 44 * MiB;
constexpr size_t WS_XBC = 109 * MiB;
constexpr size_t WS_V = WS_XBC + (size_t)M * 1536 * 2;
constexpr size_t WS_G = WS_V + (size_t)M * 1024 * 2;
constexpr size_t WS_DT = WS_G + (size_t)M * 1024 * 2;
constexpr size_t WS_WIN = 227 * MiB;
constexpr size_t WS_BCC = WS_WIN;
static_assert(WS_BCC + (size_t)M * 512 * 2 <= 256 * MiB, "BCC");
static_assert(WS_DT + (size_t)M * 64 * 4 <= WS_WIN && WS_WIN + (size_t)NINP * 1024 * 2 <= 256 * MiB, "ws map (mixer phase)");
constexpr size_t WS_WREST = 216 * MiB;
constexpr size_t WO_OUT = 0, WO_UP0 = 4 * MiB, WO_DOWN0 = 15 * MiB, WO_OD = WO_DOWN0 + (size_t)DFF * 1024 * 2, WO_VG = WO_OD + 1 * MiB, WO_UP1 = WO_VG + 2 * MiB, WO_DOWN1 = WO_UP1 + 11 * MiB;
static_assert(WO_DOWN1 + (size_t)DFF * 1024 * 2 <= 40 * MiB, "weights overlay");
constexpr size_t WS_HID = WS_XBC;
static_assert(WS_HID + (size_t)M * DFF * 2 <= WS_WREST, "hidden overlay");
constexpr size_t WS_U = WS_ZQ;
constexpr size_t WS_A2 = WS_U + (size_t)M * 512 * 4;
static_assert(WS_A2 + (size_t)ML * 512 * 2 <= WS_XBC, "layer-1 overlay");
constexpr size_t WS_YS = WS_XBC;
constexpr size_t SM_ADAP = 0;
constexpr size_t SM_MODS = SM_ADAP + 2 * 2 * 8 * 6144 * 4;
constexpr size_t SM_LB = SM_MODS + 2 * 2 * 6144 * 4;
constexpr size_t SM_LAM = SM_LB + 4096;
constexpr size_t SM_LAMP = SM_LAM + 2 * 2048 * 2 * 4;
constexpr size_t SM_BB = SM_LAMP + 2 * 2048 * 2 * 4;
constexpr size_t SM_STATS = SM_BB + 2 * 2048 * 16 * 2 * 4;
constexpr size_t SM_SSDDEC = SM_STATS + (size_t)M * 16 * 4;
constexpr size_t SM_HGDEC = SM_SSDDEC + 33 * 32 * 4 + 128;
constexpr size_t SM_S5ST = ((SM_HGDEC + 33 * 16 * 128 * 4 + 255) / 256) * 256;
static_assert(SM_S5ST + 130 * 2 * 2048 * 2 * 4 <= 8 * MiB, "small tables");
constexpr size_t SSD_ST_BYTES = (size_t)33 * 32 * 8192 * 2;
static_assert(2 * SSD_ST_BYTES <= 33 * MiB && (size_t)M * 1024 * 2 <= 33 * MiB, "RX region");
constexpr int CW_BAR = 4096;

constexpr int RING_OFF = 0, RING_BYTES = 131072;
constexpr int LDS_BYTES = 163840;
constexpr int LDSCTL_OFF = LDS_BYTES - 512, MISC_OFF = LDSCTL_OFF + 320;


struct Params { const float* in[33]; float* out; unsigned char* ws; int ph_lo, ph_hi, use_bar, pad; };
enum { I_X = 0, I_C, I_CTX, I_CCTX, I_ADAW, I_ADAB, I_NMIX, I_NFFN, I_WGATE, I_WUP, I_WDOWN, I_FNORM, I_EVIN, I_EVOUT, I_CONVW, I_CONVB, I_DTB, I_ALOG, I_SSDD, I_SSDN, I_LBL, I_HGN,
       I_ODIN, I_ARE, I_AIM, I_LOGDT, I_BRE, I_BIM, I_CRE, I_CIM, I_S5D, I_WVAL, I_WGATE2 };
typedef _Float16 f16x8 __attribute__((ext_vector_type(8)));
typedef _Float16 f16;
typedef _Float16 f16x2 __attribute__((ext_vector_type(2)));
typedef float f32x2 __attribute__((ext_vector_type(2)));
__device__ __forceinline__ float bf2f(unsigned b) { return __uint_as_float(b << 16); }
__device__ __forceinline__ float siluf(float x) { return x * __builtin_amdgcn_rcpf(1.f + __expf(-x)); }
__device__ __forceinline__ float wave_sum(float v) {
#pragma unroll
    for (int o = 1; o < 64; o <<= 1) v += __shfl_xor(v, o);
    return v;
}
__device__ __forceinline__ void unpack8(const v4u r, float (&x)[8]) {
    x[0] = bf2f(r.x & 0xffffu); x[1] = bf2f(r.x >> 16); x[2] = bf2f(r.y & 0xffffu); x[3] = bf2f(r.y >> 16);
    x[4] = bf2f(r.z & 0xffffu); x[5] = bf2f(r.z >> 16); x[6] = bf2f(r.w & 0xffffu); x[7] = bf2f(r.w >> 16);
}
__device__ __forceinline__ void tr_item(const float* W, int ldw, int col0, int K, bf16* WT, int dst_row0, LAS float* scr, int kb, int lane) {
    const int k0 = 64 * kb;
#pragma unroll 8
    for (int i = 0; i < 32; ++i) { const int kk = 2 * i + (lane >> 5); scr[kk * 33 + (lane & 31)] = W[(size_t)(k0 + kk) * ldw + col0 + (lane & 31)]; }
    LDS_WAIT(); asm volatile("" ::: "memory");
    const int c = lane & 7;
#pragma unroll
    for (int j = 0; j < 4; ++j) { const int n = (lane >> 3) + 8 * j; const LAS float* s = scr + (8 * c) * 33 + n;
        v4u o; o.x = pk2(s[0 * 33], s[1 * 33]); o.y = pk2(s[2 * 33], s[3 * 33]); o.z = pk2(s[4 * 33], s[5 * 33]); o.w = pk2(s[6 * 33], s[7 * 33]);
        *(GAS v4u*)(WT + (size_t)(dst_row0 + n) * K + k0 + 8 * c) = o; }
    LDS_WAIT(); asm volatile("" ::: "memory");
}
__device__ __forceinline__ int dst_row_of(int mode, int c0) {
    if (mode == 0) return c0 < 2560 ? c0 : (c0 < 2592 ? 7680 + (c0 - 2560) : c0 - 32);
    if (mode == 1) return c0;
    return (c0 >> 7) * 256 + (mode == 3 ? 128 : 0) + (c0 & 127);
}
__device__ __forceinline__ void tr_job(const float* W, int K, int N, int mode, bf16* WT, LAS float* scr, int gw, int ngw, int lane) {
    const int nblk = N / 32, nit = (K / 64) * nblk;
    for (int it = gw; it < nit; it += ngw) { const int kb = it / nblk, nb = it % nblk; tr_item(W, N, 32 * nb, K, WT, dst_row_of(mode, 32 * nb), scr, kb, lane); }
}

__device__ __forceinline__ void phase_prologue(const Params& p, LAS unsigned char* lds, int bid, int G, int tid, int wave, int lane) {
    unsigned char* ws = p.ws; float* sm_adap = (float*)(ws + WS_SMALL + SM_ADAP);
    for (int it = bid; it < 192; it += G) {
        const int layer = it / 96, rem = it % 96, cb = rem / 8, ks = rem % 8;
        LAS float* sl = (LAS float*)lds; LAS float* sc = sl + 128;
        if (tid < 128) { sl[tid] = siluf(p.in[I_C][ks * 128 + tid]); sc[tid] = siluf(p.in[I_CCTX][ks * 128 + tid]); }
        __syncthreads();
        const int col = cb * 512 + tid; const float* W = p.in[I_ADAW] + (size_t)layer * 1024 * 6144 + (size_t)(ks * 128) * 6144 + col;
        float a0 = 0.f, a1 = 0.f;
#pragma unroll 8
        for (int k = 0; k < 128; ++k) { const float w = W[(size_t)k * 6144]; a0 += sl[k] * w; a1 += sc[k] * w; }
        sm_adap[((layer * 2 + 0) * 8 + ks) * 6144 + col] = a0; sm_adap[((layer * 2 + 1) * 8 + ks) * 6144 + col] = a1;
        __syncthreads();
    }
    const int gw = bid * NWAVES + wave, ngw = G * NWAVES;
    LAS float* scr = (LAS float*)(lds + wave * 16384);
    bf16* win = (bf16*)(ws + WS_WIN);
    tr_job(p.in[I_EVIN], 1024, NIN, 0, win, scr, gw, ngw, lane);
    { const int gt = bid * 512 + tid, nt = G * 512; v4u z = {0u, 0u, 0u, 0u};
      for (int i = gt; i < (NINP - NIN) * 1024 / 8; i += nt) *(GAS v4u*)(win + (size_t)NIN * 1024 + (size_t)i * 8) = z; }
    const int gt = bid * 512 + tid;
    if (gt < 1024) { const float l0 = p.in[I_LBL][gt], l1 = p.in[I_LBL][1024 + gt]; const float mx = fmaxf(l0, l1), e0 = __expf(l0 - mx), e1 = __expf(l1 - mx); ((float*)(ws + WS_SMALL + SM_LB))[gt] = e0 / (e0 + e1); }
    if (gt >= 4096 && gt < 8192) {
        const int s = gt - 4096, dg = s >> 6;
        const float dt = expf(p.in[I_LOGDT][dg]), are = p.in[I_ARE][s], aim = p.in[I_AIM][s];
        const float mag = expf(are * dt); float sn, cs; sincosf(aim * dt, &sn, &cs);
        const float lr = mag * cs, li = mag * sn, den = are * are + aim * aim;
        const float cr = ((lr - 1.f) * are + li * aim) / den, ci = (li * are - (lr - 1.f) * aim) / den;
        float* lam = (float*)(ws + WS_SMALL + SM_LAM); lam[2 * s] = lr; lam[2 * s + 1] = li;
        float pr = lr, pi = li;
#pragma unroll
        for (int q = 0; q < 7; ++q) { const float nr = pr * pr - pi * pi, ni = 2.f * pr * pi; pr = nr; pi = ni; }
        float* lamp = (float*)(ws + WS_SMALL + SM_LAMP); lamp[2 * s] = pr; lamp[2 * s + 1] = pi;
        bf16* bbh = (bf16*)(ws + WS_SMALL + SM_BB) + (size_t)s * 32;
#pragma unroll
        for (int c = 0; c < 16; ++c) { const float br = p.in[I_BRE][(size_t)s * 16 + c], bi = p.in[I_BIM][(size_t)s * 16 + c]; bbh[c] = (bf16)f2bf(cr * br - ci * bi); bbh[16 + c] = (bf16)f2bf(cr * bi + ci * br); }
    }
    { bf16* cmh = (bf16*)(ws + WS_SMALL + SM_BB + 262144); const int nt = G * 512;
      for (int e = gt; e < 2 * 32 * 16 * 128; e += nt) { const int k = e & 127, dgc = e >> 7; cmh[e] = (bf16)f2bf(k < 64 ? p.in[I_CRE][(size_t)dgc * 64 + k] : -p.in[I_CIM][(size_t)dgc * 64 + k - 64]); } }
}

__device__ __forceinline__ void phase_rownorm(const Params& p, LAS unsigned char* lds, int bid, int G, int tid, int wave, int lane, int layer, int kind  , int nrows,
                                              const float* src_lat, const float* src_ctx, bool from_partials) {
    unsigned char* ws = p.ws; const float* adap = (const float*)(ws + WS_SMALL + SM_ADAP); float* mods = (float*)(ws + WS_SMALL + SM_MODS);
    LAS float* Gt = (LAS float*)lds; LAS float* St = Gt + 2048;
    const float* ng = p.in[kind == 0 ? I_NMIX : I_NFFN] + layer * 1024;
    for (int idx = tid; idx < 4096; idx += 512) {
        const int vec = idx >> 11, which = (idx >> 10) & 1, col = idx & 1023, j = (kind * 3 + which) * 1024 + col;
        float v;
        if (from_partials) { v = p.in[I_ADAB][layer * 6144 + j];
#pragma unroll
            for (int ks = 0; ks < 8; ++ks) v += adap[((layer * 2 + vec) * 8 + ks) * 6144 + j]; }
        else v = mods[(layer * 2 + vec) * 6144 + j];
        if (which == 0) St[vec * 1024 + col] = v; else Gt[vec * 1024 + col] = ng[col] * (1.f + v);
    }
    if (from_partials && bid < 48) {
        const int idx = bid * 512 + tid, lv = idx / 6144, j = idx % 6144, ly = lv >> 1;
        float v = p.in[I_ADAB][ly * 6144 + j];
#pragma unroll
        for (int ks = 0; ks < 8; ++ks) v += adap[(lv * 8 + ks) * 6144 + j];
        mods[idx] = v;
    }
    __syncthreads();
    bf16* XN = (bf16*)(ws + WS_RX);
    const int gw = bid * NWAVES + wave, ngw = G * NWAVES;
    for (int row = gw; row < nrows; row += ngw) {
        const int vec = row >= ML ? 1 : 0; const float* xr = vec ? src_ctx + (size_t)(row - ML) * 1024 : src_lat + (size_t)row * 1024;
        f32x4 v[4]; float ss = 0.f;
#pragma unroll
        for (int j = 0; j < 4; ++j) { v[j] = *(const GAS f32x4*)(xr + 4 * lane + 256 * j); ss += (v[j].x * v[j].x + v[j].y * v[j].y) + (v[j].z * v[j].z + v[j].w * v[j].w); }
        const float r = rsqrtf(wave_sum(ss) * (1.f / 1024.f) + EPS);
#pragma unroll
        for (int j = 0; j < 4; ++j) { const int c = 4 * lane + 256 * j; const LAS float* g4 = Gt + vec * 1024 + c; const LAS float* s4 = St + vec * 1024 + c;
            const unsigned lo = pk2(v[j].x * r * g4[0] + s4[0], v[j].y * r * g4[1] + s4[1]), hi = pk2(v[j].z * r * g4[2] + s4[2], v[j].w * r * g4[3] + s4[3]);
            *(GAS unsigned long long*)(XN + (size_t)row * 1024 + c) = (unsigned long long)lo | ((unsigned long long)hi << 32); }
    }
}

typedef float f32x16 __attribute__((ext_vector_type(16)));
typedef short s16x4 __attribute__((ext_vector_type(4)));
#define MFMA32(a, b, c) __builtin_amdgcn_mfma_f32_32x32x16_bf16((a), (b), (c), 0, 0, 0)
__device__ __forceinline__ bf16x8 frag_rows(LAS const unsigned char* img, int RS, int row0, int kbyte, int lane) { return *(const LAS bf16x8*)(img + (row0 + (lane & 31)) * RS + kbyte + (lane >> 5) * 16); }
__device__ __forceinline__ bf16x8 frag_tr(LAS const unsigned char* img, int RS, int k0, int col0, int lane) {
    const int h = lane >> 5, blk = (lane >> 4) & 1, q = (lane & 15) >> 2, p = lane & 3;
    LAS const unsigned char* a = img + (k0 + 8 * h + q) * RS + (col0 + 16 * blk + 4 * p) * 2;
    const s16x4 lo = __builtin_amdgcn_ds_read_tr16_b64_v4i16((LAS s16x4*)a), hi = __builtin_amdgcn_ds_read_tr16_b64_v4i16((LAS s16x4*)(a + 4 * RS));
    return (bf16x8){lo[0], lo[1], lo[2], lo[3], hi[0], hi[1], hi[2], hi[3]};
}
__device__ __forceinline__ int arow(int reg, int h) { return (reg & 3) + 8 * (reg >> 2) + 4 * h; }
__device__ __forceinline__ void store_acc_nat(const f32x16& acc, LAS unsigned char* img, int RS, int n0, int m0, int lane) {
    LAS unsigned char* base = img + (n0 + (lane & 31)) * RS + (m0 + 4 * (lane >> 5)) * 2;
#pragma unroll
    for (int g = 0; g < 4; ++g) *(LAS unsigned long long*)(base + 16 * g) = (unsigned long long)pk2(acc[4 * g], acc[4 * g + 1]) | ((unsigned long long)pk2(acc[4 * g + 2], acc[4 * g + 3]) << 32);
}

struct ScanPtrs { const bf16* XBC; const float* DT; bf16* ZQ; const bf16* V; const bf16* G; f16* Flat; f16* Fctx; float* STATS; const float* convw; const float* convb; const float* ssdd; const float* hgn;
                  bf16* SSD_ST; bf16* HG_ST; float* SSD_DEC; float* HG_DEC; const bf16* BCC; };
template <int MODE, int D>
__device__ __forceinline__ void ssd_scan(const ScanPtrs& sp, LAS unsigned char* lds, int row_begin, int nchunks, int seq_lo, int seq_hi, int h, const bf16* st_in, bf16* st_out, float* dec_out, int tid) {
    const int lane = tid & 63, wave = __builtin_amdgcn_readfirstlane(tid >> 6), hf = lane >> 5, g = h >> 3;
    LAS unsigned short* YF = (LAS unsigned short*)lds; LAS unsigned char* XI = lds + 65536; LAS unsigned char* XE = lds + 74752; LAS unsigned char* BI = lds + 83968; LAS unsigned char* CI = lds + 101376; LAS unsigned char* MI = lds + 118784;
    LAS unsigned char* SPI = lds + 128000; LAS float* YB = (LAS float*)(lds + 101376); LAS unsigned char* XR = lds + 145408; LAS float* WT = (LAS float*)(lds + 154112);
    LAS float* AC = (LAS float*)(lds + 155648); LAS float* EA = AC + 64; LAS float* ES = AC + 128; LAS float* DTS = AC + 192;
    asm volatile("" : "+s"(nchunks));
    if (tid < 384) { const int j = tid >> 6, col = h * 64 + (tid & 63); WT[tid] = j < 5 ? sp.convw[j * 1536 + col] : sp.convb[col]; }
    const int nb = wave >> 1, pb = wave & 1;
    f32x16 accS;
#pragma unroll
    for (int r = 0; r < 16; ++r) accS[r] = st_in ? bf2f(*(const GAS unsigned short*)(st_in + (32 * nb + arow(r, hf)) * 64 + 32 * pb + (lane & 31))) : 0.f;
    if (MODE != 0) store_acc_nat(accS, SPI, 272, 32 * pb, 32 * nb, lane);
    float ltot = 0.f; const float dsk = sp.ssdd[h];
    v4u px0, px1, pb0, pb1, pc0, pc1; float pdt = 0.f, pla = 0.f;
    const v4u zero4 = {0u, 0u, 0u, 0u};
    px1 = zero4; pc0 = zero4; pc1 = zero4;
#define SSD_LDX(row_, col_) (((row_) >= seq_lo && (row_) < seq_hi) ? *(const GAS v4u*)(sp.XBC + (size_t)(row_) * 1536 + (col_)) : zero4)
#define SSD_LOAD(c_, tid) do { const int rb_ = row_begin + 64 * (c_); \
        px0 = SSD_LDX(rb_ - 2 + (tid >> 3), h * 64 + (tid & 7) * 8); if (tid < 32) px1 = SSD_LDX(rb_ + 62 + (tid >> 3), h * 64 + (tid & 7) * 8); \
        { const GAS v4u* bp_ = (const GAS v4u*)(sp.BCC + (size_t)(rb_ + (tid >> 4)) * 512 + g * 128 + (tid & 15) * 8); pb0 = bp_[0]; pb1 = bp_[32 * 64]; \
          if (MODE != 0) { pc0 = bp_[32]; pc1 = bp_[32 * 64 + 32]; } } \
        if (tid < 64) { pdt = sp.DT[(size_t)(rb_ + tid) * 64 + D * 16 + h]; pla = sp.DT[(size_t)(rb_ + tid) * 64 + 32 + D * 16 + h]; } } while (0)
    SSD_LOAD(D == 0 ? 0 : nchunks - 1, tid);
#pragma unroll 1
    for (int ci = 0; ci < nchunks; ++ci) {
        const int c = D == 0 ? ci : nchunks - 1 - ci, r0 = row_begin + 64 * c;
        int tl = tid; asm volatile("" : "+v"(tl));
        *(LAS v4u*)(XR + (tl >> 3) * 128 + (tl & 7) * 16) = px0; if (tl < 32) *(LAS v4u*)(XR + (64 + (tl >> 3)) * 128 + (tl & 7) * 16) = px1;
        if (wave == 0) {
            float x = pla;
#pragma unroll
            for (int o = 1; o < 64; o <<= 1) { const float v = D == 0 ? __shfl_up(x, o) : __shfl_down(x, o); if (D == 0 ? (lane >= o) : (lane + o < 64)) x += v; }
            const float last = __shfl(x, D == 0 ? 63 : 0);
            AC[lane] = x; EA[lane] = __expf(x); ES[lane] = pdt * __expf(last - x); DTS[lane] = pdt;
            if (lane == 0) AC[256] = __expf(last);
            ltot += last;
        }
        __syncthreads();
        { const int t = tl >> 3, o8 = (tl & 7) * 8; float a8[8];
#pragma unroll
          for (int i = 0; i < 8; ++i) a8[i] = WT[320 + o8 + i];
#pragma unroll
          for (int j = 0; j < 5; ++j) { float x8[8]; unpack8(*(const LAS v4u*)(XR + (t + j) * 128 + o8 * 2), x8);
#pragma unroll
              for (int i = 0; i < 8; ++i) a8[i] += WT[j * 64 + o8 + i] * x8[i]; }
          const float es = ES[t]; v4u w, we;
#pragma unroll
          for (int i = 0; i < 8; ++i) a8[i] = siluf(a8[i]);
          w.x = pk2(a8[0], a8[1]); w.y = pk2(a8[2], a8[3]); w.z = pk2(a8[4], a8[5]); w.w = pk2(a8[6], a8[7]);
          we.x = pk2(a8[0] * es, a8[1] * es); we.y = pk2(a8[2] * es, a8[3] * es); we.z = pk2(a8[4] * es, a8[5] * es); we.w = pk2(a8[6] * es, a8[7] * es);
          *(LAS v4u*)(XI + t * 144 + o8 * 2) = w; *(LAS v4u*)(XE + t * 144 + o8 * 2) = we; }
        { const int t = tl >> 4, o16 = (tl & 15) * 16;
          *(LAS v4u*)(BI + t * 272 + o16) = pb0; *(LAS v4u*)(BI + (32 + t) * 272 + o16) = pb1;
          if (MODE != 0) { *(LAS v4u*)(CI + t * 272 + o16) = pc0; *(LAS v4u*)(CI + (32 + t) * 272 + o16) = pc1; } }
        if (ci + 1 < nchunks) SSD_LOAD(D == 0 ? ci + 1 : nchunks - 2 - ci, tl);
        __syncthreads();
        f32x16 accY;
        const int tb = (wave & 3) >> 1, qb = wave & 1;
        if (MODE != 0) {
            if (wave >= 4) { const int sb = tb; f32x16 a;
#pragma unroll
                for (int r = 0; r < 16; ++r) a[r] = 0.f;
#pragma unroll
                for (int ks = 0; ks < 8; ++ks) a = MFMA32(frag_rows(BI, 272, 32 * sb, 32 * ks, lane), frag_rows(CI, 272, 32 * qb, 32 * ks, lane), a);
                const int t = 32 * qb + (lane & 31); const float act = AC[t];
#pragma unroll
                for (int r = 0; r < 16; ++r) { const int s2 = 32 * sb + arow(r, hf); const bool keep = D == 0 ? (s2 <= t) : (s2 >= t); a[r] = keep ? a[r] * __expf(act - AC[s2]) * DTS[s2] : 0.f; }
                store_acc_nat(a, MI, 144, 32 * qb, 32 * sb, lane);
            } else {
#pragma unroll
                for (int r = 0; r < 16; ++r) accY[r] = 0.f;
#pragma unroll
                for (int ks = 0; ks < 8; ++ks) accY = MFMA32(frag_rows(CI, 272, 32 * tb, 32 * ks, lane), frag_rows(SPI, 272, 32 * qb, 32 * ks, lane), accY);
#pragma unroll
                for (int r = 0; r < 16; ++r) accY[r] *= EA[32 * tb + arow(r, hf)];
            }
            __syncthreads();
            if (wave < 4) {
#pragma unroll
                for (int ks = 0; ks < 4; ++ks) accY = MFMA32(frag_rows(MI, 144, 32 * tb, 32 * ks, lane), frag_tr(XI, 144, 16 * ks, 32 * qb, lane), accY);
#pragma unroll
                for (int r = 0; r < 16; ++r) YB[(32 * tb + arow(r, hf)) * 68 + 32 * qb + (lane & 31)] = accY[r];
            }
        }
        { const float el = AC[256];
#pragma unroll
          for (int r = 0; r < 16; ++r) accS[r] *= el;
#pragma unroll
          for (int ks = 0; ks < 4; ++ks) accS = MFMA32(frag_tr(BI, 272, 16 * ks, 32 * nb, lane), frag_tr(XE, 144, 16 * ks, 32 * pb, lane), accS);
          if (MODE != 0) store_acc_nat(accS, SPI, 272, 32 * pb, 32 * nb, lane); }
        __syncthreads();
        if (MODE != 0) {
            int t3 = tid; asm volatile("" : "+v"(t3)); const int t = t3 >> 3, p8 = (t3 & 7) * 8, row = r0 + t;
            const f32x4 y0 = *(const LAS f32x4*)(YB + t * 68 + p8), y1 = *(const LAS f32x4*)(YB + t * 68 + p8 + 4);
            LAS v4u* yp = (LAS v4u*)(YF + (row - row_begin) * 64 + p8);
            if (MODE == 1) { v4u w; w.x = pk2(y0.x, y0.y); w.y = pk2(y0.z, y0.w); w.z = pk2(y1.x, y1.y); w.w = pk2(y1.z, y1.w); *yp = w; }
            else { float yf[8], x8[8], z8[8]; unpack8(*yp, yf); unpack8(*(const LAS v4u*)(XI + t * 144 + p8 * 2), x8);
                GAS v4u* zp = (GAS v4u*)(sp.ZQ + (size_t)row * 2048 + h * 64 + p8); unpack8(*zp, z8);
                float o[8] = {y0.x, y0.y, y0.z, y0.w, y1.x, y1.y, y1.z, y1.w}; float ss = 0.f;
#pragma unroll
                for (int i = 0; i < 8; ++i) { o[i] = (o[i] + yf[i] + dsk * x8[i]) * z8[i]; ss += o[i] * o[i]; }
                v4u w; w.x = pk2(o[0], o[1]); w.y = pk2(o[2], o[3]); w.z = pk2(o[4], o[5]); w.w = pk2(o[6], o[7]); *zp = w;
                ss += __shfl_xor(ss, 1); ss += __shfl_xor(ss, 2); ss += __shfl_xor(ss, 4);
                if ((t3 & 7) == 0) sp.STATS[(size_t)row * 16 + h] = ss; }
        }
    }
#undef SSD_LOAD
#undef SSD_LDX
    if (st_out) {
#pragma unroll
        for (int r = 0; r < 16; ++r) *(GAS unsigned short*)(st_out + (32 * nb + arow(r, hf)) * 64 + 32 * pb + (lane & 31)) = (unsigned short)f2bf(accS[r]); }
    if (dec_out && tid == 0) *dec_out = __expf(ltot);
    __syncthreads();
}
__device__ __forceinline__ void phase_convbc(const Params& p, int bid, int G, int tid) {
    const bf16* XBC = (const bf16*)(p.ws + WS_XBC); bf16* BCC = (bf16*)(p.ws + WS_BCC);
    const int gt = bid * 512 + tid, nt = G * 512, oct = gt & 63, col = 1024 + oct * 8;
    float w[5][8], b8[8];
#pragma unroll
    for (int j = 0; j < 5; ++j) { const f32x4 w0 = *(const GAS f32x4*)(p.in[I_CONVW] + j * 1536 + col), w1 = *(const GAS f32x4*)(p.in[I_CONVW] + j * 1536 + col + 4);
        w[j][0] = w0.x; w[j][1] = w0.y; w[j][2] = w0.z; w[j][3] = w0.w; w[j][4] = w1.x; w[j][5] = w1.y; w[j][6] = w1.z; w[j][7] = w1.w; }
    { const f32x4 b0 = *(const GAS f32x4*)(p.in[I_CONVB] + col), b1 = *(const GAS f32x4*)(p.in[I_CONVB] + col + 4); b8[0] = b0.x; b8[1] = b0.y; b8[2] = b0.z; b8[3] = b0.w; b8[4] = b1.x; b8[5] = b1.y; b8[6] = b1.z; b8[7] = b1.w; }
    for (int row = gt >> 6; row < M; row += nt >> 6) {
        const int lo = row < ML ? 0 : ML, hi = row < ML ? ML : M;
        float a8[8];
#pragma unroll
        for (int i = 0; i < 8; ++i) a8[i] = b8[i];
#pragma unroll
        for (int j = 0; j < 5; ++j) { const int rr = row + j - 2;
            if (rr >= lo && rr < hi) { float x8[8]; unpack8(*(const GAS v4u*)(XBC + (size_t)rr * 1536 + col), x8);
#pragma unroll
                for (int i = 0; i < 8; ++i) a8[i] += w[j][i] * x8[i]; } }
        v4u o; o.x = pk2(siluf(a8[0]), siluf(a8[1])); o.y = pk2(siluf(a8[2]), siluf(a8[3])); o.z = pk2(siluf(a8[4]), siluf(a8[5])); o.w = pk2(siluf(a8[6]), siluf(a8[7]));
        *(GAS v4u*)(BCC + (size_t)row * 512 + oct * 8) = o;
    }
}
template <int MODE, int D>
__device__ __forceinline__ void hg_scan(const ScanPtrs& sp, LAS unsigned char* lds, int row_begin, int nchunks, int hh, const bf16* st_in, bf16* st_out, float* dec_out, int tid) {
    const int lane = tid & 63, wave = __builtin_amdgcn_readfirstlane(tid >> 6), h = lane >> 5;
    LAS unsigned char* QP = lds; LAS unsigned char* KP = lds + 17408; LAS unsigned char* VI = lds + 34816; LAS unsigned char* ATT = lds + 52224; LAS unsigned char* STI = lds + 61440;
    LAS float* OB = (LAS float*)(lds + 96256); LAS float* PAR = (LAS float*)(lds + 132096); LAS float* EL = (LAS float*)(lds + 136192);
    f16* Fit = (row_begin < ML) ? sp.Flat + (size_t)row_begin * 2048 : sp.Fctx + (size_t)(row_begin - ML) * 2048;
    const int k0 = (tid & 63) * 2, tg = wave, kb = wave >> 1, vb0 = (wave & 1) * 2;
    asm volatile("" : "+s"(nchunks));
    f32x16 accS[2];
#pragma unroll
    for (int i = 0; i < 2; ++i)
#pragma unroll
        for (int r = 0; r < 16; ++r) accS[i][r] = st_in ? bf2f(*(const GAS unsigned short*)(st_in + (32 * kb + arow(r, h)) * 128 + 32 * (vb0 + i) + (lane & 31))) : 0.f;
    if (MODE != 0) { store_acc_nat(accS[0], STI, 272, 32 * vb0, 32 * kb, lane); store_acc_nat(accS[1], STI, 272, 32 * (vb0 + 1), 32 * kb, lane); }
    float ltot0 = 0.f, ltot1 = 0.f;
    unsigned plf[8], pq[8]; v4u pv0, pv1;
    const int vr = tid >> 3, vc = (tid & 7) * 16;
#define HG_LOAD(c_) do { const int rr_ = 64 * (c_); \
        _Pragma("unroll") for (int i = 0; i < 8; ++i) { plf[i] = *(const GAS unsigned*)(Fit + (size_t)(rr_ + 8 * tg + i) * 2048 + D * 1024 + hh * 128 + k0); \
            if (MODE != 0) pq[i] = *(const GAS unsigned*)(sp.ZQ + (size_t)(row_begin + rr_ + 8 * tg + i) * 2048 + 1024 + hh * 128 + k0); } \
        const GAS v4u* vp_ = (const GAS v4u*)(sp.V + (size_t)(row_begin + rr_ + vr) * 1024 + hh * 128 + vc); pv0 = vp_[0]; pv1 = vp_[1]; } while (0)
    HG_LOAD(D == 0 ? 0 : nchunks - 1);
#pragma unroll 1
    for (int ci = 0; ci < nchunks; ++ci) {
        const int c = D == 0 ? ci : nchunks - 1 - ci, r0 = 64 * c;
        float lf0[8], lf1[8], cs0[8], cs1[8]; float run0 = 0.f, run1 = 0.f;
#pragma unroll
        for (int i = 0; i < 8; ++i) { const f16x2 hr = __builtin_bit_cast(f16x2, plf[i]); lf0[i] = (float)hr.x; lf1[i] = (float)hr.y; }
#pragma unroll
        for (int ii = 0; ii < 8; ++ii) { const int i = D == 0 ? ii : 7 - ii; run0 += lf0[i]; run1 += lf1[i]; cs0[i] = run0; cs1[i] = run1; }
        *(LAS f32x2*)(PAR + tg * 128 + k0) = (f32x2){run0, run1};
        __syncthreads();
        float off0 = 0.f, off1 = 0.f, tot0 = 0.f, tot1 = 0.f;
#pragma unroll
        for (int j = 0; j < 8; ++j) { const f32x2 pj = *(const LAS f32x2*)(PAR + j * 128 + k0); tot0 += pj.x; tot1 += pj.y; if (D == 0 ? (j < tg) : (j > tg)) { off0 += pj.x; off1 += pj.y; } }
#pragma unroll
        for (int i = 0; i < 8; ++i) { const float bc0 = off0 + cs0[i], bc1 = off1 + cs1[i], kk0 = 1.f - __expf(lf0[i]), kk1 = 1.f - __expf(lf1[i]); const int t = 8 * tg + i;
            if (MODE != 0) *(LAS unsigned*)(QP + t * 272 + k0 * 2) = pk2(bf2f(pq[i] & 0xffffu) * __expf(bc0), bf2f(pq[i] >> 16) * __expf(bc1));
            *(LAS unsigned*)(KP + t * 272 + k0 * 2) = pk2(kk0 * __expf(-bc0), kk1 * __expf(-bc1)); }
        if (tg == 0) { *(LAS f32x2*)(EL + k0) = (f32x2){__expf(tot0), __expf(tot1)}; ltot0 += tot0; ltot1 += tot1; }
        *(LAS v4u*)(VI + vr * 272 + vc * 2) = pv0; *(LAS v4u*)(VI + vr * 272 + vc * 2 + 16) = pv1;
        if (ci + 1 < nchunks) HG_LOAD(D == 0 ? ci + 1 : nchunks - 2 - ci);
        __syncthreads();
        f32x16 accO;
        if (MODE != 0) {
            if (wave < 4) { const int sb = wave >> 1, tb = wave & 1; f32x16 a;
#pragma unroll
                for (int r = 0; r < 16; ++r) a[r] = 0.f;
#pragma unroll
                for (int ks = 0; ks < 8; ++ks) a = MFMA32(frag_rows(KP, 272, 32 * sb, 32 * ks, lane), frag_rows(QP, 272, 32 * tb, 32 * ks, lane), a);
                const int t = 32 * tb + (lane & 31);
#pragma unroll
                for (int r = 0; r < 16; ++r) { const int s = 32 * sb + arow(r, h); if (D == 0 ? (s > t) : (s < t)) a[r] = 0.f; }
                store_acc_nat(a, ATT, 144, 32 * tb, 32 * sb, lane); }
            const int tb = wave >> 2, vb = wave & 3;
#pragma unroll
            for (int r = 0; r < 16; ++r) accO[r] = 0.f;
#pragma unroll
            for (int ks = 0; ks < 8; ++ks) accO = MFMA32(frag_rows(QP, 272, 32 * tb, 32 * ks, lane), frag_rows(STI, 272, 32 * vb, 32 * ks, lane), accO);
            __syncthreads();
#pragma unroll
            for (int ks = 0; ks < 4; ++ks) accO = MFMA32(frag_rows(ATT, 144, 32 * tb, 32 * ks, lane), frag_tr(VI, 272, 16 * ks, 32 * vb, lane), accO);
#pragma unroll
            for (int r = 0; r < 16; ++r) OB[(32 * tb + arow(r, h)) * 132 + 32 * vb + (lane & 31)] = accO[r];
        }
#pragma unroll
        for (int ks = 0; ks < 4; ++ks) { const bf16x8 a = frag_tr(KP, 272, 16 * ks, 32 * kb, lane);
            accS[0] = MFMA32(a, frag_tr(VI, 272, 16 * ks, 32 * vb0, lane), accS[0]); accS[1] = MFMA32(a, frag_tr(VI, 272, 16 * ks, 32 * (vb0 + 1), lane), accS[1]); }
#pragma unroll
        for (int r = 0; r < 16; ++r) { const float e = EL[32 * kb + arow(r, h)]; accS[0][r] *= e; accS[1][r] *= e; }
        if (MODE != 0) { store_acc_nat(accS[0], STI, 272, 32 * vb0, 32 * kb, lane); store_acc_nat(accS[1], STI, 272, 32 * (vb0 + 1), 32 * kb, lane); }
        __syncthreads();
        if (MODE != 0) {
            const int t = tid >> 3, c16 = (tid & 7) * 16, row = row_begin + r0 + t;
            float o[16];
#pragma unroll
            for (int j = 0; j < 4; ++j) { const f32x4 x = *(const LAS f32x4*)(OB + t * 132 + c16 + 4 * j); o[4 * j] = x.x; o[4 * j + 1] = x.y; o[4 * j + 2] = x.z; o[4 * j + 3] = x.w; }
            f16* fp = Fit + (size_t)(r0 + t) * 2048 + hh * 128 + c16;
            if (MODE == 1) { f16x8 a, b;
#pragma unroll
                for (int j = 0; j < 8; ++j) { a[j] = (f16)o[j]; b[j] = (f16)o[8 + j]; }
                *(GAS f16x8*)fp = a; *(GAS f16x8*)(fp + 8) = b; }
            else { const f16x8 a = *(const GAS f16x8*)fp, b = *(const GAS f16x8*)(fp + 8); float ss = 0.f;
#pragma unroll
                for (int j = 0; j < 8; ++j) { o[j] += (float)a[j]; o[8 + j] += (float)b[j]; }
#pragma unroll
                for (int j = 0; j < 16; ++j) ss += o[j] * o[j];
                ss += __shfl_xor(ss, 1); ss += __shfl_xor(ss, 2); ss += __shfl_xor(ss, 4);
                const float rn = rsqrtf(ss * (1.f / 128.f) + EPS);
                float g8[8], g9[8]; unpack8(*(const GAS v4u*)(sp.G + (size_t)row * 1024 + hh * 128 + c16), g8); unpack8(*(const GAS v4u*)(sp.G + (size_t)row * 1024 + hh * 128 + c16 + 8), g9);
                const float* hn = sp.hgn + c16;
                v4u w0, w1;
                w0.x = pk2(o[0] * rn * hn[0] * g8[0], o[1] * rn * hn[1] * g8[1]); w0.y = pk2(o[2] * rn * hn[2] * g8[2], o[3] * rn * hn[3] * g8[3]); w0.z = pk2(o[4] * rn * hn[4] * g8[4], o[5] * rn * hn[5] * g8[5]); w0.w = pk2(o[6] * rn * hn[6] * g8[6], o[7] * rn * hn[7] * g8[7]);
                w1.x = pk2(o[8] * rn * hn[8] * g9[0], o[9] * rn * hn[9] * g9[1]); w1.y = pk2(o[10] * rn * hn[10] * g9[2], o[11] * rn * hn[11] * g9[3]); w1.z = pk2(o[12] * rn * hn[12] * g9[4], o[13] * rn * hn[13] * g9[5]); w1.w = pk2(o[14] * rn * hn[14] * g9[6], o[15] * rn * hn[15] * g9[7]);
                GAS v4u* zp = (GAS v4u*)(sp.ZQ + (size_t)row * 2048 + 1024 + hh * 128 + c16); zp[0] = w0; zp[1] = w1; }
        }
    }
#undef HG_LOAD
    if (st_out) {
#pragma unroll
        for (int i = 0; i < 2; ++i)
#pragma unroll
            for (int r = 0; r < 16; ++r) *(GAS unsigned short*)(st_out + (32 * kb + arow(r, h)) * 128 + 32 * (vb0 + i) + (lane & 31)) = (unsigned short)f2bf(accS[i][r]); }
    if (dec_out && tg == 0) { dec_out[k0] = __expf(ltot0); dec_out[k0 + 1] = __expf(ltot1); }
    __syncthreads();
}
__device__ __forceinline__ void wg_fence() { __threadfence(); __syncthreads(); }

__device__ __forceinline__ void phase_scanA1(const ScanPtrs& sp, LAS unsigned char* lds, int bid, int G, int tid) {
    for (int it = bid; it < NSC * 16; it += G) { const int sc = it >> 4, chain = it & 15, hh = chain >> 1, d = chain & 1;
        bf16* so = sp.HG_ST + ((size_t)sc * 16 + chain) * 16384; float* dc = sp.HG_DEC + (sc * 16 + chain) * 128;
        if (d == 0) hg_scan<0, 0>(sp, lds, sc * SCL, SCL / 64, hh, nullptr, so, dc, tid); else hg_scan<0, 1>(sp, lds, sc * SCL, SCL / 64, hh, nullptr, so, dc, tid); }
    for (int it = bid; it < 8; it += G) { const int hh = it;
        hg_scan<1, 0>(sp, lds, ML, MC / 64, hh, nullptr, sp.HG_ST + ((size_t)NSC * 16 + hh * 2 + 0) * 16384, nullptr, tid);
        wg_fence();
        hg_scan<2, 1>(sp, lds, ML, MC / 64, hh, nullptr, sp.HG_ST + ((size_t)NSC * 16 + hh * 2 + 1) * 16384, nullptr, tid); }
}
__device__ __forceinline__ void phase_scanA2(const ScanPtrs& sp, LAS unsigned char* lds, int bid_hw, int G, int tid) {
    const int bid = (G % 8 == 0) ? (bid_hw % 8) * (G / 8) + bid_hw / 8 : bid_hw;
    for (int it = bid; it < NSC * 32; it += G) { const int sc = it >> 5, chain = it & 31, h = chain >> 1, d = chain & 1;
        bf16* so = sp.SSD_ST + ((size_t)sc * 32 + chain) * 8192; float* dc = sp.SSD_DEC + sc * 32 + chain;
        if (d == 0) ssd_scan<0, 0>(sp, lds, sc * SCL, SCL / 64, 0, ML, h, nullptr, so, dc, tid); else ssd_scan<0, 1>(sp, lds, sc * SCL, SCL / 64, 0, ML, h, nullptr, so, dc, tid); }
    for (int it = bid; it < 16; it += G) { const int h = it;
        ssd_scan<1, 0>(sp, lds, ML, MC / 64, ML, M, h, nullptr, sp.SSD_ST + ((size_t)NSC * 32 + h * 2 + 0) * 8192, nullptr, tid);
        ssd_scan<2, 1>(sp, lds, ML, MC / 64, ML, M, h, nullptr, sp.SSD_ST + ((size_t)NSC * 32 + h * 2 + 1) * 8192, nullptr, tid); }
}
__device__ __forceinline__ void phase_scanB(const ScanPtrs& sp, int bid, int G, int tid) {
    const int gt = bid * 512 + tid, nt = G * 512;
    for (int e = gt; e < 2 * 131072; e += nt) {
        const bool hg = e >= 131072; const int e2 = hg ? e - 131072 : e;
        const int chain = hg ? (e2 >> 13) : (e2 >> 12), pr = hg ? (e2 & 8191) : (e2 & 4095), d = chain & 1;
        const int nch = hg ? 16 : 32, ppc = hg ? 8192 : 4096;
        GAS unsigned* base = (GAS unsigned*)(hg ? sp.HG_ST : sp.SSD_ST);
        const unsigned w0 = base[((size_t)NSC * nch + chain) * ppc + pr];
        float r0 = bf2f(w0 & 0xffffu), r1 = bf2f(w0 >> 16);
        for (int i0 = 0; i0 < NSC; i0 += 8) {
            unsigned loc[8]; float dec[8];
#pragma unroll
            for (int j = 0; j < 8; ++j) { const int sc = d == 0 ? i0 + j : NSC - 1 - (i0 + j); loc[j] = base[((size_t)sc * nch + chain) * ppc + pr];
                dec[j] = hg ? sp.HG_DEC[(sc * 16 + chain) * 128 + (pr >> 6)] : sp.SSD_DEC[sc * 32 + chain]; }
#pragma unroll
            for (int j = 0; j < 8; ++j) { const int sc = d == 0 ? i0 + j : NSC - 1 - (i0 + j); base[((size_t)sc * nch + chain) * ppc + pr] = pk2(r0, r1);
                r0 = r0 * dec[j] + bf2f(loc[j] & 0xffffu); r1 = r1 * dec[j] + bf2f(loc[j] >> 16); }
        }
    }
}
__device__ __forceinline__ void phase_scanC(const ScanPtrs& sp, LAS unsigned char* lds, int bid_hw, int G, int tid) {
    const int bid = (G % 8 == 0) ? (bid_hw % 8) * (G / 8) + bid_hw / 8 : bid_hw;
    for (int it = bid; it < NSC * 8; it += G) { const int sc = it >> 3, hh = it & 7;
        hg_scan<1, 0>(sp, lds, sc * SCL, SCL / 64, hh, sp.HG_ST + ((size_t)sc * 16 + hh * 2 + 0) * 16384, nullptr, nullptr, tid);
        wg_fence();
        hg_scan<2, 1>(sp, lds, sc * SCL, SCL / 64, hh, sp.HG_ST + ((size_t)sc * 16 + hh * 2 + 1) * 16384, nullptr, nullptr, tid); }
    for (int it = bid; it < NSC * 16; it += G) { const int sc = it >> 4, h = it & 15;
        ssd_scan<1, 0>(sp, lds, sc * SCL, SCL / 64, 0, ML, h, sp.SSD_ST + ((size_t)sc * 32 + h * 2 + 0) * 8192, nullptr, nullptr, tid);
        ssd_scan<2, 1>(sp, lds, sc * SCL, SCL / 64, 0, ML, h, sp.SSD_ST + ((size_t)sc * 32 + h * 2 + 1) * 8192, nullptr, nullptr, tid); }
}
__device__ __forceinline__ void phase_finish(const Params& p, LAS unsigned char* lds, int bid, int G, int tid, int wave, int lane) {
    unsigned char* ws = p.ws; bf16* ZQ = (bf16*)(ws + WS_ZQ); const float* stats = (const float*)(ws + WS_SMALL + SM_STATS); const float* sng = p.in[I_SSDN];
    const int gw = bid * NWAVES + wave, ngw = G * NWAVES;
    for (int row = gw; row < M; row += ngw) {
        const int grp = lane >> 5; const float* s8 = stats + (size_t)row * 16 + grp * 8;
        const float ss = ((s8[0] + s8[1]) + (s8[2] + s8[3])) + ((s8[4] + s8[5]) + (s8[6] + s8[7]));
        const float r = rsqrtf(ss * (1.f / 512.f) + EPS);
        GAS v4u* zp = (GAS v4u*)(ZQ + (size_t)row * 2048 + lane * 16);
#pragma unroll
        for (int q = 0; q < 2; ++q) { float x8[8]; unpack8(zp[q], x8); const float* g8 = sng + lane * 16 + q * 8;
            v4u o; o.x = pk2(x8[0] * r * g8[0], x8[1] * r * g8[1]); o.y = pk2(x8[2] * r * g8[2], x8[3] * r * g8[3]); o.z = pk2(x8[4] * r * g8[4], x8[5] * r * g8[5]); o.w = pk2(x8[6] * r * g8[6], x8[7] * r * g8[7]); zp[q] = o; }
    }
    LAS float* scr = (LAS float*)(lds + wave * 16384); unsigned char* wr = ws + WS_WREST;
    tr_job(p.in[I_EVOUT], 2048, 1024, 1, (bf16*)(wr + WO_OUT), scr, gw, ngw, lane);
    tr_job(p.in[I_WGATE], 1024, DFF, 2, (bf16*)(wr + WO_UP0), scr, gw, ngw, lane);
    tr_job(p.in[I_WUP], 1024, DFF, 3, (bf16*)(wr + WO_UP0), scr, gw, ngw, lane);
    tr_job(p.in[I_WDOWN], DFF, 1024, 1, (bf16*)(wr + WO_DOWN0), scr, gw, ngw, lane);
    tr_job(p.in[I_ODIN], 1024, 512, 1, (bf16*)(wr + WO_OD), scr, gw, ngw, lane);
    tr_job(p.in[I_WVAL], 512, 1024, 2, (bf16*)(wr + WO_VG), scr, gw, ngw, lane);
    tr_job(p.in[I_WGATE2], 512, 1024, 3, (bf16*)(wr + WO_VG), scr, gw, ngw, lane);
    tr_job(p.in[I_WGATE] + (size_t)1024 * DFF, 1024, DFF, 2, (bf16*)(wr + WO_UP1), scr, gw, ngw, lane);
    tr_job(p.in[I_WUP] + (size_t)1024 * DFF, 1024, DFF, 3, (bf16*)(wr + WO_UP1), scr, gw, ngw, lane);
    tr_job(p.in[I_WDOWN] + (size_t)DFF * 1024, DFF, 1024, 1, (bf16*)(wr + WO_DOWN1), scr, gw, ngw, lane);
}

struct S5Ptrs { const bf16* U; float* YS; bf16* A2; const float* LAM; const float* LAMP; const bf16* BBH; const bf16* CMH; const float* S5D; float* ST; };
template <int MODE, int D>
__device__ __forceinline__ void s5_wave(const S5Ptrs& sp, LAS unsigned char* SI  , int row0  , int g, int slot0, int lane) {
    const int n = lane & 31, hs = lane >> 5, dg = D * 32 + g;
    bf16x8 bq[4];
#pragma unroll
    for (int q = 0; q < 4; ++q) bq[q] = *(const GAS bf16x8*)(sp.BBH + ((size_t)(dg * 64 + (q & 1) * 32 + n) * 2 + (q >> 1)) * 16 + 8 * hs);
    bf16x8 cm[8];
    if (MODE != 0) {
#pragma unroll
        for (int ks = 0; ks < 8; ++ks) cm[ks] = n < 16 ? *(const GAS bf16x8*)(sp.CMH + ((size_t)(dg * 16 + n) * 128 + 16 * ks + 8 * hs)) : (bf16x8){0, 0, 0, 0, 0, 0, 0, 0}; }
    const float lr0 = sp.LAM[2 * (dg * 64 + n)], li0 = sp.LAM[2 * (dg * 64 + n) + 1], lr1 = sp.LAM[2 * (dg * 64 + 32 + n)], li1 = sp.LAM[2 * (dg * 64 + 32 + n) + 1];
    float hr0 = 0.f, hi0 = 0.f, hr1 = 0.f, hi1 = 0.f;
    float* stp = sp.ST + ((size_t)((slot0 + hs) * 2 + D) * 2048 + g * 64 + n) * 2;
    if (MODE != 0) { const f32x2 a = *(const GAS f32x2*)stp, b = *(const GAS f32x2*)(stp + 64); hr0 = a.x; hi0 = a.y; hr1 = b.x; hi1 = b.y; }
    const int astream = (n >> 2) & 1, aidx = 4 * (n >> 3) + (n & 3);
    const bf16* ua = sp.U + (size_t)(row0 + 128 * astream) * 512 + g * 16 + 8 * hs;
    const float dsk = (MODE == 2 && n < 16) ? sp.S5D[g * 16 + n] : 0.f;
    bf16x8 afr = *(const GAS bf16x8*)(ua + (size_t)(D == 0 ? aidx : 127 - aidx) * 512);
#pragma unroll 1
    for (int i = 0; i < 8; ++i) {
        f32x16 acc[4];
#pragma unroll
        for (int q = 0; q < 4; ++q) {
#pragma unroll
            for (int r = 0; r < 16; ++r) acc[q][r] = 0.f;
            acc[q] = MFMA32(afr, bq[q], acc[q]); }
        if (i < 7) afr = *(const GAS bf16x8*)(ua + (size_t)(D == 0 ? 16 * (i + 1) + aidx : 127 - 16 * (i + 1) - aidx) * 512);
#pragma unroll
        for (int j = 0; j < 16; ++j) {
            const float nr0 = lr0 * hr0 - li0 * hi0 + acc[0][j], ni0 = lr0 * hi0 + li0 * hr0 + acc[2][j]; hr0 = nr0; hi0 = ni0; acc[0][j] = nr0; acc[2][j] = ni0;
            const float nr1 = lr1 * hr1 - li1 * hi1 + acc[1][j], ni1 = lr1 * hi1 + li1 * hr1 + acc[3][j]; hr1 = nr1; hi1 = ni1; acc[1][j] = nr1; acc[3][j] = ni1; }
        if (MODE != 0) {
            store_acc_nat(acc[0], SI, 72, 0, 0, lane); store_acc_nat(acc[1], SI, 72, 32, 0, lane); store_acc_nat(acc[2], SI, 72, 64, 0, lane); store_acc_nat(acc[3], SI, 72, 96, 0, lane);
            asm volatile("s_waitcnt lgkmcnt(0)" ::: "memory");
            f32x16 y;
#pragma unroll
            for (int r = 0; r < 16; ++r) y[r] = 0.f;
#pragma unroll
            for (int ks = 0; ks < 8; ++ks) y = MFMA32(frag_tr(SI, 72, 16 * ks, 0, lane), cm[ks], y);
            asm volatile("" ::: "memory");
            if (n < 16) {
#pragma unroll
                for (int j = 0; j < 16; ++j) { const int pos = D == 0 ? 16 * i + j : 127 - 16 * i - j, row = row0 + 128 * hs + pos;
                    float* ysp = sp.YS + (size_t)row * 512 + g * 16 + n;
                    if (MODE == 1) *(GAS float*)ysp = y[j];
                    else { const float v = y[j] + *(const GAS float*)ysp + dsk * bf2f(*(const GAS unsigned short*)(sp.U + (size_t)row * 512 + g * 16 + n));
                        const float tt = 0.7978845608f * (v + 0.044715f * v * v * v), gl = v * (1.f - __builtin_amdgcn_rcpf(__expf(2.f * tt) + 1.f));
                        const int token = (row & 255) * 64 + (row >> 8);
                        *(GAS unsigned short*)(sp.A2 + (size_t)token * 512 + g * 16 + n) = (unsigned short)f2bf(gl); } }
            }
        }
    }
    if (MODE == 0) { *(GAS f32x2*)stp = (f32x2){hr0, hi0}; *(GAS f32x2*)(stp + 64) = (f32x2){hr1, hi1}; }
}
__device__ __forceinline__ void phase_s5A(const S5Ptrs& sp, LAS unsigned char* lds, int bid, int G, int wave, int lane) {
    LAS unsigned char* SI = lds + wave * 9216;
    for (int it = bid; it < 65 * 8; it += G) { const int col = it >> 3, gb = (it >> 1) & 3, d = it & 1, g = gb * 8 + wave;
        const int row0 = col < 64 ? col * 256 : ML, slot0 = col < 64 ? 2 * col : 128;
        if (d == 0) s5_wave<0, 0>(sp, SI, row0, g, slot0, lane); else s5_wave<0, 1>(sp, SI, row0, g, slot0, lane); }
}
__device__ __forceinline__ void phase_s5B(const S5Ptrs& sp, int bid, int G, int tid) {
    const int gt = bid * 512 + tid;
    if (gt < 4096) { const int d = gt >> 11, gp = gt & 2047, s = d * 2048 + gp; const float pr = sp.LAMP[2 * s], pi = sp.LAMP[2 * s + 1];
        GAS f32x2* st = (GAS f32x2*)sp.ST; f32x2 run = {0.f, 0.f};
        for (int i0 = 0; i0 < 130; i0 += 10) { f32x2 loc[10];
#pragma unroll
            for (int j = 0; j < 10; ++j) { const int q = i0 + j, slot = d == 0 ? (q < 2 ? 128 + q : q - 2) : (q < 2 ? 129 - q : 129 - q); loc[j] = st[(size_t)(slot * 2 + d) * 2048 + gp]; }
#pragma unroll
            for (int j = 0; j < 10; ++j) { const int q = i0 + j, slot = d == 0 ? (q < 2 ? 128 + q : q - 2) : (q < 2 ? 129 - q : 129 - q); st[(size_t)(slot * 2 + d) * 2048 + gp] = run;
                const float nr = pr * run.x - pi * run.y + loc[j].x, ni = pr * run.y + pi * run.x + loc[j].y; run.x = nr; run.y = ni; } }
    }
}
__device__ __forceinline__ void phase_s5C(const S5Ptrs& sp, LAS unsigned char* lds, int bid, int G, int wave, int lane) {
    LAS unsigned char* SI = lds + wave * 9216;
    for (int it = bid; it < 256; it += G) { const int col = it >> 2, g = (it & 3) * 8 + wave;
        s5_wave<1, 0>(sp, SI, col * 256, g, 2 * col, lane);
        __threadfence();
        s5_wave<2, 1>(sp, SI, col * 256, g, 2 * col, lane); }
}
__device__ __forceinline__ void phase_final(const Params& p, int bid, int G, int wave, int lane) {
    const int gw = bid * NWAVES + wave, ngw = G * NWAVES; const float* fg = p.in[I_FNORM];
    for (int row = gw; row < ML; row += ngw) { float* xr = p.out + (size_t)row * 1024;
        f32x4 v[4]; float ss = 0.f;
#pragma unroll
        for (int j = 0; j < 4; ++j) { v[j] = *(const GAS f32x4*)(xr + 4 * lane + 256 * j); ss += (v[j].x * v[j].x + v[j].y * v[j].y) + (v[j].z * v[j].z + v[j].w * v[j].w); }
        const float r = rsqrtf(wave_sum(ss) * (1.f / 1024.f) + EPS);
#pragma unroll
        for (int j = 0; j < 4; ++j) { const f32x4 g4 = *(const GAS f32x4*)(fg + 4 * lane + 256 * j); *(GAS f32x4*)(xr + 4 * lane + 256 * j) = (f32x4){v[j].x * r * g4.x, v[j].y * r * g4.y, v[j].z * r * g4.z, v[j].w * r * g4.w}; }
    }
}

constexpr int N_PHASES = 22;
__device__ __forceinline__ void run_gmix(const Params& p, LAS unsigned char* lds, int bid, int G) {
    unsigned char* ws = p.ws;
    pg8::Gemm g{(const bf16*)(ws + WS_RX), (const bf16*)(ws + WS_WIN), M, NINP, 1024}; pg8::StaticOrder S; S.init(M, NINP, G, bid);
    pg8::EpiMix1 E{(bf16*)(ws + WS_ZQ), (bf16*)(ws + WS_XBC), (bf16*)(ws + WS_V), (bf16*)(ws + WS_G), (f16*)p.out, (f16*)(ws + WS_FCTX), (float*)(ws + WS_DT), (const float*)(ws + WS_SMALL + SM_LB), p.in[I_DTB], p.in[I_ALOG]};
    pg8::gemm_phase<pg8::EpiMix1, pg8::StaticOrder, true, true>(lds + RING_OFF, g, S, E);
}
__device__ __forceinline__ void run_gout(const Params& p, LAS unsigned char* lds, int bid, int G) {
    unsigned char* ws = p.ws; const float* mods = (const float*)(ws + WS_SMALL + SM_MODS);
    pg8::Gemm g{(const bf16*)(ws + WS_ZQ), (const bf16*)(ws + WS_WREST + WO_OUT), M, 1024, 2048}; pg8::StaticOrder S; S.init(M, 1024, G, bid);
    pg8::EpiResid E{p.in[I_X], p.in[I_CTX], p.out, (float*)(ws + WS_HCTX), mods + (0 * 2 + 0) * 6144 + 2 * 1024, mods + (0 * 2 + 1) * 6144 + 2 * 1024};
    pg8::gemm_phase<pg8::EpiResid, pg8::StaticOrder, true, true>(lds + RING_OFF, g, S, E);
}
__device__ __forceinline__ void run_gup(const Params& p, LAS unsigned char* lds, int bid, int G, int layer) {
    unsigned char* ws = p.ws; const int rows = layer ? ML : M;
    pg8::Gemm g{(const bf16*)(ws + WS_RX), (const bf16*)(ws + WS_WREST + (layer ? WO_UP1 : WO_UP0)), rows, 2 * DFF, 1024}; pg8::StaticOrder S; S.init(rows, 2 * DFF, G, bid);
    pg8::EpiSwiglu E{(bf16*)(ws + WS_HID)};
    pg8::gemm_phase<pg8::EpiSwiglu, pg8::StaticOrder, true, true>(lds + RING_OFF, g, S, E);
}
__device__ __forceinline__ void run_gdown(const Params& p, LAS unsigned char* lds, int bid, int G, int layer) {
    unsigned char* ws = p.ws; const int rows = layer ? ML : M; const float* mods = (const float*)(ws + WS_SMALL + SM_MODS); float* Hctx = (float*)(ws + WS_HCTX);
    pg8::Gemm g{(const bf16*)(ws + WS_HID), (const bf16*)(ws + WS_WREST + (layer ? WO_DOWN1 : WO_DOWN0)), rows, 1024, DFF}; pg8::StaticOrder S; S.init(rows, 1024, G, bid);
    pg8::EpiResid E{p.out, Hctx, p.out, Hctx, mods + (layer * 2 + 0) * 6144 + 5 * 1024, mods + (layer * 2 + 1) * 6144 + 5 * 1024};
    pg8::gemm_phase<pg8::EpiResid, pg8::StaticOrder, true, true>(lds + RING_OFF, g, S, E);
}
__device__ __forceinline__ void run_god(const Params& p, LAS unsigned char* lds, int bid, int G) {
    unsigned char* ws = p.ws;
    pg8::Gemm g{(const bf16*)(ws + WS_RX), (const bf16*)(ws + WS_WREST + WO_OD), M, 512, 1024}; pg8::StaticOrder S; S.init(M, 512, G, bid);
    pg8::EpiU E{(bf16*)(ws + WS_U)};
    pg8::gemm_phase<pg8::EpiU, pg8::StaticOrder, true, true>(lds + RING_OFF, g, S, E);
}
__device__ __forceinline__ void run_gvg(const Params& p, LAS unsigned char* lds, int bid, int G) {
    unsigned char* ws = p.ws; const float* mods = (const float*)(ws + WS_SMALL + SM_MODS);
    pg8::Gemm g{(const bf16*)(ws + WS_A2), (const bf16*)(ws + WS_WREST + WO_VG), ML, 2048, 512}; pg8::StaticOrder S; S.init(ML, 2048, G, bid);
    pg8::EpiValGate E{p.out, mods + (1 * 2 + 0) * 6144 + 2 * 1024};
    pg8::gemm_phase<pg8::EpiValGate, pg8::StaticOrder, true, true>(lds + RING_OFF, g, S, E);
}
__device__ __forceinline__ ScanPtrs make_scanptrs(const Params& p) {
    unsigned char* ws = p.ws; ScanPtrs sp; sp.XBC = (const bf16*)(ws + WS_XBC); sp.DT = (const float*)(ws + WS_DT); sp.ZQ = (bf16*)(ws + WS_ZQ); sp.V = (const bf16*)(ws + WS_V); sp.G = (const bf16*)(ws + WS_G); sp.Flat = (f16*)p.out; sp.Fctx = (f16*)(ws + WS_FCTX);
    sp.STATS = (float*)(ws + WS_SMALL + SM_STATS); sp.convw = p.in[I_CONVW]; sp.convb = p.in[I_CONVB]; sp.ssdd = p.in[I_SSDD]; sp.hgn = p.in[I_HGN];
    sp.SSD_ST = (bf16*)(ws + WS_RX); sp.HG_ST = (bf16*)(ws + WS_RX + SSD_ST_BYTES); sp.SSD_DEC = (float*)(ws + WS_SMALL + SM_SSDDEC); sp.HG_DEC = (float*)(ws + WS_SMALL + SM_HGDEC); sp.BCC = (const bf16*)(ws + WS_BCC); return sp;
}
__device__ __forceinline__ S5Ptrs make_s5ptrs(const Params& p) {
    unsigned char* ws = p.ws; S5Ptrs s5; s5.U = (const bf16*)(ws + WS_U); s5.YS = (float*)(ws + WS_YS); s5.A2 = (bf16*)(ws + WS_A2); s5.LAM = (const float*)(ws + WS_SMALL + SM_LAM); s5.LAMP = (const float*)(ws + WS_SMALL + SM_LAMP);
    s5.BBH = (const bf16*)(ws + WS_SMALL + SM_BB); s5.CMH = (const bf16*)(ws + WS_SMALL + SM_BB + 262144); s5.S5D = p.in[I_S5D]; s5.ST = (float*)(ws + WS_SMALL + SM_S5ST); return s5;
}
__global__ void __launch_bounds__(NWAVES * 64, 2) mk_fwd(Params p) {
    extern __shared__ __attribute__((aligned(16))) unsigned char lds_raw[];
    LAS unsigned char* lds = (LAS unsigned char*)lds_raw;
    volatile LAS unsigned* MISC = (volatile LAS unsigned*)(lds + MISC_OFF);
    const int tid = threadIdx.x, lane = tid & 63, wave = __builtin_amdgcn_readfirstlane(tid >> 6), G = gridDim.x, bid = blockIdx.x;
    gu32* ctl = (gu32*)(p.ws + WS_CTL);
    for (int u = tid; u < (LDS_BYTES - LDSCTL_OFF) / 4; u += NWAVES * 64) ((LAS unsigned*)(lds + LDSCTL_OFF))[u] = 0u;
    __syncthreads();
    XcdBarrier bar; bar.bar = (unsigned*)(ctl + CW_BAR); bar.x = 0; bar.st = nullptr;
    if (p.use_bar) bar = xcd_barrier_post((unsigned*)(ctl + CW_BAR), MISC + 8);
    const int lo = p.ph_lo, hi = p.ph_hi;
#ifndef MK_ONLYPH
#define MK_ONLYPH -1
#endif
#define IN(k) ((MK_ONLYPH < 0 || MK_ONLYPH == (k)) && lo <= (k) && (k) < hi)
#define SEAM(k) do { if ((k) + 1 < hi) xcd_barrier(bar); } while (0)
    if (IN(0)) { phase_prologue(p, lds, bid, G, tid, wave, lane); SEAM(0); }
    if (IN(1)) { phase_rownorm(p, lds, bid, G, tid, wave, lane, 0, 0, M, p.in[I_X], p.in[I_CTX], true); SEAM(1); }
    if (IN(2)) { run_gmix(p, lds, bid, G); SEAM(2); }
    if (IN(3)) { phase_convbc(p, bid, G, tid); const ScanPtrs sp = make_scanptrs(p); phase_scanA1(sp, lds, bid, G, tid); SEAM(3); }
    if (IN(4)) { const ScanPtrs sp = make_scanptrs(p); phase_scanA2(sp, lds, bid, G, tid); SEAM(4); }
    if (IN(5)) { const ScanPtrs sp = make_scanptrs(p); phase_scanB(sp, bid, G, tid); SEAM(5); }
    if (IN(6)) { const ScanPtrs sp = make_scanptrs(p); phase_scanC(sp, lds, bid, G, tid); SEAM(6); }
    if (IN(7)) { phase_finish(p, lds, bid, G, tid, wave, lane); SEAM(7); }
    if (IN(8)) { run_gout(p, lds, bid, G); SEAM(8); }
    if (IN(9)) { phase_rownorm(p, lds, bid, G, tid, wave, lane, 0, 1, M, p.out, (const float*)(p.ws + WS_HCTX), false); SEAM(9); }
    if (IN(10)) { run_gup(p, lds, bid, G, 0); SEAM(10); }
    if (IN(11)) { run_gdown(p, lds, bid, G, 0); SEAM(11); }
    if (IN(12)) { phase_rownorm(p, lds, bid, G, tid, wave, lane, 1, 0, M, p.out, (const float*)(p.ws + WS_HCTX), false); SEAM(12); }
    if (IN(13)) { run_god(p, lds, bid, G); SEAM(13); }
    if (IN(14)) { const S5Ptrs s5 = make_s5ptrs(p); phase_s5A(s5, lds, bid, G, wave, lane); SEAM(14); }
    if (IN(15)) { const S5Ptrs s5 = make_s5ptrs(p); phase_s5B(s5, bid, G, tid); SEAM(15); }
    if (IN(16)) { const S5Ptrs s5 = make_s5ptrs(p); phase_s5C(s5, lds, bid, G, wave, lane); SEAM(16); }
    if (IN(17)) { run_gvg(p, lds, bid, G); SEAM(17); }
    if (IN(18)) { phase_rownorm(p, lds, bid, G, tid, wave, lane, 1, 1, ML, p.out, (const float*)(p.ws + WS_HCTX), false); SEAM(18); }
    if (IN(19)) { run_gup(p, lds, bid, G, 1); SEAM(19); }
    if (IN(20)) { run_gdown(p, lds, bid, G, 1); SEAM(20); }
    if (IN(21)) { phase_final(p, bid, G, wave, lane); }
#undef IN
#undef SEAM
}

extern "C" void kernel_launch(void* const* d_in, const int* in_sizes, int n_in, void* d_out, int out_size, void* d_ws, size_t ws_size, hipStream_t stream) {
    static int grid = 0;
    if (grid == 0) {
        if (n_in != 33 || out_size != ML * D || ws_size < 256 * MiB) { fprintf(stderr, "kernel_launch: unexpected shapes (n_in %d, out %d, ws %zu); nothing launched\n", n_in, out_size, ws_size); grid = -1; return; }
        int dev = 0, cus = 0, per_cu = 0;
        if (hipGetDevice(&dev) != hipSuccess || hipDeviceGetAttribute(&cus, hipDeviceAttributeMultiprocessorCount, dev) != hipSuccess) { grid = -1; return; }
        if (hipFuncSetAttribute((const void*)mk_fwd, hipFuncAttributeMaxDynamicSharedMemorySize, LDS_BYTES) != hipSuccess) { fprintf(stderr, "kernel_launch: hipFuncSetAttribute failed\n"); grid = -1; return; }
        if (hipOccupancyMaxActiveBlocksPerMultiprocessor(&per_cu, (const void*)mk_fwd, NWAVES * 64, LDS_BYTES) != hipSuccess || per_cu < 1) fprintf(stderr, "kernel_launch: occupancy query reports %d\n", per_cu);
        (void)hipGetLastError();
        grid = cus;
    }
    if (grid < 0) return;
    (void)hipMemsetAsync((char*)d_ws + WS_CTL, 0, CTL_ZERO_BYTES, stream);
    Params a{};
    for (int i = 0; i < 33; ++i) a.in[i] = (const float*)d_in[i];
    a.out = (float*)d_out; a.ws = (unsigned char*)d_ws;
#if MK_N_LAUNCHES == 1
    a.ph_lo = 0; a.ph_hi = N_PHASES; a.use_bar = 1;
    hipLaunchKernelGGL(mk_fwd, dim3(grid), dim3(NWAVES * 64), LDS_BYTES, stream, a);
#else
    for (int ph = 0; ph < N_PHASES; ++ph) { a.ph_lo = ph; a.ph_hi = ph + 1; a.use_bar = 0; hipLaunchKernelGGL(mk_fwd, dim3(grid), dim3(NWAVES * 64), LDS_BYTES, stream, a); }
#endif
}
```

```cpp
#include <hip/hip_runtime.h>
#include <cstdio>
#include <cstdint>

#ifndef MK_N_LAUNCHES
#define MK_N_LAUNCHES 1
#endif
namespace pg8 {
#define PG8_LAS __attribute__((address_space(3)))
typedef unsigned short bf16_t;
typedef short bf16x8 __attribute__((ext_vector_type(8)));
typedef float f32x4 __attribute__((ext_vector_type(4)));
typedef unsigned u32x4 __attribute__((ext_vector_type(4)));
constexpr int BM = 256, BK = 64, HALF = 128, HTB = HALF * BK * 2  , STAGE_BYTES = 8 * HTB, NXCD = 8, WGM = 8;

__host__ __device__ __forceinline__ int lds_byte(int r, int c) { const int st = (r >> 4) * 2 + (c >> 5), rr = r & 15, cc = c & 31, ob = rr * 64 + cc * 2; return st * 1024 + (ob ^ (((ob >> 9) & 1) << 5)); }
__host__ __device__ __forceinline__ void stage_rc(int b, int& R, int& C) { const int st = b / 1024, sb = b % 1024, swz = sb ^ (((sb >> 9) & 1) << 5); R = (st >> 1) * 16 + swz / 64; C = (st & 1) * 32 + (swz % 64) / 2; }
__host__ __device__ __forceinline__ int perm32(int rho) { const int n = rho >> 4, i = rho & 15; return 8 * (i >> 2) + 4 * n + (i & 3); }

struct Unit { int pm, pn; };
struct Gemm { const bf16_t* A; const bf16_t* Bt; int M, N, K; };

struct StaticOrder {
    int nM, nN, nwg, G, c;
    __host__ __device__ void init(int M, int N, int G_, int c_) { nM = M / BM; nN = N / BM; nwg = nM * nN; G = G_; c = c_; }
    __host__ __device__ bool next(int i, Unit& u) const {
        const long L = (long)i * G + c; if (L >= nwg) return false;
        int wgid = (int)L; { const int q = nwg / NXCD, r = nwg % NXCD, xcd = wgid % NXCD, off = wgid / NXCD; wgid = (xcd < r ? xcd * (q + 1) : r * (q + 1) + (xcd - r) * q) + off; }
        const int nig = WGM * nN, gid = wgid / nig, fm = gid * WGM, gsz = (nM - fm) < WGM ? (nM - fm) : WGM;
        u.pm = fm + ((wgid % nig) % gsz); u.pn = (wgid % nig) / gsz; return true;
    }
    __device__ __forceinline__ void a_ready(const Unit&) const {}
    __device__ __forceinline__ void done(const Unit&) const {}
};

__device__ __forceinline__ unsigned cvt_pk_bf16(float lo, float hi) { unsigned r; asm volatile("v_cvt_pk_bf16_f32 %0, %1, %2" : "=v"(r) : "v"(lo), "v"(hi)); return r; }
typedef float f32x2 __attribute__((ext_vector_type(2)));
typedef _Float16 f16x8 __attribute__((ext_vector_type(8)));
__device__ __forceinline__ float siluf(float x) { return x * __builtin_amdgcn_rcpf(1.f + __expf(-x)); }
__device__ __forceinline__ float sigmf(float x) { return __builtin_amdgcn_rcpf(1.f + __expf(-x)); }
__device__ __forceinline__ u32x4 pack8_bf16(const float (&x)[8]) { u32x4 w; w.x = cvt_pk_bf16(x[0], x[1]); w.y = cvt_pk_bf16(x[2], x[3]); w.z = cvt_pk_bf16(x[4], x[5]); w.w = cvt_pk_bf16(x[6], x[7]); return w; }
constexpr int EP_ML = 16384;

struct EpiMix1 {
    static constexpr bool PERM = true, AFTER_DRAIN = false;
    bf16_t* ZQ; bf16_t* XBC; bf16_t* V; bf16_t* G; _Float16* Flat; _Float16* Fctx; float* DT; const float* lb; const float* dt_bias; const float* a_log;
    template <int KIND> __device__ __forceinline__ void tile(const f32x4 (&acc)[2][2][4][2], const Unit& u, int wr, int wc, int fr, int fq, int seg_tile) const {
        const int row0 = u.pm * BM + wr * 64 + fr, cw = wc * 32 + 8 * fq;
#pragma unroll
        for (int ai = 0; ai < 2; ++ai)
#pragma unroll
            for (int m = 0; m < 4; ++m) { const int row = row0 + ai * HALF + m * 16;
#pragma unroll
                for (int bj = 0; bj < 2; ++bj) { const f32x4 v0 = acc[ai][bj][m][0], v1 = acc[ai][bj][m][1]; const int c = seg_tile * 256 + bj * HALF + cw;
                    float x[8] = {v0[0], v0[1], v0[2], v0[3], v1[0], v1[1], v1[2], v1[3]};
                    if constexpr (KIND == 0) {
#pragma unroll
                        for (int i = 0; i < 8; ++i) x[i] = siluf(x[i]);
                        *(u32x4*)(ZQ + (size_t)row * 2048 + c) = pack8_bf16(x);
                    } else if constexpr (KIND == 1) {
                        *(u32x4*)(XBC + (size_t)row * 1536 + c) = pack8_bf16(x);
                    } else if constexpr (KIND == 2) {
#pragma unroll
                        for (int i = 0; i < 8; ++i) x[i] = siluf(x[i]);
                        *(u32x4*)(ZQ + (size_t)row * 2048 + 1024 + c) = pack8_bf16(x);
                    } else if constexpr (KIND == 3) {
                        f16x8 h;
#pragma unroll
                        for (int i = 0; i < 8; ++i) { const float l = lb[(c + i) & 1023]; const float f = l + (1.f - l) * sigmf(x[i]); h[i] = (_Float16)__logf(f); }
                        _Float16* dst = (row < EP_ML) ? Flat + (size_t)row * 2048 : Fctx + (size_t)(row - EP_ML) * 2048;
                        *(f16x8*)(dst + c) = h;
                    } else if constexpr (KIND == 4) {
                        *(u32x4*)(V + (size_t)row * 1024 + c) = pack8_bf16(x);
                    } else if constexpr (KIND == 5) {
#pragma unroll
                        for (int i = 0; i < 8; ++i) x[i] = siluf(x[i]);
                        *(u32x4*)(G + (size_t)row * 1024 + c) = pack8_bf16(x);
                    } else {
                        if (bj == 0 && wc == 0) {
                            float dtv[8], la[8];
#pragma unroll
                            for (int i = 0; i < 8; ++i) { const int j = 8 * fq + i; const float r = x[i] + dt_bias[j]; dtv[i] = r > 20.f ? r : log1pf(__expf(r)); la[i] = -dtv[i] * __expf(a_log[j]); }
                            float* d = DT + (size_t)row * 64 + 8 * fq;
                            *(f32x4*)(d) = (f32x4){dtv[0], dtv[1], dtv[2], dtv[3]}; *(f32x4*)(d + 4) = (f32x4){dtv[4], dtv[5], dtv[6], dtv[7]};
                            *(f32x4*)(d + 32) = (f32x4){la[0], la[1], la[2], la[3]}; *(f32x4*)(d + 36) = (f32x4){la[4], la[5], la[6], la[7]};
                        }
                    } } }
    }
    __device__ __forceinline__ void operator()(const f32x4 (&acc)[2][2][4][2], const Unit& u, int wr, int wc, int fr, int fq) const {
        const int pn = u.pn;
        if (pn < 4) tile<0>(acc, u, wr, wc, fr, fq, pn);
        else if (pn < 10) tile<1>(acc, u, wr, wc, fr, fq, pn - 4);
        else if (pn < 14) tile<2>(acc, u, wr, wc, fr, fq, pn - 10);
        else if (pn < 22) tile<3>(acc, u, wr, wc, fr, fq, pn - 14);
        else if (pn < 26) tile<4>(acc, u, wr, wc, fr, fq, pn - 22);
        else if (pn < 30) tile<5>(acc, u, wr, wc, fr, fq, pn - 26);
        else tile<6>(acc, u, wr, wc, fr, fq, 0);
    }
};
struct EpiResid {
    static constexpr bool PERM = false, AFTER_DRAIN = false;
    const float* base_lat; const float* base_ctx; float* out_lat; float* out_ctx; const float* gate_lat; const float* gate_ctx;
    __device__ __forceinline__ void operator()(const f32x4 (&acc)[2][2][4][2], const Unit& u, int wr, int wc, int fr, int fq) const {
        const bool isc = u.pm >= 64; const float* base = isc ? base_ctx : base_lat; float* out = isc ? out_ctx : out_lat; const float* gate = isc ? gate_ctx : gate_lat;
        const int row0 = (isc ? 0 : u.pm * BM) + wr * 64 + fr, col0 = u.pn * BM + wc * 32 + 4 * fq;
        f32x4 gv[2][2];
#pragma unroll
        for (int bj = 0; bj < 2; ++bj)
#pragma unroll
            for (int n = 0; n < 2; ++n) gv[bj][n] = *(const f32x4*)(gate + col0 + bj * HALF + n * 16);
#pragma unroll
        for (int ai = 0; ai < 2; ++ai)
#pragma unroll
            for (int m = 0; m < 4; ++m) { const size_t off = (size_t)(row0 + ai * HALF + m * 16) * 1024 + col0;
#pragma unroll
                for (int bj = 0; bj < 2; ++bj)
#pragma unroll
                    for (int n = 0; n < 2; ++n) { const f32x4 b = *(const f32x4*)(base + off + bj * HALF + n * 16); *(f32x4*)(out + off + bj * HALF + n * 16) = b + gv[bj][n] * acc[ai][bj][m][n]; } }
    }
};
struct EpiSwiglu {
    static constexpr bool PERM = true, AFTER_DRAIN = false;
    bf16_t* HID;
    __device__ __forceinline__ void operator()(const f32x4 (&acc)[2][2][4][2], const Unit& u, int wr, int wc, int fr, int fq) const {
        const int row0 = u.pm * BM + wr * 64 + fr, c = u.pn * HALF + wc * 32 + 8 * fq;
#pragma unroll
        for (int ai = 0; ai < 2; ++ai)
#pragma unroll
            for (int m = 0; m < 4; ++m) { const f32x4 g0 = acc[ai][0][m][0], g1 = acc[ai][0][m][1], u0 = acc[ai][1][m][0], u1 = acc[ai][1][m][1];
                float x[8] = {siluf(g0[0]) * u0[0], siluf(g0[1]) * u0[1], siluf(g0[2]) * u0[2], siluf(g0[3]) * u0[3], siluf(g1[0]) * u1[0], siluf(g1[1]) * u1[1], siluf(g1[2]) * u1[2], siluf(g1[3]) * u1[3]};
                *(u32x4*)(HID + (size_t)(row0 + ai * HALF + m * 16) * 2816 + c) = pack8_bf16(x); }
    }
};
struct EpiU {
    static constexpr bool PERM = true, AFTER_DRAIN = false;
    bf16_t* U;
    __device__ __forceinline__ void operator()(const f32x4 (&acc)[2][2][4][2], const Unit& u, int wr, int wc, int fr, int fq) const {
        const int row0 = u.pm * BM + wr * 64 + fr, col0 = u.pn * BM + wc * 32 + 8 * fq;
#pragma unroll
        for (int ai = 0; ai < 2; ++ai)
#pragma unroll
            for (int m = 0; m < 4; ++m) { const int row = row0 + ai * HALF + m * 16; const int srow = row < EP_ML ? (row & 63) * 256 + (row >> 6) : row;
#pragma unroll
                for (int bj = 0; bj < 2; ++bj) { const f32x4 v0 = acc[ai][bj][m][0], v1 = acc[ai][bj][m][1]; float x[8] = {v0[0], v0[1], v0[2], v0[3], v1[0], v1[1], v1[2], v1[3]};
                    *(u32x4*)(U + (size_t)srow * 512 + col0 + bj * HALF) = pack8_bf16(x); } }
    }
};
struct EpiValGate {
    static constexpr bool PERM = false, AFTER_DRAIN = false;
    float* H; const float* gate;
    __device__ __forceinline__ void operator()(const f32x4 (&acc)[2][2][4][2], const Unit& u, int wr, int wc, int fr, int fq) const {
        const int row0 = u.pm * BM + wr * 64 + fr, col0 = u.pn * HALF + wc * 32 + 4 * fq;
#pragma unroll
        for (int ai = 0; ai < 2; ++ai)
#pragma unroll
            for (int m = 0; m < 4; ++m) { const int srow = row0 + ai * HALF + m * 16, token = (srow & 255) * 64 + (srow >> 8); float* hp = H + (size_t)token * 1024 + col0;
#pragma unroll
                for (int n = 0; n < 2; ++n) { const f32x4 v = acc[ai][0][m][n], g = acc[ai][1][m][n]; const f32x4 gm = *(const f32x4*)(gate + col0 + n * 16); f32x4 h = *(const f32x4*)(hp + n * 16);
                    h[0] += gm[0] * v[0] * sigmf(g[0]); h[1] += gm[1] * v[1] * sigmf(g[1]); h[2] += gm[2] * v[2] * sigmf(g[2]); h[3] += gm[3] * v[3] * sigmf(g[3]); *(f32x4*)(hp + n * 16) = h; } }
    }
};
template <class Epi, class Sched, bool ALIGN_EPI = false, bool SP2 = false>
__device__ __forceinline__ void gemm_phase(PG8_LAS unsigned char* lds, const Gemm g, const Sched& S, const Epi& E) {
    const int tid = threadIdx.x, wid = __builtin_amdgcn_readfirstlane(tid >> 6), lane = tid & 63, wr = wid >> 2, wc = wid & 3, fr = lane & 15, fq = lane >> 4;
    const int K = g.K, nt = K / BK;
    unsigned voffA[2], voffB[2];
#pragma unroll
    for (int i = 0; i < 2; ++i) { int R, C; stage_rc(tid * 16 + i * 8192, R, C); const int Rb = Epi::PERM ? ((R & ~31) + perm32(R & 31)) : R;
        voffA[i] = (unsigned)(R * K + C) * 2u; voffB[i] = (unsigned)(Rb * K + C) * 2u; }
    const size_t kstep = (size_t)(BK * 2);
    const size_t hstep = (size_t)HALF * K * 2;
    const size_t tstep = 2 * hstep;
    const unsigned ldsw = (unsigned)wid * 1024u;
    const int aoff = lds_byte(wr * 64 + fr, fq * 8), boff = lds_byte(wc * 32 + fr, fq * 8);
#define PG8_SA(b, h) (((b) * 2 + (h)) * HTB)
#define PG8_SB(b, h) ((4 + (b) * 2 + (h)) * HTB)
#define PG8_STAGE(bufoff, gbase, voff) do { _Pragma("unroll") for (int _i = 0; _i < 2; ++_i) \
        __builtin_amdgcn_global_load_lds((const unsigned*)((const char*)(gbase) + (voff)[_i]), (PG8_LAS unsigned*)(lds + (bufoff) + ldsw + _i * 8192), 16, 0, 0); } while (0)
#define PG8_LDA(dst, b, h) do { _Pragma("unroll") for (int m = 0; m < 4; ++m) _Pragma("unroll") for (int k = 0; k < 2; ++k) dst[m][k] = *(const PG8_LAS bf16x8*)(lds + PG8_SA(b, h) + aoff + m * 2048 + k * 1024); } while (0)
#define PG8_LDB(dst, b, h) do { _Pragma("unroll") for (int n = 0; n < 2; ++n) _Pragma("unroll") for (int k = 0; k < 2; ++k) dst[n][k] = *(const PG8_LAS bf16x8*)(lds + PG8_SB(b, h) + boff + n * 2048 + k * 1024); } while (0)
#define PG8_MMA(ai, bj, At, Bt) do { __builtin_amdgcn_s_setprio(1); _Pragma("unroll") for (int m = 0; m < 4; ++m) _Pragma("unroll") for (int n = 0; n < 2; ++n) _Pragma("unroll") for (int k = 0; k < 2; ++k) \
        acc[ai][bj][m][n] = __builtin_amdgcn_mfma_f32_16x16x32_bf16(Bt[n][k], At[m][k], acc[ai][bj][m][n], 0, 0, 0); __builtin_amdgcn_s_setprio(0); } while (0)
#define PG8_WAIT_V(n) asm volatile("s_waitcnt vmcnt(" #n ")" ::: "memory")
#define PG8_WAIT_L(n) asm volatile("s_waitcnt lgkmcnt(" #n ")" ::: "memory")
#define PG8_BAR __builtin_amdgcn_s_barrier()
#define PG8_SCHED __builtin_amdgcn_sched_barrier(0)
    Unit cur, nxt; int ui = 0;
    if (!S.next(0, cur)) return;
    f32x4 acc[2][2][4][2];
#pragma unroll
    for (int a = 0; a < 2; ++a)
#pragma unroll
        for (int b = 0; b < 2; ++b)
#pragma unroll
            for (int m = 0; m < 4; ++m)
#pragma unroll
                for (int n = 0; n < 2; ++n) acc[a][b][m][n] = (f32x4){0.f, 0.f, 0.f, 0.f};
    bf16x8 At[4][2], B0[2][2], B1[2][2];
    const char* cA = (const char*)g.A + (size_t)cur.pm * tstep; const char* cB = (const char*)g.Bt + (size_t)cur.pn * tstep;
    S.a_ready(cur);
    if constexpr (SP2) {
        PG8_STAGE(PG8_SB(0, 0), cB, voffB); PG8_STAGE(PG8_SB(0, 1), cB + hstep, voffB); PG8_STAGE(PG8_SA(0, 0), cA, voffA); PG8_STAGE(PG8_SA(0, 1), cA + hstep, voffA);
        if (wr == 1) PG8_BAR;
        PG8_WAIT_V(2); PG8_BAR;
        PG8_STAGE(PG8_SB(1, 0), cB + kstep, voffB); PG8_STAGE(PG8_SA(1, 0), cA + kstep, voffA); PG8_STAGE(PG8_SB(1, 1), cB + hstep + kstep, voffB);
        PG8_WAIT_V(6); PG8_BAR;
    } else {
        PG8_STAGE(PG8_SB(0, 0), cB, voffB); PG8_STAGE(PG8_SA(0, 0), cA, voffA); PG8_STAGE(PG8_SB(0, 1), cB + hstep, voffB); PG8_STAGE(PG8_SA(0, 1), cA + hstep, voffA);
        if (wr == 1) PG8_BAR;
        PG8_WAIT_V(4); PG8_BAR;
        PG8_STAGE(PG8_SB(1, 0), cB + kstep, voffB); PG8_STAGE(PG8_SA(1, 0), cA + kstep, voffA); PG8_STAGE(PG8_SB(1, 1), cB + hstep + kstep, voffB);
        PG8_WAIT_V(6); PG8_BAR;
    }
    for (;;) {
        const bool has_next = S.next(ui + 1, nxt);
        const char* nA = has_next ? (const char*)g.A + (size_t)nxt.pm * tstep : cA; const char* nB = has_next ? (const char*)g.Bt + (size_t)nxt.pn * tstep : cB;
        for (int t = 0; t < nt; t += 2) {
            const bool last = (t == nt - 2);
            const char* a1 = cA + (size_t)(t + 1) * kstep;
            const char* a2 = last ? nA : cA + (size_t)(t + 2) * kstep; const char* b2 = last ? nB : cB + (size_t)(t + 2) * kstep;
            const char* a3 = a2 + kstep; const char* b3 = b2 + kstep;
            if (last && has_next) S.a_ready(nxt);
            if constexpr (SP2) {
            PG8_LDB(B0, 0, 0); PG8_LDB(B1, 0, 1); PG8_SCHED; PG8_LDA(At, 0, 0); PG8_STAGE(PG8_SA(1, 1), a1 + hstep, voffA);
            PG8_WAIT_V(8); PG8_WAIT_L(0); PG8_BAR; PG8_MMA(0, 0, At, B0); PG8_MMA(0, 1, At, B1); PG8_BAR; PG8_SCHED;
            PG8_LDA(At, 0, 1); PG8_STAGE(PG8_SB(0, 0), b2, voffB); PG8_STAGE(PG8_SB(0, 1), b2 + hstep, voffB); PG8_STAGE(PG8_SA(0, 0), a2, voffA);
            PG8_WAIT_V(8); PG8_WAIT_L(0); PG8_BAR; PG8_MMA(1, 0, At, B0); PG8_MMA(1, 1, At, B1); PG8_BAR; PG8_SCHED;
            PG8_LDB(B0, 1, 0); PG8_LDB(B1, 1, 1); PG8_SCHED; PG8_LDA(At, 1, 0); PG8_STAGE(PG8_SA(0, 1), a2 + hstep, voffA);
            PG8_WAIT_V(8); PG8_WAIT_L(0); PG8_BAR; PG8_MMA(0, 0, At, B0); PG8_MMA(0, 1, At, B1); PG8_BAR; PG8_SCHED;
            PG8_LDA(At, 1, 1); PG8_STAGE(PG8_SB(1, 0), b3, voffB); PG8_STAGE(PG8_SB(1, 1), b3 + hstep, voffB); PG8_STAGE(PG8_SA(1, 0), a3, voffA);
            PG8_WAIT_V(8); PG8_WAIT_L(0); PG8_BAR; PG8_MMA(1, 0, At, B0); PG8_MMA(1, 1, At, B1); PG8_BAR; PG8_SCHED;
            } else {
            PG8_LDB(B0, 0, 0); PG8_SCHED; PG8_LDA(At, 0, 0); PG8_STAGE(PG8_SA(1, 1), a1 + hstep, voffA);
            PG8_WAIT_L(8); PG8_BAR; PG8_WAIT_L(0); PG8_MMA(0, 0, At, B0); PG8_BAR; PG8_SCHED;
            PG8_LDB(B1, 0, 1); PG8_STAGE(PG8_SB(0, 0), b2, voffB);
            PG8_BAR; PG8_WAIT_L(0); PG8_MMA(0, 1, At, B1); PG8_BAR;
            PG8_LDA(At, 0, 1); PG8_STAGE(PG8_SA(0, 0), a2, voffA);
            PG8_BAR; PG8_WAIT_L(0); PG8_MMA(1, 0, At, B0); PG8_BAR; PG8_SCHED;
            PG8_STAGE(PG8_SB(0, 1), b2 + hstep, voffB);
            PG8_WAIT_V(6); PG8_BAR; PG8_MMA(1, 1, At, B1); PG8_BAR;
            PG8_LDB(B0, 1, 0); PG8_SCHED; PG8_LDA(At, 1, 0); PG8_STAGE(PG8_SA(0, 1), a2 + hstep, voffA);
            PG8_WAIT_L(8); PG8_BAR; PG8_WAIT_L(0); PG8_MMA(0, 0, At, B0); PG8_BAR; PG8_SCHED;
            PG8_LDB(B1, 1, 1); PG8_STAGE(PG8_SB(1, 0), b3, voffB);
            PG8_BAR; PG8_WAIT_L(0); PG8_MMA(0, 1, At, B1); PG8_BAR;
            PG8_LDA(At, 1, 1); PG8_STAGE(PG8_SA(1, 0), a3, voffA);
            PG8_BAR; PG8_WAIT_L(0); PG8_MMA(1, 0, At, B0); PG8_BAR; PG8_SCHED;
            PG8_STAGE(PG8_SB(1, 1), b3 + hstep, voffB);
            PG8_WAIT_V(6); PG8_BAR; PG8_MMA(1, 1, At, B1); PG8_BAR;
            }
        }
        if constexpr (ALIGN_EPI) { if (wr == 0) PG8_BAR; }
        if constexpr (!Epi::AFTER_DRAIN) { E(acc, cur, wr, wc, fr, fq); S.done(cur); }
        if (!has_next) break;
#pragma unroll
        for (int a = 0; a < 2; ++a)
#pragma unroll
            for (int b = 0; b < 2; ++b)
#pragma unroll
                for (int m = 0; m < 4; ++m)
#pragma unroll
                    for (int n = 0; n < 2; ++n) acc[a][b][m][n] = (f32x4){0.f, 0.f, 0.f, 0.f};
        cur = nxt; cA = nA; cB = nB; ++ui;
        if constexpr (ALIGN_EPI) { if (wr == 1) PG8_BAR; }
    }
    PG8_WAIT_V(0);
    if constexpr (!ALIGN_EPI) { if (wr == 0) PG8_BAR; }
    PG8_BAR;
    if constexpr (Epi::AFTER_DRAIN) { E.fused(acc, cur, wr, wc, fr, fq, lds, wid, lane); S.done(cur); }
#undef PG8_SA
#undef PG8_SB
#undef PG8_STAGE
#undef PG8_LDA
#undef PG8_LDB
#undef PG8_MMA
#undef PG8_WAIT_V
#undef PG8_WAIT_L
#undef PG8_BAR
#undef PG8_SCHED
}
}
#define GAS __attribute__((address_space(1)))
#define LAS __attribute__((address_space(3)))
typedef unsigned short bf16;
typedef unsigned v4u __attribute__((ext_vector_type(4)));
typedef float f32x4 __attribute__((ext_vector_type(4)));
typedef short bf16x8 __attribute__((ext_vector_type(8)));
typedef GAS unsigned gu32;
typedef GAS unsigned long long gu64;
#define RLX_AGENT __ATOMIC_RELAXED, __HIP_MEMORY_SCOPE_AGENT
#define LDS_WAIT() asm volatile("s_waitcnt lgkmcnt(0)" ::: "memory")
#define VM_WAIT() asm volatile("s_waitcnt vmcnt(0)" ::: "memory")
__device__ __forceinline__ unsigned long long rt() { return __builtin_amdgcn_s_memrealtime(); }
typedef __bf16 bf16x2_t __attribute__((ext_vector_type(2)));
__device__ __forceinline__ unsigned f2bf(float f) { return (unsigned)__builtin_bit_cast(unsigned short, (__bf16)f); }
__device__ __forceinline__ unsigned pk2(float lo, float hi) { const bf16x2_t v = {(__bf16)lo, (__bf16)hi}; return __builtin_bit_cast(unsigned, v); }

#define XB_TMO      128
#define XB_XCNT(j)  (256  + 64 * (j))
#define XB_XSUB(j)  (1280 + 64 * (j))
#define XB_XGEN(j)  (2304 + 64 * (j))
#define XB_TOP      3328
#define XB_TOPGEN   3392
#define XCD_BAR_WORDS 3456
#define XB_SPIN_CAP (1u << 18)

__device__ __forceinline__ unsigned xb_ld(unsigned* p)              { return __hip_atomic_load(p, __ATOMIC_RELAXED, __HIP_MEMORY_SCOPE_AGENT); }
__device__ __forceinline__ unsigned xb_add(unsigned* p, unsigned v) { return __hip_atomic_fetch_add(p, v, __ATOMIC_RELAXED, __HIP_MEMORY_SCOPE_AGENT); }
__device__ __forceinline__ unsigned xb_xcc_id() { return (unsigned)__builtin_amdgcn_s_getreg((3 << 11) | 20) & 0xFu; }
#define XB_SPIN(cond, bar) do { unsigned _sp = 0; while (cond) { __builtin_amdgcn_s_sleep(1); \
    if ((++_sp & 255u) == 0u) { if (xb_ld(&(bar)[XB_TMO])) break; if (_sp > XB_SPIN_CAP) { atomicAdd(&(bar)[XB_TMO], 1u); break; } } } } while (0)

struct XcdBarrier {
    unsigned* bar; unsigned x;
    volatile LAS unsigned* st;
};

__device__ __forceinline__ XcdBarrier xcd_barrier_post(unsigned* bar, volatile LAS unsigned* st) {
    XcdBarrier b; b.bar = bar; b.x = xb_xcc_id(); b.st = st;
    if (threadIdx.x == 0) (void)xb_add(&bar[XB_XCNT(b.x)], 1u);
    return b;
}
__device__ __forceinline__ void xcd_barrier_complete(unsigned* bar, unsigned x, unsigned& nloc, unsigned& nx) {
    const unsigned G = gridDim.x * gridDim.y * gridDim.z;
    unsigned sum, cnt, mine, sp = 0u;
    for (;;) {
        sum = 0u; cnt = 0u; mine = 0u;
#pragma unroll
        for (unsigned j = 0; j < 16; ++j) { const unsigned c = xb_ld(&bar[XB_XCNT(j)]); sum += c; cnt += (c > 0u) ? 1u : 0u; mine = (j == x) ? c : mine; }
        if (sum == G) break;
        __builtin_amdgcn_s_sleep(1);
        if ((++sp & 255u) == 0u) { if (xb_ld(&bar[XB_TMO])) break; if (sp > XB_SPIN_CAP) { atomicAdd(&bar[XB_TMO], 1u); break; } }
    }
    nloc = mine > 0u ? mine : 1u; nx = cnt > 0u ? cnt : 1u;
}

__device__ __forceinline__ void xcd_barrier(const XcdBarrier& b) {
    asm volatile("s_waitcnt vmcnt(0)" ::: "memory");
    __syncthreads();
    if (threadIdx.x == 0) {
        unsigned* bar = b.bar;
        __builtin_amdgcn_s_waitcnt(0);
        unsigned nloc = b.st[0], nx = b.st[1];
        if (nloc == 0u) { xcd_barrier_complete(bar, b.x, nloc, nx); b.st[0] = nloc; b.st[1] = nx; }
        const unsigned old = xb_add(&bar[XB_XSUB(b.x)], 1u);
        const unsigned gen = old / nloc;
        if (old + 1u == (gen + 1u) * nloc) {
            __builtin_amdgcn_fence(__ATOMIC_RELEASE, "agent");
            asm volatile("s_waitcnt vmcnt(0)" ::: "memory");
            const unsigned og = xb_add(&bar[XB_TOP], 1u);
            const unsigned tg = og / nx;
            if (og + 1u == (tg + 1u) * nx) xb_add(&bar[XB_TOPGEN], 1u);
            else XB_SPIN(xb_ld(&bar[XB_TOPGEN]) == tg, bar);
            __builtin_amdgcn_fence(__ATOMIC_ACQUIRE, "agent");
            xb_add(&bar[XB_XGEN(b.x)], 1u);
            asm volatile("s_waitcnt vmcnt(0)" ::: "memory");
        } else {
            XB_SPIN(xb_ld(&bar[XB_XGEN(b.x)]) == gen, bar);
            __builtin_amdgcn_fence(__ATOMIC_ACQUIRE, "agent");
            asm volatile("s_waitcnt vmcnt(0)" ::: "memory");
        }
    }
    __syncthreads();
}


constexpr int NWAVES = 8;
constexpr int D = 1024, ML = 16384, MC = 256, M = ML + MC, DFF = 2816;
constexpr int NIN = 7712, NINP = 7936;
constexpr int NSC = 32, SCL = 512;
constexpr float EPS = 1e-6f;
static_assert(pg8::EP_ML == ML, "epilogue constant");

constexpr size_t MiB = 1u << 20, KiB = 1024;
constexpr size_t WS_CTL = 0, CTL_ZERO_BYTES = 1 * MiB;
constexpr size_t WS_SMALL = 1 * MiB;
constexpr size_t WS_HCTX = 9 * MiB;
constexpr size_t WS_FCTX = 10 * MiB;
constexpr size_t WS_RX = 11 * MiB;
constexpr size_t WS_ZQ = 44 * MiB;
constexpr size_t WS_XBC = 109 * MiB;
constexpr size_t WS_V = WS_XBC + (size_t)M * 1536 * 2;
constexpr size_t WS_G = WS_V + (size_t)M * 1024 * 2;
constexpr size_t WS_DT = WS_G + (size_t)M * 1024 * 2;
constexpr size_t WS_WIN = 227 * MiB;
constexpr size_t WS_BCC = WS_WIN;
static_assert(WS_BCC + (size_t)M * 512 * 2 <= 256 * MiB, "BCC");
static_assert(WS_DT + (size_t)M * 64 * 4 <= WS_WIN && WS_WIN + (size_t)NINP * 1024 * 2 <= 256 * MiB, "ws map (mixer phase)");
constexpr size_t WS_WREST = 216 * MiB;
constexpr size_t WO_OUT = 0, WO_UP0 = 4 * MiB, WO_DOWN0 = 15 * MiB, WO_OD = WO_DOWN0 + (size_t)DFF * 1024 * 2, WO_VG = WO_OD + 1 * MiB, WO_UP1 = WO_VG + 2 * MiB, WO_DOWN1 = WO_UP1 + 11 * MiB;
static_assert(WO_DOWN1 + (size_t)DFF * 1024 * 2 <= 40 * MiB, "weights overlay");
constexpr size_t WS_HID = WS_XBC;
static_assert(WS_HID + (size_t)M * DFF * 2 <= WS_WREST, "hidden overlay");
constexpr size_t WS_U = WS_ZQ;
constexpr size_t WS_A2 = WS_U + (size_t)M * 512 * 4;
static_assert(WS_A2 + (size_t)ML * 512 * 2 <= WS_XBC, "layer-1 overlay");
constexpr size_t WS_YS = WS_XBC;
constexpr size_t SM_ADAP = 0;
constexpr size_t SM_MODS = SM_ADAP + 2 * 2 * 8 * 6144 * 4;
constexpr size_t SM_LB = SM_MODS + 2 * 2 * 6144 * 4;
constexpr size_t SM_LAM = SM_LB + 4096;
constexpr size_t SM_LAMP = SM_LAM + 2 * 2048 * 2 * 4;
constexpr size_t SM_BB = SM_LAMP + 2 * 2048 * 2 * 4;
constexpr size_t SM_STATS = SM_BB + 2 * 2048 * 16 * 2 * 4;
constexpr size_t SM_SSDDEC = SM_STATS + (size_t)M * 16 * 4;
constexpr size_t SM_HGDEC = SM_SSDDEC + 33 * 32 * 4 + 128;
constexpr size_t SM_S5ST = ((SM_HGDEC + 33 * 16 * 128 * 4 + 255) / 256) * 256;
static_assert(SM_S5ST + 130 * 2 * 2048 * 2 * 4 <= 8 * MiB, "small tables");
constexpr size_t SSD_ST_BYTES = (size_t)33 * 32 * 8192 * 2;
static_assert(2 * SSD_ST_BYTES <= 33 * MiB && (size_t)M * 1024 * 2 <= 33 * MiB, "RX region");
constexpr int CW_BAR = 4096;

constexpr int RING_OFF = 0, RING_BYTES = 131072;
constexpr int LDS_BYTES = 163840;
constexpr int LDSCTL_OFF = LDS_BYTES - 512, MISC_OFF = LDSCTL_OFF + 320;


struct Params { const float* in[33]; float* out; unsigned char* ws; int ph_lo, ph_hi, use_bar, pad; };
enum { I_X = 0, I_C, I_CTX, I_CCTX, I_ADAW, I_ADAB, I_NMIX, I_NFFN, I_WGATE, I_WUP, I_WDOWN, I_FNORM, I_EVIN, I_EVOUT, I_CONVW, I_CONVB, I_DTB, I_ALOG, I_SSDD, I_SSDN, I_LBL, I_HGN,
       I_ODIN, I_ARE, I_AIM, I_LOGDT, I_BRE, I_BIM, I_CRE, I_CIM, I_S5D, I_WVAL, I_WGATE2 };
typedef _Float16 f16x8 __attribute__((ext_vector_type(8)));
typedef _Float16 f16;
typedef _Float16 f16x2 __attribute__((ext_vector_type(2)));
typedef float f32x2 __attribute__((ext_vector_type(2)));
__device__ __forceinline__ float bf2f(unsigned b) { return __uint_as_float(b << 16); }
__device__ __forceinline__ float siluf(float x) { return x * __builtin_amdgcn_rcpf(1.f + __expf(-x)); }
__device__ __forceinline__ float wave_sum(float v) {
#pragma unroll
    for (int o = 1; o < 64; o <<= 1) v += __shfl_xor(v, o);
    return v;
}
__device__ __forceinline__ void unpack8(const v4u r, float (&x)[8]) {
    x[0] = bf2f(r.x & 0xffffu); x[1] = bf2f(r.x >> 16); x[2] = bf2f(r.y & 0xffffu); x[3] = bf2f(r.y >> 16);
    x[4] = bf2f(r.z & 0xffffu); x[5] = bf2f(r.z >> 16); x[6] = bf2f(r.w & 0xffffu); x[7] = bf2f(r.w >> 16);
}
__device__ __forceinline__ void tr_item(const float* W, int ldw, int col0, int K, bf16* WT, int dst_row0, LAS float* scr, int kb, int lane) {
    const int k0 = 64 * kb;
#pragma unroll 8
    for (int i = 0; i < 32; ++i) { const int kk = 2 * i + (lane >> 5); scr[kk * 33 + (lane & 31)] = W[(size_t)(k0 + kk) * ldw + col0 + (lane & 31)]; }
    LDS_WAIT(); asm volatile("" ::: "memory");
    const int c = lane & 7;
#pragma unroll
    for (int j = 0; j < 4; ++j) { const int n = (lane >> 3) + 8 * j; const LAS float* s = scr + (8 * c) * 33 + n;
        v4u o; o.x = pk2(s[0 * 33], s[1 * 33]); o.y = pk2(s[2 * 33], s[3 * 33]); o.z = pk2(s[4 * 33], s[5 * 33]); o.w = pk2(s[6 * 33], s[7 * 33]);
        *(GAS v4u*)(WT + (size_t)(dst_row0 + n) * K + k0 + 8 * c) = o; }
    LDS_WAIT(); asm volatile("" ::: "memory");
}
__device__ __forceinline__ int dst_row_of(int mode, int c0) {
    if (mode == 0) return c0 < 2560 ? c0 : (c0 < 2592 ? 7680 + (c0 - 2560) : c0 - 32);
    if (mode == 1) return c0;
    return (c0 >> 7) * 256 + (mode == 3 ? 128 : 0) + (c0 & 127);
}
__device__ __forceinline__ void tr_job(const float* W, int K, int N, int mode, bf16* WT, LAS float* scr, int gw, int ngw, int lane) {
    const int nblk = N / 32, nit = (K / 64) * nblk;
    for (int it = gw; it < nit; it += ngw) { const int kb = it / nblk, nb = it % nblk; tr_item(W, N, 32 * nb, K, WT, dst_row_of(mode, 32 * nb), scr, kb, lane); }
}

__device__ __forceinline__ void phase_prologue(const Params& p, LAS unsigned char* lds, int bid, int G, int tid, int wave, int lane) {
    unsigned char* ws = p.ws; float* sm_adap = (float*)(ws + WS_SMALL + SM_ADAP);
    for (int it = bid; it < 192; it += G) {
        const int layer = it / 96, rem = it % 96, cb = rem / 8, ks = rem % 8;
        LAS float* sl = (LAS float*)lds; LAS float* sc = sl + 128;
        if (tid < 128) { sl[tid] = siluf(p.in[I_C][ks * 128 + tid]); sc[tid] = siluf(p.in[I_CCTX][ks * 128 + tid]); }
        __syncthreads();
        const int col = cb * 512 + tid; const float* W = p.in[I_ADAW] + (size_t)layer * 1024 * 6144 + (size_t)(ks * 128) * 6144 + col;
        float a0 = 0.f, a1 = 0.f;
#pragma unroll 8
        for (int k = 0; k < 128; ++k) { const float w = W[(size_t)k * 6144]; a0 += sl[k] * w; a1 += sc[k] * w; }
        sm_adap[((layer * 2 + 0) * 8 + ks) * 6144 + col] = a0; sm_adap[((layer * 2 + 1) * 8 + ks) * 6144 + col] = a1;
        __syncthreads();
    }
    const int gw = bid * NWAVES + wave, ngw = G * NWAVES;
    LAS float* scr = (LAS float*)(lds + wave * 16384);
    bf16* win = (bf16*)(ws + WS_WIN);
    tr_job(p.in[I_EVIN], 1024, NIN, 0, win, scr, gw, ngw, lane);
    { const int gt = bid * 512 + tid, nt = G * 512; v4u z = {0u, 0u, 0u, 0u};
      for (int i = gt; i < (NINP - NIN) * 1024 / 8; i += nt) *(GAS v4u*)(win + (size_t)NIN * 1024 + (size_t)i * 8) = z; }
    const int gt = bid * 512 + tid;
    if (gt < 1024) { const float l0 = p.in[I_LBL][gt], l1 = p.in[I_LBL][1024 + gt]; const float mx = fmaxf(l0, l1), e0 = __expf(l0 - mx), e1 = __expf(l1 - mx); ((float*)(ws + WS_SMALL + SM_LB))[gt] = e0 / (e0 + e1); }
    if (gt >= 4096 && gt < 8192) {
        const int s = gt - 4096, dg = s >> 6;
        const float dt = expf(p.in[I_LOGDT][dg]), are = p.in[I_ARE][s], aim = p.in[I_AIM][s];
        const float mag = expf(are * dt); float sn, cs; sincosf(aim * dt, &sn, &cs);
        const float lr = mag * cs, li = mag * sn, den = are * are + aim * aim;
        const float cr = ((lr - 1.f) * are + li * aim) / den, ci = (li * are - (lr - 1.f) * aim) / den;
        float* lam = (float*)(ws + WS_SMALL + SM_LAM); lam[2 * s] = lr; lam[2 * s + 1] = li;
        float pr = lr, pi = li;
#pragma unroll
        for (int q = 0; q < 7; ++q) { const float nr = pr * pr - pi * pi, ni = 2.f * pr * pi; pr = nr; pi = ni; }
        float* lamp = (float*)(ws + WS_SMALL + SM_LAMP); lamp[2 * s] = pr; lamp[2 * s + 1] = pi;
        bf16* bbh = (bf16*)(ws + WS_SMALL + SM_BB) + (size_t)s * 32;
#pragma unroll
        for (int c = 0; c < 16; ++c) { const float br = p.in[I_BRE][(size_t)s * 16 + c], bi = p.in[I_BIM][(size_t)s * 16 + c]; bbh[c] = (bf16)f2bf(cr * br - ci * bi); bbh[16 + c] = (bf16)f2bf(cr * bi + ci * br); }
    }
    { bf16* cmh = (bf16*)(ws + WS_SMALL + SM_BB + 262144); const int nt = G * 512;
      for (int e = gt; e < 2 * 32 * 16 * 128; e += nt) { const int k = e & 127, dgc = e >> 7; cmh[e] = (bf16)f2bf(k < 64 ? p.in[I_CRE][(size_t)dgc * 64 + k] : -p.in[I_CIM][(size_t)dgc * 64 + k - 64]); } }
}

__device__ __forceinline__ void phase_rownorm(const Params& p, LAS unsigned char* lds, int bid, int G, int tid, int wave, int lane, int layer, int kind  , int nrows,
                                              const float* src_lat, const float* src_ctx, bool from_partials) {
    unsigned char* ws = p.ws; const float* adap = (const float*)(ws + WS_SMALL + SM_ADAP); float* mods = (float*)(ws + WS_SMALL + SM_MODS);
    LAS float* Gt = (LAS float*)lds; LAS float* St = Gt + 2048;
    const float* ng = p.in[kind == 0 ? I_NMIX : I_NFFN] + layer * 1024;
    for (int idx = tid; idx < 4096; idx += 512) {
        const int vec = idx >> 11, which = (idx >> 10) & 1, col = idx & 1023, j = (kind * 3 + which) * 1024 + col;
        float v;
        if (from_partials) { v = p.in[I_ADAB][layer * 6144 + j];
#pragma unroll
            for (int ks = 0; ks < 8; ++ks) v += adap[((layer * 2 + vec) * 8 + ks) * 6144 + j]; }
        else v = mods[(layer * 2 + vec) * 6144 + j];
        if (which == 0) St[vec * 1024 + col] = v; else Gt[vec * 1024 + col] = ng[col] * (1.f + v);
    }
    if (from_partials && bid < 48) {
        const int idx = bid * 512 + tid, lv = idx / 6144, j = idx % 6144, ly = lv >> 1;
        float v = p.in[I_ADAB][ly * 6144 + j];
#pragma unroll
        for (int ks = 0; ks < 8; ++ks) v += adap[(lv * 8 + ks) * 6144 + j];
        mods[idx] = v;
    }
    __syncthreads();
    bf16* XN = (bf16*)(ws + WS_RX);
    const int gw = bid * NWAVES + wave, ngw = G * NWAVES;
    for (int row = gw; row < nrows; row += ngw) {
        const int vec = row >= ML ? 1 : 0; const float* xr = vec ? src_ctx + (size_t)(row - ML) * 1024 : src_lat + (size_t)row * 1024;
        f32x4 v[4]; float ss = 0.f;
#pragma unroll
        for (int j = 0; j < 4; ++j) { v[j] = *(const GAS f32x4*)(xr + 4 * lane + 256 * j); ss += (v[j].x * v[j].x + v[j].y * v[j].y) + (v[j].z * v[j].z + v[j].w * v[j].w); }
        const float r = rsqrtf(wave_sum(ss) * (1.f / 1024.f) + EPS);
#pragma unroll
        for (int j = 0; j < 4; ++j) { const int c = 4 * lane + 256 * j; const LAS float* g4 = Gt + vec * 1024 + c; const LAS float* s4 = St + vec * 1024 + c;
            const unsigned lo = pk2(v[j].x * r * g4[0] + s4[0], v[j].y * r * g4[1] + s4[1]), hi = pk2(v[j].z * r * g4[2] + s4[2], v[j].w * r * g4[3] + s4[3]);
            *(GAS unsigned long long*)(XN + (size_t)row * 1024 + c) = (unsigned long long)lo | ((unsigned long long)hi << 32); }
    }
}

typedef float f32x16 __attribute__((ext_vector_type(16)));
typedef short s16x4 __attribute__((ext_vector_type(4)));
#define MFMA32(a, b, c) __builtin_amdgcn_mfma_f32_32x32x16_bf16((a), (b), (c), 0, 0, 0)
__device__ __forceinline__ bf16x8 frag_rows(LAS const unsigned char* img, int RS, int row0, int kbyte, int lane) { return *(const LAS bf16x8*)(img + (row0 + (lane & 31)) * RS + kbyte + (lane >> 5) * 16); }
__device__ __forceinline__ bf16x8 frag_tr(LAS const unsigned char* img, int RS, int k0, int col0, int lane) {
    const int h = lane >> 5, blk = (lane >> 4) & 1, q = (lane & 15) >> 2, p = lane & 3;
    LAS const unsigned char* a = img + (k0 + 8 * h + q) * RS + (col0 + 16 * blk + 4 * p) * 2;
    const s16x4 lo = __builtin_amdgcn_ds_read_tr16_b64_v4i16((LAS s16x4*)a), hi = __builtin_amdgcn_ds_read_tr16_b64_v4i16((LAS s16x4*)(a + 4 * RS));
    return (bf16x8){lo[0], lo[1], lo[2], lo[3], hi[0], hi[1], hi[2], hi[3]};
}
__device__ __forceinline__ int arow(int reg, int h) { return (reg & 3) + 8 * (reg >> 2) + 4 * h; }
__device__ __forceinline__ void store_acc_nat(const f32x16& acc, LAS unsigned char* img, int RS, int n0, int m0, int lane) {
    LAS unsigned char* base = img + (n0 + (lane & 31)) * RS + (m0 + 4 * (lane >> 5)) * 2;
#pragma unroll
    for (int g = 0; g < 4; ++g) *(LAS unsigned long long*)(base + 16 * g) = (unsigned long long)pk2(acc[4 * g], acc[4 * g + 1]) | ((unsigned long long)pk2(acc[4 * g + 2], acc[4 * g + 3]) << 32);
}

struct ScanPtrs { const bf16* XBC; const float* DT; bf16* ZQ; const bf16* V; const bf16* G; f16* Flat; f16* Fctx; float* STATS; const float* convw; const float* convb; const float* ssdd; const float* hgn;
                  bf16* SSD_ST; bf16* HG_ST; float* SSD_DEC; float* HG_DEC; const bf16* BCC; };
template <int MODE, int D>
__device__ __forceinline__ void ssd_scan(const ScanPtrs& sp, LAS unsigned char* lds, int row_begin, int nchunks, int seq_lo, int seq_hi, int h, const bf16* st_in, bf16* st_out, float* dec_out, int tid) {
    const int lane = tid & 63, wave = __builtin_amdgcn_readfirstlane(tid >> 6), hf = lane >> 5, g = h >> 3;
    LAS unsigned short* YF = (LAS unsigned short*)lds; LAS unsigned char* XI = lds + 65536; LAS unsigned char* XE = lds + 74752; LAS unsigned char* BI = lds + 83968; LAS unsigned char* CI = lds + 101376; LAS unsigned char* MI = lds + 118784;
    LAS unsigned char* SPI = lds + 128000; LAS float* YB = (LAS float*)(lds + 101376); LAS unsigned char* XR = lds + 145408; LAS float* WT = (LAS float*)(lds + 154112);
    LAS float* AC = (LAS float*)(lds + 155648); LAS float* EA = AC + 64; LAS float* ES = AC + 128; LAS float* DTS = AC + 192;
    asm volatile("" : "+s"(nchunks));
    if (tid < 384) { const int j = tid >> 6, col = h * 64 + (tid & 63); WT[tid] = j < 5 ? sp.convw[j * 1536 + col] : sp.convb[col]; }
    const int nb = wave >> 1, pb = wave & 1;
    f32x16 accS;
#pragma unroll
    for (int r = 0; r < 16; ++r) accS[r] = st_in ? bf2f(*(const GAS unsigned short*)(st_in + (32 * nb + arow(r, hf)) * 64 + 32 * pb + (lane & 31))) : 0.f;
    if (MODE != 0) store_acc_nat(accS, SPI, 272, 32 * pb, 32 * nb, lane);
    float ltot = 0.f; const float dsk = sp.ssdd[h];
    v4u px0, px1, pb0, pb1, pc0, pc1; float pdt = 0.f, pla = 0.f;
    const v4u zero4 = {0u, 0u, 0u, 0u};
    px1 = zero4; pc0 = zero4; pc1 = zero4;
#define SSD_LDX(row_, col_) (((row_) >= seq_lo && (row_) < seq_hi) ? *(const GAS v4u*)(sp.XBC + (size_t)(row_) * 1536 + (col_)) : zero4)
#define SSD_LOAD(c_, tid) do { const int rb_ = row_begin + 64 * (c_); \
        px0 = SSD_LDX(rb_ - 2 + (tid >> 3), h * 64 + (tid & 7) * 8); if (tid < 32) px1 = SSD_LDX(rb_ + 62 + (tid >> 3), h * 64 + (tid & 7) * 8); \
        { const GAS v4u* bp_ = (const GAS v4u*)(sp.BCC + (size_t)(rb_ + (tid >> 4)) * 512 + g * 128 + (tid & 15) * 8); pb0 = bp_[0]; pb1 = bp_[32 * 64]; \
          if (MODE != 0) { pc0 = bp_[32]; pc1 = bp_[32 * 64 + 32]; } } \
        if (tid < 64) { pdt = sp.DT[(size_t)(rb_ + tid) * 64 + D * 16 + h]; pla = sp.DT[(size_t)(rb_ + tid) * 64 + 32 + D * 16 + h]; } } while (0)
    SSD_LOAD(D == 0 ? 0 : nchunks - 1, tid);
#pragma unroll 1
    for (int ci = 0; ci < nchunks; ++ci) {
        const int c = D == 0 ? ci : nchunks - 1 - ci, r0 = row_begin + 64 * c;
        int tl = tid; asm volatile("" : "+v"(tl));
        *(LAS v4u*)(XR + (tl >> 3) * 128 + (tl & 7) * 16) = px0; if (tl < 32) *(LAS v4u*)(XR + (64 + (tl >> 3)) * 128 + (tl & 7) * 16) = px1;
        if (wave == 0) {
            float x = pla;
#pragma unroll
            for (int o = 1; o < 64; o <<= 1) { const float v = D == 0 ? __shfl_up(x, o) : __shfl_down(x, o); if (D == 0 ? (lane >= o) : (lane + o < 64)) x += v; }
            const float last = __shfl(x, D == 0 ? 63 : 0);
            AC[lane] = x; EA[lane] = __expf(x); ES[lane] = pdt * __expf(last - x); DTS[lane] = pdt;
            if (lane == 0) AC[256] = __expf(last);
            ltot += last;
        }
        __syncthreads();
        { const int t = tl >> 3, o8 = (tl & 7) * 8; float a8[8];
#pragma unroll
          for (int i = 0; i < 8; ++i) a8[i] = WT[320 + o8 + i];
#pragma unroll
          for (int j = 0; j < 5; ++j) { float x8[8]; unpack8(*(const LAS v4u*)(XR + (t + j) * 128 + o8 * 2), x8);
#pragma unroll
              for (int i = 0; i < 8; ++i) a8[i] += WT[j * 64 + o8 + i] * x8[i]; }
          const float es = ES[t]; v4u w, we;
#pragma unroll
          for (int i = 0; i < 8; ++i) a8[i] = siluf(a8[i]);
          w.x = pk2(a8[0], a8[1]); w.y = pk2(a8[2], a8[3]); w.z = pk2(a8[4], a8[5]); w.w = pk2(a8[6], a8[7]);
          we.x = pk2(a8[0] * es, a8[1] * es); we.y = pk2(a8[2] * es, a8[3] * es); we.z = pk2(a8[4] * es, a8[5] * es); we.w = pk2(a8[6] * es, a8[7] * es);
          *(LAS v4u*)(XI + t * 144 + o8 * 2) = w; *(LAS v4u*)(XE + t * 144 + o8 * 2) = we; }
        { const int t = tl >> 4, o16 = (tl & 15) * 16;
          *(LAS v4u*)(BI + t * 272 + o16) = pb0; *(LAS v4u*)(BI + (32 + t) * 272 + o16) = pb1;
          if (MODE != 0) { *(LAS v4u*)(CI + t * 272 + o16) = pc0; *(LAS v4u*)(CI + (32 + t) * 272 + o16) = pc1; } }
        if (ci + 1 < nchunks) SSD_LOAD(D == 0 ? ci + 1 : nchunks - 2 - ci, tl);
        __syncthreads();
        f32x16 accY;
        const int tb = (wave & 3) >> 1, qb = wave & 1;
        if (MODE != 0) {
            if (wave >= 4) { const int sb = tb; f32x16 a;
#pragma unroll
                for (int r = 0; r < 16; ++r) a[r] = 0.f;
#pragma unroll
                for (int ks = 0; ks < 8; ++ks) a = MFMA32(frag_rows(BI, 272, 32 * sb, 32 * ks, lane), frag_rows(CI, 272, 32 * qb, 32 * ks, lane), a);
                const int t = 32 * qb + (lane & 31); const float act = AC[t];
#pragma unroll
                for (int r = 0; r < 16; ++r) { const int s2 = 32 * sb + arow(r, hf); const bool keep = D == 0 ? (s2 <= t) : (s2 >= t); a[r] = keep ? a[r] * __expf(act - AC[s2]) * DTS[s2] : 0.f; }
                store_acc_nat(a, MI, 144, 32 * qb, 32 * sb, lane);
            } else {
#pragma unroll
                for (int r = 0; r < 16; ++r) accY[r] = 0.f;
#pragma unroll
                for (int ks = 0; ks < 8; ++ks) accY = MFMA32(frag_rows(CI, 272, 32 * tb, 32 * ks, lane), frag_rows(SPI, 272, 32 * qb, 32 * ks, lane), accY);
#pragma unroll
                for (int r = 0; r < 16; ++r) accY[r] *= EA[32 * tb + arow(r, hf)];
            }
            __syncthreads();
            if (wave < 4) {
#pragma unroll
                for (int ks = 0; ks < 4; ++ks) accY = MFMA32(frag_rows(MI, 144, 32 * tb, 32 * ks, lane), frag_tr(XI, 144, 16 * ks, 32 * qb, lane), accY);
#pragma unroll
                for (int r = 0; r < 16; ++r) YB[(32 * tb + arow(r, hf)) * 68 + 32 * qb + (lane & 31)] = accY[r];
            }
        }
        { const float el = AC[256];
#pragma unroll
          for (int r = 0; r < 16; ++r) accS[r] *= el;
#pragma unroll
          for (int ks = 0; ks < 4; ++ks) accS = MFMA32(frag_tr(BI, 272, 16 * ks, 32 * nb, lane), frag_tr(XE, 144, 16 * ks, 32 * pb, lane), accS);
          if (MODE != 0) store_acc_nat(accS, SPI, 272, 32 * pb, 32 * nb, lane); }
        __syncthreads();
        if (MODE != 0) {
            int t3 = tid; asm volatile("" : "+v"(t3)); const int t = t3 >> 3, p8 = (t3 & 7) * 8, row = r0 + t;
            const f32x4 y0 = *(const LAS f32x4*)(YB + t * 68 + p8), y1 = *(const LAS f32x4*)(YB + t * 68 + p8 + 4);
            LAS v4u* yp = (LAS v4u*)(YF + (row - row_begin) * 64 + p8);
            if (MODE == 1) { v4u w; w.x = pk2(y0.x, y0.y); w.y = pk2(y0.z, y0.w); w.z = pk2(y1.x, y1.y); w.w = pk2(y1.z, y1.w); *yp = w; }
            else { float yf[8], x8[8], z8[8]; unpack8(*yp, yf); unpack8(*(const LAS v4u*)(XI + t * 144 + p8 * 2), x8);
                GAS v4u* zp = (GAS v4u*)(sp.ZQ + (size_t)row * 2048 + h * 64 + p8); unpack8(*zp, z8);
                float o[8] = {y0.x, y0.y, y0.z, y0.w, y1.x, y1.y, y1.z, y1.w}; float ss = 0.f;
#pragma unroll
                for (int i = 0; i < 8; ++i) { o[i] = (o[i] + yf[i] + dsk * x8[i]) * z8[i]; ss += o[i] * o[i]; }
                v4u w; w.x = pk2(o[0], o[1]); w.y = pk2(o[2], o[3]); w.z = pk2(o[4], o[5]); w.w = pk2(o[6], o[7]); *zp = w;
                ss += __shfl_xor(ss, 1); ss += __shfl_xor(ss, 2); ss += __shfl_xor(ss, 4);
                if ((t3 & 7) == 0) sp.STATS[(size_t)row * 16 + h] = ss; }
        }
    }
#undef SSD_LOAD
#undef SSD_LDX
    if (st_out) {
#pragma unroll
        for (int r = 0; r < 16; ++r) *(GAS unsigned short*)(st_out + (32 * nb + arow(r, hf)) * 64 + 32 * pb + (lane & 31)) = (unsigned short)f2bf(accS[r]); }
    if (dec_out && tid == 0) *dec_out = __expf(ltot);
    __syncthreads();
}
__device__ __forceinline__ void phase_convbc(const Params& p, int bid, int G, int tid) {
    const bf16* XBC = (const bf16*)(p.ws + WS_XBC); bf16* BCC = (bf16*)(p.ws + WS_BCC);
    const int gt = bid * 512 + tid, nt = G * 512, oct = gt & 63, col = 1024 + oct * 8;
    float w[5][8], b8[8];
#pragma unroll
    for (int j = 0; j < 5; ++j) { const f32x4 w0 = *(const GAS f32x4*)(p.in[I_CONVW] + j * 1536 + col), w1 = *(const GAS f32x4*)(p.in[I_CONVW] + j * 1536 + col + 4);
        w[j][0] = w0.x; w[j][1] = w0.y; w[j][2] = w0.z; w[j][3] = w0.w; w[j][4] = w1.x; w[j][5] = w1.y; w[j][6] = w1.z; w[j][7] = w1.w; }
    { const f32x4 b0 = *(const GAS f32x4*)(p.in[I_CONVB] + col), b1 = *(const GAS f32x4*)(p.in[I_CONVB] + col + 4); b8[0] = b0.x; b8[1] = b0.y; b8[2] = b0.z; b8[3] = b0.w; b8[4] = b1.x; b8[5] = b1.y; b8[6] = b1.z; b8[7] = b1.w; }
    for (int row = gt >> 6; row < M; row += nt >> 6) {
        const int lo = row < ML ? 0 : ML, hi = row < ML ? ML : M;
        float a8[8];
#pragma unroll
        for (int i = 0; i < 8; ++i) a8[i] = b8[i];
#pragma unroll
        for (int j = 0; j < 5; ++j) { const int rr = row + j - 2;
            if (rr >= lo && rr < hi) { float x8[8]; unpack8(*(const GAS v4u*)(XBC + (size_t)rr * 1536 + col), x8);
#pragma unroll
                for (int i = 0; i < 8; ++i) a8[i] += w[j][i] * x8[i]; } }
        v4u o; o.x = pk2(siluf(a8[0]), siluf(a8[1])); o.y = pk2(siluf(a8[2]), siluf(a8[3])); o.z = pk2(siluf(a8[4]), siluf(a8[5])); o.w = pk2(siluf(a8[6]), siluf(a8[7]));
        *(GAS v4u*)(BCC + (size_t)row * 512 + oct * 8) = o;
    }
}
template <int MODE, int D>
__device__ __forceinline__ void hg_scan(const ScanPtrs& sp, LAS unsigned char* lds, int row_begin, int nchunks, int hh, const bf16* st_in, bf16* st_out, float* dec_out, int tid) {
    const int lane = tid & 63, wave = __builtin_amdgcn_readfirstlane(tid >> 6), h = lane >> 5;
    LAS unsigned char* QP = lds; LAS unsigned char* KP = lds + 17408; LAS unsigned char* VI = lds + 34816; LAS unsigned char* ATT = lds + 52224; LAS unsigned char* STI = lds + 61440;
    LAS float* OB = (LAS float*)(lds + 96256); LAS float* PAR = (LAS float*)(lds + 132096); LAS float* EL = (LAS float*)(lds + 136192);
    f16* Fit = (row_begin < ML) ? sp.Flat + (size_t)row_begin * 2048 : sp.Fctx + (size_t)(row_begin - ML) * 2048;
    const int k0 = (tid & 63) * 2, tg = wave, kb = wave >> 1, vb0 = (wave & 1) * 2;
    asm volatile("" : "+s"(nchunks));
    f32x16 accS[2];
#pragma unroll
    for (int i = 0; i < 2; ++i)
#pragma unroll
        for (int r = 0; r < 16; ++r) accS[i][r] = st_in ? bf2f(*(const GAS unsigned short*)(st_in + (32 * kb + arow(r, h)) * 128 + 32 * (vb0 + i) + (lane & 31))) : 0.f;
    if (MODE != 0) { store_acc_nat(accS[0], STI, 272, 32 * vb0, 32 * kb, lane); store_acc_nat(accS[1], STI, 272, 32 * (vb0 + 1), 32 * kb, lane); }
    float ltot0 = 0.f, ltot1 = 0.f;
    unsigned plf[8], pq[8]; v4u pv0, pv1;
    const int vr = tid >> 3, vc = (tid & 7) * 16;
#define HG_LOAD(c_) do { const int rr_ = 64 * (c_); \
        _Pragma("unroll") for (int i = 0; i < 8; ++i) { plf[i] = *(const GAS unsigned*)(Fit + (size_t)(rr_ + 8 * tg + i) * 2048 + D * 1024 + hh * 128 + k0); \
            if (MODE != 0) pq[i] = *(const GAS unsigned*)(sp.ZQ + (size_t)(row_begin + rr_ + 8 * tg + i) * 2048 + 1024 + hh * 128 + k0); } \
        const GAS v4u* vp_ = (const GAS v4u*)(sp.V + (size_t)(row_begin + rr_ + vr) * 1024 + hh * 128 + vc); pv0 = vp_[0]; pv1 = vp_[1]; } while (0)
    HG_LOAD(D == 0 ? 0 : nchunks - 1);
#pragma unroll 1
    for (int ci = 0; ci < nchunks; ++ci) {
        const int c = D == 0 ? ci : nchunks - 1 - ci, r0 = 64 * c;
        float lf0[8], lf1[8], cs0[8], cs1[8]; float run0 = 0.f, run1 = 0.f;
#pragma unroll
        for (int i = 0; i < 8; ++i) { const f16x2 hr = __builtin_bit_cast(f16x2, plf[i]); lf0[i] = (float)hr.x; lf1[i] = (float)hr.y; }
#pragma unroll
        for (int ii = 0; ii < 8; ++ii) { const int i = D == 0 ? ii : 7 - ii; run0 += lf0[i]; run1 += lf1[i]; cs0[i] = run0; cs1[i] = run1; }
        *(LAS f32x2*)(PAR + tg * 128 + k0) = (f32x2){run0, run1};
        __syncthreads();
        float off0 = 0.f, off1 = 0.f, tot0 = 0.f, tot1 = 0.f;
#pragma unroll
        for (int j = 0; j < 8; ++j) { const f32x2 pj = *(const LAS f32x2*)(PAR + j * 128 + k0); tot0 += pj.x; tot1 += pj.y; if (D == 0 ? (j < tg) : (j > tg)) { off0 += pj.x; off1 += pj.y; } }
#pragma unroll
        for (int i = 0; i < 8; ++i) { const float bc0 = off0 + cs0[i], bc1 = off1 + cs1[i], kk0 = 1.f - __expf(lf0[i]), kk1 = 1.f - __expf(lf1[i]); const int t = 8 * tg + i;
            if (MODE != 0) *(LAS unsigned*)(QP + t * 272 + k0 * 2) = pk2(bf2f(pq[i] & 0xffffu) * __expf(bc0), bf2f(pq[i] >> 16) * __expf(bc1));
            *(LAS unsigned*)(KP + t * 272 + k0 * 2) = pk2(kk0 * __expf(-bc0), kk1 * __expf(-bc1)); }
        if (tg == 0) { *(LAS f32x2*)(EL + k0) = (f32x2){__expf(tot0), __expf(tot1)}; ltot0 += tot0; ltot1 += tot1; }
        *(LAS v4u*)(VI + vr * 272 + vc * 2) = pv0; *(LAS v4u*)(VI + vr * 272 + vc * 2 + 16) = pv1;
        if (ci + 1 < nchunks) HG_LOAD(D == 0 ? ci + 1 : nchunks - 2 - ci);
        __syncthreads();
        f32x16 accO;
        if (MODE != 0) {
            if (wave < 4) { const int sb = wave >> 1, tb = wave & 1; f32x16 a;
#pragma unroll
                for (int r = 0; r < 16; ++r) a[r] = 0.f;
#pragma unroll
                for (int ks = 0; ks < 8; ++ks) a = MFMA32(frag_rows(KP, 272, 32 * sb, 32 * ks, lane), frag_rows(QP, 272, 32 * tb, 32 * ks, lane), a);
                const int t = 32 * tb + (lane & 31);
#pragma unroll
                for (int r = 0; r < 16; ++r) { const int s = 32 * sb + arow(r, h); if (D == 0 ? (s > t) : (s < t)) a[r] = 0.f; }
                store_acc_nat(a, ATT, 144, 32 * tb, 32 * sb, lane); }
            const int tb = wave >> 2, vb = wave & 3;
#pragma unroll
            for (int r = 0; r < 16; ++r) accO[r] = 0.f;
#pragma unroll
            for (int ks = 0; ks < 8; ++ks) accO = MFMA32(frag_rows(QP, 272, 32 * tb, 32 * ks, lane), frag_rows(STI, 272, 32 * vb, 32 * ks, lane), accO);
            __syncthreads();
#pragma unroll
            for (int ks = 0; ks < 4; ++ks) accO = MFMA32(frag_rows(ATT, 144, 32 * tb, 32 * ks, lane), frag_tr(VI, 272, 16 * ks, 32 * vb, lane), accO);
#pragma unroll
            for (int r = 0; r < 16; ++r) OB[(32 * tb + arow(r, h)) * 132 + 32 * vb + (lane & 31)] = accO[r];
        }
#pragma unroll
        for (int ks = 0; ks < 4; ++ks) { const bf16x8 a = frag_tr(KP, 272, 16 * ks, 32 * kb, lane);
            accS[0] = MFMA32(a, frag_tr(VI, 272, 16 * ks, 32 * vb0, lane), accS[0]); accS[1] = MFMA32(a, frag_tr(VI, 272, 16 * ks, 32 * (vb0 + 1), lane), accS[1]); }
#pragma unroll
        for (int r = 0; r < 16; ++r) { const float e = EL[32 * kb + arow(r, h)]; accS[0][r] *= e; accS[1][r] *= e; }
        if (MODE != 0) { store_acc_nat(accS[0], STI, 272, 32 * vb0, 32 * kb, lane); store_acc_nat(accS[1], STI, 272, 32 * (vb0 + 1), 32 * kb, lane); }
        __syncthreads();
        if (MODE != 0) {
            const int t = tid >> 3, c16 = (tid & 7) * 16, row = row_begin + r0 + t;
            float o[16];
#pragma unroll
            for (int j = 0; j < 4; ++j) { const f32x4 x = *(const LAS f32x4*)(OB + t * 132 + c16 + 4 * j); o[4 * j] = x.x; o[4 * j + 1] = x.y; o[4 * j + 2] = x.z; o[4 * j + 3] = x.w; }
            f16* fp = Fit + (size_t)(r0 + t) * 2048 + hh * 128 + c16;
            if (MODE == 1) { f16x8 a, b;
#pragma unroll
                for (int j = 0; j < 8; ++j) { a[j] = (f16)o[j]; b[j] = (f16)o[8 + j]; }
                *(GAS f16x8*)fp = a; *(GAS f16x8*)(fp + 8) = b; }
            else { const f16x8 a = *(const GAS f16x8*)fp, b = *(const GAS f16x8*)(fp + 8); float ss = 0.f;
#pragma unroll
                for (int j = 0; j < 8; ++j) { o[j] += (float)a[j]; o[8 + j] += (float)b[j]; }
#pragma unroll
                for (int j = 0; j < 16; ++j) ss += o[j] * o[j];
                ss += __shfl_xor(ss, 1); ss += __shfl_xor(ss, 2); ss += __shfl_xor(ss, 4);
                const float rn = rsqrtf(ss * (1.f / 128.f) + EPS);
                float g8[8], g9[8]; unpack8(*(const GAS v4u*)(sp.G + (size_t)row * 1024 + hh * 128 + c16), g8); unpack8(*(const GAS v4u*)(sp.G + (size_t)row * 1024 + hh * 128 + c16 + 8), g9);
                const float* hn = sp.hgn + c16;
                v4u w0, w1;
                w0.x = pk2(o[0] * rn * hn[0] * g8[0], o[1] * rn * hn[1] * g8[1]); w0.y = pk2(o[2] * rn * hn[2] * g8[2], o[3] * rn * hn[3] * g8[3]); w0.z = pk2(o[4] * rn * hn[4] * g8[4], o[5] * rn * hn[5] * g8[5]); w0.w = pk2(o[6] * rn * hn[6] * g8[6], o[7] * rn * hn[7] * g8[7]);
                w1.x = pk2(o[8] * rn * hn[8] * g9[0], o[9] * rn * hn[9] * g9[1]); w1.y = pk2(o[10] * rn * hn[10] * g9[2], o[11] * rn * hn[11] * g9[3]); w1.z = pk2(o[12] * rn * hn[12] * g9[4], o[13] * rn * hn[13] * g9[5]); w1.w = pk2(o[14] * rn * hn[14] * g9[6], o[15] * rn * hn[15] * g9[7]);
                GAS v4u* zp = (GAS v4u*)(sp.ZQ + (size_t)row * 2048 + 1024 + hh * 128 + c16); zp[0] = w0; zp[1] = w1; }
        }
    }
#undef HG_LOAD
    if (st_out) {
#pragma unroll
        for (int i = 0; i < 2; ++i)
#pragma unroll
            for (int r = 0; r < 16; ++r) *(GAS unsigned short*)(st_out + (32 * kb + arow(r, h)) * 128 + 32 * (vb0 + i) + (lane & 31)) = (unsigned short)f2bf(accS[i][r]); }
    if (dec_out && tg == 0) { dec_out[k0] = __expf(ltot0); dec_out[k0 + 1] = __expf(ltot1); }
    __syncthreads();
}
__device__ __forceinline__ void wg_fence() { __threadfence(); __syncthreads(); }

__device__ __forceinline__ void phase_scanA1(const ScanPtrs& sp, LAS unsigned char* lds, int bid, int G, int tid) {
    for (int it = bid; it < NSC * 16; it += G) { const int sc = it >> 4, chain = it & 15, hh = chain >> 1, d = chain & 1;
        bf16* so = sp.HG_ST + ((size_t)sc * 16 + chain) * 16384; float* dc = sp.HG_DEC + (sc * 16 + chain) * 128;
        if (d == 0) hg_scan<0, 0>(sp, lds, sc * SCL, SCL / 64, hh, nullptr, so, dc, tid); else hg_scan<0, 1>(sp, lds, sc * SCL, SCL / 64, hh, nullptr, so, dc, tid); }
    for (int it = bid; it < 8; it += G) { const int hh = it;
        hg_scan<1, 0>(sp, lds, ML, MC / 64, hh, nullptr, sp.HG_ST + ((size_t)NSC * 16 + hh * 2 + 0) * 16384, nullptr, tid);
        wg_fence();
        hg_scan<2, 1>(sp, lds, ML, MC / 64, hh, nullptr, sp.HG_ST + ((size_t)NSC * 16 + hh * 2 + 1) * 16384, nullptr, tid); }
}
__device__ __forceinline__ void phase_scanA2(const ScanPtrs& sp, LAS unsigned char* lds, int bid_hw, int G, int tid) {
    const int bid = (G % 8 == 0) ? (bid_hw % 8) * (G / 8) + bid_hw / 8 : bid_hw;
    for (int it = bid; it < NSC * 32; it += G) { const int sc = it >> 5, chain = it & 31, h = chain >> 1, d = chain & 1;
        bf16* so = sp.SSD_ST + ((size_t)sc * 32 + chain) * 8192; float* dc = sp.SSD_DEC + sc * 32 + chain;
        if (d == 0) ssd_scan<0, 0>(sp, lds, sc * SCL, SCL / 64, 0, ML, h, nullptr, so, dc, tid); else ssd_scan<0, 1>(sp, lds, sc * SCL, SCL / 64, 0, ML, h, nullptr, so, dc, tid); }
    for (int it = bid; it < 16; it += G) { const int h = it;
        ssd_scan<1, 0>(sp, lds, ML, MC / 64, ML, M, h, nullptr, sp.SSD_ST + ((size_t)NSC * 32 + h * 2 + 0) * 8192, nullptr, tid);
        ssd_scan<2, 1>(sp, lds, ML, MC / 64, ML, M, h, nullptr, sp.SSD_ST + ((size_t)NSC * 32 + h * 2 + 1) * 8192, nullptr, tid); }
}
__device__ __forceinline__ void phase_scanB(const ScanPtrs& sp, int bid, int G, int tid) {
    const int gt = bid * 512 + tid, nt = G * 512;
    for (int e = gt; e < 2 * 131072; e += nt) {
        const bool hg = e >= 131072; const int e2 = hg ? e - 131072 : e;
        const int chain = hg ? (e2 >> 13) : (e2 >> 12), pr = hg ? (e2 & 8191) : (e2 & 4095), d = chain & 1;
        const int nch = hg ? 16 : 32, ppc = hg ? 8192 : 4096;
        GAS unsigned* base = (GAS unsigned*)(hg ? sp.HG_ST : sp.SSD_ST);
        const unsigned w0 = base[((size_t)NSC * nch + chain) * ppc + pr];
        float r0 = bf2f(w0 & 0xffffu), r1 = bf2f(w0 >> 16);
        for (int i0 = 0; i0 < NSC; i0 += 8) {
            unsigned loc[8]; float dec[8];
#pragma unroll
            for (int j = 0; j < 8; ++j) { const int sc = d == 0 ? i0 + j : NSC - 1 - (i0 + j); loc[j] = base[((size_t)sc * nch + chain) * ppc + pr];
                dec[j] = hg ? sp.HG_DEC[(sc * 16 + chain) * 128 + (pr >> 6)] : sp.SSD_DEC[sc * 32 + chain]; }
#pragma unroll
            for (int j = 0; j < 8; ++j) { const int sc = d == 0 ? i0 + j : NSC - 1 - (i0 + j); base[((size_t)sc * nch + chain) * ppc + pr] = pk2(r0, r1);
                r0 = r0 * dec[j] + bf2f(loc[j] & 0xffffu); r1 = r1 * dec[j] + bf2f(loc[j] >> 16); }
        }
    }
}
__device__ __forceinline__ void phase_scanC(const ScanPtrs& sp, LAS unsigned char* lds, int bid_hw, int G, int tid) {
    const int bid = (G % 8 == 0) ? (bid_hw % 8) * (G / 8) + bid_hw / 8 : bid_hw;
    for (int it = bid; it < NSC * 8; it += G) { const int sc = it >> 3, hh = it & 7;
        hg_scan<1, 0>(sp, lds, sc * SCL, SCL / 64, hh, sp.HG_ST + ((size_t)sc * 16 + hh * 2 + 0) * 16384, nullptr, nullptr, tid);
        wg_fence();
        hg_scan<2, 1>(sp, lds, sc * SCL, SCL / 64, hh, sp.HG_ST + ((size_t)sc * 16 + hh * 2 + 1) * 16384, nullptr, nullptr, tid); }
    for (int it = bid; it < NSC * 16; it += G) { const int sc = it >> 4, h = it & 15;
        ssd_scan<1, 0>(sp, lds, sc * SCL, SCL / 64, 0, ML, h, sp.SSD_ST + ((size_t)sc * 32 + h * 2 + 0) * 8192, nullptr, nullptr, tid);
        ssd_scan<2, 1>(sp, lds, sc * SCL, SCL / 64, 0, ML, h, sp.SSD_ST + ((size_t)sc * 32 + h * 2 + 1) * 8192, nullptr, nullptr, tid); }
}
__device__ __forceinline__ void phase_finish(const Params& p, LAS unsigned char* lds, int bid, int G, int tid, int wave, int lane) {
    unsigned char* ws = p.ws; bf16* ZQ = (bf16*)(ws + WS_ZQ); const float* stats = (const float*)(ws + WS_SMALL + SM_STATS); const float* sng = p.in[I_SSDN];
    const int gw = bid * NWAVES + wave, ngw = G * NWAVES;
    for (int row = gw; row < M; row += ngw) {
        const int grp = lane >> 5; const float* s8 = stats + (size_t)row * 16 + grp * 8;
        const float ss = ((s8[0] + s8[1]) + (s8[2] + s8[3])) + ((s8[4] + s8[5]) + (s8[6] + s8[7]));
        const float r = rsqrtf(ss * (1.f / 512.f) + EPS);
        GAS v4u* zp = (GAS v4u*)(ZQ + (size_t)row * 2048 + lane * 16);
#pragma unroll
        for (int q = 0; q < 2; ++q) { float x8[8]; unpack8(zp[q], x8); const float* g8 = sng + lane * 16 + q * 8;
            v4u o; o.x = pk2(x8[0] * r * g8[0], x8[1] * r * g8[1]); o.y = pk2(x8[2] * r * g8[2], x8[3] * r * g8[3]); o.z = pk2(x8[4] * r * g8[4], x8[5] * r * g8[5]); o.w = pk2(x8[6] * r * g8[6], x8[7] * r * g8[7]); zp[q] = o; }
    }
    LAS float* scr = (LAS float*)(lds + wave * 16384); unsigned char* wr = ws + WS_WREST;
    tr_job(p.in[I_EVOUT], 2048, 1024, 1, (bf16*)(wr + WO_OUT), scr, gw, ngw, lane);
    tr_job(p.in[I_WGATE], 1024, DFF, 2, (bf16*)(wr + WO_UP0), scr, gw, ngw, lane);
    tr_job(p.in[I_WUP], 1024, DFF, 3, (bf16*)(wr + WO_UP0), scr, gw, ngw, lane);
    tr_job(p.in[I_WDOWN], DFF, 1024, 1, (bf16*)(wr + WO_DOWN0), scr, gw, ngw, lane);
    tr_job(p.in[I_ODIN], 1024, 512, 1, (bf16*)(wr + WO_OD), scr, gw, ngw, lane);
    tr_job(p.in[I_WVAL], 512, 1024, 2, (bf16*)(wr + WO_VG), scr, gw, ngw, lane);
    tr_job(p.in[I_WGATE2], 512, 1024, 3, (bf16*)(wr + WO_VG), scr, gw, ngw, lane);
    tr_job(p.in[I_WGATE] + (size_t)1024 * DFF, 1024, DFF, 2, (bf16*)(wr + WO_UP1), scr, gw, ngw, lane);
    tr_job(p.in[I_WUP] + (size_t)1024 * DFF, 1024, DFF, 3, (bf16*)(wr + WO_UP1), scr, gw, ngw, lane);
    tr_job(p.in[I_WDOWN] + (size_t)DFF * 1024, DFF, 1024, 1, (bf16*)(wr + WO_DOWN1), scr, gw, ngw, lane);
}

struct S5Ptrs { const bf16* U; float* YS; bf16* A2; const float* LAM; const float* LAMP; const bf16* BBH; const bf16* CMH; const float* S5D; float* ST; };
template <int MODE, int D>
__device__ __forceinline__ void s5_wave(const S5Ptrs& sp, LAS unsigned char* SI  , int row0  , int g, int slot0, int lane) {
    const int n = lane & 31, hs = lane >> 5, dg = D * 32 + g;
    bf16x8 bq[4];
#pragma unroll
    for (int q = 0; q < 4; ++q) bq[q] = *(const GAS bf16x8*)(sp.BBH + ((size_t)(dg * 64 + (q & 1) * 32 + n) * 2 + (q >> 1)) * 16 + 8 * hs);
    bf16x8 cm[8];
    if (MODE != 0) {
#pragma unroll
        for (int ks = 0; ks < 8; ++ks) cm[ks] = n < 16 ? *(const GAS bf16x8*)(sp.CMH + ((size_t)(dg * 16 + n) * 128 + 16 * ks + 8 * hs)) : (bf16x8){0, 0, 0, 0, 0, 0, 0, 0}; }
    const float lr0 = sp.LAM[2 * (dg * 64 + n)], li0 = sp.LAM[2 * (dg * 64 + n) + 1], lr1 = sp.LAM[2 * (dg * 64 + 32 + n)], li1 = sp.LAM[2 * (dg * 64 + 32 + n) + 1];
    float hr0 = 0.f, hi0 = 0.f, hr1 = 0.f, hi1 = 0.f;
    float* stp = sp.ST + ((size_t)((slot0 + hs) * 2 + D) * 2048 + g * 64 + n) * 2;
    if (MODE != 0) { const f32x2 a = *(const GAS f32x2*)stp, b = *(const GAS f32x2*)(stp + 64); hr0 = a.x; hi0 = a.y; hr1 = b.x; hi1 = b.y; }
    const int astream = (n >> 2) & 1, aidx = 4 * (n >> 3) + (n & 3);
    const bf16* ua = sp.U + (size_t)(row0 + 128 * astream) * 512 + g * 16 + 8 * hs;
    bf16x8 afr = *(const GAS bf16x8*)(ua + (size_t)(D == 0 ? aidx : 127 - aidx) * 512);
#pragma unroll 1
    for (int i = 0; i < 8; ++i) {
        f32x16 acc[4];
#pragma unroll
        for (int q = 0; q < 4; ++q) {
#pragma unroll
            for (int r = 0; r < 16; ++r) acc[q][r] = 0.f;
            acc[q] = MFMA32(afr, bq[q], acc[q]); }
        if (i < 7) afr = *(const GAS bf16x8*)(ua + (size_t)(D == 0 ? 16 * (i + 1) + aidx : 127 - 16 * (i + 1) - aidx) * 512);
#pragma unroll
        for (int j = 0; j < 16; ++j) {
            const float nr0 = lr0 * hr0 - li0 * hi0 + acc[0][j], ni0 = lr0 * hi0 + li0 * hr0 + acc[2][j]; hr0 = nr0; hi0 = ni0; acc[0][j] = nr0; acc[2][j] = ni0;
            const float nr1 = lr1 * hr1 - li1 * hi1 + acc[1][j], ni1 = lr1 * hi1 + li1 * hr1 + acc[3][j]; hr1 = nr1; hi1 = ni1; acc[1][j] = nr1; acc[3][j] = ni1; }
        if (MODE != 0) {
            store_acc_nat(acc[0], SI, 72, 0, 0, lane); store_acc_nat(acc[1], SI, 72, 32, 0, lane); store_acc_nat(acc[2], SI, 72, 64, 0, lane); store_acc_nat(acc[3], SI, 72, 96, 0, lane);
            asm volatile("s_waitcnt lgkmcnt(0)" ::: "memory");
            f32x16 y;
#pragma unroll
            for (int r = 0; r < 16; ++r) y[r] = 0.f;
#pragma unroll
            for (int ks = 0; ks < 8; ++ks) y = MFMA32(frag_tr(SI, 72, 16 * ks, 0, lane), cm[ks], y);
            asm volatile("" ::: "memory");
            LAS float* YT = (LAS float*)(SI + 9216);
            if (n < 16) {
#pragma unroll
                for (int j = 0; j < 16; ++j) YT[arow(j, hs) * 20 + n] = y[j]; }
            asm volatile("s_waitcnt lgkmcnt(0)" ::: "memory");
            { const int m = lane >> 1, c8 = (lane & 1) * 8, ms = (m >> 2) & 1, mi = 4 * (m >> 3) + (m & 3);
              const int pos = D == 0 ? 16 * i + mi : 127 - 16 * i - mi, row = row0 + 128 * ms + pos;
              const f32x4 ya = *(const LAS f32x4*)(YT + m * 20 + c8), yb2 = *(const LAS f32x4*)(YT + m * 20 + c8 + 4);
              LAS v4u* yfp = (LAS v4u*)(SI + 11776 + (128 * ms + pos) * 32 + c8 * 2);
              if (MODE == 1) { v4u w; w.x = pk2(ya.x, ya.y); w.y = pk2(ya.z, ya.w); w.z = pk2(yb2.x, yb2.y); w.w = pk2(yb2.z, yb2.w); *yfp = w; }
              else { float f8[8]; unpack8(*yfp, f8); const f32x4 fa = {f8[0], f8[1], f8[2], f8[3]}, fb = {f8[4], f8[5], f8[6], f8[7]}; float u8[8]; unpack8(*(const GAS v4u*)(sp.U + (size_t)row * 512 + g * 16 + c8), u8);
                  const f32x4 d0 = *(const GAS f32x4*)(sp.S5D + g * 16 + c8), d1 = *(const GAS f32x4*)(sp.S5D + g * 16 + c8 + 4);
                  float v[8] = {ya.x + fa.x + d0.x * u8[0], ya.y + fa.y + d0.y * u8[1], ya.z + fa.z + d0.z * u8[2], ya.w + fa.w + d0.w * u8[3], yb2.x + fb.x + d1.x * u8[4], yb2.y + fb.y + d1.y * u8[5], yb2.z + fb.z + d1.z * u8[6], yb2.w + fb.w + d1.w * u8[7]};
#pragma unroll
                  for (int q = 0; q < 8; ++q) { const float tt = 0.7978845608f * (v[q] + 0.044715f * v[q] * v[q] * v[q]); v[q] = v[q] * (1.f - __builtin_amdgcn_rcpf(__expf(2.f * tt) + 1.f)); }
                  v4u w; w.x = pk2(v[0], v[1]); w.y = pk2(v[2], v[3]); w.z = pk2(v[4], v[5]); w.w = pk2(v[6], v[7]);
                  *(GAS v4u*)(sp.A2 + (size_t)row * 512 + g * 16 + c8) = w; } }
        }
    }
    if (MODE == 0) { *(GAS f32x2*)stp = (f32x2){hr0, hi0}; *(GAS f32x2*)(stp + 64) = (f32x2){hr1, hi1}; }
}
__device__ __forceinline__ void phase_s5A(const S5Ptrs& sp, LAS unsigned char* lds, int bid, int G, int wave, int lane) {
    LAS unsigned char* SI = lds + wave * 19968;
    for (int it = bid; it < 65 * 8; it += G) { const int col = it >> 3, gb = (it >> 1) & 3, d = it & 1, g = gb * 8 + wave;
        const int row0 = col < 64 ? col * 256 : ML, slot0 = col < 64 ? 2 * col : 128;
        if (d == 0) s5_wave<0, 0>(sp, SI, row0, g, slot0, lane); else s5_wave<0, 1>(sp, SI, row0, g, slot0, lane); }
}
__device__ __forceinline__ void phase_s5B(const S5Ptrs& sp, int bid, int G, int tid) {
    const int gt = bid * 512 + tid;
    if (gt < 4096) { const int d = gt >> 11, gp = gt & 2047, s = d * 2048 + gp; const float pr = sp.LAMP[2 * s], pi = sp.LAMP[2 * s + 1];
        GAS f32x2* st = (GAS f32x2*)sp.ST; f32x2 run = {0.f, 0.f};
        for (int i0 = 0; i0 < 130; i0 += 10) { f32x2 loc[10];
#pragma unroll
            for (int j = 0; j < 10; ++j) { const int q = i0 + j, slot = d == 0 ? (q < 2 ? 128 + q : q - 2) : (q < 2 ? 129 - q : 129 - q); loc[j] = st[(size_t)(slot * 2 + d) * 2048 + gp]; }
#pragma unroll
            for (int j = 0; j < 10; ++j) { const int q = i0 + j, slot = d == 0 ? (q < 2 ? 128 + q : q - 2) : (q < 2 ? 129 - q : 129 - q); st[(size_t)(slot * 2 + d) * 2048 + gp] = run;
                const float nr = pr * run.x - pi * run.y + loc[j].x, ni = pr * run.y + pi * run.x + loc[j].y; run.x = nr; run.y = ni; } }
    }
}
__device__ __forceinline__ void phase_s5C(const S5Ptrs& sp, LAS unsigned char* lds, int bid, int G, int wave, int lane) {
    LAS unsigned char* SI = lds + wave * 19968;
    for (int it = bid; it < 256; it += G) { const int col = it >> 2, g = (it & 3) * 8 + wave;
        s5_wave<1, 0>(sp, SI, col * 256, g, 2 * col, lane);
        asm volatile("s_waitcnt lgkmcnt(0)" ::: "memory");
        s5_wave<2, 1>(sp, SI, col * 256, g, 2 * col, lane); }
}
__device__ __forceinline__ void phase_final(const Params& p, int bid, int G, int wave, int lane) {
    const int gw = bid * NWAVES + wave, ngw = G * NWAVES; const float* fg = p.in[I_FNORM];
    for (int row = gw; row < ML; row += ngw) { float* xr = p.out + (size_t)row * 1024;
        f32x4 v[4]; float ss = 0.f;
#pragma unroll
        for (int j = 0; j < 4; ++j) { v[j] = *(const GAS f32x4*)(xr + 4 * lane + 256 * j); ss += (v[j].x * v[j].x + v[j].y * v[j].y) + (v[j].z * v[j].z + v[j].w * v[j].w); }
        const float r = rsqrtf(wave_sum(ss) * (1.f / 1024.f) + EPS);
#pragma unroll
        for (int j = 0; j < 4; ++j) { const f32x4 g4 = *(const GAS f32x4*)(fg + 4 * lane + 256 * j); *(GAS f32x4*)(xr + 4 * lane + 256 * j) = (f32x4){v[j].x * r * g4.x, v[j].y * r * g4.y, v[j].z * r * g4.z, v[j].w * r * g4.w}; }
    }
}

constexpr int N_PHASES = 22;
__device__ __forceinline__ void run_gmix(const Params& p, LAS unsigned char* lds, int bid, int G) {
    unsigned char* ws = p.ws;
    pg8::Gemm g{(const bf16*)(ws + WS_RX), (const bf16*)(ws + WS_WIN), M, NINP, 1024}; pg8::StaticOrder S; S.init(M, NINP, G, bid);
    pg8::EpiMix1 E{(bf16*)(ws + WS_ZQ), (bf16*)(ws + WS_XBC), (bf16*)(ws + WS_V), (bf16*)(ws + WS_G), (f16*)p.out, (f16*)(ws + WS_FCTX), (float*)(ws + WS_DT), (const float*)(ws + WS_SMALL + SM_LB), p.in[I_DTB], p.in[I_ALOG]};
    pg8::gemm_phase<pg8::EpiMix1, pg8::StaticOrder, true, true>(lds + RING_OFF, g, S, E);
}
__device__ __forceinline__ void run_gout(const Params& p, LAS unsigned char* lds, int bid, int G) {
    unsigned char* ws = p.ws; const float* mods = (const float*)(ws + WS_SMALL + SM_MODS);
    pg8::Gemm g{(const bf16*)(ws + WS_ZQ), (const bf16*)(ws + WS_WREST + WO_OUT), M, 1024, 2048}; pg8::StaticOrder S; S.init(M, 1024, G, bid);
    pg8::EpiResid E{p.in[I_X], p.in[I_CTX], p.out, (float*)(ws + WS_HCTX), mods + (0 * 2 + 0) * 6144 + 2 * 1024, mods + (0 * 2 + 1) * 6144 + 2 * 1024};
    pg8::gemm_phase<pg8::EpiResid, pg8::StaticOrder, true, true>(lds + RING_OFF, g, S, E);
}
__device__ __forceinline__ void run_gup(const Params& p, LAS unsigned char* lds, int bid, int G, int layer) {
    unsigned char* ws = p.ws; const int rows = layer ? ML : M;
    pg8::Gemm g{(const bf16*)(ws + WS_RX), (const bf16*)(ws + WS_WREST + (layer ? WO_UP1 : WO_UP0)), rows, 2 * DFF, 1024}; pg8::StaticOrder S; S.init(rows, 2 * DFF, G, bid);
    pg8::EpiSwiglu E{(bf16*)(ws + WS_HID)};
    pg8::gemm_phase<pg8::EpiSwiglu, pg8::StaticOrder, true, true>(lds + RING_OFF, g, S, E);
}
__device__ __forceinline__ void run_gdown(const Params& p, LAS unsigned char* lds, int bid, int G, int layer) {
    unsigned char* ws = p.ws; const int rows = layer ? ML : M; const float* mods = (const float*)(ws + WS_SMALL + SM_MODS); float* Hctx = (float*)(ws + WS_HCTX);
    pg8::Gemm g{(const bf16*)(ws + WS_HID), (const bf16*)(ws + WS_WREST + (layer ? WO_DOWN1 : WO_DOWN0)), rows, 1024, DFF}; pg8::StaticOrder S; S.init(rows, 1024, G, bid);
    pg8::EpiResid E{p.out, Hctx, p.out, Hctx, mods + (layer * 2 + 0) * 6144 + 5 * 1024, mods + (layer * 2 + 1) * 6144 + 5 * 1024};
    pg8::gemm_phase<pg8::EpiResid, pg8::StaticOrder, true, true>(lds + RING_OFF, g, S, E);
}
__device__ __forceinline__ void run_god(const Params& p, LAS unsigned char* lds, int bid, int G) {
    unsigned char* ws = p.ws;
    pg8::Gemm g{(const bf16*)(ws + WS_RX), (const bf16*)(ws + WS_WREST + WO_OD), M, 512, 1024}; pg8::StaticOrder S; S.init(M, 512, G, bid);
    pg8::EpiU E{(bf16*)(ws + WS_U)};
    pg8::gemm_phase<pg8::EpiU, pg8::StaticOrder, true, true>(lds + RING_OFF, g, S, E);
}
__device__ __forceinline__ void run_gvg(const Params& p, LAS unsigned char* lds, int bid, int G) {
    unsigned char* ws = p.ws; const float* mods = (const float*)(ws + WS_SMALL + SM_MODS);
    pg8::Gemm g{(const bf16*)(ws + WS_A2), (const bf16*)(ws + WS_WREST + WO_VG), ML, 2048, 512}; pg8::StaticOrder S; S.init(ML, 2048, G, bid);
    pg8::EpiValGate E{p.out, mods + (1 * 2 + 0) * 6144 + 2 * 1024};
    pg8::gemm_phase<pg8::EpiValGate, pg8::StaticOrder, true, true>(lds + RING_OFF, g, S, E);
}
__device__ __forceinline__ ScanPtrs make_scanptrs(const Params& p) {
    unsigned char* ws = p.ws; ScanPtrs sp; sp.XBC = (const bf16*)(ws + WS_XBC); sp.DT = (const float*)(ws + WS_DT); sp.ZQ = (bf16*)(ws + WS_ZQ); sp.V = (const bf16*)(ws + WS_V); sp.G = (const bf16*)(ws + WS_G); sp.Flat = (f16*)p.out; sp.Fctx = (f16*)(ws + WS_FCTX);
    sp.STATS = (float*)(ws + WS_SMALL + SM_STATS); sp.convw = p.in[I_CONVW]; sp.convb = p.in[I_CONVB]; sp.ssdd = p.in[I_SSDD]; sp.hgn = p.in[I_HGN];
    sp.SSD_ST = (bf16*)(ws + WS_RX); sp.HG_ST = (bf16*)(ws + WS_RX + SSD_ST_BYTES); sp.SSD_DEC = (float*)(ws + WS_SMALL + SM_SSDDEC); sp.HG_DEC = (float*)(ws + WS_SMALL + SM_HGDEC); sp.BCC = (const bf16*)(ws + WS_BCC); return sp;
}
__device__ __forceinline__ S5Ptrs make_s5ptrs(const Params& p) {
    unsigned char* ws = p.ws; S5Ptrs s5; s5.U = (const bf16*)(ws + WS_U); s5.YS = (float*)(ws + WS_YS); s5.A2 = (bf16*)(ws + WS_A2); s5.LAM = (const float*)(ws + WS_SMALL + SM_LAM); s5.LAMP = (const float*)(ws + WS_SMALL + SM_LAMP);
    s5.BBH = (const bf16*)(ws + WS_SMALL + SM_BB); s5.CMH = (const bf16*)(ws + WS_SMALL + SM_BB + 262144); s5.S5D = p.in[I_S5D]; s5.ST = (float*)(ws + WS_SMALL + SM_S5ST); return s5;
}
__global__ void __launch_bounds__(NWAVES * 64, 2) mk_fwd(Params p) {
    extern __shared__ __attribute__((aligned(16))) unsigned char lds_raw[];
    LAS unsigned char* lds = (LAS unsigned char*)lds_raw;
    volatile LAS unsigned* MISC = (volatile LAS unsigned*)(lds + MISC_OFF);
    const int tid = threadIdx.x, lane = tid & 63, wave = __builtin_amdgcn_readfirstlane(tid >> 6), G = gridDim.x, bid = blockIdx.x;
    gu32* ctl = (gu32*)(p.ws + WS_CTL);
    for (int u = tid; u < (LDS_BYTES - LDSCTL_OFF) / 4; u += NWAVES * 64) ((LAS unsigned*)(lds + LDSCTL_OFF))[u] = 0u;
    __syncthreads();
    XcdBarrier bar; bar.bar = (unsigned*)(ctl + CW_BAR); bar.x = 0; bar.st = nullptr;
    if (p.use_bar) bar = xcd_barrier_post((unsigned*)(ctl + CW_BAR), MISC + 8);
    const int lo = p.ph_lo, hi = p.ph_hi;
#ifndef MK_ONLYPH
#define MK_ONLYPH -1
#endif
#define IN(k) ((MK_ONLYPH < 0 || MK_ONLYPH == (k)) && lo <= (k) && (k) < hi)
#define SEAM(k) do { if ((k) + 1 < hi) xcd_barrier(bar); } while (0)
    if (IN(0)) { phase_prologue(p, lds, bid, G, tid, wave, lane); SEAM(0); }
    if (IN(1)) { phase_rownorm(p, lds, bid, G, tid, wave, lane, 0, 0, M, p.in[I_X], p.in[I_CTX], true); SEAM(1); }
    if (IN(2)) { run_gmix(p, lds, bid, G); SEAM(2); }
    if (IN(3)) { phase_convbc(p, bid, G, tid); const ScanPtrs sp = make_scanptrs(p); phase_scanA1(sp, lds, bid, G, tid); SEAM(3); }
    if (IN(4)) { const ScanPtrs sp = make_scanptrs(p); phase_scanA2(sp, lds, bid, G, tid); SEAM(4); }
    if (IN(5)) { const ScanPtrs sp = make_scanptrs(p); phase_scanB(sp, bid, G, tid); SEAM(5); }
    if (IN(6)) { const ScanPtrs sp = make_scanptrs(p); phase_scanC(sp, lds, bid, G, tid); SEAM(6); }
    if (IN(7)) { phase_finish(p, lds, bid, G, tid, wave, lane); SEAM(7); }
    if (IN(8)) { run_gout(p, lds, bid, G); SEAM(8); }
    if (IN(9)) { phase_rownorm(p, lds, bid, G, tid, wave, lane, 0, 1, M, p.out, (const float*)(p.ws + WS_HCTX), false); SEAM(9); }
    if (IN(10)) { run_gup(p, lds, bid, G, 0); SEAM(10); }
    if (IN(11)) { run_gdown(p, lds, bid, G, 0); SEAM(11); }
    if (IN(12)) { phase_rownorm(p, lds, bid, G, tid, wave, lane, 1, 0, M, p.out, (const float*)(p.ws + WS_HCTX), false); SEAM(12); }
    if (IN(13)) { run_god(p, lds, bid, G); SEAM(13); }
    if (IN(14)) { const S5Ptrs s5 = make_s5ptrs(p); phase_s5A(s5, lds, bid, G, wave, lane); SEAM(14); }
    if (IN(15)) { const S5Ptrs s5 = make_s5ptrs(p); phase_s5B(s5, bid, G, tid); SEAM(15); }
    if (IN(16)) { const S5Ptrs s5 = make_s5ptrs(p); phase_s5C(s5, lds, bid, G, wave, lane); SEAM(16); }
    if (IN(17)) { run_gvg(p, lds, bid, G); SEAM(17); }
    if (IN(18)) { phase_rownorm(p, lds, bid, G, tid, wave, lane, 1, 1, ML, p.out, (const float*)(p.ws + WS_HCTX), false); SEAM(18); }
    if (IN(19)) { run_gup(p, lds, bid, G, 1); SEAM(19); }
    if (IN(20)) { run_gdown(p, lds, bid, G, 1); SEAM(20); }
    if (IN(21)) { phase_final(p, bid, G, wave, lane); }
#undef IN
#undef SEAM
}

extern "C" void kernel_launch(void* const* d_in, const int* in_sizes, int n_in, void* d_out, int out_size, void* d_ws, size_t ws_size, hipStream_t stream) {
    static int grid = 0;
    if (grid == 0) {
        if (n_in != 33 || out_size != ML * D || ws_size < 256 * MiB) { fprintf(stderr, "kernel_launch: unexpected shapes (n_in %d, out %d, ws %zu); nothing launched\n", n_in, out_size, ws_size); grid = -1; return; }
        int dev = 0, cus = 0, per_cu = 0;
        if (hipGetDevice(&dev) != hipSuccess || hipDeviceGetAttribute(&cus, hipDeviceAttributeMultiprocessorCount, dev) != hipSuccess) { grid = -1; return; }
        if (hipFuncSetAttribute((const void*)mk_fwd, hipFuncAttributeMaxDynamicSharedMemorySize, LDS_BYTES) != hipSuccess) { fprintf(stderr, "kernel_launch: hipFuncSetAttribute failed\n"); grid = -1; return; }
        if (hipOccupancyMaxActiveBlocksPerMultiprocessor(&per_cu, (const void*)mk_fwd, NWAVES * 64, LDS_BYTES) != hipSuccess || per_cu < 1) fprintf(stderr, "kernel_launch: occupancy query reports %d\n", per_cu);
        (void)hipGetLastError();
        grid = cus;
    }
    if (grid < 0) return;
    (void)hipMemsetAsync((char*)d_ws + WS_CTL, 0, CTL_ZERO_BYTES, stream);
    Params a{};
    for (int i = 0; i < 33; ++i) a.in[i] = (const float*)d_in[i];
    a.out = (float*)d_out; a.ws = (unsigned char*)d_ws;
#if MK_N_LAUNCHES == 1
    a.ph_lo = 0; a.ph_hi = N_PHASES; a.use_bar = 1;
    hipLaunchKernelGGL(mk_fwd, dim3(grid), dim3(NWAVES * 64), LDS_BYTES, stream, a);
#else
    for (int ph = 0; ph < N_PHASES; ++ph) { a.ph_lo = ph; a.ph_hi = ph + 1; a.use_bar = 0; hipLaunchKernelGGL(mk_fwd, dim3(grid), dim3(NWAVES * 64), LDS_BYTES, stream, a); }
#endif
}
```

```cpp
#include <hip/hip_runtime.h>
#include <cstdio>
#include <cstdint>

#ifndef MK_N_LAUNCHES
#define MK_N_LAUNCHES 1
#endif
namespace pg8 {
#define PG8_LAS __attribute__((address_space(3)))
typedef unsigned short bf16_t;
typedef short bf16x8 __attribute__((ext_vector_type(8)));
typedef float f32x4 __attribute__((ext_vector_type(4)));
typedef unsigned u32x4 __attribute__((ext_vector_type(4)));
constexpr int BM = 256, BK = 64, HALF = 128, HTB = HALF * BK * 2  , STAGE_BYTES = 8 * HTB, NXCD = 8, WGM = 8;

__host__ __device__ __forceinline__ int lds_byte(int r, int c) { const int st = (r >> 4) * 2 + (c >> 5), rr = r & 15, cc = c & 31, ob = rr * 64 + cc * 2; return st * 1024 + (ob ^ (((ob >> 9) & 1) << 5)); }
__host__ __device__ __forceinline__ void stage_rc(int b, int& R, int& C) { const int st = b / 1024, sb = b % 1024, swz = sb ^ (((sb >> 9) & 1) << 5); R = (st >> 1) * 16 + swz / 64; C = (st & 1) * 32 + (swz % 64) / 2; }
__host__ __device__ __forceinline__ int perm32(int rho) { const int n = rho >> 4, i = rho & 15; return 8 * (i >> 2) + 4 * n + (i & 3); }

struct Unit { int pm, pn; };
struct Gemm { const bf16_t* A; const bf16_t* Bt; int M, N, K; };

struct StaticOrder {
    int nM, nN, nwg, G, c;
    __host__ __device__ void init(int M, int N, int G_, int c_) { nM = M / BM; nN = N / BM; nwg = nM * nN; G = G_; c = c_; }
    __host__ __device__ bool next(int i, Unit& u) const {
        const long L = (long)i * G + c; if (L >= nwg) return false;
        int wgid = (int)L; { const int q = nwg / NXCD, r = nwg % NXCD, xcd = wgid % NXCD, off = wgid / NXCD; wgid = (xcd < r ? xcd * (q + 1) : r * (q + 1) + (xcd - r) * q) + off; }
        const int nig = WGM * nN, gid = wgid / nig, fm = gid * WGM, gsz = (nM - fm) < WGM ? (nM - fm) : WGM;
        u.pm = fm + ((wgid % nig) % gsz); u.pn = (wgid % nig) / gsz; return true;
    }
    __device__ __forceinline__ void a_ready(const Unit&) const {}
    __device__ __forceinline__ void done(const Unit&) const {}
};

__device__ __forceinline__ unsigned cvt_pk_bf16(float lo, float hi) { unsigned r; asm volatile("v_cvt_pk_bf16_f32 %0, %1, %2" : "=v"(r) : "v"(lo), "v"(hi)); return r; }
typedef float f32x2 __attribute__((ext_vector_type(2)));
typedef _Float16 f16x8 __attribute__((ext_vector_type(8)));
__device__ __forceinline__ float siluf(float x) { return x * __builtin_amdgcn_rcpf(1.f + __expf(-x)); }
__device__ __forceinline__ float sigmf(float x) { return __builtin_amdgcn_rcpf(1.f + __expf(-x)); }
__device__ __forceinline__ u32x4 pack8_bf16(const float (&x)[8]) { u32x4 w; w.x = cvt_pk_bf16(x[0], x[1]); w.y = cvt_pk_bf16(x[2], x[3]); w.z = cvt_pk_bf16(x[4], x[5]); w.w = cvt_pk_bf16(x[6], x[7]); return w; }
constexpr int EP_ML = 16384;

struct EpiMix1 {
    static constexpr bool PERM = true, AFTER_DRAIN = false;
    bf16_t* ZQ; bf16_t* XBC; bf16_t* V; bf16_t* G; _Float16* Flat; _Float16* Fctx; float* DT; const float* lb; const float* dt_bias; const float* a_log;
    template <int KIND> __device__ __forceinline__ void tile(const f32x4 (&acc)[2][2][4][2], const Unit& u, int wr, int wc, int fr, int fq, int seg_tile) const {
        const int row0 = u.pm * BM + wr * 64 + fr, cw = wc * 32 + 8 * fq;
#pragma unroll
        for (int ai = 0; ai < 2; ++ai)
#pragma unroll
            for (int m = 0; m < 4; ++m) { const int row = row0 + ai * HALF + m * 16;
#pragma unroll
                for (int bj = 0; bj < 2; ++bj) { const f32x4 v0 = acc[ai][bj][m][0], v1 = acc[ai][bj][m][1]; const int c = seg_tile * 256 + bj * HALF + cw;
                    float x[8] = {v0[0], v0[1], v0[2], v0[3], v1[0], v1[1], v1[2], v1[3]};
                    if constexpr (KIND == 0) {
#pragma unroll
                        for (int i = 0; i < 8; ++i) x[i] = siluf(x[i]);
                        *(u32x4*)(ZQ + (size_t)row * 2048 + c) = pack8_bf16(x);
                    } else if constexpr (KIND == 1) {
                        *(u32x4*)(XBC + (size_t)row * 1536 + c) = pack8_bf16(x);
                    } else if constexpr (KIND == 2) {
#pragma unroll
                        for (int i = 0; i < 8; ++i) x[i] = siluf(x[i]);
                        *(u32x4*)(ZQ + (size_t)row * 2048 + 1024 + c) = pack8_bf16(x);
                    } else if constexpr (KIND == 3) {
                        f16x8 h;
#pragma unroll
                        for (int i = 0; i < 8; ++i) { const float l = lb[(c + i) & 1023]; const float f = l + (1.f - l) * sigmf(x[i]); h[i] = (_Float16)__logf(f); }
                        _Float16* dst = (row < EP_ML) ? Flat + (size_t)row * 2048 : Fctx + (size_t)(row - EP_ML) * 2048;
                        *(f16x8*)(dst + c) = h;
                    } else if constexpr (KIND == 4) {
                        *(u32x4*)(V + (size_t)row * 1024 + c) = pack8_bf16(x);
                    } else if constexpr (KIND == 5) {
#pragma unroll
                        for (int i = 0; i < 8; ++i) x[i] = siluf(x[i]);
                        *(u32x4*)(G + (size_t)row * 1024 + c) = pack8_bf16(x);
                    } else {
                        if (bj == 0 && wc == 0) {
                            float dtv[8], la[8];
#pragma unroll
                            for (int i = 0; i < 8; ++i) { const int j = 8 * fq + i; const float r = x[i] + dt_bias[j]; dtv[i] = r > 20.f ? r : log1pf(__expf(r)); la[i] = -dtv[i] * __expf(a_log[j]); }
                            float* d = DT + (size_t)row * 64 + 8 * fq;
                            *(f32x4*)(d) = (f32x4){dtv[0], dtv[1], dtv[2], dtv[3]}; *(f32x4*)(d + 4) = (f32x4){dtv[4], dtv[5], dtv[6], dtv[7]};
                            *(f32x4*)(d + 32) = (f32x4){la[0], la[1], la[2], la[3]}; *(f32x4*)(d + 36) = (f32x4){la[4], la[5], la[6], la[7]};
                        }
                    } } }
    }
    __device__ __forceinline__ void operator()(const f32x4 (&acc)[2][2][4][2], const Unit& u, int wr, int wc, int fr, int fq) const {
        const int pn = u.pn;
        if (pn < 4) tile<0>(acc, u, wr, wc, fr, fq, pn);
        else if (pn < 10) tile<1>(acc, u, wr, wc, fr, fq, pn - 4);
        else if (pn < 14) tile<2>(acc, u, wr, wc, fr, fq, pn - 10);
        else if (pn < 22) tile<3>(acc, u, wr, wc, fr, fq, pn - 14);
        else if (pn < 26) tile<4>(acc, u, wr, wc, fr, fq, pn - 22);
        else if (pn < 30) tile<5>(acc, u, wr, wc, fr, fq, pn - 26);
        else tile<6>(acc, u, wr, wc, fr, fq, 0);
    }
};
struct EpiResid {
    static constexpr bool PERM = false, AFTER_DRAIN = false;
    const float* base_lat; const float* base_ctx; float* out_lat; float* out_ctx; const float* gate_lat; const float* gate_ctx;
    __device__ __forceinline__ void operator()(const f32x4 (&acc)[2][2][4][2], const Unit& u, int wr, int wc, int fr, int fq) const {
        const bool isc = u.pm >= 64; const float* base = isc ? base_ctx : base_lat; float* out = isc ? out_ctx : out_lat; const float* gate = isc ? gate_ctx : gate_lat;
        const int row0 = (isc ? 0 : u.pm * BM) + wr * 64 + fr, col0 = u.pn * BM + wc * 32 + 4 * fq;
        f32x4 gv[2][2];
#pragma unroll
        for (int bj = 0; bj < 2; ++bj)
#pragma unroll
            for (int n = 0; n < 2; ++n) gv[bj][n] = *(const f32x4*)(gate + col0 + bj * HALF + n * 16);
#pragma unroll
        for (int ai = 0; ai < 2; ++ai)
#pragma unroll
            for (int m = 0; m < 4; ++m) { const size_t off = (size_t)(row0 + ai * HALF + m * 16) * 1024 + col0;
#pragma unroll
                for (int bj = 0; bj < 2; ++bj)
#pragma unroll
                    for (int n = 0; n < 2; ++n) { const f32x4 b = *(const f32x4*)(base + off + bj * HALF + n * 16); *(f32x4*)(out + off + bj * HALF + n * 16) = b + gv[bj][n] * acc[ai][bj][m][n]; } }
    }
};
struct EpiSwiglu {
    static constexpr bool PERM = true, AFTER_DRAIN = false;
    bf16_t* HID;
    __device__ __forceinline__ void operator()(const f32x4 (&acc)[2][2][4][2], const Unit& u, int wr, int wc, int fr, int fq) const {
        const int row0 = u.pm * BM + wr * 64 + fr, c = u.pn * HALF + wc * 32 + 8 * fq;
#pragma unroll
        for (int ai = 0; ai < 2; ++ai)
#pragma unroll
            for (int m = 0; m < 4; ++m) { const f32x4 g0 = acc[ai][0][m][0], g1 = acc[ai][0][m][1], u0 = acc[ai][1][m][0], u1 = acc[ai][1][m][1];
                float x[8] = {siluf(g0[0]) * u0[0], siluf(g0[1]) * u0[1], siluf(g0[2]) * u0[2], siluf(g0[3]) * u0[3], siluf(g1[0]) * u1[0], siluf(g1[1]) * u1[1], siluf(g1[2]) * u1[2], siluf(g1[3]) * u1[3]};
                *(u32x4*)(HID + (size_t)(row0 + ai * HALF + m * 16) * 2816 + c) = pack8_bf16(x); }
    }
};
struct EpiU {
    static constexpr bool PERM = true, AFTER_DRAIN = false;
    bf16_t* U;
    __device__ __forceinline__ void operator()(const f32x4 (&acc)[2][2][4][2], const Unit& u, int wr, int wc, int fr, int fq) const {
        const int row0 = u.pm * BM + wr * 64 + fr, col0 = u.pn * BM + wc * 32 + 8 * fq;
#pragma unroll
        for (int ai = 0; ai < 2; ++ai)
#pragma unroll
            for (int m = 0; m < 4; ++m) { const int row = row0 + ai * HALF + m * 16; const int srow = row < EP_ML ? (row & 63) * 256 + (row >> 6) : row;
#pragma unroll
                for (int bj = 0; bj < 2; ++bj) { const f32x4 v0 = acc[ai][bj][m][0], v1 = acc[ai][bj][m][1]; float x[8] = {v0[0], v0[1], v0[2], v0[3], v1[0], v1[1], v1[2], v1[3]};
                    *(u32x4*)(U + (size_t)srow * 512 + col0 + bj * HALF) = pack8_bf16(x); } }
    }
};
struct EpiValGate {
    static constexpr bool PERM = false, AFTER_DRAIN = false;
    float* H; const float* gate;
    __device__ __forceinline__ void operator()(const f32x4 (&acc)[2][2][4][2], const Unit& u, int wr, int wc, int fr, int fq) const {
        const int row0 = u.pm * BM + wr * 64 + fr, col0 = u.pn * HALF + wc * 32 + 4 * fq;
#pragma unroll
        for (int ai = 0; ai < 2; ++ai)
#pragma unroll
            for (int m = 0; m < 4; ++m) { const int srow = row0 + ai * HALF + m * 16, token = (srow & 255) * 64 + (srow >> 8); float* hp = H + (size_t)token * 1024 + col0;
#pragma unroll
                for (int n = 0; n < 2; ++n) { const f32x4 v = acc[ai][0][m][n], g = acc[ai][1][m][n]; const f32x4 gm = *(const f32x4*)(gate + col0 + n * 16); f32x4 h = *(const f32x4*)(hp + n * 16);
                    h[0] += gm[0] * v[0] * sigmf(g[0]); h[1] += gm[1] * v[1] * sigmf(g[1]); h[2] += gm[2] * v[2] * sigmf(g[2]); h[3] += gm[3] * v[3] * sigmf(g[3]); *(f32x4*)(hp + n * 16) = h; } }
    }
};
template <class Epi, class Sched, bool ALIGN_EPI = false, bool SP2 = false>
__device__ __forceinline__ void gemm_phase(PG8_LAS unsigned char* lds, const Gemm g, const Sched& S, const Epi& E) {
    const int tid = threadIdx.x, wid = __builtin_amdgcn_readfirstlane(tid >> 6), lane = tid & 63, wr = wid >> 2, wc = wid & 3, fr = lane & 15, fq = lane >> 4;
    const int K = g.K, nt = K / BK;
    unsigned voffA[2], voffB[2];
#pragma unroll
    for (int i = 0; i < 2; ++i) { int R, C; stage_rc(tid * 16 + i * 8192, R, C); const int Rb = Epi::PERM ? ((R & ~31) + perm32(R & 31)) : R;
        voffA[i] = (unsigned)(R * K + C) * 2u; voffB[i] = (unsigned)(Rb * K + C) * 2u; }
    const size_t kstep = (size_t)(BK * 2);
    const size_t hstep = (size_t)HALF * K * 2;
    const size_t tstep = 2 * hstep;
    const unsigned ldsw = (unsigned)wid * 1024u;
    const int aoff = lds_byte(wr * 64 + fr, fq * 8), boff = lds_byte(wc * 32 + fr, fq * 8);
#define PG8_SA(b, h) (((b) * 2 + (h)) * HTB)
#define PG8_SB(b, h) ((4 + (b) * 2 + (h)) * HTB)
#define PG8_STAGE(bufoff, gbase, voff) do { _Pragma("unroll") for (int _i = 0; _i < 2; ++_i) \
        __builtin_amdgcn_global_load_lds((const unsigned*)((const char*)(gbase) + (voff)[_i]), (PG8_LAS unsigned*)(lds + (bufoff) + ldsw + _i * 8192), 16, 0, 0); } while (0)
#define PG8_LDA(dst, b, h) do { _Pragma("unroll") for (int m = 0; m < 4; ++m) _Pragma("unroll") for (int k = 0; k < 2; ++k) dst[m][k] = *(const PG8_LAS bf16x8*)(lds + PG8_SA(b, h) + aoff + m * 2048 + k * 1024); } while (0)
#define PG8_LDB(dst, b, h) do { _Pragma("unroll") for (int n = 0; n < 2; ++n) _Pragma("unroll") for (int k = 0; k < 2; ++k) dst[n][k] = *(const PG8_LAS bf16x8*)(lds + PG8_SB(b, h) + boff + n * 2048 + k * 1024); } while (0)
#define PG8_MMA(ai, bj, At, Bt) do { __builtin_amdgcn_s_setprio(1); _Pragma("unroll") for (int m = 0; m < 4; ++m) _Pragma("unroll") for (int n = 0; n < 2; ++n) _Pragma("unroll") for (int k = 0; k < 2; ++k) \
        acc[ai][bj][m][n] = __builtin_amdgcn_mfma_f32_16x16x32_bf16(Bt[n][k], At[m][k], acc[ai][bj][m][n], 0, 0, 0); __builtin_amdgcn_s_setprio(0); } while (0)
#define PG8_WAIT_V(n) asm volatile("s_waitcnt vmcnt(" #n ")" ::: "memory")
#define PG8_WAIT_L(n) asm volatile("s_waitcnt lgkmcnt(" #n ")" ::: "memory")
#define PG8_BAR __builtin_amdgcn_s_barrier()
#define PG8_SCHED __builtin_amdgcn_sched_barrier(0)
    Unit cur, nxt; int ui = 0;
    if (!S.next(0, cur)) return;
    f32x4 acc[2][2][4][2];
#pragma unroll
    for (int a = 0; a < 2; ++a)
#pragma unroll
        for (int b = 0; b < 2; ++b)
#pragma unroll
            for (int m = 0; m < 4; ++m)
#pragma unroll
                for (int n = 0; n < 2; ++n) acc[a][b][m][n] = (f32x4){0.f, 0.f, 0.f, 0.f};
    bf16x8 At[4][2], B0[2][2], B1[2][2];
    const char* cA = (const char*)g.A + (size_t)cur.pm * tstep; const char* cB = (const char*)g.Bt + (size_t)cur.pn * tstep;
    S.a_ready(cur);
    if constexpr (SP2) {
        PG8_STAGE(PG8_SB(0, 0), cB, voffB); PG8_STAGE(PG8_SB(0, 1), cB + hstep, voffB); PG8_STAGE(PG8_SA(0, 0), cA, voffA); PG8_STAGE(PG8_SA(0, 1), cA + hstep, voffA);
        if (wr == 1) PG8_BAR;
        PG8_WAIT_V(2); PG8_BAR;
        PG8_STAGE(PG8_SB(1, 0), cB + kstep, voffB); PG8_STAGE(PG8_SA(1, 0), cA + kstep, voffA); PG8_STAGE(PG8_SB(1, 1), cB + hstep + kstep, voffB);
        PG8_WAIT_V(6); PG8_BAR;
    } else {
        PG8_STAGE(PG8_SB(0, 0), cB, voffB); PG8_STAGE(PG8_SA(0, 0), cA, voffA); PG8_STAGE(PG8_SB(0, 1), cB + hstep, voffB); PG8_STAGE(PG8_SA(0, 1), cA + hstep, voffA);
        if (wr == 1) PG8_BAR;
        PG8_WAIT_V(4); PG8_BAR;
        PG8_STAGE(PG8_SB(1, 0), cB + kstep, voffB); PG8_STAGE(PG8_SA(1, 0), cA + kstep, voffA); PG8_STAGE(PG8_SB(1, 1), cB + hstep + kstep, voffB);
        PG8_WAIT_V(6); PG8_BAR;
    }
    for (;;) {
        const bool has_next = S.next(ui + 1, nxt);
        const char* nA = has_next ? (const char*)g.A + (size_t)nxt.pm * tstep : cA; const char* nB = has_next ? (const char*)g.Bt + (size_t)nxt.pn * tstep : cB;
        for (int t = 0; t < nt; t += 2) {
            const bool last = (t == nt - 2);
            const char* a1 = cA + (size_t)(t + 1) * kstep;
            const char* a2 = last ? nA : cA + (size_t)(t + 2) * kstep; const char* b2 = last ? nB : cB + (size_t)(t + 2) * kstep;
            const char* a3 = a2 + kstep; const char* b3 = b2 + kstep;
            if (last && has_next) S.a_ready(nxt);
            if constexpr (SP2) {
            PG8_LDB(B0, 0, 0); PG8_LDB(B1, 0, 1); PG8_SCHED; PG8_LDA(At, 0, 0); PG8_STAGE(PG8_SA(1, 1), a1 + hstep, voffA);
            PG8_WAIT_V(8); PG8_WAIT_L(0); PG8_BAR; PG8_MMA(0, 0, At, B0); PG8_MMA(0, 1, At, B1); PG8_BAR; PG8_SCHED;
            PG8_LDA(At, 0, 1); PG8_STAGE(PG8_SB(0, 0), b2, voffB); PG8_STAGE(PG8_SB(0, 1), b2 + hstep, voffB); PG8_STAGE(PG8_SA(0, 0), a2, voffA);
            PG8_WAIT_V(8); PG8_WAIT_L(0); PG8_BAR; PG8_MMA(1, 0, At, B0); PG8_MMA(1, 1, At, B1); PG8_BAR; PG8_SCHED;
            PG8_LDB(B0, 1, 0); PG8_LDB(B1, 1, 1); PG8_SCHED; PG8_LDA(At, 1, 0); PG8_STAGE(PG8_SA(0, 1), a2 + hstep, voffA);
            PG8_WAIT_V(8); PG8_WAIT_L(0); PG8_BAR; PG8_MMA(0, 0, At, B0); PG8_MMA(0, 1, At, B1); PG8_BAR; PG8_SCHED;
            PG8_LDA(At, 1, 1); PG8_STAGE(PG8_SB(1, 0), b3, voffB); PG8_STAGE(PG8_SB(1, 1), b3 + hstep, voffB); PG8_STAGE(PG8_SA(1, 0), a3, voffA);
            PG8_WAIT_V(8); PG8_WAIT_L(0); PG8_BAR; PG8_MMA(1, 0, At, B0); PG8_MMA(1, 1, At, B1); PG8_BAR; PG8_SCHED;
            } else {
            PG8_LDB(B0, 0, 0); PG8_SCHED; PG8_LDA(At, 0, 0); PG8_STAGE(PG8_SA(1, 1), a1 + hstep, voffA);
            PG8_WAIT_L(8); PG8_BAR; PG8_WAIT_L(0); PG8_MMA(0, 0, At, B0); PG8_BAR; PG8_SCHED;
            PG8_LDB(B1, 0, 1); PG8_STAGE(PG8_SB(0, 0), b2, voffB);
            PG8_BAR; PG8_WAIT_L(0); PG8_MMA(0, 1, At, B1); PG8_BAR;
            PG8_LDA(At, 0, 1); PG8_STAGE(PG8_SA(0, 0), a2, voffA);
            PG8_BAR; PG8_WAIT_L(0); PG8_MMA(1, 0, At, B0); PG8_BAR; PG8_SCHED;
            PG8_STAGE(PG8_SB(0, 1), b2 + hstep, voffB);
            PG8_WAIT_V(6); PG8_BAR; PG8_MMA(1, 1, At, B1); PG8_BAR;
            PG8_LDB(B0, 1, 0); PG8_SCHED; PG8_LDA(At, 1, 0); PG8_STAGE(PG8_SA(0, 1), a2 + hstep, voffA);
            PG8_WAIT_L(8); PG8_BAR; PG8_WAIT_L(0); PG8_MMA(0, 0, At, B0); PG8_BAR; PG8_SCHED;
            PG8_LDB(B1, 1, 1); PG8_STAGE(PG8_SB(1, 0), b3, voffB);
            PG8_BAR; PG8_WAIT_L(0); PG8_MMA(0, 1, At, B1); PG8_BAR;
            PG8_LDA(At, 1, 1); PG8_STAGE(PG8_SA(1, 0), a3, voffA);
            PG8_BAR; PG8_WAIT_L(0); PG8_MMA(1, 0, At, B0); PG8_BAR; PG8_SCHED;
            PG8_STAGE(PG8_SB(1, 1), b3 + hstep, voffB);
            PG8_WAIT_V(6); PG8_BAR; PG8_MMA(1, 1, At, B1); PG8_BAR;
            }
        }
        if constexpr (ALIGN_EPI) { if (wr == 0) PG8_BAR; }
        if constexpr (!Epi::AFTER_DRAIN) { E(acc, cur, wr, wc, fr, fq); S.done(cur); }
        if (!has_next) break;
#pragma unroll
        for (int a = 0; a < 2; ++a)
#pragma unroll
            for (int b = 0; b < 2; ++b)
#pragma unroll
                for (int m = 0; m < 4; ++m)
#pragma unroll
                    for (int n = 0; n < 2; ++n) acc[a][b][m][n] = (f32x4){0.f, 0.f, 0.f, 0.f};
        cur = nxt; cA = nA; cB = nB; ++ui;
        if constexpr (ALIGN_EPI) { if (wr == 1) PG8_BAR; }
    }
    PG8_WAIT_V(0);
    if constexpr (!ALIGN_EPI) { if (wr == 0) PG8_BAR; }
    PG8_BAR;
    if constexpr (Epi::AFTER_DRAIN) { E.fused(acc, cur, wr, wc, fr, fq, lds, wid, lane); S.done(cur); }
#undef PG8_SA
#undef PG8_SB
#undef PG8_STAGE
#undef PG8_LDA
#undef PG8_LDB
#undef PG8_MMA
#undef PG8_WAIT_V
#undef PG8_WAIT_L
#undef PG8_BAR
#undef PG8_SCHED
}
}
#define GAS __attribute__((address_space(1)))
#define LAS __attribute__((address_space(3)))
typedef unsigned short bf16;
typedef unsigned v4u __attribute__((ext_vector_type(4)));
typedef float f32x4 __attribute__((ext_vector_type(4)));
typedef short bf16x8 __attribute__((ext_vector_type(8)));
typedef GAS unsigned gu32;
typedef GAS unsigned long long gu64;
#define RLX_AGENT __ATOMIC_RELAXED, __HIP_MEMORY_SCOPE_AGENT
#define LDS_WAIT() asm volatile("s_waitcnt lgkmcnt(0)" ::: "memory")
#define VM_WAIT() asm volatile("s_waitcnt vmcnt(0)" ::: "memory")
__device__ __forceinline__ unsigned long long rt() { return __builtin_amdgcn_s_memrealtime(); }
typedef __bf16 bf16x2_t __attribute__((ext_vector_type(2)));
__device__ __forceinline__ unsigned f2bf(float f) { return (unsigned)__builtin_bit_cast(unsigned short, (__bf16)f); }
__device__ __forceinline__ unsigned pk2(float lo, float hi) { const bf16x2_t v = {(__bf16)lo, (__bf16)hi}; return __builtin_bit_cast(unsigned, v); }

#define XB_TMO      128
#define XB_XCNT(j)  (256  + 64 * (j))
#define XB_XSUB(j)  (1280 + 64 * (j))
#define XB_XGEN(j)  (2304 + 64 * (j))
#define XB_TOP      3328
#define XB_TOPGEN   3392
#define XCD_BAR_WORDS 3456
#define XB_SPIN_CAP (1u << 18)

__device__ __forceinline__ unsigned xb_ld(unsigned* p)              { return __hip_atomic_load(p, __ATOMIC_RELAXED, __HIP_MEMORY_SCOPE_AGENT); }
__device__ __forceinline__ unsigned xb_add(unsigned* p, unsigned v) { return __hip_atomic_fetch_add(p, v, __ATOMIC_RELAXED, __HIP_MEMORY_SCOPE_AGENT); }
__device__ __forceinline__ unsigned xb_xcc_id() { return (unsigned)__builtin_amdgcn_s_getreg((3 << 11) | 20) & 0xFu; }
#define XB_SPIN(cond, bar) do { unsigned _sp = 0; while (cond) { __builtin_amdgcn_s_sleep(1); \
    if ((++_sp & 255u) == 0u) { if (xb_ld(&(bar)[XB_TMO])) break; if (_sp > XB_SPIN_CAP) { atomicAdd(&(bar)[XB_TMO], 1u); break; } } } } while (0)

struct XcdBarrier {
    unsigned* bar; unsigned x;
    volatile LAS unsigned* st;
};

__device__ __forceinline__ XcdBarrier xcd_barrier_post(unsigned* bar, volatile LAS unsigned* st) {
    XcdBarrier b; b.bar = bar; b.x = xb_xcc_id(); b.st = st;
    if (threadIdx.x == 0) (void)xb_add(&bar[XB_XCNT(b.x)], 1u);
    return b;
}
__device__ __forceinline__ void xcd_barrier_complete(unsigned* bar, unsigned x, unsigned& nloc, unsigned& nx) {
    const unsigned G = gridDim.x * gridDim.y * gridDim.z;
    unsigned sum, cnt, mine, sp = 0u;
    for (;;) {
        sum = 0u; cnt = 0u; mine = 0u;
#pragma unroll
        for (unsigned j = 0; j < 16; ++j) { const unsigned c = xb_ld(&bar[XB_XCNT(j)]); sum += c; cnt += (c > 0u) ? 1u : 0u; mine = (j == x) ? c : mine; }
        if (sum == G) break;
        __builtin_amdgcn_s_sleep(1);
        if ((++sp & 255u) == 0u) { if (xb_ld(&bar[XB_TMO])) break; if (sp > XB_SPIN_CAP) { atomicAdd(&bar[XB_TMO], 1u); break; } }
    }
    nloc = mine > 0u ? mine : 1u; nx = cnt > 0u ? cnt : 1u;
}

__device__ __forceinline__ void xcd_barrier(const XcdBarrier& b) {
    asm volatile("s_waitcnt vmcnt(0)" ::: "memory");
    __syncthreads();
    if (threadIdx.x == 0) {
        unsigned* bar = b.bar;
        __builtin_amdgcn_s_waitcnt(0);
        unsigned nloc = b.st[0], nx = b.st[1];
        if (nloc == 0u) { xcd_barrier_complete(bar, b.x, nloc, nx); b.st[0] = nloc; b.st[1] = nx; }
        const unsigned old = xb_add(&bar[XB_XSUB(b.x)], 1u);
        const unsigned gen = old / nloc;
        if (old + 1u == (gen + 1u) * nloc) {
            __builtin_amdgcn_fence(__ATOMIC_RELEASE, "agent");
            asm volatile("s_waitcnt vmcnt(0)" ::: "memory");
            const unsigned og = xb_add(&bar[XB_TOP], 1u);
            const unsigned tg = og / nx;
            if (og + 1u == (tg + 1u) * nx) xb_add(&bar[XB_TOPGEN], 1u);
            else XB_SPIN(xb_ld(&bar[XB_TOPGEN]) == tg, bar);
            __builtin_amdgcn_fence(__ATOMIC_ACQUIRE, "agent");
            xb_add(&bar[XB_XGEN(b.x)], 1u);
            asm volatile("s_waitcnt vmcnt(0)" ::: "memory");
        } else {
            XB_SPIN(xb_ld(&bar[XB_XGEN(b.x)]) == gen, bar);
            __builtin_amdgcn_fence(__ATOMIC_ACQUIRE, "agent");
            asm volatile("s_waitcnt vmcnt(0)" ::: "memory");
        }
    }
    __syncthreads();
}


constexpr int NWAVES = 8;
constexpr int D = 1024, ML = 16384, MC = 256, M = ML + MC, DFF = 2816;
constexpr int NIN = 7712, NINP = 7936;
constexpr int NSC = 32, SCL = 512;
constexpr float EPS = 1e-6f;
static_assert(pg8::EP_ML == ML, "epilogue constant");

constexpr size_t MiB = 1u << 20, KiB = 1024;
constexpr size_t WS_CTL = 0, CTL_ZERO_BYTES = 1 * MiB;
constexpr size_t WS_SMALL = 1 * MiB;
constexpr size_t WS_HCTX = 9 * MiB;
constexpr size_t WS_FCTX = 10 * MiB;
constexpr size_t WS_RX = 11 * MiB;
constexpr size_t WS_ZQ = 44 * MiB;
constexpr size_t WS_XBC = 109 * MiB;
constexpr size_t WS_V = WS_XBC + (size_t)M * 1536 * 2;
constexpr size_t WS_G = WS_V + (size_t)M * 1024 * 2;
constexpr size_t WS_DT = WS_G + (size_t)M * 1024 * 2;
constexpr size_t WS_WIN = 227 * MiB;
constexpr size_t WS_BCC = WS_WIN;
static_assert(WS_BCC + (size_t)M * 512 * 2 <= 256 * MiB, "BCC");
static_assert(WS_DT + (size_t)M * 64 * 4 <= WS_WIN && WS_WIN + (size_t)NINP * 1024 * 2 <= 256 * MiB, "ws map (mixer phase)");
constexpr size_t WS_WREST = 216 * MiB;
constexpr size_t WO_OUT = 0, WO_UP0 = 4 * MiB, WO_DOWN0 = 15 * MiB, WO_OD = WO_DOWN0 + (size_t)DFF * 1024 * 2, WO_VG = WO_OD + 1 * MiB, WO_UP1 = WO_VG + 2 * MiB, WO_DOWN1 = WO_UP1 + 11 * MiB;
static_assert(WO_DOWN1 + (size_t)DFF * 1024 * 2 <= 40 * MiB, "weights overlay");
constexpr size_t WS_HID = WS_XBC;
static_assert(WS_HID + (size_t)M * DFF * 2 <= WS_WREST, "hidden overlay");
constexpr size_t WS_U = WS_ZQ;
constexpr size_t WS_A2 = WS_U + (size_t)M * 512 * 4;
static_assert(WS_A2 + (size_t)ML * 512 * 2 <= WS_XBC, "layer-1 overlay");
constexpr size_t WS_YS = WS_XBC;
constexpr size_t SM_ADAP = 0;
constexpr size_t SM_MODS = SM_ADAP + 2 * 2 * 8 * 6144 * 4;
constexpr size_t SM_LB = SM_MODS + 2 * 2 * 6144 * 4;
constexpr size_t SM_LAM = SM_LB + 4096;
constexpr size_t SM_LAMP = SM_LAM + 2 * 2048 * 2 * 4;
constexpr size_t SM_BB = SM_LAMP + 2 * 2048 * 2 * 4;
constexpr size_t SM_STATS = SM_BB + 2 * 2048 * 16 * 2 * 4;
constexpr size_t SM_SSDDEC = SM_STATS + (size_t)M * 16 * 4;
constexpr size_t SM_HGDEC = SM_SSDDEC + 33 * 32 * 4 + 128;
constexpr size_t SM_S5ST = ((SM_HGDEC + 33 * 16 * 128 * 4 + 255) / 256) * 256;
static_assert(SM_S5ST + 130 * 2 * 2048 * 2 * 4 <= 8 * MiB, "small tables");
constexpr size_t SSD_ST_BYTES = (size_t)33 * 32 * 8192 * 2;
static_assert(2 * SSD_ST_BYTES <= 33 * MiB && (size_t)M * 1024 * 2 <= 33 * MiB, "RX region");
constexpr int CW_BAR = 4096;

constexpr int RING_OFF = 0, RING_BYTES = 131072;
constexpr int LDS_BYTES = 163840;
constexpr int LDSCTL_OFF = LDS_BYTES - 512, MISC_OFF = LDSCTL_OFF + 320;


struct Params { const float* in[33]; float* out; unsigned char* ws; int ph_lo, ph_hi, use_bar, pad; };
enum { I_X = 0, I_C, I_CTX, I_CCTX, I_ADAW, I_ADAB, I_NMIX, I_NFFN, I_WGATE, I_WUP, I_WDOWN, I_FNORM, I_EVIN, I_EVOUT, I_CONVW, I_CONVB, I_DTB, I_ALOG, I_SSDD, I_SSDN, I_LBL, I_HGN,
       I_ODIN, I_ARE, I_AIM, I_LOGDT, I_BRE, I_BIM, I_CRE, I_CIM, I_S5D, I_WVAL, I_WGATE2 };
typedef _Float16 f16x8 __attribute__((ext_vector_type(8)));
typedef _Float16 f16;
typedef _Float16 f16x2 __attribute__((ext_vector_type(2)));
typedef float f32x2 __attribute__((ext_vector_type(2)));
__device__ __forceinline__ float bf2f(unsigned b) { return __uint_as_float(b << 16); }
__device__ __forceinline__ float siluf(float x) { return x * __builtin_amdgcn_rcpf(1.f + __expf(-x)); }
__device__ __forceinline__ float wave_sum(float v) {
#pragma unroll
    for (int o = 1; o < 64; o <<= 1) v += __shfl_xor(v, o);
    return v;
}
__device__ __forceinline__ void unpack8(const v4u r, float (&x)[8]) {
    x[0] = bf2f(r.x & 0xffffu); x[1] = bf2f(r.x >> 16); x[2] = bf2f(r.y & 0xffffu); x[3] = bf2f(r.y >> 16);
    x[4] = bf2f(r.z & 0xffffu); x[5] = bf2f(r.z >> 16); x[6] = bf2f(r.w & 0xffffu); x[7] = bf2f(r.w >> 16);
}
__device__ __forceinline__ void tr_item(const float* W, int ldw, int col0, int K, bf16* WT, int dst_row0, LAS float* scr, int kb, int lane) {
    const int k0 = 64 * kb;
#pragma unroll 8
    for (int i = 0; i < 32; ++i) { const int kk = 2 * i + (lane >> 5); scr[kk * 33 + (lane & 31)] = W[(size_t)(k0 + kk) * ldw + col0 + (lane & 31)]; }
    LDS_WAIT(); asm volatile("" ::: "memory");
    const int c = lane & 7;
#pragma unroll
    for (int j = 0; j < 4; ++j) { const int n = (lane >> 3) + 8 * j; const LAS float* s = scr + (8 * c) * 33 + n;
        v4u o; o.x = pk2(s[0 * 33], s[1 * 33]); o.y = pk2(s[2 * 33], s[3 * 33]); o.z = pk2(s[4 * 33], s[5 * 33]); o.w = pk2(s[6 * 33], s[7 * 33]);
        *(GAS v4u*)(WT + (size_t)(dst_row0 + n) * K + k0 + 8 * c) = o; }
    LDS_WAIT(); asm volatile("" ::: "memory");
}
__device__ __forceinline__ int dst_row_of(int mode, int c0) {
    if (mode == 0) return c0 < 2560 ? c0 : (c0 < 2592 ? 7680 + (c0 - 2560) : c0 - 32);
    if (mode == 1) return c0;
    return (c0 >> 7) * 256 + (mode == 3 ? 128 : 0) + (c0 & 127);
}
__device__ __forceinline__ void tr_job(const float* W, int K, int N, int mode, bf16* WT, LAS float* scr, int gw, int ngw, int lane) {
    const int nblk = N / 32, nit = (K / 64) * nblk;
    for (int it = gw; it < nit; it += ngw) { const int kb = it / nblk, nb = it % nblk; tr_item(W, N, 32 * nb, K, WT, dst_row_of(mode, 32 * nb), scr, kb, lane); }
}

__device__ __forceinline__ void phase_prologue(const Params& p, LAS unsigned char* lds, int bid, int G, int tid, int wave, int lane) {
    unsigned char* ws = p.ws; float* sm_adap = (float*)(ws + WS_SMALL + SM_ADAP);
    for (int it = bid; it < 192; it += G) {
        const int layer = it / 96, rem = it % 96, cb = rem / 8, ks = rem % 8;
        LAS float* sl = (LAS float*)lds; LAS float* sc = sl + 128;
        if (tid < 128) { sl[tid] = siluf(p.in[I_C][ks * 128 + tid]); sc[tid] = siluf(p.in[I_CCTX][ks * 128 + tid]); }
        __syncthreads();
        const int col = cb * 512 + tid; const float* W = p.in[I_ADAW] + (size_t)layer * 1024 * 6144 + (size_t)(ks * 128) * 6144 + col;
        float a0 = 0.f, a1 = 0.f;
#pragma unroll 8
        for (int k = 0; k < 128; ++k) { const float w = W[(size_t)k * 6144]; a0 += sl[k] * w; a1 += sc[k] * w; }
        sm_adap[((layer * 2 + 0) * 8 + ks) * 6144 + col] = a0; sm_adap[((layer * 2 + 1) * 8 + ks) * 6144 + col] = a1;
        __syncthreads();
    }
    const int gw = bid * NWAVES + wave, ngw = G * NWAVES;
    LAS float* scr = (LAS float*)(lds + wave * 16384);
    bf16* win = (bf16*)(ws + WS_WIN);
    tr_job(p.in[I_EVIN], 1024, NIN, 0, win, scr, gw, ngw, lane);
    { const int gt = bid * 512 + tid, nt = G * 512; v4u z = {0u, 0u, 0u, 0u};
      for (int i = gt; i < (NINP - NIN) * 1024 / 8; i += nt) *(GAS v4u*)(win + (size_t)NIN * 1024 + (size_t)i * 8) = z; }
    const int gt = bid * 512 + tid;
    if (gt < 1024) { const float l0 = p.in[I_LBL][gt], l1 = p.in[I_LBL][1024 + gt]; const float mx = fmaxf(l0, l1), e0 = __expf(l0 - mx), e1 = __expf(l1 - mx); ((float*)(ws + WS_SMALL + SM_LB))[gt] = e0 / (e0 + e1); }
    if (gt >= 4096 && gt < 8192) {
        const int s = gt - 4096, dg = s >> 6;
        const float dt = expf(p.in[I_LOGDT][dg]), are = p.in[I_ARE][s], aim = p.in[I_AIM][s];
        const float mag = expf(are * dt); float sn, cs; sincosf(aim * dt, &sn, &cs);
        const float lr = mag * cs, li = mag * sn, den = are * are + aim * aim;
        const float cr = ((lr - 1.f) * are + li * aim) / den, ci = (li * are - (lr - 1.f) * aim) / den;
        float* lam = (float*)(ws + WS_SMALL + SM_LAM); lam[2 * s] = lr; lam[2 * s + 1] = li;
        float pr = lr, pi = li;
#pragma unroll
        for (int q = 0; q < 7; ++q) { const float nr = pr * pr - pi * pi, ni = 2.f * pr * pi; pr = nr; pi = ni; }
        float* lamp = (float*)(ws + WS_SMALL + SM_LAMP); lamp[2 * s] = pr; lamp[2 * s + 1] = pi;
        bf16* bbh = (bf16*)(ws + WS_SMALL + SM_BB) + (size_t)s * 32;
#pragma unroll
        for (int c = 0; c < 16; ++c) { const float br = p.in[I_BRE][(size_t)s * 16 + c], bi = p.in[I_BIM][(size_t)s * 16 + c]; bbh[c] = (bf16)f2bf(cr * br - ci * bi); bbh[16 + c] = (bf16)f2bf(cr * bi + ci * br); }
    }
    { bf16* cmh = (bf16*)(ws + WS_SMALL + SM_BB + 262144); const int nt = G * 512;
      for (int e = gt; e < 2 * 32 * 16 * 128; e += nt) { const int k = e & 127, dgc = e >> 7; cmh[e] = (bf16)f2bf(k < 64 ? p.in[I_CRE][(size_t)dgc * 64 + k] : -p.in[I_CIM][(size_t)dgc * 64 + k - 64]); } }
}

__device__ __forceinline__ void phase_rownorm(const Params& p, LAS unsigned char* lds, int bid, int G, int tid, int wave, int lane, int layer, int kind  , int nrows,
                                              const float* src_lat, const float* src_ctx, bool from_partials) {
    unsigned char* ws = p.ws; const float* adap = (const float*)(ws + WS_SMALL + SM_ADAP); float* mods = (float*)(ws + WS_SMALL + SM_MODS);
    LAS float* Gt = (LAS float*)lds; LAS float* St = Gt + 2048;
    const float* ng = p.in[kind == 0 ? I_NMIX : I_NFFN] + layer * 1024;
    for (int idx = tid; idx < 4096; idx += 512) {
        const int vec = idx >> 11, which = (idx >> 10) & 1, col = idx & 1023, j = (kind * 3 + which) * 1024 + col;
        float v;
        if (from_partials) { v = p.in[I_ADAB][layer * 6144 + j];
#pragma unroll
            for (int ks = 0; ks < 8; ++ks) v += adap[((layer * 2 + vec) * 8 + ks) * 6144 + j]; }
        else v = mods[(layer * 2 + vec) * 6144 + j];
        if (which == 0) St[vec * 1024 + col] = v; else Gt[vec * 1024 + col] = ng[col] * (1.f + v);
    }
    if (from_partials && bid < 48) {
        const int idx = bid * 512 + tid, lv = idx / 6144, j = idx % 6144, ly = lv >> 1;
        float v = p.in[I_ADAB][ly * 6144 + j];
#pragma unroll
        for (int ks = 0; ks < 8; ++ks) v += adap[(lv * 8 + ks) * 6144 + j];
        mods[idx] = v;
    }
    __syncthreads();
    bf16* XN = (bf16*)(ws + WS_RX);
    const int gw = bid * NWAVES + wave, ngw = G * NWAVES;
    for (int row = gw; row < nrows; row += ngw) {
        const int vec = row >= ML ? 1 : 0; const float* xr = vec ? src_ctx + (size_t)(row - ML) * 1024 : src_lat + (size_t)row * 1024;
        f32x4 v[4]; float ss = 0.f;
#pragma unroll
        for (int j = 0; j < 4; ++j) { v[j] = *(const GAS f32x4*)(xr + 4 * lane + 256 * j); ss += (v[j].x * v[j].x + v[j].y * v[j].y) + (v[j].z * v[j].z + v[j].w * v[j].w); }
        const float r = rsqrtf(wave_sum(ss) * (1.f / 1024.f) + EPS);
#pragma unroll
        for (int j = 0; j < 4; ++j) { const int c = 4 * lane + 256 * j; const LAS float* g4 = Gt + vec * 1024 + c; const LAS float* s4 = St + vec * 1024 + c;
            const unsigned lo = pk2(v[j].x * r * g4[0] + s4[0], v[j].y * r * g4[1] + s4[1]), hi = pk2(v[j].z * r * g4[2] + s4[2], v[j].w * r * g4[3] + s4[3]);
            *(GAS unsigned long long*)(XN + (size_t)row * 1024 + c) = (unsigned long long)lo | ((unsigned long long)hi << 32); }
    }
}

typedef float f32x16 __attribute__((ext_vector_type(16)));
typedef short s16x4 __attribute__((ext_vector_type(4)));
#define MFMA32(a, b, c) __builtin_amdgcn_mfma_f32_32x32x16_bf16((a), (b), (c), 0, 0, 0)
__device__ __forceinline__ bf16x8 frag_rows(LAS const unsigned char* img, int RS, int row0, int kbyte, int lane) { return *(const LAS bf16x8*)(img + (row0 + (lane & 31)) * RS + kbyte + (lane >> 5) * 16); }
__device__ __forceinline__ bf16x8 frag_tr(LAS const unsigned char* img, int RS, int k0, int col0, int lane) {
    const int h = lane >> 5, blk = (lane >> 4) & 1, q = (lane & 15) >> 2, p = lane & 3;
    LAS const unsigned char* a = img + (k0 + 8 * h + q) * RS + (col0 + 16 * blk + 4 * p) * 2;
    const s16x4 lo = __builtin_amdgcn_ds_read_tr16_b64_v4i16((LAS s16x4*)a), hi = __builtin_amdgcn_ds_read_tr16_b64_v4i16((LAS s16x4*)(a + 4 * RS));
    return (bf16x8){lo[0], lo[1], lo[2], lo[3], hi[0], hi[1], hi[2], hi[3]};
}
__device__ __forceinline__ int arow(int reg, int h) { return (reg & 3) + 8 * (reg >> 2) + 4 * h; }
__device__ __forceinline__ void store_acc_nat(const f32x16& acc, LAS unsigned char* img, int RS, int n0, int m0, int lane) {
    LAS unsigned char* base = img + (n0 + (lane & 31)) * RS + (m0 + 4 * (lane >> 5)) * 2;
#pragma unroll
    for (int g = 0; g < 4; ++g) *(LAS unsigned long long*)(base + 16 * g) = (unsigned long long)pk2(acc[4 * g], acc[4 * g + 1]) | ((unsigned long long)pk2(acc[4 * g + 2], acc[4 * g + 3]) << 32);
}

struct ScanPtrs { const bf16* XBC; const float* DT; bf16* ZQ; const bf16* V; const bf16* G; f16* Flat; f16* Fctx; float* STATS; const float* convw; const float* convb; const float* ssdd; const float* hgn;
                  bf16* SSD_ST; bf16* HG_ST; float* SSD_DEC; float* HG_DEC; const bf16* BCC; };
template <int MODE, int D>
__device__ __forceinline__ void ssd_scan(const ScanPtrs& sp, LAS unsigned char* lds, int row_begin, int nchunks, int seq_lo, int seq_hi, int h, const bf16* st_in, bf16* st_out, float* dec_out, int tid) {
    const int lane = tid & 63, wave = __builtin_amdgcn_readfirstlane(tid >> 6), hf = lane >> 5, g = h >> 3;
    LAS unsigned short* YF = (LAS unsigned short*)lds; LAS unsigned char* XI = lds + 65536; LAS unsigned char* XE = lds + 74752; LAS unsigned char* BI = lds + 83968; LAS unsigned char* CI = lds + 101376; LAS unsigned char* MI = lds + 118784;
    LAS unsigned char* SPI = lds + 128000; LAS float* YB = (LAS float*)(lds + 101376); LAS unsigned char* XR = lds + 145408; LAS float* WT = (LAS float*)(lds + 154112);
    LAS float* AC = (LAS float*)(lds + 155648); LAS float* EA = AC + 64; LAS float* ES = AC + 128; LAS float* DTS = AC + 192;
    asm volatile("" : "+s"(nchunks));
    if (tid < 384) { const int j = tid >> 6, col = h * 64 + (tid & 63); WT[tid] = j < 5 ? sp.convw[j * 1536 + col] : sp.convb[col]; }
    const int nb = wave >> 1, pb = wave & 1;
    f32x16 accS;
#pragma unroll
    for (int r = 0; r < 16; ++r) accS[r] = st_in ? bf2f(*(const GAS unsigned short*)(st_in + (32 * nb + arow(r, hf)) * 64 + 32 * pb + (lane & 31))) : 0.f;
    if (MODE != 0) store_acc_nat(accS, SPI, 272, 32 * pb, 32 * nb, lane);
    float ltot = 0.f; const float dsk = sp.ssdd[h];
    v4u px0, px1, pb0, pb1, pc0, pc1; float pdt = 0.f, pla = 0.f;
    const v4u zero4 = {0u, 0u, 0u, 0u};
    px1 = zero4; pc0 = zero4; pc1 = zero4;
#define SSD_LDX(row_, col_) (((row_) >= seq_lo && (row_) < seq_hi) ? *(const GAS v4u*)(sp.XBC + (size_t)(row_) * 1536 + (col_)) : zero4)
#define SSD_LOAD(c_, tid) do { const int rb_ = row_begin + 64 * (c_); \
        px0 = SSD_LDX(rb_ - 2 + (tid >> 3), h * 64 + (tid & 7) * 8); if (tid < 32) px1 = SSD_LDX(rb_ + 62 + (tid >> 3), h * 64 + (tid & 7) * 8); \
        { const GAS v4u* bp_ = (const GAS v4u*)(sp.BCC + (size_t)(rb_ + (tid >> 4)) * 512 + g * 128 + (tid & 15) * 8); pb0 = bp_[0]; pb1 = bp_[32 * 64]; \
          if (MODE != 0) { pc0 = bp_[32]; pc1 = bp_[32 * 64 + 32]; } } \
        if (tid < 64) { pdt = sp.DT[(size_t)(rb_ + tid) * 64 + D * 16 + h]; pla = sp.DT[(size_t)(rb_ + tid) * 64 + 32 + D * 16 + h]; } } while (0)
    SSD_LOAD(D == 0 ? 0 : nchunks - 1, tid);
#pragma unroll 1
    for (int ci = 0; ci < nchunks; ++ci) {
        const int c = D == 0 ? ci : nchunks - 1 - ci, r0 = row_begin + 64 * c;
        int tl = tid; asm volatile("" : "+v"(tl));
        *(LAS v4u*)(XR + (tl >> 3) * 128 + (tl & 7) * 16) = px0; if (tl < 32) *(LAS v4u*)(XR + (64 + (tl >> 3)) * 128 + (tl & 7) * 16) = px1;
        if (wave == 0) {
            float x = pla;
#pragma unroll
            for (int o = 1; o < 64; o <<= 1) { const float v = D == 0 ? __shfl_up(x, o) : __shfl_down(x, o); if (D == 0 ? (lane >= o) : (lane + o < 64)) x += v; }
            const float last = __shfl(x, D == 0 ? 63 : 0);
            AC[lane] = x; EA[lane] = __expf(x); ES[lane] = pdt * __expf(last - x); DTS[lane] = pdt;
            if (lane == 0) AC[256] = __expf(last);
            ltot += last;
        }
        __syncthreads();
        { const int t = tl >> 3, o8 = (tl & 7) * 8; float a8[8];
#pragma unroll
          for (int i = 0; i < 8; ++i) a8[i] = WT[320 + o8 + i];
#pragma unroll
          for (int j = 0; j < 5; ++j) { float x8[8]; unpack8(*(const LAS v4u*)(XR + (t + j) * 128 + o8 * 2), x8);
#pragma unroll
              for (int i = 0; i < 8; ++i) a8[i] += WT[j * 64 + o8 + i] * x8[i]; }
          const float es = ES[t]; v4u w, we;
#pragma unroll
          for (int i = 0; i < 8; ++i) a8[i] = siluf(a8[i]);
          w.x = pk2(a8[0], a8[1]); w.y = pk2(a8[2], a8[3]); w.z = pk2(a8[4], a8[5]); w.w = pk2(a8[6], a8[7]);
          we.x = pk2(a8[0] * es, a8[1] * es); we.y = pk2(a8[2] * es, a8[3] * es); we.z = pk2(a8[4] * es, a8[5] * es); we.w = pk2(a8[6] * es, a8[7] * es);
          *(LAS v4u*)(XI + t * 144 + o8 * 2) = w; *(LAS v4u*)(XE + t * 144 + o8 * 2) = we; }
        { const int t = tl >> 4, o16 = (tl & 15) * 16;
          *(LAS v4u*)(BI + t * 272 + o16) = pb0; *(LAS v4u*)(BI + (32 + t) * 272 + o16) = pb1;
          if (MODE != 0) { *(LAS v4u*)(CI + t * 272 + o16) = pc0; *(LAS v4u*)(CI + (32 + t) * 272 + o16) = pc1; } }
        if (ci + 1 < nchunks) SSD_LOAD(D == 0 ? ci + 1 : nchunks - 2 - ci, tl);
        __syncthreads();
        f32x16 accY;
        const int tb = (wave & 3) >> 1, qb = wave & 1;
        if (MODE != 0) {
            if (wave >= 4) { const int sb = tb; f32x16 a;
#pragma unroll
                for (int r = 0; r < 16; ++r) a[r] = 0.f;
#pragma unroll
                for (int ks = 0; ks < 8; ++ks) a = MFMA32(frag_rows(BI, 272, 32 * sb, 32 * ks, lane), frag_rows(CI, 272, 32 * qb, 32 * ks, lane), a);
                const int t = 32 * qb + (lane & 31); const float act = AC[t];
#pragma unroll
                for (int r = 0; r < 16; ++r) { const int s2 = 32 * sb + arow(r, hf); const bool keep = D == 0 ? (s2 <= t) : (s2 >= t); a[r] = keep ? a[r] * __expf(act - AC[s2]) * DTS[s2] : 0.f; }
                store_acc_nat(a, MI, 144, 32 * qb, 32 * sb, lane);
            } else {
#pragma unroll
                for (int r = 0; r < 16; ++r) accY[r] = 0.f;
#pragma unroll
                for (int ks = 0; ks < 8; ++ks) accY = MFMA32(frag_rows(CI, 272, 32 * tb, 32 * ks, lane), frag_rows(SPI, 272, 32 * qb, 32 * ks, lane), accY);
#pragma unroll
                for (int r = 0; r < 16; ++r) accY[r] *= EA[32 * tb + arow(r, hf)];
            }
            __syncthreads();
            if (wave < 4) {
#pragma unroll
                for (int ks = 0; ks < 4; ++ks) accY = MFMA32(frag_rows(MI, 144, 32 * tb, 32 * ks, lane), frag_tr(XI, 144, 16 * ks, 32 * qb, lane), accY);
#pragma unroll
                for (int r = 0; r < 16; ++r) YB[(32 * tb + arow(r, hf)) * 68 + 32 * qb + (lane & 31)] = accY[r];
            }
        }
        { const float el = AC[256];
#pragma unroll
          for (int r = 0; r < 16; ++r) accS[r] *= el;
#pragma unroll
          for (int ks = 0; ks < 4; ++ks) accS = MFMA32(frag_tr(BI, 272, 16 * ks, 32 * nb, lane), frag_tr(XE, 144, 16 * ks, 32 * pb, lane), accS);
          if (MODE != 0) store_acc_nat(accS, SPI, 272, 32 * pb, 32 * nb, lane); }
        __syncthreads();
        if (MODE != 0) {
            int t3 = tid; asm volatile("" : "+v"(t3)); const int t = t3 >> 3, p8 = (t3 & 7) * 8, row = r0 + t;
            const f32x4 y0 = *(const LAS f32x4*)(YB + t * 68 + p8), y1 = *(const LAS f32x4*)(YB + t * 68 + p8 + 4);
            LAS v4u* yp = (LAS v4u*)(YF + (row - row_begin) * 64 + p8);
            if (MODE == 1) { v4u w; w.x = pk2(y0.x, y0.y); w.y = pk2(y0.z, y0.w); w.z = pk2(y1.x, y1.y); w.w = pk2(y1.z, y1.w); *yp = w; }
            else { float yf[8], x8[8], z8[8]; unpack8(*yp, yf); unpack8(*(const LAS v4u*)(XI + t * 144 + p8 * 2), x8);
                GAS v4u* zp = (GAS v4u*)(sp.ZQ + (size_t)row * 2048 + h * 64 + p8); unpack8(*zp, z8);
                float o[8] = {y0.x, y0.y, y0.z, y0.w, y1.x, y1.y, y1.z, y1.w}; float ss = 0.f;
#pragma unroll
                for (int i = 0; i < 8; ++i) { o[i] = (o[i] + yf[i] + dsk * x8[i]) * z8[i]; ss += o[i] * o[i]; }
                v4u w; w.x = pk2(o[0], o[1]); w.y = pk2(o[2], o[3]); w.z = pk2(o[4], o[5]); w.w = pk2(o[6], o[7]); *zp = w;
                ss += __shfl_xor(ss, 1); ss += __shfl_xor(ss, 2); ss += __shfl_xor(ss, 4);
                if ((t3 & 7) == 0) sp.STATS[(size_t)row * 16 + h] = ss; }
        }
    }
#undef SSD_LOAD
#undef SSD_LDX
    if (st_out) {
#pragma unroll
        for (int r = 0; r < 16; ++r) *(GAS unsigned short*)(st_out + (32 * nb + arow(r, hf)) * 64 + 32 * pb + (lane & 31)) = (unsigned short)f2bf(accS[r]); }
    if (dec_out && tid == 0) *dec_out = __expf(ltot);
    __syncthreads();
}
__device__ __forceinline__ void phase_convbc(const Params& p, int bid, int G, int tid) {
    const bf16* XBC = (const bf16*)(p.ws + WS_XBC); bf16* BCC = (bf16*)(p.ws + WS_BCC);
    const int gt = bid * 512 + tid, nt = G * 512, oct = gt & 63, col = 1024 + oct * 8;
    float w[5][8], b8[8];
#pragma unroll
    for (int j = 0; j < 5; ++j) { const f32x4 w0 = *(const GAS f32x4*)(p.in[I_CONVW] + j * 1536 + col), w1 = *(const GAS f32x4*)(p.in[I_CONVW] + j * 1536 + col + 4);
        w[j][0] = w0.x; w[j][1] = w0.y; w[j][2] = w0.z; w[j][3] = w0.w; w[j][4] = w1.x; w[j][5] = w1.y; w[j][6] = w1.z; w[j][7] = w1.w; }
    { const f32x4 b0 = *(const GAS f32x4*)(p.in[I_CONVB] + col), b1 = *(const GAS f32x4*)(p.in[I_CONVB] + col + 4); b8[0] = b0.x; b8[1] = b0.y; b8[2] = b0.z; b8[3] = b0.w; b8[4] = b1.x; b8[5] = b1.y; b8[6] = b1.z; b8[7] = b1.w; }
    for (int row = gt >> 6; row < M; row += nt >> 6) {
        const int lo = row < ML ? 0 : ML, hi = row < ML ? ML : M;
        float a8[8];
#pragma unroll
        for (int i = 0; i < 8; ++i) a8[i] = b8[i];
#pragma unroll
        for (int j = 0; j < 5; ++j) { const int rr = row + j - 2;
            if (rr >= lo && rr < hi) { float x8[8]; unpack8(*(const GAS v4u*)(XBC + (size_t)rr * 1536 + col), x8);
#pragma unroll
                for (int i = 0; i < 8; ++i) a8[i] += w[j][i] * x8[i]; } }
        v4u o; o.x = pk2(siluf(a8[0]), siluf(a8[1])); o.y = pk2(siluf(a8[2]), siluf(a8[3])); o.z = pk2(siluf(a8[4]), siluf(a8[5])); o.w = pk2(siluf(a8[6]), siluf(a8[7]));
        *(GAS v4u*)(BCC + (size_t)row * 512 + oct * 8) = o;
    }
}
template <int MODE, int D>
__device__ __forceinline__ void hg_scan(const ScanPtrs& sp, LAS unsigned char* lds, int row_begin, int nchunks, int hh, const bf16* st_in, bf16* st_out, float* dec_out, int tid) {
    const int lane = tid & 63, wave = __builtin_amdgcn_readfirstlane(tid >> 6), h = lane >> 5;
    LAS unsigned char* QP = lds; LAS unsigned char* KP = lds + 17408; LAS unsigned char* VI = lds + 34816; LAS unsigned char* ATT = lds + 52224; LAS unsigned char* STI = lds + 61440;
    LAS float* OB = (LAS float*)(lds + 96256); LAS float* PAR = (LAS float*)(lds + 132096); LAS float* EL = (LAS float*)(lds + 136192);
    f16* Fit = (row_begin < ML) ? sp.Flat + (size_t)row_begin * 2048 : sp.Fctx + (size_t)(row_begin - ML) * 2048;
    const int k0 = (tid & 63) * 2, tg = wave, kb = wave >> 1, vb0 = (wave & 1) * 2;
    asm volatile("" : "+s"(nchunks));
    f32x16 accS[2];
#pragma unroll
    for (int i = 0; i < 2; ++i)
#pragma unroll
        for (int r = 0; r < 16; ++r) accS[i][r] = st_in ? bf2f(*(const GAS unsigned short*)(st_in + (32 * kb + arow(r, h)) * 128 + 32 * (vb0 + i) + (lane & 31))) : 0.f;
    if (MODE != 0) { store_acc_nat(accS[0], STI, 272, 32 * vb0, 32 * kb, lane); store_acc_nat(accS[1], STI, 272, 32 * (vb0 + 1), 32 * kb, lane); }
    float ltot0 = 0.f, ltot1 = 0.f;
    unsigned plf[8], pq[8]; v4u pv0, pv1;
    const int vr = tid >> 3, vc = (tid & 7) * 16;
#define HG_LOAD(c_) do { const int rr_ = 64 * (c_); \
        _Pragma("unroll") for (int i = 0; i < 8; ++i) { plf[i] = *(const GAS unsigned*)(Fit + (size_t)(rr_ + 8 * tg + i) * 2048 + D * 1024 + hh * 128 + k0); \
            if (MODE != 0) pq[i] = *(const GAS unsigned*)(sp.ZQ + (size_t)(row_begin + rr_ + 8 * tg + i) * 2048 + 1024 + hh * 128 + k0); } \
        const GAS v4u* vp_ = (const GAS v4u*)(sp.V + (size_t)(row_begin + rr_ + vr) * 1024 + hh * 128 + vc); pv0 = vp_[0]; pv1 = vp_[1]; } while (0)
    HG_LOAD(D == 0 ? 0 : nchunks - 1);
#pragma unroll 1
    for (int ci = 0; ci < nchunks; ++ci) {
        const int c = D == 0 ? ci : nchunks - 1 - ci, r0 = 64 * c;
        float lf0[8], lf1[8], cs0[8], cs1[8]; float run0 = 0.f, run1 = 0.f;
#pragma unroll
        for (int i = 0; i < 8; ++i) { const f16x2 hr = __builtin_bit_cast(f16x2, plf[i]); lf0[i] = (float)hr.x; lf1[i] = (float)hr.y; }
#pragma unroll
        for (int ii = 0; ii < 8; ++ii) { const int i = D == 0 ? ii : 7 - ii; run0 += lf0[i]; run1 += lf1[i]; cs0[i] = run0; cs1[i] = run1; }
        *(LAS f32x2*)(PAR + tg * 128 + k0) = (f32x2){run0, run1};
        __syncthreads();
        float off0 = 0.f, off1 = 0.f, tot0 = 0.f, tot1 = 0.f;
#pragma unroll
        for (int j = 0; j < 8; ++j) { const f32x2 pj = *(const LAS f32x2*)(PAR + j * 128 + k0); tot0 += pj.x; tot1 += pj.y; if (D == 0 ? (j < tg) : (j > tg)) { off0 += pj.x; off1 += pj.y; } }
#pragma unroll
        for (int i = 0; i < 8; ++i) { const float bc0 = off0 + cs0[i], bc1 = off1 + cs1[i], kk0 = 1.f - __expf(lf0[i]), kk1 = 1.f - __expf(lf1[i]); const int t = 8 * tg + i;
            if (MODE != 0) *(LAS unsigned*)(QP + t * 272 + k0 * 2) = pk2(bf2f(pq[i] & 0xffffu) * __expf(bc0), bf2f(pq[i] >> 16) * __expf(bc1));
            *(LAS unsigned*)(KP + t * 272 + k0 * 2) = pk2(kk0 * __expf(-bc0), kk1 * __expf(-bc1)); }
        if (tg == 0) { *(LAS f32x2*)(EL + k0) = (f32x2){__expf(tot0), __expf(tot1)}; ltot0 += tot0; ltot1 += tot1; }
        *(LAS v4u*)(VI + vr * 272 + vc * 2) = pv0; *(LAS v4u*)(VI + vr * 272 + vc * 2 + 16) = pv1;
        if (ci + 1 < nchunks) HG_LOAD(D == 0 ? ci + 1 : nchunks - 2 - ci);
        __syncthreads();
        f32x16 accO;
        if (MODE != 0) {
            if (wave < 4) { const int sb = wave >> 1, tb = wave & 1; f32x16 a;
#pragma unroll
                for (int r = 0; r < 16; ++r) a[r] = 0.f;
#pragma unroll
                for (int ks = 0; ks < 8; ++ks) a = MFMA32(frag_rows(KP, 272, 32 * sb, 32 * ks, lane), frag_rows(QP, 272, 32 * tb, 32 * ks, lane), a);
                const int t = 32 * tb + (lane & 31);
#pragma unroll
                for (int r = 0; r < 16; ++r) { const int s = 32 * sb + arow(r, h); if (D == 0 ? (s > t) : (s < t)) a[r] = 0.f; }
                store_acc_nat(a, ATT, 144, 32 * tb, 32 * sb, lane); }
            const int tb = wave >> 2, vb = wave & 3;
#pragma unroll
            for (int r = 0; r < 16; ++r) accO[r] = 0.f;
#pragma unroll
            for (int ks = 0; ks < 8; ++ks) accO = MFMA32(frag_rows(QP, 272, 32 * tb, 32 * ks, lane), frag_rows(STI, 272, 32 * vb, 32 * ks, lane), accO);
            __syncthreads();
#pragma unroll
            for (int ks = 0; ks < 4; ++ks) accO = MFMA32(frag_rows(ATT, 144, 32 * tb, 32 * ks, lane), frag_tr(VI, 272, 16 * ks, 32 * vb, lane), accO);
#pragma unroll
            for (int r = 0; r < 16; ++r) OB[(32 * tb + arow(r, h)) * 132 + 32 * vb + (lane & 31)] = accO[r];
        }
#pragma unroll
        for (int ks = 0; ks < 4; ++ks) { const bf16x8 a = frag_tr(KP, 272, 16 * ks, 32 * kb, lane);
            accS[0] = MFMA32(a, frag_tr(VI, 272, 16 * ks, 32 * vb0, lane), accS[0]); accS[1] = MFMA32(a, frag_tr(VI, 272, 16 * ks, 32 * (vb0 + 1), lane), accS[1]); }
#pragma unroll
        for (int r = 0; r < 16; ++r) { const float e = EL[32 * kb + arow(r, h)]; accS[0][r] *= e; accS[1][r] *= e; }
        if (MODE != 0) { store_acc_nat(accS[0], STI, 272, 32 * vb0, 32 * kb, lane); store_acc_nat(accS[1], STI, 272, 32 * (vb0 + 1), 32 * kb, lane); }
        __syncthreads();
        if (MODE != 0) {
            const int t = tid >> 3, c16 = (tid & 7) * 16, row = row_begin + r0 + t;
            float o[16];
#pragma unroll
            for (int j = 0; j < 4; ++j) { const f32x4 x = *(const LAS f32x4*)(OB + t * 132 + c16 + 4 * j); o[4 * j] = x.x; o[4 * j + 1] = x.y; o[4 * j + 2] = x.z; o[4 * j + 3] = x.w; }
            f16* fp = Fit + (size_t)(r0 + t) * 2048 + hh * 128 + c16;
            if (MODE == 1) { f16x8 a, b;
#pragma unroll
                for (int j = 0; j < 8; ++j) { a[j] = (f16)o[j]; b[j] = (f16)o[8 + j]; }
                *(GAS f16x8*)fp = a; *(GAS f16x8*)(fp + 8) = b; }
            else { const f16x8 a = *(const GAS f16x8*)fp, b = *(const GAS f16x8*)(fp + 8); float ss = 0.f;
#pragma unroll
                for (int j = 0; j < 8; ++j) { o[j] += (float)a[j]; o[8 + j] += (float)b[j]; }
#pragma unroll
                for (int j = 0; j < 16; ++j) ss += o[j] * o[j];
                ss += __shfl_xor(ss, 1); ss += __shfl_xor(ss, 2); ss += __shfl_xor(ss, 4);
                const float rn = rsqrtf(ss * (1.f / 128.f) + EPS);
                float g8[8], g9[8]; unpack8(*(const GAS v4u*)(sp.G + (size_t)row * 1024 + hh * 128 + c16), g8); unpack8(*(const GAS v4u*)(sp.G + (size_t)row * 1024 + hh * 128 + c16 + 8), g9);
                const float* hn = sp.hgn + c16;
                v4u w0, w1;
                w0.x = pk2(o[0] * rn * hn[0] * g8[0], o[1] * rn * hn[1] * g8[1]); w0.y = pk2(o[2] * rn * hn[2] * g8[2], o[3] * rn * hn[3] * g8[3]); w0.z = pk2(o[4] * rn * hn[4] * g8[4], o[5] * rn * hn[5] * g8[5]); w0.w = pk2(o[6] * rn * hn[6] * g8[6], o[7] * rn * hn[7] * g8[7]);
                w1.x = pk2(o[8] * rn * hn[8] * g9[0], o[9] * rn * hn[9] * g9[1]); w1.y = pk2(o[10] * rn * hn[10] * g9[2], o[11] * rn * hn[11] * g9[3]); w1.z = pk2(o[12] * rn * hn[12] * g9[4], o[13] * rn * hn[13] * g9[5]); w1.w = pk2(o[14] * rn * hn[14] * g9[6], o[15] * rn * hn[15] * g9[7]);
                GAS v4u* zp = (GAS v4u*)(sp.ZQ + (size_t)row * 2048 + 1024 + hh * 128 + c16); zp[0] = w0; zp[1] = w1; }
        }
    }
#undef HG_LOAD
    if (st_out) {
#pragma unroll
        for (int i = 0; i < 2; ++i)
#pragma unroll
            for (int r = 0; r < 16; ++r) *(GAS unsigned short*)(st_out + (32 * kb + arow(r, h)) * 128 + 32 * (vb0 + i) + (lane & 31)) = (unsigned short)f2bf(accS[i][r]); }
    if (dec_out && tg == 0) { dec_out[k0] = __expf(ltot0); dec_out[k0 + 1] = __expf(ltot1); }
    __syncthreads();
}
__device__ __forceinline__ void wg_fence() { __threadfence(); __syncthreads(); }

__device__ __forceinline__ void phase_scanA1(const ScanPtrs& sp, LAS unsigned char* lds, int bid, int G, int tid) {
    for (int it = bid; it < NSC * 16; it += G) { const int sc = it >> 4, chain = it & 15, hh = chain >> 1, d = chain & 1;
        bf16* so = sp.HG_ST + ((size_t)sc * 16 + chain) * 16384; float* dc = sp.HG_DEC + (sc * 16 + chain) * 128;
        if (d == 0) hg_scan<0, 0>(sp, lds, sc * SCL, SCL / 64, hh, nullptr, so, dc, tid); else hg_scan<0, 1>(sp, lds, sc * SCL, SCL / 64, hh, nullptr, so, dc, tid); }
    for (int it = bid; it < 8; it += G) { const int hh = it;
        hg_scan<1, 0>(sp, lds, ML, MC / 64, hh, nullptr, sp.HG_ST + ((size_t)NSC * 16 + hh * 2 + 0) * 16384, nullptr, tid);
        wg_fence();
        hg_scan<2, 1>(sp, lds, ML, MC / 64, hh, nullptr, sp.HG_ST + ((size_t)NSC * 16 + hh * 2 + 1) * 16384, nullptr, tid); }
}
__device__ __forceinline__ void phase_scanA2(const ScanPtrs& sp, LAS unsigned char* lds, int bid_hw, int G, int tid) {
    const int bid = (G % 8 == 0) ? (bid_hw % 8) * (G / 8) + bid_hw / 8 : bid_hw;
    for (int it = bid; it < NSC * 32; it += G) { const int sc = it >> 5, chain = it & 31, h = chain >> 1, d = chain & 1;
        bf16* so = sp.SSD_ST + ((size_t)sc * 32 + chain) * 8192; float* dc = sp.SSD_DEC + sc * 32 + chain;
        if (d == 0) ssd_scan<0, 0>(sp, lds, sc * SCL, SCL / 64, 0, ML, h, nullptr, so, dc, tid); else ssd_scan<0, 1>(sp, lds, sc * SCL, SCL / 64, 0, ML, h, nullptr, so, dc, tid); }
    for (int it = bid; it < 16; it += G) { const int h = it;
        ssd_scan<1, 0>(sp, lds, ML, MC / 64, ML, M, h, nullptr, sp.SSD_ST + ((size_t)NSC * 32 + h * 2 + 0) * 8192, nullptr, tid);
        ssd_scan<2, 1>(sp, lds, ML, MC / 64, ML, M, h, nullptr, sp.SSD_ST + ((size_t)NSC * 32 + h * 2 + 1) * 8192, nullptr, tid); }
}
__device__ __forceinline__ void phase_scanB(const ScanPtrs& sp, int bid, int G, int tid) {
    const int gt = bid * 512 + tid, nt = G * 512;
    for (int e = gt; e < 2 * 131072; e += nt) {
        const bool hg = e >= 131072; const int e2 = hg ? e - 131072 : e;
        const int chain = hg ? (e2 >> 13) : (e2 >> 12), pr = hg ? (e2 & 8191) : (e2 & 4095), d = chain & 1;
        const int nch = hg ? 16 : 32, ppc = hg ? 8192 : 4096;
        GAS unsigned* base = (GAS unsigned*)(hg ? sp.HG_ST : sp.SSD_ST);
        const unsigned w0 = base[((size_t)NSC * nch + chain) * ppc + pr];
        float r0 = bf2f(w0 & 0xffffu), r1 = bf2f(w0 >> 16);
        for (int i0 = 0; i0 < NSC; i0 += 8) {
            unsigned loc[8]; float dec[8];
#pragma unroll
            for (int j = 0; j < 8; ++j) { const int sc = d == 0 ? i0 + j : NSC - 1 - (i0 + j); loc[j] = base[((size_t)sc * nch + chain) * ppc + pr];
                dec[j] = hg ? sp.HG_DEC[(sc * 16 + chain) * 128 + (pr >> 6)] : sp.SSD_DEC[sc * 32 + chain]; }
#pragma unroll
            for (int j = 0; j < 8; ++j) { const int sc = d == 0 ? i0 + j : NSC - 1 - (i0 + j); base[((size_t)sc * nch + chain) * ppc + pr] = pk2(r0, r1);
                r0 = r0 * dec[j] + bf2f(loc[j] & 0xffffu); r1 = r1 * dec[j] + bf2f(loc[j] >> 16); }
        }
    }
}
__device__ __forceinline__ void phase_scanC(const ScanPtrs& sp, LAS unsigned char* lds, int bid_hw, int G, int tid) {
    const int bid = (G % 8 == 0) ? (bid_hw % 8) * (G / 8) + bid_hw / 8 : bid_hw;
    for (int it = bid; it < NSC * 8; it += G) { const int sc = it >> 3, hh = it & 7;
        hg_scan<1, 0>(sp, lds, sc * SCL, SCL / 64, hh, sp.HG_ST + ((size_t)sc * 16 + hh * 2 + 0) * 16384, nullptr, nullptr, tid);
        wg_fence();
        hg_scan<2, 1>(sp, lds, sc * SCL, SCL / 64, hh, sp.HG_ST + ((size_t)sc * 16 + hh * 2 + 1) * 16384, nullptr, nullptr, tid); }
    for (int it = bid; it < NSC * 16; it += G) { const int sc = it >> 4, h = it & 15;
        ssd_scan<1, 0>(sp, lds, sc * SCL, SCL / 64, 0, ML, h, sp.SSD_ST + ((size_t)sc * 32 + h * 2 + 0) * 8192, nullptr, nullptr, tid);
        ssd_scan<2, 1>(sp, lds, sc * SCL, SCL / 64, 0, ML, h, sp.SSD_ST + ((size_t)sc * 32 + h * 2 + 1) * 8192, nullptr, nullptr, tid); }
}
__device__ __forceinline__ void phase_finish(const Params& p, LAS unsigned char* lds, int bid, int G, int tid, int wave, int lane) {
    unsigned char* ws = p.ws; bf16* ZQ = (bf16*)(ws + WS_ZQ); const float* stats = (const float*)(ws + WS_SMALL + SM_STATS); const float* sng = p.in[I_SSDN];
    const int gw = bid * NWAVES + wave, ngw = G * NWAVES;
    for (int row = gw; row < M; row += ngw) {
        const int grp = lane >> 5; const float* s8 = stats + (size_t)row * 16 + grp * 8;
        const float ss = ((s8[0] + s8[1]) + (s8[2] + s8[3])) + ((s8[4] + s8[5]) + (s8[6] + s8[7]));
        const float r = rsqrtf(ss * (1.f / 512.f) + EPS);
        GAS v4u* zp = (GAS v4u*)(ZQ + (size_t)row * 2048 + lane * 16);
#pragma unroll
        for (int q = 0; q < 2; ++q) { float x8[8]; unpack8(zp[q], x8); const float* g8 = sng + lane * 16 + q * 8;
            v4u o; o.x = pk2(x8[0] * r * g8[0], x8[1] * r * g8[1]); o.y = pk2(x8[2] * r * g8[2], x8[3] * r * g8[3]); o.z = pk2(x8[4] * r * g8[4], x8[5] * r * g8[5]); o.w = pk2(x8[6] * r * g8[6], x8[7] * r * g8[7]); zp[q] = o; }
    }
    LAS float* scr = (LAS float*)(lds + wave * 16384); unsigned char* wr = ws + WS_WREST;
    tr_job(p.in[I_EVOUT], 2048, 1024, 1, (bf16*)(wr + WO_OUT), scr, gw, ngw, lane);
    tr_job(p.in[I_WGATE], 1024, DFF, 2, (bf16*)(wr + WO_UP0), scr, gw, ngw, lane);
    tr_job(p.in[I_WUP], 1024, DFF, 3, (bf16*)(wr + WO_UP0), scr, gw, ngw, lane);
    tr_job(p.in[I_WDOWN], DFF, 1024, 1, (bf16*)(wr + WO_DOWN0), scr, gw, ngw, lane);
    tr_job(p.in[I_ODIN], 1024, 512, 1, (bf16*)(wr + WO_OD), scr, gw, ngw, lane);
    tr_job(p.in[I_WVAL], 512, 1024, 2, (bf16*)(wr + WO_VG), scr, gw, ngw, lane);
    tr_job(p.in[I_WGATE2], 512, 1024, 3, (bf16*)(wr + WO_VG), scr, gw, ngw, lane);
    tr_job(p.in[I_WGATE] + (size_t)1024 * DFF, 1024, DFF, 2, (bf16*)(wr + WO_UP1), scr, gw, ngw, lane);
    tr_job(p.in[I_WUP] + (size_t)1024 * DFF, 1024, DFF, 3, (bf16*)(wr + WO_UP1), scr, gw, ngw, lane);
    tr_job(p.in[I_WDOWN] + (size_t)DFF * 1024, DFF, 1024, 1, (bf16*)(wr + WO_DOWN1), scr, gw, ngw, lane);
}

struct S5Ptrs { const bf16* U; float* YS; bf16* A2; const float* LAM; const float* LAMP; const bf16* BBH; const bf16* CMH; const float* S5D; float* ST; };
template <int MODE, int D>
__device__ __forceinline__ void s5_wave(const S5Ptrs& sp, LAS unsigned char* SI  , int row0  , int g, int slot0, int lane) {
    const int n = lane & 31, hs = lane >> 5, dg = D * 32 + g;
    bf16x8 bq[4];
#pragma unroll
    for (int q = 0; q < 4; ++q) bq[q] = *(const GAS bf16x8*)(sp.BBH + ((size_t)(dg * 64 + (q & 1) * 32 + n) * 2 + (q >> 1)) * 16 + 8 * hs);
    bf16x8 cm[8];
    if (MODE != 0) {
#pragma unroll
        for (int ks = 0; ks < 8; ++ks) cm[ks] = n < 16 ? *(const GAS bf16x8*)(sp.CMH + ((size_t)(dg * 16 + n) * 128 + 16 * ks + 8 * hs)) : (bf16x8){0, 0, 0, 0, 0, 0, 0, 0}; }
    const float lr0 = sp.LAM[2 * (dg * 64 + n)], li0 = sp.LAM[2 * (dg * 64 + n) + 1], lr1 = sp.LAM[2 * (dg * 64 + 32 + n)], li1 = sp.LAM[2 * (dg * 64 + 32 + n) + 1];
    float hr0 = 0.f, hi0 = 0.f, hr1 = 0.f, hi1 = 0.f;
    float* stp = sp.ST + ((size_t)((slot0 + hs) * 2 + D) * 2048 + g * 64 + n) * 2;
    if (MODE != 0) { const f32x2 a = *(const GAS f32x2*)stp, b = *(const GAS f32x2*)(stp + 64); hr0 = a.x; hi0 = a.y; hr1 = b.x; hi1 = b.y; }
    const int astream = (n >> 2) & 1, aidx = 4 * (n >> 3) + (n & 3);
    const bf16* ua = sp.U + (size_t)(row0 + 128 * astream) * 512 + g * 16 + 8 * hs;
    bf16x8 afr = *(const GAS bf16x8*)(ua + (size_t)(D == 0 ? aidx : 127 - aidx) * 512);
#pragma unroll 1
    for (int i = 0; i < 8; ++i) {
        f32x16 acc[4];
#pragma unroll
        for (int q = 0; q < 4; ++q) {
#pragma unroll
            for (int r = 0; r < 16; ++r) acc[q][r] = 0.f;
            acc[q] = MFMA32(afr, bq[q], acc[q]); }
        if (i < 7) afr = *(const GAS bf16x8*)(ua + (size_t)(D == 0 ? 16 * (i + 1) + aidx : 127 - 16 * (i + 1) - aidx) * 512);
#pragma unroll
        for (int j = 0; j < 16; ++j) {
            const float nr0 = lr0 * hr0 - li0 * hi0 + acc[0][j], ni0 = lr0 * hi0 + li0 * hr0 + acc[2][j]; hr0 = nr0; hi0 = ni0; acc[0][j] = nr0; acc[2][j] = ni0;
            const float nr1 = lr1 * hr1 - li1 * hi1 + acc[1][j], ni1 = lr1 * hi1 + li1 * hr1 + acc[3][j]; hr1 = nr1; hi1 = ni1; acc[1][j] = nr1; acc[3][j] = ni1; }
        if (MODE != 0) {
            store_acc_nat(acc[0], SI, 72, 0, 0, lane); store_acc_nat(acc[1], SI, 72, 32, 0, lane); store_acc_nat(acc[2], SI, 72, 64, 0, lane); store_acc_nat(acc[3], SI, 72, 96, 0, lane);
            asm volatile("s_waitcnt lgkmcnt(0)" ::: "memory");
            f32x16 y;
#pragma unroll
            for (int r = 0; r < 16; ++r) y[r] = 0.f;
#pragma unroll
            for (int ks = 0; ks < 8; ++ks) y = MFMA32(frag_tr(SI, 72, 16 * ks, 0, lane), cm[ks], y);
            asm volatile("" ::: "memory");
            LAS float* YT = (LAS float*)(SI + 9216);
            if (n < 16) {
#pragma unroll
                for (int j = 0; j < 16; ++j) YT[arow(j, hs) * 20 + n] = y[j]; }
            asm volatile("s_waitcnt lgkmcnt(0)" ::: "memory");
            { const int m = lane >> 1, c8 = (lane & 1) * 8, ms = (m >> 2) & 1, mi = 4 * (m >> 3) + (m & 3);
              const int pos = D == 0 ? 16 * i + mi : 127 - 16 * i - mi, row = row0 + 128 * ms + pos;
              const f32x4 ya = *(const LAS f32x4*)(YT + m * 20 + c8), yb2 = *(const LAS f32x4*)(YT + m * 20 + c8 + 4);
              LAS v4u* yfp = (LAS v4u*)(SI + 11776 + (128 * ms + pos) * 32 + c8 * 2);
              if (MODE == 1) { v4u w; w.x = pk2(ya.x, ya.y); w.y = pk2(ya.z, ya.w); w.z = pk2(yb2.x, yb2.y); w.w = pk2(yb2.z, yb2.w); *yfp = w; }
              else { float f8[8]; unpack8(*yfp, f8); const f32x4 fa = {f8[0], f8[1], f8[2], f8[3]}, fb = {f8[4], f8[5], f8[6], f8[7]}; float u8[8]; unpack8(*(const GAS v4u*)(sp.U + (size_t)row * 512 + g * 16 + c8), u8);
                  const f32x4 d0 = *(const GAS f32x4*)(sp.S5D + g * 16 + c8), d1 = *(const GAS f32x4*)(sp.S5D + g * 16 + c8 + 4);
                  float v[8] = {ya.x + fa.x + d0.x * u8[0], ya.y + fa.y + d0.y * u8[1], ya.z + fa.z + d0.z * u8[2], ya.w + fa.w + d0.w * u8[3], yb2.x + fb.x + d1.x * u8[4], yb2.y + fb.y + d1.y * u8[5], yb2.z + fb.z + d1.z * u8[6], yb2.w + fb.w + d1.w * u8[7]};
#pragma unroll
                  for (int q = 0; q < 8; ++q) { const float tt = 0.7978845608f * (v[q] + 0.044715f * v[q] * v[q] * v[q]); v[q] = v[q] * (1.f - __builtin_amdgcn_rcpf(__expf(2.f * tt) + 1.f)); }
                  v4u w; w.x = pk2(v[0], v[1]); w.y = pk2(v[2], v[3]); w.z = pk2(v[4], v[5]); w.w = pk2(v[6], v[7]);
                  *(GAS v4u*)(sp.A2 + (size_t)row * 512 + g * 16 + c8) = w; } }
        }
    }
    if (MODE == 0) { *(GAS f32x2*)stp = (f32x2){hr0, hi0}; *(GAS f32x2*)(stp + 64) = (f32x2){hr1, hi1}; }
}
__device__ __forceinline__ void phase_s5A(const S5Ptrs& sp, LAS unsigned char* lds, int bid, int G, int wave, int lane) {
    LAS unsigned char* SI = lds + wave * 19968;
    for (int it = bid; it < 65 * 8; it += G) { const int col = it >> 3, gb = (it >> 1) & 3, d = it & 1, g = gb * 8 + wave;
        const int row0 = col < 64 ? col * 256 : ML, slot0 = col < 64 ? 2 * col : 128;
        if (d == 0) s5_wave<0, 0>(sp, SI, row0, g, slot0, lane); else s5_wave<0, 1>(sp, SI, row0, g, slot0, lane); }
}
__device__ __forceinline__ void phase_s5B(const S5Ptrs& sp, int bid, int G, int tid) {
    const int gt = bid * 512 + tid;
    if (gt < 4096) { const int d = gt >> 11, gp = gt & 2047, s = d * 2048 + gp; const float pr = sp.LAMP[2 * s], pi = sp.LAMP[2 * s + 1];
        GAS f32x2* st = (GAS f32x2*)sp.ST; f32x2 run = {0.f, 0.f};
        for (int i0 = 0; i0 < 130; i0 += 10) { f32x2 loc[10];
#pragma unroll
            for (int j = 0; j < 10; ++j) { const int q = i0 + j, slot = d == 0 ? (q < 2 ? 128 + q : q - 2) : (q < 2 ? 129 - q : 129 - q); loc[j] = st[(size_t)(slot * 2 + d) * 2048 + gp]; }
#pragma unroll
            for (int j = 0; j < 10; ++j) { const int q = i0 + j, slot = d == 0 ? (q < 2 ? 128 + q : q - 2) : (q < 2 ? 129 - q : 129 - q); st[(size_t)(slot * 2 + d) * 2048 + gp] = run;
                const float nr = pr * run.x - pi * run.y + loc[j].x, ni = pr * run.y + pi * run.x + loc[j].y; run.x = nr; run.y = ni; } }
    }
}
__device__ __forceinline__ void phase_s5C(const S5Ptrs& sp, LAS unsigned char* lds, int bid, int G, int wave, int lane) {
    LAS unsigned char* SI = lds + wave * 19968;
    for (int it = bid; it < 256; it += G) { const int col = it >> 2, g = (it & 3) * 8 + wave;
        s5_wave<1, 0>(sp, SI, col * 256, g, 2 * col, lane);
        asm volatile("s_waitcnt lgkmcnt(0)" ::: "memory");
        s5_wave<2, 1>(sp, SI, col * 256, g, 2 * col, lane); }
}
__device__ __forceinline__ void phase_final(const Params& p, int bid, int G, int wave, int lane) {
    const int gw = bid * NWAVES + wave, ngw = G * NWAVES; const float* fg = p.in[I_FNORM];
    for (int row = gw; row < ML; row += ngw) { float* xr = p.out + (size_t)row * 1024;
        f32x4 v[4]; float ss = 0.f;
#pragma unroll
        for (int j = 0; j < 4; ++j) { v[j] = *(const GAS f32x4*)(xr + 4 * lane + 256 * j); ss += (v[j].x * v[j].x + v[j].y * v[j].y) + (v[j].z * v[j].z + v[j].w * v[j].w); }
        const float r = rsqrtf(wave_sum(ss) * (1.f / 1024.f) + EPS);
#pragma unroll
        for (int j = 0; j < 4; ++j) { const f32x4 g4 = *(const GAS f32x4*)(fg + 4 * lane + 256 * j); *(GAS f32x4*)(xr + 4 * lane + 256 * j) = (f32x4){v[j].x * r * g4.x, v[j].y * r * g4.y, v[j].z * r * g4.z, v[j].w * r * g4.w}; }
    }
}

__device__ __forceinline__ void ctx_mini_gemm(LAS unsigned char* lds, const bf16* A, const bf16* Bt, int K, const float* base, float* out, const float* gate, int bid, int G, int tid) {
    const int lane = tid & 63, wave = __builtin_amdgcn_readfirstlane(tid >> 6), hf = lane >> 5;
    LAS float* red = (LAS float*)lds;
    for (int t = bid; t < 256; t += G) {
        const int rb = t >> 5, cb = t & 31, kw = K >> 3;
        const bf16* ap = A + (size_t)(32 * rb + (lane & 31)) * K + wave * kw + 8 * hf;
        const bf16* bp = Bt + (size_t)(32 * cb + (lane & 31)) * K + wave * kw + 8 * hf;
        f32x16 acc;
#pragma unroll
        for (int r = 0; r < 16; ++r) acc[r] = 0.f;
        for (int k0 = 0; k0 < kw; k0 += 64) {
            bf16x8 af[4], bfr[4];
#pragma unroll
            for (int q = 0; q < 4; ++q) if (k0 + 16 * q < kw) { af[q] = *(const GAS bf16x8*)(ap + k0 + 16 * q); bfr[q] = *(const GAS bf16x8*)(bp + k0 + 16 * q); }
#pragma unroll
            for (int q = 0; q < 4; ++q) if (k0 + 16 * q < kw) acc = MFMA32(af[q], bfr[q], acc);
        }
#pragma unroll
        for (int r = 0; r < 16; ++r) red[(wave * 32 + arow(r, hf)) * 33 + (lane & 31)] = acc[r];
        __syncthreads();
#pragma unroll
        for (int q = 0; q < 2; ++q) { const int e = tid + 512 * q, r = e >> 5, c = e & 31; float v = 0.f;
#pragma unroll
            for (int w = 0; w < 8; ++w) v += red[(w * 32 + r) * 33 + c];
            const size_t o = (size_t)(32 * rb + r) * 1024 + 32 * cb + c; out[o] = base[o] + gate[32 * cb + c] * v; }
        __syncthreads();
    }
}
constexpr int N_PHASES = 22;
__device__ __forceinline__ void run_gmix(const Params& p, LAS unsigned char* lds, int bid, int G) {
    unsigned char* ws = p.ws;
    pg8::Gemm g{(const bf16*)(ws + WS_RX), (const bf16*)(ws + WS_WIN), M, NINP, 1024}; pg8::StaticOrder S; S.init(M, NINP, G, bid);
    pg8::EpiMix1 E{(bf16*)(ws + WS_ZQ), (bf16*)(ws + WS_XBC), (bf16*)(ws + WS_V), (bf16*)(ws + WS_G), (f16*)p.out, (f16*)(ws + WS_FCTX), (float*)(ws + WS_DT), (const float*)(ws + WS_SMALL + SM_LB), p.in[I_DTB], p.in[I_ALOG]};
    pg8::gemm_phase<pg8::EpiMix1, pg8::StaticOrder, true, true>(lds + RING_OFF, g, S, E);
}
__device__ __forceinline__ void run_gout(const Params& p, LAS unsigned char* lds, int bid, int G, int tid) {
    unsigned char* ws = p.ws; const float* mods = (const float*)(ws + WS_SMALL + SM_MODS);
    pg8::Gemm g{(const bf16*)(ws + WS_ZQ), (const bf16*)(ws + WS_WREST + WO_OUT), ML, 1024, 2048}; pg8::StaticOrder S; S.init(ML, 1024, G, bid);
    pg8::EpiResid E{p.in[I_X], p.in[I_CTX], p.out, (float*)(ws + WS_HCTX), mods + (0 * 2 + 0) * 6144 + 2 * 1024, mods + (0 * 2 + 1) * 6144 + 2 * 1024};
    pg8::gemm_phase<pg8::EpiResid, pg8::StaticOrder, true, true>(lds + RING_OFF, g, S, E);
    ctx_mini_gemm(lds, (const bf16*)(ws + WS_ZQ) + (size_t)ML * 2048, (const bf16*)(ws + WS_WREST + WO_OUT), 2048, p.in[I_CTX], (float*)(ws + WS_HCTX), mods + (0 * 2 + 1) * 6144 + 2 * 1024, bid, G, tid);
}
__device__ __forceinline__ void run_gup(const Params& p, LAS unsigned char* lds, int bid, int G, int layer) {
    unsigned char* ws = p.ws; const int rows = layer ? ML : M;
    pg8::Gemm g{(const bf16*)(ws + WS_RX), (const bf16*)(ws + WS_WREST + (layer ? WO_UP1 : WO_UP0)), rows, 2 * DFF, 1024}; pg8::StaticOrder S; S.init(rows, 2 * DFF, G, bid);
    pg8::EpiSwiglu E{(bf16*)(ws + WS_HID)};
    pg8::gemm_phase<pg8::EpiSwiglu, pg8::StaticOrder, true, true>(lds + RING_OFF, g, S, E);
}
__device__ __forceinline__ void run_gdown(const Params& p, LAS unsigned char* lds, int bid, int G, int layer, int tid) {
    unsigned char* ws = p.ws; const float* mods = (const float*)(ws + WS_SMALL + SM_MODS); float* Hctx = (float*)(ws + WS_HCTX);
    pg8::Gemm g{(const bf16*)(ws + WS_HID), (const bf16*)(ws + WS_WREST + (layer ? WO_DOWN1 : WO_DOWN0)), ML, 1024, DFF}; pg8::StaticOrder S; S.init(ML, 1024, G, bid);
    pg8::EpiResid E{p.out, Hctx, p.out, Hctx, mods + (layer * 2 + 0) * 6144 + 5 * 1024, mods + (layer * 2 + 1) * 6144 + 5 * 1024};
    pg8::gemm_phase<pg8::EpiResid, pg8::StaticOrder, true, true>(lds + RING_OFF, g, S, E);
    if (layer == 0) ctx_mini_gemm(lds, (const bf16*)(ws + WS_HID) + (size_t)ML * DFF, (const bf16*)(ws + WS_WREST + WO_DOWN0), DFF, Hctx, Hctx, mods + (0 * 2 + 1) * 6144 + 5 * 1024, bid, G, tid);
}
__device__ __forceinline__ void run_god(const Params& p, LAS unsigned char* lds, int bid, int G) {
    unsigned char* ws = p.ws;
    pg8::Gemm g{(const bf16*)(ws + WS_RX), (const bf16*)(ws + WS_WREST + WO_OD), M, 512, 1024}; pg8::StaticOrder S; S.init(M, 512, G, bid);
    pg8::EpiU E{(bf16*)(ws + WS_U)};
    pg8::gemm_phase<pg8::EpiU, pg8::StaticOrder, true, true>(lds + RING_OFF, g, S, E);
}
__device__ __forceinline__ void run_gvg(const Params& p, LAS unsigned char* lds, int bid, int G) {
    unsigned char* ws = p.ws; const float* mods = (const float*)(ws + WS_SMALL + SM_MODS);
    pg8::Gemm g{(const bf16*)(ws + WS_A2), (const bf16*)(ws + WS_WREST + WO_VG), ML, 2048, 512}; pg8::StaticOrder S; S.init(ML, 2048, G, bid);
    pg8::EpiValGate E{p.out, mods + (1 * 2 + 0) * 6144 + 2 * 1024};
    pg8::gemm_phase<pg8::EpiValGate, pg8::StaticOrder, true, true>(lds + RING_OFF, g, S, E);
}
__device__ __forceinline__ ScanPtrs make_scanptrs(const Params& p) {
    unsigned char* ws = p.ws; ScanPtrs sp; sp.XBC = (const bf16*)(ws + WS_XBC); sp.DT = (const float*)(ws + WS_DT); sp.ZQ = (bf16*)(ws + WS_ZQ); sp.V = (const bf16*)(ws + WS_V); sp.G = (const bf16*)(ws + WS_G); sp.Flat = (f16*)p.out; sp.Fctx = (f16*)(ws + WS_FCTX);
    sp.STATS = (float*)(ws + WS_SMALL + SM_STATS); sp.convw = p.in[I_CONVW]; sp.convb = p.in[I_CONVB]; sp.ssdd = p.in[I_SSDD]; sp.hgn = p.in[I_HGN];
    sp.SSD_ST = (bf16*)(ws + WS_RX); sp.HG_ST = (bf16*)(ws + WS_RX + SSD_ST_BYTES); sp.SSD_DEC = (float*)(ws + WS_SMALL + SM_SSDDEC); sp.HG_DEC = (float*)(ws + WS_SMALL + SM_HGDEC); sp.BCC = (const bf16*)(ws + WS_BCC); return sp;
}
__device__ __forceinline__ S5Ptrs make_s5ptrs(const Params& p) {
    unsigned char* ws = p.ws; S5Ptrs s5; s5.U = (const bf16*)(ws + WS_U); s5.YS = (float*)(ws + WS_YS); s5.A2 = (bf16*)(ws + WS_A2); s5.LAM = (const float*)(ws + WS_SMALL + SM_LAM); s5.LAMP = (const float*)(ws + WS_SMALL + SM_LAMP);
    s5.BBH = (const bf16*)(ws + WS_SMALL + SM_BB); s5.CMH = (const bf16*)(ws + WS_SMALL + SM_BB + 262144); s5.S5D = p.in[I_S5D]; s5.ST = (float*)(ws + WS_SMALL + SM_S5ST); return s5;
}
__global__ void __launch_bounds__(NWAVES * 64, 2) mk_fwd(Params p) {
    extern __shared__ __attribute__((aligned(16))) unsigned char lds_raw[];
    LAS unsigned char* lds = (LAS unsigned char*)lds_raw;
    volatile LAS unsigned* MISC = (volatile LAS unsigned*)(lds + MISC_OFF);
    const int tid = threadIdx.x, lane = tid & 63, wave = __builtin_amdgcn_readfirstlane(tid >> 6), G = gridDim.x, bid = blockIdx.x;
    gu32* ctl = (gu32*)(p.ws + WS_CTL);
    for (int u = tid; u < (LDS_BYTES - LDSCTL_OFF) / 4; u += NWAVES * 64) ((LAS unsigned*)(lds + LDSCTL_OFF))[u] = 0u;
    __syncthreads();
    XcdBarrier bar; bar.bar = (unsigned*)(ctl + CW_BAR); bar.x = 0; bar.st = nullptr;
    if (p.use_bar) bar = xcd_barrier_post((unsigned*)(ctl + CW_BAR), MISC + 8);
    const int lo = p.ph_lo, hi = p.ph_hi;
#ifndef MK_ONLYPH
#define MK_ONLYPH -1
#endif
#define IN(k) ((MK_ONLYPH < 0 || MK_ONLYPH == (k)) && lo <= (k) && (k) < hi)
#define SEAM(k) do { if ((k) + 1 < hi) xcd_barrier(bar); } while (0)
    if (IN(0)) { phase_prologue(p, lds, bid, G, tid, wave, lane); SEAM(0); }
    if (IN(1)) { phase_rownorm(p, lds, bid, G, tid, wave, lane, 0, 0, M, p.in[I_X], p.in[I_CTX], true); SEAM(1); }
    if (IN(2)) { run_gmix(p, lds, bid, G); SEAM(2); }
    if (IN(3)) { phase_convbc(p, bid, G, tid); const ScanPtrs sp = make_scanptrs(p); phase_scanA1(sp, lds, bid, G, tid); SEAM(3); }
    if (IN(4)) { const ScanPtrs sp = make_scanptrs(p); phase_scanA2(sp, lds, bid, G, tid); SEAM(4); }
    if (IN(5)) { const ScanPtrs sp = make_scanptrs(p); phase_scanB(sp, bid, G, tid); SEAM(5); }
    if (IN(6)) { const ScanPtrs sp = make_scanptrs(p); phase_scanC(sp, lds, bid, G, tid); SEAM(6); }
    if (IN(7)) { phase_finish(p, lds, bid, G, tid, wave, lane); SEAM(7); }
    if (IN(8)) { run_gout(p, lds, bid, G, tid); SEAM(8); }
    if (IN(9)) { phase_rownorm(p, lds, bid, G, tid, wave, lane, 0, 1, M, p.out, (const float*)(p.ws + WS_HCTX), false); SEAM(9); }
    if (IN(10)) { run_gup(p, lds, bid, G, 0); SEAM(10); }
    if (IN(11)) { run_gdown(p, lds, bid, G, 0, tid); SEAM(11); }
    if (IN(12)) { phase_rownorm(p, lds, bid, G, tid, wave, lane, 1, 0, M, p.out, (const float*)(p.ws + WS_HCTX), false); SEAM(12); }
    if (IN(13)) { run_god(p, lds, bid, G); SEAM(13); }
    if (IN(14)) { const S5Ptrs s5 = make_s5ptrs(p); phase_s5A(s5, lds, bid, G, wave, lane); SEAM(14); }
    if (IN(15)) { const S5Ptrs s5 = make_s5ptrs(p); phase_s5B(s5, bid, G, tid); SEAM(15); }
    if (IN(16)) { const S5Ptrs s5 = make_s5ptrs(p); phase_s5C(s5, lds, bid, G, wave, lane); SEAM(16); }
    if (IN(17)) { run_gvg(p, lds, bid, G); SEAM(17); }
    if (IN(18)) { phase_rownorm(p, lds, bid, G, tid, wave, lane, 1, 1, ML, p.out, (const float*)(p.ws + WS_HCTX), false); SEAM(18); }
    if (IN(19)) { run_gup(p, lds, bid, G, 1); SEAM(19); }
    if (IN(20)) { run_gdown(p, lds, bid, G, 1, tid); SEAM(20); }
    if (IN(21)) { phase_final(p, bid, G, wave, lane); }
#undef IN
#undef SEAM
}

extern "C" void kernel_launch(void* const* d_in, const int* in_sizes, int n_in, void* d_out, int out_size, void* d_ws, size_t ws_size, hipStream_t stream) {
    static int grid = 0;
    if (grid == 0) {
        if (n_in != 33 || out_size != ML * D || ws_size < 256 * MiB) { fprintf(stderr, "kernel_launch: unexpected shapes (n_in %d, out %d, ws %zu); nothing launched\n", n_in, out_size, ws_size); grid = -1; return; }
        int dev = 0, cus = 0, per_cu = 0;
        if (hipGetDevice(&dev) != hipSuccess || hipDeviceGetAttribute(&cus, hipDeviceAttributeMultiprocessorCount, dev) != hipSuccess) { grid = -1; return; }
        if (hipFuncSetAttribute((const void*)mk_fwd, hipFuncAttributeMaxDynamicSharedMemorySize, LDS_BYTES) != hipSuccess) { fprintf(stderr, "kernel_launch: hipFuncSetAttribute failed\n"); grid = -1; return; }
        if (hipOccupancyMaxActiveBlocksPerMultiprocessor(&per_cu, (const void*)mk_fwd, NWAVES * 64, LDS_BYTES) != hipSuccess || per_cu < 1) fprintf(stderr, "kernel_launch: occupancy query reports %d\n", per_cu);
        (void)hipGetLastError();
        grid = cus;
    }
    if (grid < 0) return;
    (void)hipMemsetAsync((char*)d_ws + WS_CTL, 0, CTL_ZERO_BYTES, stream);
    Params a{};
    for (int i = 0; i < 33; ++i) a.in[i] = (const float*)d_in[i];
    a.out = (float*)d_out; a.ws = (unsigned char*)d_ws;
#if MK_N_LAUNCHES == 1
    a.ph_lo = 0; a.ph_hi = N_PHASES; a.use_bar = 1;
    hipLaunchKernelGGL(mk_fwd, dim3(grid), dim3(NWAVES * 64), LDS_BYTES, stream, a);
#else
    for (int ph = 0; ph < N_PHASES; ++ph) { a.ph_lo = ph; a.ph_hi = ph + 1; a.use_bar = 0; hipLaunchKernelGGL(mk_fwd, dim3(grid), dim3(NWAVES * 64), LDS_BYTES, stream, a); }
#endif
}
```

```cpp
#include <hip/hip_runtime.h>
#include <cstdio>
#include <cstdint>

#ifndef MK_N_LAUNCHES
#define MK_N_LAUNCHES 1
#endif
namespace pg8 {
#define PG8_LAS __attribute__((address_space(3)))
typedef unsigned short bf16_t;
typedef short bf16x8 __attribute__((ext_vector_type(8)));
typedef float f32x4 __attribute__((ext_vector_type(4)));
typedef unsigned u32x4 __attribute__((ext_vector_type(4)));
constexpr int BM = 256, BK = 64, HALF = 128, HTB = HALF * BK * 2  , STAGE_BYTES = 8 * HTB, NXCD = 8, WGM = 8;

__host__ __device__ __forceinline__ int lds_byte(int r, int c) { const int st = (r >> 4) * 2 + (c >> 5), rr = r & 15, cc = c & 31, ob = rr * 64 + cc * 2; return st * 1024 + (ob ^ (((ob >> 9) & 1) << 5)); }
__host__ __device__ __forceinline__ void stage_rc(int b, int& R, int& C) { const int st = b / 1024, sb = b % 1024, swz = sb ^ (((sb >> 9) & 1) << 5); R = (st >> 1) * 16 + swz / 64; C = (st & 1) * 32 + (swz % 64) / 2; }
__host__ __device__ __forceinline__ int perm32(int rho) { const int n = rho >> 4, i = rho & 15; return 8 * (i >> 2) + 4 * n + (i & 3); }

struct Unit { int pm, pn; };
struct Gemm { const bf16_t* A; const bf16_t* Bt; int M, N, K; };

struct StaticOrder {
    int nM, nN, nwg, G, c;
    __host__ __device__ void init(int M, int N, int G_, int c_) { nM = M / BM; nN = N / BM; nwg = nM * nN; G = G_; c = c_; }
    __host__ __device__ bool next(int i, Unit& u) const {
        const long L = (long)i * G + c; if (L >= nwg) return false;
        int wgid = (int)L; { const int q = nwg / NXCD, r = nwg % NXCD, xcd = wgid % NXCD, off = wgid / NXCD; wgid = (xcd < r ? xcd * (q + 1) : r * (q + 1) + (xcd - r) * q) + off; }
        const int nig = WGM * nN, gid = wgid / nig, fm = gid * WGM, gsz = (nM - fm) < WGM ? (nM - fm) : WGM;
        u.pm = fm + ((wgid % nig) % gsz); u.pn = (wgid % nig) / gsz; return true;
    }
    __device__ __forceinline__ void a_ready(const Unit&) const {}
    __device__ __forceinline__ void done(const Unit&) const {}
};

__device__ __forceinline__ unsigned cvt_pk_bf16(float lo, float hi) { unsigned r; asm volatile("v_cvt_pk_bf16_f32 %0, %1, %2" : "=v"(r) : "v"(lo), "v"(hi)); return r; }
typedef float f32x2 __attribute__((ext_vector_type(2)));
typedef _Float16 f16x8 __attribute__((ext_vector_type(8)));
__device__ __forceinline__ float siluf(float x) { return x * __builtin_amdgcn_rcpf(1.f + __expf(-x)); }
__device__ __forceinline__ float sigmf(float x) { return __builtin_amdgcn_rcpf(1.f + __expf(-x)); }
__device__ __forceinline__ u32x4 pack8_bf16(const float (&x)[8]) { u32x4 w; w.x = cvt_pk_bf16(x[0], x[1]); w.y = cvt_pk_bf16(x[2], x[3]); w.z = cvt_pk_bf16(x[4], x[5]); w.w = cvt_pk_bf16(x[6], x[7]); return w; }
constexpr int EP_ML = 16384;

struct EpiMix1 {
    static constexpr bool PERM = true, AFTER_DRAIN = false;
    bf16_t* ZQ; bf16_t* XBC; bf16_t* V; bf16_t* G; _Float16* Flat; _Float16* Fctx; float* DT; const float* lb; const float* dt_bias; const float* a_log;
    template <int KIND> __device__ __forceinline__ void tile(const f32x4 (&acc)[2][2][4][2], const Unit& u, int wr, int wc, int fr, int fq, int seg_tile) const {
        const int row0 = u.pm * BM + wr * 64 + fr, cw = wc * 32 + 8 * fq;
#pragma unroll
        for (int ai = 0; ai < 2; ++ai)
#pragma unroll
            for (int m = 0; m < 4; ++m) { const int row = row0 + ai * HALF + m * 16;
#pragma unroll
                for (int bj = 0; bj < 2; ++bj) { const f32x4 v0 = acc[ai][bj][m][0], v1 = acc[ai][bj][m][1]; const int c = seg_tile * 256 + bj * HALF + cw;
                    float x[8] = {v0[0], v0[1], v0[2], v0[3], v1[0], v1[1], v1[2], v1[3]};
                    if constexpr (KIND == 0) {
#pragma unroll
                        for (int i = 0; i < 8; ++i) x[i] = siluf(x[i]);
                        *(u32x4*)(ZQ + (size_t)row * 2048 + c) = pack8_bf16(x);
                    } else if constexpr (KIND == 1) {
                        *(u32x4*)(XBC + (size_t)row * 1536 + c) = pack8_bf16(x);
                    } else if constexpr (KIND == 2) {
#pragma unroll
                        for (int i = 0; i < 8; ++i) x[i] = siluf(x[i]);
                        *(u32x4*)(ZQ + (size_t)row * 2048 + 1024 + c) = pack8_bf16(x);
                    } else if constexpr (KIND == 3) {
                        f16x8 h;
#pragma unroll
                        for (int i = 0; i < 8; ++i) { const float l = lb[(c + i) & 1023]; const float f = l + (1.f - l) * sigmf(x[i]); h[i] = (_Float16)__logf(f); }
                        _Float16* dst = (row < EP_ML) ? Flat + (size_t)row * 2048 : Fctx + (size_t)(row - EP_ML) * 2048;
                        *(f16x8*)(dst + c) = h;
                    } else if constexpr (KIND == 4) {
                        *(u32x4*)(V + (size_t)row * 1024 + c) = pack8_bf16(x);
                    } else if constexpr (KIND == 5) {
#pragma unroll
                        for (int i = 0; i < 8; ++i) x[i] = siluf(x[i]);
                        *(u32x4*)(G + (size_t)row * 1024 + c) = pack8_bf16(x);
                    } else {
                        if (bj == 0 && wc == 0) {
                            float dtv[8], la[8];
#pragma unroll
                            for (int i = 0; i < 8; ++i) { const int j = 8 * fq + i; const float r = x[i] + dt_bias[j]; dtv[i] = r > 20.f ? r : log1pf(__expf(r)); la[i] = -dtv[i] * __expf(a_log[j]); }
                            float* d = DT + (size_t)row * 64 + 8 * fq;
                            *(f32x4*)(d) = (f32x4){dtv[0], dtv[1], dtv[2], dtv[3]}; *(f32x4*)(d + 4) = (f32x4){dtv[4], dtv[5], dtv[6], dtv[7]};
                            *(f32x4*)(d + 32) = (f32x4){la[0], la[1], la[2], la[3]}; *(f32x4*)(d + 36) = (f32x4){la[4], la[5], la[6], la[7]};
                        }
                    } } }
    }
    __device__ __forceinline__ void operator()(const f32x4 (&acc)[2][2][4][2], const Unit& u, int wr, int wc, int fr, int fq) const {
        const int pn = u.pn;
        if (pn < 4) tile<0>(acc, u, wr, wc, fr, fq, pn);
        else if (pn < 10) tile<1>(acc, u, wr, wc, fr, fq, pn - 4);
        else if (pn < 14) tile<2>(acc, u, wr, wc, fr, fq, pn - 10);
        else if (pn < 22) tile<3>(acc, u, wr, wc, fr, fq, pn - 14);
        else if (pn < 26) tile<4>(acc, u, wr, wc, fr, fq, pn - 22);
        else if (pn < 30) tile<5>(acc, u, wr, wc, fr, fq, pn - 26);
        else tile<6>(acc, u, wr, wc, fr, fq, 0);
    }
};
struct EpiResid {
    static constexpr bool PERM = false, AFTER_DRAIN = false;
    const float* base_lat; const float* base_ctx; float* out_lat; float* out_ctx; const float* gate_lat; const float* gate_ctx;
    __device__ __forceinline__ void operator()(const f32x4 (&acc)[2][2][4][2], const Unit& u, int wr, int wc, int fr, int fq) const {
        const bool isc = u.pm >= 64; const float* base = isc ? base_ctx : base_lat; float* out = isc ? out_ctx : out_lat; const float* gate = isc ? gate_ctx : gate_lat;
        const int row0 = (isc ? 0 : u.pm * BM) + wr * 64 + fr, col0 = u.pn * BM + wc * 32 + 4 * fq;
        f32x4 gv[2][2];
#pragma unroll
        for (int bj = 0; bj < 2; ++bj)
#pragma unroll
            for (int n = 0; n < 2; ++n) gv[bj][n] = *(const f32x4*)(gate + col0 + bj * HALF + n * 16);
#pragma unroll
        for (int ai = 0; ai < 2; ++ai)
#pragma unroll
            for (int m = 0; m < 4; ++m) { const size_t off = (size_t)(row0 + ai * HALF + m * 16) * 1024 + col0;
#pragma unroll
                for (int bj = 0; bj < 2; ++bj)
#pragma unroll
                    for (int n = 0; n < 2; ++n) { const f32x4 b = *(const f32x4*)(base + off + bj * HALF + n * 16); *(f32x4*)(out + off + bj * HALF + n * 16) = b + gv[bj][n] * acc[ai][bj][m][n]; } }
    }
};
struct EpiSwiglu {
    static constexpr bool PERM = true, AFTER_DRAIN = false;
    bf16_t* HID;
    __device__ __forceinline__ void operator()(const f32x4 (&acc)[2][2][4][2], const Unit& u, int wr, int wc, int fr, int fq) const {
        const int row0 = u.pm * BM + wr * 64 + fr, c = u.pn * HALF + wc * 32 + 8 * fq;
#pragma unroll
        for (int ai = 0; ai < 2; ++ai)
#pragma unroll
            for (int m = 0; m < 4; ++m) { const f32x4 g0 = acc[ai][0][m][0], g1 = acc[ai][0][m][1], u0 = acc[ai][1][m][0], u1 = acc[ai][1][m][1];
                float x[8] = {siluf(g0[0]) * u0[0], siluf(g0[1]) * u0[1], siluf(g0[2]) * u0[2], siluf(g0[3]) * u0[3], siluf(g1[0]) * u1[0], siluf(g1[1]) * u1[1], siluf(g1[2]) * u1[2], siluf(g1[3]) * u1[3]};
                *(u32x4*)(HID + (size_t)(row0 + ai * HALF + m * 16) * 2816 + c) = pack8_bf16(x); }
    }
};
struct EpiU {
    static constexpr bool PERM = true, AFTER_DRAIN = false;
    bf16_t* U;
    __device__ __forceinline__ void operator()(const f32x4 (&acc)[2][2][4][2], const Unit& u, int wr, int wc, int fr, int fq) const {
        const int row0 = u.pm * BM + wr * 64 + fr, col0 = u.pn * BM + wc * 32 + 8 * fq;
#pragma unroll
        for (int ai = 0; ai < 2; ++ai)
#pragma unroll
            for (int m = 0; m < 4; ++m) { const int row = row0 + ai * HALF + m * 16; const int srow = row < EP_ML ? (row & 63) * 256 + (row >> 6) : row;
#pragma unroll
                for (int bj = 0; bj < 2; ++bj) { const f32x4 v0 = acc[ai][bj][m][0], v1 = acc[ai][bj][m][1]; float x[8] = {v0[0], v0[1], v0[2], v0[3], v1[0], v1[1], v1[2], v1[3]};
                    *(u32x4*)(U + (size_t)srow * 512 + col0 + bj * HALF) = pack8_bf16(x); } }
    }
};
struct EpiValGate {
    static constexpr bool PERM = false, AFTER_DRAIN = false;
    float* H; const float* gate;
    __device__ __forceinline__ void operator()(const f32x4 (&acc)[2][2][4][2], const Unit& u, int wr, int wc, int fr, int fq) const {
        const int row0 = u.pm * BM + wr * 64 + fr, col0 = u.pn * HALF + wc * 32 + 4 * fq;
#pragma unroll
        for (int ai = 0; ai < 2; ++ai)
#pragma unroll
            for (int m = 0; m < 4; ++m) { const int srow = row0 + ai * HALF + m * 16, token = (srow & 255) * 64 + (srow >> 8); float* hp = H + (size_t)token * 1024 + col0;
#pragma unroll
                for (int n = 0; n < 2; ++n) { const f32x4 v = acc[ai][0][m][n], g = acc[ai][1][m][n]; const f32x4 gm = *(const f32x4*)(gate + col0 + n * 16); f32x4 h = *(const f32x4*)(hp + n * 16);
                    h[0] += gm[0] * v[0] * sigmf(g[0]); h[1] += gm[1] * v[1] * sigmf(g[1]); h[2] += gm[2] * v[2] * sigmf(g[2]); h[3] += gm[3] * v[3] * sigmf(g[3]); *(f32x4*)(hp + n * 16) = h; } }
    }
};
template <class Epi, class Sched, bool ALIGN_EPI = false, bool SP2 = false>
__device__ __forceinline__ void gemm_phase(PG8_LAS unsigned char* lds, const Gemm g, const Sched& S, const Epi& E) {
    const int tid = threadIdx.x, wid = __builtin_amdgcn_readfirstlane(tid >> 6), lane = tid & 63, wr = wid >> 2, wc = wid & 3, fr = lane & 15, fq = lane >> 4;
    const int K = g.K, nt = K / BK;
    unsigned voffA[2], voffB[2];
#pragma unroll
    for (int i = 0; i < 2; ++i) { int R, C; stage_rc(tid * 16 + i * 8192, R, C); const int Rb = Epi::PERM ? ((R & ~31) + perm32(R & 31)) : R;
        voffA[i] = (unsigned)(R * K + C) * 2u; voffB[i] = (unsigned)(Rb * K + C) * 2u; }
    const size_t kstep = (size_t)(BK * 2);
    const size_t hstep = (size_t)HALF * K * 2;
    const size_t tstep = 2 * hstep;
    const unsigned ldsw = (unsigned)wid * 1024u;
    const int aoff = lds_byte(wr * 64 + fr, fq * 8), boff = lds_byte(wc * 32 + fr, fq * 8);
#define PG8_SA(b, h) (((b) * 2 + (h)) * HTB)
#define PG8_SB(b, h) ((4 + (b) * 2 + (h)) * HTB)
#define PG8_STAGE(bufoff, gbase, voff) do { _Pragma("unroll") for (int _i = 0; _i < 2; ++_i) \
        __builtin_amdgcn_global_load_lds((const unsigned*)((const char*)(gbase) + (voff)[_i]), (PG8_LAS unsigned*)(lds + (bufoff) + ldsw + _i * 8192), 16, 0, 0); } while (0)
#define PG8_LDA(dst, b, h) do { _Pragma("unroll") for (int m = 0; m < 4; ++m) _Pragma("unroll") for (int k = 0; k < 2; ++k) dst[m][k] = *(const PG8_LAS bf16x8*)(lds + PG8_SA(b, h) + aoff + m * 2048 + k * 1024); } while (0)
#define PG8_LDB(dst, b, h) do { _Pragma("unroll") for (int n = 0; n < 2; ++n) _Pragma("unroll") for (int k = 0; k < 2; ++k) dst[n][k] = *(const PG8_LAS bf16x8*)(lds + PG8_SB(b, h) + boff + n * 2048 + k * 1024); } while (0)
#define PG8_MMA(ai, bj, At, Bt) do { __builtin_amdgcn_s_setprio(1); _Pragma("unroll") for (int m = 0; m < 4; ++m) _Pragma("unroll") for (int n = 0; n < 2; ++n) _Pragma("unroll") for (int k = 0; k < 2; ++k) \
        acc[ai][bj][m][n] = __builtin_amdgcn_mfma_f32_16x16x32_bf16(Bt[n][k], At[m][k], acc[ai][bj][m][n], 0, 0, 0); __builtin_amdgcn_s_setprio(0); } while (0)
#define PG8_WAIT_V(n) asm volatile("s_waitcnt vmcnt(" #n ")" ::: "memory")
#define PG8_WAIT_L(n) asm volatile("s_waitcnt lgkmcnt(" #n ")" ::: "memory")
#define PG8_BAR __builtin_amdgcn_s_barrier()
#define PG8_SCHED __builtin_amdgcn_sched_barrier(0)
    Unit cur, nxt; int ui = 0;
    if (!S.next(0, cur)) return;
    f32x4 acc[2][2][4][2];
#pragma unroll
    for (int a = 0; a < 2; ++a)
#pragma unroll
        for (int b = 0; b < 2; ++b)
#pragma unroll
            for (int m = 0; m < 4; ++m)
#pragma unroll
                for (int n = 0; n < 2; ++n) acc[a][b][m][n] = (f32x4){0.f, 0.f, 0.f, 0.f};
    bf16x8 At[4][2], B0[2][2], B1[2][2];
    const char* cA = (const char*)g.A + (size_t)cur.pm * tstep; const char* cB = (const char*)g.Bt + (size_t)cur.pn * tstep;
    S.a_ready(cur);
    if constexpr (SP2) {
        PG8_STAGE(PG8_SB(0, 0), cB, voffB); PG8_STAGE(PG8_SB(0, 1), cB + hstep, voffB); PG8_STAGE(PG8_SA(0, 0), cA, voffA); PG8_STAGE(PG8_SA(0, 1), cA + hstep, voffA);
        if (wr == 1) PG8_BAR;
        PG8_WAIT_V(2); PG8_BAR;
        PG8_STAGE(PG8_SB(1, 0), cB + kstep, voffB); PG8_STAGE(PG8_SA(1, 0), cA + kstep, voffA); PG8_STAGE(PG8_SB(1, 1), cB + hstep + kstep, voffB);
        PG8_WAIT_V(6); PG8_BAR;
    } else {
        PG8_STAGE(PG8_SB(0, 0), cB, voffB); PG8_STAGE(PG8_SA(0, 0), cA, voffA); PG8_STAGE(PG8_SB(0, 1), cB + hstep, voffB); PG8_STAGE(PG8_SA(0, 1), cA + hstep, voffA);
        if (wr == 1) PG8_BAR;
        PG8_WAIT_V(4); PG8_BAR;
        PG8_STAGE(PG8_SB(1, 0), cB + kstep, voffB); PG8_STAGE(PG8_SA(1, 0), cA + kstep, voffA); PG8_STAGE(PG8_SB(1, 1), cB + hstep + kstep, voffB);
        PG8_WAIT_V(6); PG8_BAR;
    }
    for (;;) {
        const bool has_next = S.next(ui + 1, nxt);
        const char* nA = has_next ? (const char*)g.A + (size_t)nxt.pm * tstep : cA; const char* nB = has_next ? (const char*)g.Bt + (size_t)nxt.pn * tstep : cB;
        for (int t = 0; t < nt; t += 2) {
            const bool last = (t == nt - 2);
            const char* a1 = cA + (size_t)(t + 1) * kstep;
            const char* a2 = last ? nA : cA + (size_t)(t + 2) * kstep; const char* b2 = last ? nB : cB + (size_t)(t + 2) * kstep;
            const char* a3 = a2 + kstep; const char* b3 = b2 + kstep;
            if (last && has_next) S.a_ready(nxt);
            if constexpr (SP2) {
            PG8_LDB(B0, 0, 0); PG8_LDB(B1, 0, 1); PG8_SCHED; PG8_LDA(At, 0, 0); PG8_STAGE(PG8_SA(1, 1), a1 + hstep, voffA);
            PG8_WAIT_V(8); PG8_WAIT_L(0); PG8_BAR; PG8_MMA(0, 0, At, B0); PG8_MMA(0, 1, At, B1); PG8_BAR; PG8_SCHED;
            PG8_LDA(At, 0, 1); PG8_STAGE(PG8_SB(0, 0), b2, voffB); PG8_STAGE(PG8_SB(0, 1), b2 + hstep, voffB); PG8_STAGE(PG8_SA(0, 0), a2, voffA);
            PG8_WAIT_V(8); PG8_WAIT_L(0); PG8_BAR; PG8_MMA(1, 0, At, B0); PG8_MMA(1, 1, At, B1); PG8_BAR; PG8_SCHED;
            PG8_LDB(B0, 1, 0); PG8_LDB(B1, 1, 1); PG8_SCHED; PG8_LDA(At, 1, 0); PG8_STAGE(PG8_SA(0, 1), a2 + hstep, voffA);
            PG8_WAIT_V(8); PG8_WAIT_L(0); PG8_BAR; PG8_MMA(0, 0, At, B0); PG8_MMA(0, 1, At, B1); PG8_BAR; PG8_SCHED;
            PG8_LDA(At, 1, 1); PG8_STAGE(PG8_SB(1, 0), b3, voffB); PG8_STAGE(PG8_SB(1, 1), b3 + hstep, voffB); PG8_STAGE(PG8_SA(1, 0), a3, voffA);
            PG8_WAIT_V(8); PG8_WAIT_L(0); PG8_BAR; PG8_MMA(1, 0, At, B0); PG8_MMA(1, 1, At, B1); PG8_BAR; PG8_SCHED;
            } else {
            PG8_LDB(B0, 0, 0); PG8_SCHED; PG8_LDA(At, 0, 0); PG8_STAGE(PG8_SA(1, 1), a1 + hstep, voffA);
            PG8_WAIT_L(8); PG8_BAR; PG8_WAIT_L(0); PG8_MMA(0, 0, At, B0); PG8_BAR; PG8_SCHED;
            PG8_LDB(B1, 0, 1); PG8_STAGE(PG8_SB(0, 0), b2, voffB);
            PG8_BAR; PG8_WAIT_L(0); PG8_MMA(0, 1, At, B1); PG8_BAR;
            PG8_LDA(At, 0, 1); PG8_STAGE(PG8_SA(0, 0), a2, voffA);
            PG8_BAR; PG8_WAIT_L(0); PG8_MMA(1, 0, At, B0); PG8_BAR; PG8_SCHED;
            PG8_STAGE(PG8_SB(0, 1), b2 + hstep, voffB);
            PG8_WAIT_V(6); PG8_BAR; PG8_MMA(1, 1, At, B1); PG8_BAR;
            PG8_LDB(B0, 1, 0); PG8_SCHED; PG8_LDA(At, 1, 0); PG8_STAGE(PG8_SA(0, 1), a2 + hstep, voffA);
            PG8_WAIT_L(8); PG8_BAR; PG8_WAIT_L(0); PG8_MMA(0, 0, At, B0); PG8_BAR; PG8_SCHED;
            PG8_LDB(B1, 1, 1); PG8_STAGE(PG8_SB(1, 0), b3, voffB);
            PG8_BAR; PG8_WAIT_L(0); PG8_MMA(0, 1, At, B1); PG8_BAR;
            PG8_LDA(At, 1, 1); PG8_STAGE(PG8_SA(1, 0), a3, voffA);
            PG8_BAR; PG8_WAIT_L(0); PG8_MMA(1, 0, At, B0); PG8_BAR; PG8_SCHED;
            PG8_STAGE(PG8_SB(1, 1), b3 + hstep, voffB);
            PG8_WAIT_V(6); PG8_BAR; PG8_MMA(1, 1, At, B1); PG8_BAR;
            }
        }
        if constexpr (ALIGN_EPI) { if (wr == 0) PG8_BAR; }
        if constexpr (!Epi::AFTER_DRAIN) { E(acc, cur, wr, wc, fr, fq); S.done(cur); }
        if (!has_next) break;
#pragma unroll
        for (int a = 0; a < 2; ++a)
#pragma unroll
            for (int b = 0; b < 2; ++b)
#pragma unroll
                for (int m = 0; m < 4; ++m)
#pragma unroll
                    for (int n = 0; n < 2; ++n) acc[a][b][m][n] = (f32x4){0.f, 0.f, 0.f, 0.f};
        cur = nxt; cA = nA; cB = nB; ++ui;
        if constexpr (ALIGN_EPI) { if (wr == 1) PG8_BAR; }
    }
    PG8_WAIT_V(0);
    if constexpr (!ALIGN_EPI) { if (wr == 0) PG8_BAR; }
    PG8_BAR;
    if constexpr (Epi::AFTER_DRAIN) { E.fused(acc, cur, wr, wc, fr, fq, lds, wid, lane); S.done(cur); }
#undef PG8_SA
#undef PG8_SB
#undef PG8_STAGE
#undef PG8_LDA
#undef PG8_LDB
#undef PG8_MMA
#undef PG8_WAIT_V
#undef PG8_WAIT_L
#undef PG8_BAR
#undef PG8_SCHED
}
}
#define GAS __attribute__((address_space(1)))
#define LAS __attribute__((address_space(3)))
typedef unsigned short bf16;
typedef unsigned v4u __attribute__((ext_vector_type(4)));
typedef float f32x4 __attribute__((ext_vector_type(4)));
typedef short bf16x8 __attribute__((ext_vector_type(8)));
typedef GAS unsigned gu32;
typedef GAS unsigned long long gu64;
#define RLX_AGENT __ATOMIC_RELAXED, __HIP_MEMORY_SCOPE_AGENT
#define LDS_WAIT() asm volatile("s_waitcnt lgkmcnt(0)" ::: "memory")
#define VM_WAIT() asm volatile("s_waitcnt vmcnt(0)" ::: "memory")
__device__ __forceinline__ unsigned long long rt() { return __builtin_amdgcn_s_memrealtime(); }
typedef __bf16 bf16x2_t __attribute__((ext_vector_type(2)));
__device__ __forceinline__ unsigned f2bf(float f) { return (unsigned)__builtin_bit_cast(unsigned short, (__bf16)f); }
__device__ __forceinline__ unsigned pk2(float lo, float hi) { const bf16x2_t v = {(__bf16)lo, (__bf16)hi}; return __builtin_bit_cast(unsigned, v); }

#define XB_TMO      128
#define XB_XCNT(j)  (256  + 64 * (j))
#define XB_XSUB(j)  (1280 + 64 * (j))
#define XB_XGEN(j)  (2304 + 64 * (j))
#define XB_TOP      3328
#define XB_TOPGEN   3392
#define XCD_BAR_WORDS 3456
#define XB_SPIN_CAP (1u << 18)

__device__ __forceinline__ unsigned xb_ld(unsigned* p)              { return __hip_atomic_load(p, __ATOMIC_RELAXED, __HIP_MEMORY_SCOPE_AGENT); }
__device__ __forceinline__ unsigned xb_add(unsigned* p, unsigned v) { return __hip_atomic_fetch_add(p, v, __ATOMIC_RELAXED, __HIP_MEMORY_SCOPE_AGENT); }
__device__ __forceinline__ unsigned xb_xcc_id() { return (unsigned)__builtin_amdgcn_s_getreg((3 << 11) | 20) & 0xFu; }
#define XB_SPIN(cond, bar) do { unsigned _sp = 0; while (cond) { __builtin_amdgcn_s_sleep(1); \
    if ((++_sp & 255u) == 0u) { if (xb_ld(&(bar)[XB_TMO])) break; if (_sp > XB_SPIN_CAP) { atomicAdd(&(bar)[XB_TMO], 1u); break; } } } } while (0)

struct XcdBarrier {
    unsigned* bar; unsigned x;
    volatile LAS unsigned* st;
};

__device__ __forceinline__ XcdBarrier xcd_barrier_post(unsigned* bar, volatile LAS unsigned* st) {
    XcdBarrier b; b.bar = bar; b.x = xb_xcc_id(); b.st = st;
    if (threadIdx.x == 0) (void)xb_add(&bar[XB_XCNT(b.x)], 1u);
    return b;
}
__device__ __forceinline__ void xcd_barrier_complete(unsigned* bar, unsigned x, unsigned& nloc, unsigned& nx) {
    const unsigned G = gridDim.x * gridDim.y * gridDim.z;
    unsigned sum, cnt, mine, sp = 0u;
    for (;;) {
        sum = 0u; cnt = 0u; mine = 0u;
#pragma unroll
        for (unsigned j = 0; j < 16; ++j) { const unsigned c = xb_ld(&bar[XB_XCNT(j)]); sum += c; cnt += (c > 0u) ? 1u : 0u; mine = (j == x) ? c : mine; }
        if (sum == G) break;
        __builtin_amdgcn_s_sleep(1);
        if ((++sp & 255u) == 0u) { if (xb_ld(&bar[XB_TMO])) break; if (sp > XB_SPIN_CAP) { atomicAdd(&bar[XB_TMO], 1u); break; } }
    }
    nloc = mine > 0u ? mine : 1u; nx = cnt > 0u ? cnt : 1u;
}

__device__ __forceinline__ void xcd_barrier(const XcdBarrier& b) {
    asm volatile("s_waitcnt vmcnt(0)" ::: "memory");
    __syncthreads();
    if (threadIdx.x == 0) {
        unsigned* bar = b.bar;
        __builtin_amdgcn_s_waitcnt(0);
        unsigned nloc = b.st[0], nx = b.st[1];
        if (nloc == 0u) { xcd_barrier_complete(bar, b.x, nloc, nx); b.st[0] = nloc; b.st[1] = nx; }
        const unsigned old = xb_add(&bar[XB_XSUB(b.x)], 1u);
        const unsigned gen = old / nloc;
        if (old + 1u == (gen + 1u) * nloc) {
            __builtin_amdgcn_fence(__ATOMIC_RELEASE, "agent");
            asm volatile("s_waitcnt vmcnt(0)" ::: "memory");
            const unsigned og = xb_add(&bar[XB_TOP], 1u);
            const unsigned tg = og / nx;
            if (og + 1u == (tg + 1u) * nx) xb_add(&bar[XB_TOPGEN], 1u);
            else XB_SPIN(xb_ld(&bar[XB_TOPGEN]) == tg, bar);
            __builtin_amdgcn_fence(__ATOMIC_ACQUIRE, "agent");
            xb_add(&bar[XB_XGEN(b.x)], 1u);
            asm volatile("s_waitcnt vmcnt(0)" ::: "memory");
        } else {
            XB_SPIN(xb_ld(&bar[XB_XGEN(b.x)]) == gen, bar);
            __builtin_amdgcn_fence(__ATOMIC_ACQUIRE, "agent");
            asm volatile("s_waitcnt vmcnt(0)" ::: "memory");
        }
    }
    __syncthreads();
}


constexpr int NWAVES = 8;
constexpr int D = 1024, ML = 16384, MC = 256, M = ML + MC, DFF = 2816;
constexpr int NIN = 7712, NINP = 7936;
constexpr int NSC = 32, SCL = 512;
constexpr float EPS = 1e-6f;
static_assert(pg8::EP_ML == ML, "epilogue constant");

constexpr size_t MiB = 1u << 20, KiB = 1024;
constexpr size_t WS_CTL = 0, CTL_ZERO_BYTES = 1 * MiB;
constexpr size_t WS_SMALL = 1 * MiB;
constexpr size_t WS_HCTX = 9 * MiB;
constexpr size_t WS_FCTX = 10 * MiB;
constexpr size_t WS_RX = 11 * MiB;
constexpr size_t WS_ZQ = 44 * MiB;
constexpr size_t WS_XBC = 109 * MiB;
constexpr size_t WS_V = WS_XBC + (size_t)M * 1536 * 2;
constexpr size_t WS_G = WS_V + (size_t)M * 1024 * 2;
constexpr size_t WS_DT = WS_G + (size_t)M * 1024 * 2;
constexpr size_t WS_WIN = 227 * MiB;
constexpr size_t WS_BCC = WS_WIN;
static_assert(WS_BCC + (size_t)M * 512 * 2 <= 256 * MiB, "BCC");
static_assert(WS_DT + (size_t)M * 64 * 4 <= WS_WIN && WS_WIN + (size_t)NINP * 1024 * 2 <= 256 * MiB, "ws map (mixer phase)");
constexpr size_t WS_WREST = 216 * MiB;
constexpr size_t WO_OUT = 0, WO_UP0 = 4 * MiB, WO_DOWN0 = 15 * MiB, WO_OD = WO_DOWN0 + (size_t)DFF * 1024 * 2, WO_VG = WO_OD + 1 * MiB, WO_UP1 = WO_VG + 2 * MiB, WO_DOWN1 = WO_UP1 + 11 * MiB;
static_assert(WO_DOWN1 + (size_t)DFF * 1024 * 2 <= 40 * MiB, "weights overlay");
constexpr size_t WS_HID = WS_XBC;
static_assert(WS_HID + (size_t)M * DFF * 2 <= WS_WREST, "hidden overlay");
constexpr size_t WS_U = WS_ZQ;
constexpr size_t WS_A2 = WS_U + (size_t)M * 512 * 4;
static_assert(WS_A2 + (size_t)ML * 512 * 2 <= WS_XBC, "layer-1 overlay");
constexpr size_t WS_YS = WS_XBC;
constexpr size_t SM_ADAP = 0;
constexpr size_t SM_MODS = SM_ADAP + 2 * 2 * 8 * 6144 * 4;
constexpr size_t SM_LB = SM_MODS + 2 * 2 * 6144 * 4;
constexpr size_t SM_LAM = SM_LB + 4096;
constexpr size_t SM_LAMP = SM_LAM + 2 * 2048 * 2 * 4;
constexpr size_t SM_BB = SM_LAMP + 2 * 2048 * 2 * 4;
constexpr size_t SM_STATS = SM_BB + 2 * 2048 * 16 * 2 * 4;
constexpr size_t SM_SSDDEC = SM_STATS + (size_t)M * 16 * 4;
constexpr size_t SM_HGDEC = SM_SSDDEC + 33 * 32 * 4 + 128;
constexpr size_t SM_S5ST = ((SM_HGDEC + 33 * 16 * 128 * 4 + 255) / 256) * 256;
static_assert(SM_S5ST + 130 * 2 * 2048 * 2 * 4 <= 8 * MiB, "small tables");
constexpr size_t SSD_ST_BYTES = (size_t)33 * 32 * 8192 * 2;
static_assert(2 * SSD_ST_BYTES <= 33 * MiB && (size_t)M * 1024 * 2 <= 33 * MiB, "RX region");
constexpr int CW_BAR = 4096;

constexpr int RING_OFF = 0, RING_BYTES = 131072;
constexpr int LDS_BYTES = 163840;
constexpr int LDSCTL_OFF = LDS_BYTES - 512, MISC_OFF = LDSCTL_OFF + 320;


struct Params { const float* in[33]; float* out; unsigned char* ws; int ph_lo, ph_hi, use_bar, pad; };
enum { I_X = 0, I_C, I_CTX, I_CCTX, I_ADAW, I_ADAB, I_NMIX, I_NFFN, I_WGATE, I_WUP, I_WDOWN, I_FNORM, I_EVIN, I_EVOUT, I_CONVW, I_CONVB, I_DTB, I_ALOG, I_SSDD, I_SSDN, I_LBL, I_HGN,
       I_ODIN, I_ARE, I_AIM, I_LOGDT, I_BRE, I_BIM, I_CRE, I_CIM, I_S5D, I_WVAL, I_WGATE2 };
typedef _Float16 f16x8 __attribute__((ext_vector_type(8)));
typedef _Float16 f16;
typedef _Float16 f16x2 __attribute__((ext_vector_type(2)));
typedef float f32x2 __attribute__((ext_vector_type(2)));
__device__ __forceinline__ float bf2f(unsigned b) { return __uint_as_float(b << 16); }
__device__ __forceinline__ float siluf(float x) { return x * __builtin_amdgcn_rcpf(1.f + __expf(-x)); }
__device__ __forceinline__ float wave_sum(float v) {
#pragma unroll
    for (int o = 1; o < 64; o <<= 1) v += __shfl_xor(v, o);
    return v;
}
__device__ __forceinline__ void unpack8(const v4u r, float (&x)[8]) {
    x[0] = bf2f(r.x & 0xffffu); x[1] = bf2f(r.x >> 16); x[2] = bf2f(r.y & 0xffffu); x[3] = bf2f(r.y >> 16);
    x[4] = bf2f(r.z & 0xffffu); x[5] = bf2f(r.z >> 16); x[6] = bf2f(r.w & 0xffffu); x[7] = bf2f(r.w >> 16);
}
__device__ __forceinline__ void tr_item(const float* W, int ldw, int col0, int K, bf16* WT, int dst_row0, LAS float* scr, int kb, int lane) {
    const int k0 = 64 * kb;
#pragma unroll 8
    for (int i = 0; i < 32; ++i) { const int kk = 2 * i + (lane >> 5); scr[kk * 33 + (lane & 31)] = W[(size_t)(k0 + kk) * ldw + col0 + (lane & 31)]; }
    LDS_WAIT(); asm volatile("" ::: "memory");
    const int c = lane & 7;
#pragma unroll
    for (int j = 0; j < 4; ++j) { const int n = (lane >> 3) + 8 * j; const LAS float* s = scr + (8 * c) * 33 + n;
        v4u o; o.x = pk2(s[0 * 33], s[1 * 33]); o.y = pk2(s[2 * 33], s[3 * 33]); o.z = pk2(s[4 * 33], s[5 * 33]); o.w = pk2(s[6 * 33], s[7 * 33]);
        *(GAS v4u*)(WT + (size_t)(dst_row0 + n) * K + k0 + 8 * c) = o; }
    LDS_WAIT(); asm volatile("" ::: "memory");
}
__device__ __forceinline__ int dst_row_of(int mode, int c0) {
    if (mode == 0) return c0 < 2560 ? c0 : (c0 < 2592 ? 7680 + (c0 - 2560) : c0 - 32);
    if (mode == 1) return c0;
    return (c0 >> 7) * 256 + (mode == 3 ? 128 : 0) + (c0 & 127);
}
__device__ __forceinline__ void tr_job(const float* W, int K, int N, int mode, bf16* WT, LAS float* scr, int gw, int ngw, int lane) {
    const int nblk = N / 32, nit = (K / 64) * nblk;
    for (int it = gw; it < nit; it += ngw) { const int kb = it / nblk, nb = it % nblk; tr_item(W, N, 32 * nb, K, WT, dst_row_of(mode, 32 * nb), scr, kb, lane); }
}

__device__ __forceinline__ void phase_prologue(const Params& p, LAS unsigned char* lds, int bid, int G, int tid, int wave, int lane) {
    unsigned char* ws = p.ws; float* sm_adap = (float*)(ws + WS_SMALL + SM_ADAP);
    for (int it = bid; it < 192; it += G) {
        const int layer = it / 96, rem = it % 96, cb = rem / 8, ks = rem % 8;
        LAS float* sl = (LAS float*)lds; LAS float* sc = sl + 128;
        if (tid < 128) { sl[tid] = siluf(p.in[I_C][ks * 128 + tid]); sc[tid] = siluf(p.in[I_CCTX][ks * 128 + tid]); }
        __syncthreads();
        const int col = cb * 512 + tid; const float* W = p.in[I_ADAW] + (size_t)layer * 1024 * 6144 + (size_t)(ks * 128) * 6144 + col;
        float a0 = 0.f, a1 = 0.f;
#pragma unroll 8
        for (int k = 0; k < 128; ++k) { const float w = W[(size_t)k * 6144]; a0 += sl[k] * w; a1 += sc[k] * w; }
        sm_adap[((layer * 2 + 0) * 8 + ks) * 6144 + col] = a0; sm_adap[((layer * 2 + 1) * 8 + ks) * 6144 + col] = a1;
        __syncthreads();
    }
    const int gw = bid * NWAVES + wave, ngw = G * NWAVES;
    LAS float* scr = (LAS float*)(lds + wave * 16384);
    bf16* win = (bf16*)(ws + WS_WIN);
    tr_job(p.in[I_EVIN], 1024, NIN, 0, win, scr, gw, ngw, lane);
    { const int gt = bid * 512 + tid, nt = G * 512; v4u z = {0u, 0u, 0u, 0u};
      for (int i = gt; i < (NINP - NIN) * 1024 / 8; i += nt) *(GAS v4u*)(win + (size_t)NIN * 1024 + (size_t)i * 8) = z; }
    const int gt = bid * 512 + tid;
    if (gt < 1024) { const float l0 = p.in[I_LBL][gt], l1 = p.in[I_LBL][1024 + gt]; const float mx = fmaxf(l0, l1), e0 = __expf(l0 - mx), e1 = __expf(l1 - mx); ((float*)(ws + WS_SMALL + SM_LB))[gt] = e0 / (e0 + e1); }
    if (gt >= 4096 && gt < 8192) {
        const int s = gt - 4096, dg = s >> 6;
        const float dt = expf(p.in[I_LOGDT][dg]), are = p.in[I_ARE][s], aim = p.in[I_AIM][s];
        const float mag = expf(are * dt); float sn, cs; sincosf(aim * dt, &sn, &cs);
        const float lr = mag * cs, li = mag * sn, den = are * are + aim * aim;
        const float cr = ((lr - 1.f) * are + li * aim) / den, ci = (li * are - (lr - 1.f) * aim) / den;
        float* lam = (float*)(ws + WS_SMALL + SM_LAM); lam[2 * s] = lr; lam[2 * s + 1] = li;
        float pr = lr, pi = li;
#pragma unroll
        for (int q = 0; q < 7; ++q) { const float nr = pr * pr - pi * pi, ni = 2.f * pr * pi; pr = nr; pi = ni; }
        float* lamp = (float*)(ws + WS_SMALL + SM_LAMP); lamp[2 * s] = pr; lamp[2 * s + 1] = pi;
        bf16* bbh = (bf16*)(ws + WS_SMALL + SM_BB) + (size_t)s * 32;
#pragma unroll
        for (int c = 0; c < 16; ++c) { const float br = p.in[I_BRE][(size_t)s * 16 + c], bi = p.in[I_BIM][(size_t)s * 16 + c]; bbh[c] = (bf16)f2bf(cr * br - ci * bi); bbh[16 + c] = (bf16)f2bf(cr * bi + ci * br); }
    }
    { bf16* cmh = (bf16*)(ws + WS_SMALL + SM_BB + 262144); const int nt = G * 512;
      for (int e = gt; e < 2 * 32 * 16 * 128; e += nt) { const int k = e & 127, dgc = e >> 7; cmh[e] = (bf16)f2bf(k < 64 ? p.in[I_CRE][(size_t)dgc * 64 + k] : -p.in[I_CIM][(size_t)dgc * 64 + k - 64]); } }
}

__device__ __forceinline__ void phase_rownorm(const Params& p, LAS unsigned char* lds, int bid, int G, int tid, int wave, int lane, int layer, int kind  , int nrows,
                                              const float* src_lat, const float* src_ctx, bool from_partials) {
    unsigned char* ws = p.ws; const float* adap = (const float*)(ws + WS_SMALL + SM_ADAP); float* mods = (float*)(ws + WS_SMALL + SM_MODS);
    LAS float* Gt = (LAS float*)lds; LAS float* St = Gt + 2048;
    const float* ng = p.in[kind == 0 ? I_NMIX : I_NFFN] + layer * 1024;
    for (int idx = tid; idx < 4096; idx += 512) {
        const int vec = idx >> 11, which = (idx >> 10) & 1, col = idx & 1023, j = (kind * 3 + which) * 1024 + col;
        float v;
        if (from_partials) { v = p.in[I_ADAB][layer * 6144 + j];
#pragma unroll
            for (int ks = 0; ks < 8; ++ks) v += adap[((layer * 2 + vec) * 8 + ks) * 6144 + j]; }
        else v = mods[(layer * 2 + vec) * 6144 + j];
        if (which == 0) St[vec * 1024 + col] = v; else Gt[vec * 1024 + col] = ng[col] * (1.f + v);
    }
    if (from_partials && bid < 48) {
        const int idx = bid * 512 + tid, lv = idx / 6144, j = idx % 6144, ly = lv >> 1;
        float v = p.in[I_ADAB][ly * 6144 + j];
#pragma unroll
        for (int ks = 0; ks < 8; ++ks) v += adap[(lv * 8 + ks) * 6144 + j];
        mods[idx] = v;
    }
    __syncthreads();
    bf16* XN = (bf16*)(ws + WS_RX);
    const int gw = bid * NWAVES + wave, ngw = G * NWAVES;
    for (int row = gw; row < nrows; row += ngw) {
        const int vec = row >= ML ? 1 : 0; const float* xr = vec ? src_ctx + (size_t)(row - ML) * 1024 : src_lat + (size_t)row * 1024;
        f32x4 v[4]; float ss = 0.f;
#pragma unroll
        for (int j = 0; j < 4; ++j) { v[j] = *(const GAS f32x4*)(xr + 4 * lane + 256 * j); ss += (v[j].x * v[j].x + v[j].y * v[j].y) + (v[j].z * v[j].z + v[j].w * v[j].w); }
        const float r = rsqrtf(wave_sum(ss) * (1.f / 1024.f) + EPS);
#pragma unroll
        for (int j = 0; j < 4; ++j) { const int c = 4 * lane + 256 * j; const LAS float* g4 = Gt + vec * 1024 + c; const LAS float* s4 = St + vec * 1024 + c;
            const unsigned lo = pk2(v[j].x * r * g4[0] + s4[0], v[j].y * r * g4[1] + s4[1]), hi = pk2(v[j].z * r * g4[2] + s4[2], v[j].w * r * g4[3] + s4[3]);
            *(GAS unsigned long long*)(XN + (size_t)row * 1024 + c) = (unsigned long long)lo | ((unsigned long long)hi << 32); }
    }
}

typedef float f32x16 __attribute__((ext_vector_type(16)));
typedef short s16x4 __attribute__((ext_vector_type(4)));
#define MFMA32(a, b, c) __builtin_amdgcn_mfma_f32_32x32x16_bf16((a), (b), (c), 0, 0, 0)
__device__ __forceinline__ bf16x8 frag_rows(LAS const unsigned char* img, int RS, int row0, int kbyte, int lane) { return *(const LAS bf16x8*)(img + (row0 + (lane & 31)) * RS + kbyte + (lane >> 5) * 16); }
__device__ __forceinline__ bf16x8 frag_tr(LAS const unsigned char* img, int RS, int k0, int col0, int lane) {
    const int h = lane >> 5, blk = (lane >> 4) & 1, q = (lane & 15) >> 2, p = lane & 3;
    LAS const unsigned char* a = img + (k0 + 8 * h + q) * RS + (col0 + 16 * blk + 4 * p) * 2;
    const s16x4 lo = __builtin_amdgcn_ds_read_tr16_b64_v4i16((LAS s16x4*)a), hi = __builtin_amdgcn_ds_read_tr16_b64_v4i16((LAS s16x4*)(a + 4 * RS));
    return (bf16x8){lo[0], lo[1], lo[2], lo[3], hi[0], hi[1], hi[2], hi[3]};
}
__device__ __forceinline__ int arow(int reg, int h) { return (reg & 3) + 8 * (reg >> 2) + 4 * h; }
__device__ __forceinline__ void store_acc_nat(const f32x16& acc, LAS unsigned char* img, int RS, int n0, int m0, int lane) {
    LAS unsigned char* base = img + (n0 + (lane & 31)) * RS + (m0 + 4 * (lane >> 5)) * 2;
#pragma unroll
    for (int g = 0; g < 4; ++g) *(LAS unsigned long long*)(base + 16 * g) = (unsigned long long)pk2(acc[4 * g], acc[4 * g + 1]) | ((unsigned long long)pk2(acc[4 * g + 2], acc[4 * g + 3]) << 32);
}

struct ScanPtrs { const bf16* XBC; const float* DT; bf16* ZQ; const bf16* V; const bf16* G; f16* Flat; f16* Fctx; float* STATS; const float* convw; const float* convb; const float* ssdd; const float* hgn;
                  bf16* SSD_ST; bf16* HG_ST; float* SSD_DEC; float* HG_DEC; const bf16* BCC; };
template <int MODE, int D>
__device__ __forceinline__ void ssd_scan(const ScanPtrs& sp, LAS unsigned char* lds, int row_begin, int nchunks, int seq_lo, int seq_hi, int h, const bf16* st_in, bf16* st_out, float* dec_out, int tid) {
    const int lane = tid & 63, wave = __builtin_amdgcn_readfirstlane(tid >> 6), hf = lane >> 5, g = h >> 3;
    LAS unsigned short* YF = (LAS unsigned short*)lds; LAS unsigned char* XI = lds + 65536; LAS unsigned char* XE = lds + 74752; LAS unsigned char* BI = lds + 83968; LAS unsigned char* CI = lds + 101376; LAS unsigned char* MI = lds + 118784;
    LAS unsigned char* SPI = lds + 128000; LAS float* YB = (LAS float*)(lds + 101376); LAS unsigned char* XR = lds + 145408; LAS float* WT = (LAS float*)(lds + 154112);
    LAS float* AC = (LAS float*)(lds + 155648); LAS float* EA = AC + 64; LAS float* ES = AC + 128; LAS float* DTS = AC + 192;
    asm volatile("" : "+s"(nchunks));
    if (tid < 384) { const int j = tid >> 6, col = h * 64 + (tid & 63); WT[tid] = j < 5 ? sp.convw[j * 1536 + col] : sp.convb[col]; }
    const int nb = wave >> 1, pb = wave & 1;
    f32x16 accS;
#pragma unroll
    for (int r = 0; r < 16; ++r) accS[r] = st_in ? bf2f(*(const GAS unsigned short*)(st_in + (32 * nb + arow(r, hf)) * 64 + 32 * pb + (lane & 31))) : 0.f;
    if (MODE != 0) store_acc_nat(accS, SPI, 272, 32 * pb, 32 * nb, lane);
    float ltot = 0.f; const float dsk = sp.ssdd[h];
    v4u px0, px1, pb0, pb1, pc0, pc1; float pdt = 0.f, pla = 0.f;
    const v4u zero4 = {0u, 0u, 0u, 0u};
    px1 = zero4; pc0 = zero4; pc1 = zero4;
#define SSD_LDX(row_, col_) (((row_) >= seq_lo && (row_) < seq_hi) ? *(const GAS v4u*)(sp.XBC + (size_t)(row_) * 1536 + (col_)) : zero4)
#define SSD_LOAD(c_, tid) do { const int rb_ = row_begin + 64 * (c_); \
        px0 = SSD_LDX(rb_ - 2 + (tid >> 3), h * 64 + (tid & 7) * 8); if (tid < 32) px1 = SSD_LDX(rb_ + 62 + (tid >> 3), h * 64 + (tid & 7) * 8); \
        { const GAS v4u* bp_ = (const GAS v4u*)(sp.BCC + (size_t)(rb_ + (tid >> 4)) * 512 + g * 128 + (tid & 15) * 8); pb0 = bp_[0]; pb1 = bp_[32 * 64]; \
          if (MODE != 0) { pc0 = bp_[32]; pc1 = bp_[32 * 64 + 32]; } } \
        if (tid < 64) { pdt = sp.DT[(size_t)(rb_ + tid) * 64 + D * 16 + h]; pla = sp.DT[(size_t)(rb_ + tid) * 64 + 32 + D * 16 + h]; } } while (0)
    SSD_LOAD(D == 0 ? 0 : nchunks - 1, tid);
#pragma unroll 1
    for (int ci = 0; ci < nchunks; ++ci) {
        const int c = D == 0 ? ci : nchunks - 1 - ci, r0 = row_begin + 64 * c;
        int tl = tid; asm volatile("" : "+v"(tl));
        *(LAS v4u*)(XR + (tl >> 3) * 128 + (tl & 7) * 16) = px0; if (tl < 32) *(LAS v4u*)(XR + (64 + (tl >> 3)) * 128 + (tl & 7) * 16) = px1;
        if (wave == 0) {
            float x = pla;
#pragma unroll
            for (int o = 1; o < 64; o <<= 1) { const float v = D == 0 ? __shfl_up(x, o) : __shfl_down(x, o); if (D == 0 ? (lane >= o) : (lane + o < 64)) x += v; }
            const float last = __shfl(x, D == 0 ? 63 : 0);
            AC[lane] = x; EA[lane] = __expf(x); ES[lane] = pdt * __expf(last - x); DTS[lane] = pdt;
            if (lane == 0) AC[256] = __expf(last);
            ltot += last;
        }
        __syncthreads();
        { const int t = tl >> 3, o8 = (tl & 7) * 8; float a8[8];
#pragma unroll
          for (int i = 0; i < 8; ++i) a8[i] = WT[320 + o8 + i];
#pragma unroll
          for (int j = 0; j < 5; ++j) { float x8[8]; unpack8(*(const LAS v4u*)(XR + (t + j) * 128 + o8 * 2), x8);
#pragma unroll
              for (int i = 0; i < 8; ++i) a8[i] += WT[j * 64 + o8 + i] * x8[i]; }
          const float es = ES[t]; v4u w, we;
#pragma unroll
          for (int i = 0; i < 8; ++i) a8[i] = siluf(a8[i]);
          w.x = pk2(a8[0], a8[1]); w.y = pk2(a8[2], a8[3]); w.z = pk2(a8[4], a8[5]); w.w = pk2(a8[6], a8[7]);
          we.x = pk2(a8[0] * es, a8[1] * es); we.y = pk2(a8[2] * es, a8[3] * es); we.z = pk2(a8[4] * es, a8[5] * es); we.w = pk2(a8[6] * es, a8[7] * es);
          *(LAS v4u*)(XI + t * 144 + o8 * 2) = w; *(LAS v4u*)(XE + t * 144 + o8 * 2) = we; }
        { const int t = tl >> 4, o16 = (tl & 15) * 16;
          *(LAS v4u*)(BI + t * 272 + o16) = pb0; *(LAS v4u*)(BI + (32 + t) * 272 + o16) = pb1;
          if (MODE != 0) { *(LAS v4u*)(CI + t * 272 + o16) = pc0; *(LAS v4u*)(CI + (32 + t) * 272 + o16) = pc1; } }
        if (ci + 1 < nchunks) SSD_LOAD(D == 0 ? ci + 1 : nchunks - 2 - ci, tl);
        __syncthreads();
        f32x16 accY;
        const int tb = (wave & 3) >> 1, qb = wave & 1;
        if (MODE != 0) {
            if (wave >= 4) { const int sb = tb; f32x16 a;
#pragma unroll
                for (int r = 0; r < 16; ++r) a[r] = 0.f;
#pragma unroll
                for (int ks = 0; ks < 8; ++ks) a = MFMA32(frag_rows(BI, 272, 32 * sb, 32 * ks, lane), frag_rows(CI, 272, 32 * qb, 32 * ks, lane), a);
                const int t = 32 * qb + (lane & 31); const float act = AC[t];
#pragma unroll
                for (int r = 0; r < 16; ++r) { const int s2 = 32 * sb + arow(r, hf); const bool keep = D == 0 ? (s2 <= t) : (s2 >= t); a[r] = keep ? a[r] * __expf(act - AC[s2]) * DTS[s2] : 0.f; }
                store_acc_nat(a, MI, 144, 32 * qb, 32 * sb, lane);
            } else {
#pragma unroll
                for (int r = 0; r < 16; ++r) accY[r] = 0.f;
#pragma unroll
                for (int ks = 0; ks < 8; ++ks) accY = MFMA32(frag_rows(CI, 272, 32 * tb, 32 * ks, lane), frag_rows(SPI, 272, 32 * qb, 32 * ks, lane), accY);
#pragma unroll
                for (int r = 0; r < 16; ++r) accY[r] *= EA[32 * tb + arow(r, hf)];
            }
            __syncthreads();
            if (wave < 4) {
#pragma unroll
                for (int ks = 0; ks < 4; ++ks) accY = MFMA32(frag_rows(MI, 144, 32 * tb, 32 * ks, lane), frag_tr(XI, 144, 16 * ks, 32 * qb, lane), accY);
#pragma unroll
                for (int r = 0; r < 16; ++r) YB[(32 * tb + arow(r, hf)) * 68 + 32 * qb + (lane & 31)] = accY[r];
            }
        }
        { const float el = AC[256];
#pragma unroll
          for (int r = 0; r < 16; ++r) accS[r] *= el;
#pragma unroll
          for (int ks = 0; ks < 4; ++ks) accS = MFMA32(frag_tr(BI, 272, 16 * ks, 32 * nb, lane), frag_tr(XE, 144, 16 * ks, 32 * pb, lane), accS);
          if (MODE != 0) store_acc_nat(accS, SPI, 272, 32 * pb, 32 * nb, lane); }
        __syncthreads();
        if (MODE != 0) {
            int t3 = tid; asm volatile("" : "+v"(t3)); const int t = t3 >> 3, p8 = (t3 & 7) * 8, row = r0 + t;
            const f32x4 y0 = *(const LAS f32x4*)(YB + t * 68 + p8), y1 = *(const LAS f32x4*)(YB + t * 68 + p8 + 4);
            LAS v4u* yp = (LAS v4u*)(YF + (row - row_begin) * 64 + p8);
            if (MODE == 1) { v4u w; w.x = pk2(y0.x, y0.y); w.y = pk2(y0.z, y0.w); w.z = pk2(y1.x, y1.y); w.w = pk2(y1.z, y1.w); *yp = w; }
            else { float yf[8], x8[8], z8[8]; unpack8(*yp, yf); unpack8(*(const LAS v4u*)(XI + t * 144 + p8 * 2), x8);
                GAS v4u* zp = (GAS v4u*)(sp.ZQ + (size_t)row * 2048 + h * 64 + p8); unpack8(*zp, z8);
                float o[8] = {y0.x, y0.y, y0.z, y0.w, y1.x, y1.y, y1.z, y1.w}; float ss = 0.f;
#pragma unroll
                for (int i = 0; i < 8; ++i) { o[i] = (o[i] + yf[i] + dsk * x8[i]) * z8[i]; ss += o[i] * o[i]; }
                v4u w; w.x = pk2(o[0], o[1]); w.y = pk2(o[2], o[3]); w.z = pk2(o[4], o[5]); w.w = pk2(o[6], o[7]); *zp = w;
                ss += __shfl_xor(ss, 1); ss += __shfl_xor(ss, 2); ss += __shfl_xor(ss, 4);
                if ((t3 & 7) == 0) sp.STATS[(size_t)row * 16 + h] = ss; }
        }
    }
#undef SSD_LOAD
#undef SSD_LDX
    if (st_out) {
#pragma unroll
        for (int r = 0; r < 16; ++r) *(GAS unsigned short*)(st_out + (32 * nb + arow(r, hf)) * 64 + 32 * pb + (lane & 31)) = (unsigned short)f2bf(accS[r]); }
    if (dec_out && tid == 0) *dec_out = __expf(ltot);
    __syncthreads();
}
__device__ __forceinline__ void phase_convbc(const Params& p, int bid, int G, int tid) {
    const bf16* XBC = (const bf16*)(p.ws + WS_XBC); bf16* BCC = (bf16*)(p.ws + WS_BCC);
    const int gt = bid * 512 + tid, nt = G * 512, oct = gt & 63, col = 1024 + oct * 8;
    float w[5][8], b8[8];
#pragma unroll
    for (int j = 0; j < 5; ++j) { const f32x4 w0 = *(const GAS f32x4*)(p.in[I_CONVW] + j * 1536 + col), w1 = *(const GAS f32x4*)(p.in[I_CONVW] + j * 1536 + col + 4);
        w[j][0] = w0.x; w[j][1] = w0.y; w[j][2] = w0.z; w[j][3] = w0.w; w[j][4] = w1.x; w[j][5] = w1.y; w[j][6] = w1.z; w[j][7] = w1.w; }
    { const f32x4 b0 = *(const GAS f32x4*)(p.in[I_CONVB] + col), b1 = *(const GAS f32x4*)(p.in[I_CONVB] + col + 4); b8[0] = b0.x; b8[1] = b0.y; b8[2] = b0.z; b8[3] = b0.w; b8[4] = b1.x; b8[5] = b1.y; b8[6] = b1.z; b8[7] = b1.w; }
    for (int row = gt >> 6; row < M; row += nt >> 6) {
        const int lo = row < ML ? 0 : ML, hi = row < ML ? ML : M;
        float a8[8];
#pragma unroll
        for (int i = 0; i < 8; ++i) a8[i] = b8[i];
#pragma unroll
        for (int j = 0; j < 5; ++j) { const int rr = row + j - 2;
            if (rr >= lo && rr < hi) { float x8[8]; unpack8(*(const GAS v4u*)(XBC + (size_t)rr * 1536 + col), x8);
#pragma unroll
                for (int i = 0; i < 8; ++i) a8[i] += w[j][i] * x8[i]; } }
        v4u o; o.x = pk2(siluf(a8[0]), siluf(a8[1])); o.y = pk2(siluf(a8[2]), siluf(a8[3])); o.z = pk2(siluf(a8[4]), siluf(a8[5])); o.w = pk2(siluf(a8[6]), siluf(a8[7]));
        *(GAS v4u*)(BCC + (size_t)row * 512 + oct * 8) = o;
    }
}
template <int MODE, int D>
__device__ __forceinline__ void hg_scan(const ScanPtrs& sp, LAS unsigned char* lds, int row_begin, int nchunks, int hh, const bf16* st_in, bf16* st_out, float* dec_out, int tid) {
    const int lane = tid & 63, wave = __builtin_amdgcn_readfirstlane(tid >> 6), h = lane >> 5;
    LAS unsigned char* QP = lds; LAS unsigned char* KP = lds + 17408; LAS unsigned char* VI = lds + 34816; LAS unsigned char* ATT = lds + 52224; LAS unsigned char* STI = lds + 61440;
    LAS float* OB = (LAS float*)(lds + 96256); LAS float* PAR = (LAS float*)(lds + 132096); LAS float* EL = (LAS float*)(lds + 136192);
    f16* Fit = (row_begin < ML) ? sp.Flat + (size_t)row_begin * 2048 : sp.Fctx + (size_t)(row_begin - ML) * 2048;
    const int k0 = (tid & 63) * 2, tg = wave, kb = wave >> 1, vb0 = (wave & 1) * 2;
    asm volatile("" : "+s"(nchunks));
    f32x16 accS[2];
#pragma unroll
    for (int i = 0; i < 2; ++i)
#pragma unroll
        for (int r = 0; r < 16; ++r) accS[i][r] = st_in ? bf2f(*(const GAS unsigned short*)(st_in + (32 * kb + arow(r, h)) * 128 + 32 * (vb0 + i) + (lane & 31))) : 0.f;
    if (MODE != 0) { store_acc_nat(accS[0], STI, 272, 32 * vb0, 32 * kb, lane); store_acc_nat(accS[1], STI, 272, 32 * (vb0 + 1), 32 * kb, lane); }
    float ltot0 = 0.f, ltot1 = 0.f;
    unsigned plf[8], pq[8]; v4u pv0, pv1;
    const int vr = tid >> 3, vc = (tid & 7) * 16;
#define HG_LOAD(c_) do { const int rr_ = 64 * (c_); \
        _Pragma("unroll") for (int i = 0; i < 8; ++i) { plf[i] = *(const GAS unsigned*)(Fit + (size_t)(rr_ + 8 * tg + i) * 2048 + D * 1024 + hh * 128 + k0); \
            if (MODE != 0) pq[i] = *(const GAS unsigned*)(sp.ZQ + (size_t)(row_begin + rr_ + 8 * tg + i) * 2048 + 1024 + hh * 128 + k0); } \
        const GAS v4u* vp_ = (const GAS v4u*)(sp.V + (size_t)(row_begin + rr_ + vr) * 1024 + hh * 128 + vc); pv0 = vp_[0]; pv1 = vp_[1]; } while (0)
    HG_LOAD(D == 0 ? 0 : nchunks - 1);
#pragma unroll 1
    for (int ci = 0; ci < nchunks; ++ci) {
        const int c = D == 0 ? ci : nchunks - 1 - ci, r0 = 64 * c;
        v4u pof0, pof1, pg0, pg1;
        if (MODE == 2) { int t3 = tid; asm volatile("" : "+v"(t3)); const int t = t3 >> 3, c16 = (t3 & 7) * 16;
            const v4u* fp = (const v4u*)(Fit + (size_t)(r0 + t) * 2048 + hh * 128 + c16); pof0 = __builtin_nontemporal_load(fp); pof1 = __builtin_nontemporal_load(fp + 1);
            const GAS v4u* gp = (const GAS v4u*)(sp.G + (size_t)(row_begin + r0 + t) * 1024 + hh * 128 + c16); pg0 = gp[0]; pg1 = gp[1]; }
        float lf0[8], lf1[8], cs0[8], cs1[8]; float run0 = 0.f, run1 = 0.f;
#pragma unroll
        for (int i = 0; i < 8; ++i) { const f16x2 hr = __builtin_bit_cast(f16x2, plf[i]); lf0[i] = (float)hr.x; lf1[i] = (float)hr.y; }
#pragma unroll
        for (int ii = 0; ii < 8; ++ii) { const int i = D == 0 ? ii : 7 - ii; run0 += lf0[i]; run1 += lf1[i]; cs0[i] = run0; cs1[i] = run1; }
        *(LAS f32x2*)(PAR + tg * 128 + k0) = (f32x2){run0, run1};
        __syncthreads();
        float off0 = 0.f, off1 = 0.f, tot0 = 0.f, tot1 = 0.f;
#pragma unroll
        for (int j = 0; j < 8; ++j) { const f32x2 pj = *(const LAS f32x2*)(PAR + j * 128 + k0); tot0 += pj.x; tot1 += pj.y; if (D == 0 ? (j < tg) : (j > tg)) { off0 += pj.x; off1 += pj.y; } }
#pragma unroll
        for (int i = 0; i < 8; ++i) { const float bc0 = off0 + cs0[i], bc1 = off1 + cs1[i], kk0 = 1.f - __expf(lf0[i]), kk1 = 1.f - __expf(lf1[i]); const int t = 8 * tg + i;
            if (MODE != 0) *(LAS unsigned*)(QP + t * 272 + k0 * 2) = pk2(bf2f(pq[i] & 0xffffu) * __expf(bc0), bf2f(pq[i] >> 16) * __expf(bc1));
            *(LAS unsigned*)(KP + t * 272 + k0 * 2) = pk2(kk0 * __expf(-bc0), kk1 * __expf(-bc1)); }
        if (tg == 0) { *(LAS f32x2*)(EL + k0) = (f32x2){__expf(tot0), __expf(tot1)}; ltot0 += tot0; ltot1 += tot1; }
        *(LAS v4u*)(VI + vr * 272 + vc * 2) = pv0; *(LAS v4u*)(VI + vr * 272 + vc * 2 + 16) = pv1;
        if (ci + 1 < nchunks) HG_LOAD(D == 0 ? ci + 1 : nchunks - 2 - ci);
        __syncthreads();
        f32x16 accO;
        if (MODE != 0) {
            if (wave < 4) { const int sb = wave >> 1, tb = wave & 1; f32x16 a;
#pragma unroll
                for (int r = 0; r < 16; ++r) a[r] = 0.f;
#pragma unroll
                for (int ks = 0; ks < 8; ++ks) a = MFMA32(frag_rows(KP, 272, 32 * sb, 32 * ks, lane), frag_rows(QP, 272, 32 * tb, 32 * ks, lane), a);
                const int t = 32 * tb + (lane & 31);
#pragma unroll
                for (int r = 0; r < 16; ++r) { const int s = 32 * sb + arow(r, h); if (D == 0 ? (s > t) : (s < t)) a[r] = 0.f; }
                store_acc_nat(a, ATT, 144, 32 * tb, 32 * sb, lane); }
            const int tb = wave >> 2, vb = wave & 3;
#pragma unroll
            for (int r = 0; r < 16; ++r) accO[r] = 0.f;
#pragma unroll
            for (int ks = 0; ks < 8; ++ks) accO = MFMA32(frag_rows(QP, 272, 32 * tb, 32 * ks, lane), frag_rows(STI, 272, 32 * vb, 32 * ks, lane), accO);
            __syncthreads();
#pragma unroll
            for (int ks = 0; ks < 4; ++ks) accO = MFMA32(frag_rows(ATT, 144, 32 * tb, 32 * ks, lane), frag_tr(VI, 272, 16 * ks, 32 * vb, lane), accO);
#pragma unroll
            for (int r = 0; r < 16; ++r) OB[(32 * tb + arow(r, h)) * 132 + 32 * vb + (lane & 31)] = accO[r];
        }
#pragma unroll
        for (int ks = 0; ks < 4; ++ks) { const bf16x8 a = frag_tr(KP, 272, 16 * ks, 32 * kb, lane);
            accS[0] = MFMA32(a, frag_tr(VI, 272, 16 * ks, 32 * vb0, lane), accS[0]); accS[1] = MFMA32(a, frag_tr(VI, 272, 16 * ks, 32 * (vb0 + 1), lane), accS[1]); }
#pragma unroll
        for (int r = 0; r < 16; ++r) { const float e = EL[32 * kb + arow(r, h)]; accS[0][r] *= e; accS[1][r] *= e; }
        if (MODE != 0) { store_acc_nat(accS[0], STI, 272, 32 * vb0, 32 * kb, lane); store_acc_nat(accS[1], STI, 272, 32 * (vb0 + 1), 32 * kb, lane); }
        __syncthreads();
        if (MODE != 0) {
            const int t = tid >> 3, c16 = (tid & 7) * 16, row = row_begin + r0 + t;
            float o[16];
#pragma unroll
            for (int j = 0; j < 4; ++j) { const f32x4 x = *(const LAS f32x4*)(OB + t * 132 + c16 + 4 * j); o[4 * j] = x.x; o[4 * j + 1] = x.y; o[4 * j + 2] = x.z; o[4 * j + 3] = x.w; }
            f16* fp = Fit + (size_t)(r0 + t) * 2048 + hh * 128 + c16;
            if (MODE == 1) { f16x8 a, b;
#pragma unroll
                for (int j = 0; j < 8; ++j) { a[j] = (f16)o[j]; b[j] = (f16)o[8 + j]; }
                *(GAS f16x8*)fp = a; *(GAS f16x8*)(fp + 8) = b; }
            else { const f16x8 a = __builtin_bit_cast(f16x8, pof0), b = __builtin_bit_cast(f16x8, pof1); float ss = 0.f;
#pragma unroll
                for (int j = 0; j < 8; ++j) { o[j] += (float)a[j]; o[8 + j] += (float)b[j]; }
#pragma unroll
                for (int j = 0; j < 16; ++j) ss += o[j] * o[j];
                ss += __shfl_xor(ss, 1); ss += __shfl_xor(ss, 2); ss += __shfl_xor(ss, 4);
                const float rn = rsqrtf(ss * (1.f / 128.f) + EPS);
                float g8[8], g9[8]; unpack8(pg0, g8); unpack8(pg1, g9);
                const float* hn = sp.hgn + c16;
                v4u w0, w1;
                w0.x = pk2(o[0] * rn * hn[0] * g8[0], o[1] * rn * hn[1] * g8[1]); w0.y = pk2(o[2] * rn * hn[2] * g8[2], o[3] * rn * hn[3] * g8[3]); w0.z = pk2(o[4] * rn * hn[4] * g8[4], o[5] * rn * hn[5] * g8[5]); w0.w = pk2(o[6] * rn * hn[6] * g8[6], o[7] * rn * hn[7] * g8[7]);
                w1.x = pk2(o[8] * rn * hn[8] * g9[0], o[9] * rn * hn[9] * g9[1]); w1.y = pk2(o[10] * rn * hn[10] * g9[2], o[11] * rn * hn[11] * g9[3]); w1.z = pk2(o[12] * rn * hn[12] * g9[4], o[13] * rn * hn[13] * g9[5]); w1.w = pk2(o[14] * rn * hn[14] * g9[6], o[15] * rn * hn[15] * g9[7]);
                GAS v4u* zp = (GAS v4u*)(sp.ZQ + (size_t)row * 2048 + 1024 + hh * 128 + c16); zp[0] = w0; zp[1] = w1; }
        }
    }
#undef HG_LOAD
    if (st_out) {
#pragma unroll
        for (int i = 0; i < 2; ++i)
#pragma unroll
            for (int r = 0; r < 16; ++r) *(GAS unsigned short*)(st_out + (32 * kb + arow(r, h)) * 128 + 32 * (vb0 + i) + (lane & 31)) = (unsigned short)f2bf(accS[i][r]); }
    if (dec_out && tg == 0) { dec_out[k0] = __expf(ltot0); dec_out[k0 + 1] = __expf(ltot1); }
    __syncthreads();
}
__device__ __forceinline__ void wg_fence() { asm volatile("s_waitcnt vmcnt(0)" ::: "memory"); __syncthreads(); }

__device__ __forceinline__ void phase_scanA1(const ScanPtrs& sp, LAS unsigned char* lds, int bid, int G, int tid) {
    for (int it = bid; it < NSC * 16; it += G) { const int sc = it >> 4, chain = it & 15, hh = chain >> 1, d = chain & 1;
        bf16* so = sp.HG_ST + ((size_t)sc * 16 + chain) * 16384; float* dc = sp.HG_DEC + (sc * 16 + chain) * 128;
        if (d == 0) hg_scan<0, 0>(sp, lds, sc * SCL, SCL / 64, hh, nullptr, so, dc, tid); else hg_scan<0, 1>(sp, lds, sc * SCL, SCL / 64, hh, nullptr, so, dc, tid); }
    for (int it = bid; it < 8; it += G) { const int hh = it;
        hg_scan<1, 0>(sp, lds, ML, MC / 64, hh, nullptr, sp.HG_ST + ((size_t)NSC * 16 + hh * 2 + 0) * 16384, nullptr, tid);
        wg_fence();
        hg_scan<2, 1>(sp, lds, ML, MC / 64, hh, nullptr, sp.HG_ST + ((size_t)NSC * 16 + hh * 2 + 1) * 16384, nullptr, tid); }
}
__device__ __forceinline__ void phase_scanA2(const ScanPtrs& sp, LAS unsigned char* lds, int bid_hw, int G, int tid) {
    const int bid = (G % 8 == 0) ? (bid_hw % 8) * (G / 8) + bid_hw / 8 : bid_hw;
    for (int it = bid; it < NSC * 32; it += G) { const int sc = it >> 5, chain = it & 31, h = chain >> 1, d = chain & 1;
        bf16* so = sp.SSD_ST + ((size_t)sc * 32 + chain) * 8192; float* dc = sp.SSD_DEC + sc * 32 + chain;
        if (d == 0) ssd_scan<0, 0>(sp, lds, sc * SCL, SCL / 64, 0, ML, h, nullptr, so, dc, tid); else ssd_scan<0, 1>(sp, lds, sc * SCL, SCL / 64, 0, ML, h, nullptr, so, dc, tid); }
    for (int it = bid; it < 16; it += G) { const int h = it;
        ssd_scan<1, 0>(sp, lds, ML, MC / 64, ML, M, h, nullptr, sp.SSD_ST + ((size_t)NSC * 32 + h * 2 + 0) * 8192, nullptr, tid);
        ssd_scan<2, 1>(sp, lds, ML, MC / 64, ML, M, h, nullptr, sp.SSD_ST + ((size_t)NSC * 32 + h * 2 + 1) * 8192, nullptr, tid); }
}
__device__ __forceinline__ void phase_scanB(const ScanPtrs& sp, int bid, int G, int tid) {
    const int gt = bid * 512 + tid, nt = G * 512;
    for (int e = gt; e < 2 * 131072; e += nt) {
        const bool hg = e >= 131072; const int e2 = hg ? e - 131072 : e;
        const int chain = hg ? (e2 >> 13) : (e2 >> 12), pr = hg ? (e2 & 8191) : (e2 & 4095), d = chain & 1;
        const int nch = hg ? 16 : 32, ppc = hg ? 8192 : 4096;
        GAS unsigned* base = (GAS unsigned*)(hg ? sp.HG_ST : sp.SSD_ST);
        const unsigned w0 = base[((size_t)NSC * nch + chain) * ppc + pr];
        float r0 = bf2f(w0 & 0xffffu), r1 = bf2f(w0 >> 16);
        for (int i0 = 0; i0 < NSC; i0 += 8) {
            unsigned loc[8]; float dec[8];
#pragma unroll
            for (int j = 0; j < 8; ++j) { const int sc = d == 0 ? i0 + j : NSC - 1 - (i0 + j); loc[j] = base[((size_t)sc * nch + chain) * ppc + pr];
                dec[j] = hg ? sp.HG_DEC[(sc * 16 + chain) * 128 + (pr >> 6)] : sp.SSD_DEC[sc * 32 + chain]; }
#pragma unroll
            for (int j = 0; j < 8; ++j) { const int sc = d == 0 ? i0 + j : NSC - 1 - (i0 + j); base[((size_t)sc * nch + chain) * ppc + pr] = pk2(r0, r1);
                r0 = r0 * dec[j] + bf2f(loc[j] & 0xffffu); r1 = r1 * dec[j] + bf2f(loc[j] >> 16); }
        }
    }
}
__device__ __forceinline__ void phase_scanC(const ScanPtrs& sp, LAS unsigned char* lds, int bid_hw, int G, int tid) {
    const int bid = (G % 8 == 0) ? (bid_hw % 8) * (G / 8) + bid_hw / 8 : bid_hw;
    for (int it = bid; it < NSC * 8; it += G) { const int sc = it >> 3, hh = it & 7;
        hg_scan<1, 0>(sp, lds, sc * SCL, SCL / 64, hh, sp.HG_ST + ((size_t)sc * 16 + hh * 2 + 0) * 16384, nullptr, nullptr, tid);
        wg_fence();
        hg_scan<2, 1>(sp, lds, sc * SCL, SCL / 64, hh, sp.HG_ST + ((size_t)sc * 16 + hh * 2 + 1) * 16384, nullptr, nullptr, tid); }
    for (int it = bid; it < NSC * 16; it += G) { const int sc = it >> 4, h = it & 15;
        ssd_scan<1, 0>(sp, lds, sc * SCL, SCL / 64, 0, ML, h, sp.SSD_ST + ((size_t)sc * 32 + h * 2 + 0) * 8192, nullptr, nullptr, tid);
        ssd_scan<2, 1>(sp, lds, sc * SCL, SCL / 64, 0, ML, h, sp.SSD_ST + ((size_t)sc * 32 + h * 2 + 1) * 8192, nullptr, nullptr, tid); }
}
__device__ __forceinline__ void phase_finish(const Params& p, LAS unsigned char* lds, int bid, int G, int tid, int wave, int lane) {
    unsigned char* ws = p.ws; bf16* ZQ = (bf16*)(ws + WS_ZQ); const float* stats = (const float*)(ws + WS_SMALL + SM_STATS); const float* sng = p.in[I_SSDN];
    const int gw = bid * NWAVES + wave, ngw = G * NWAVES;
    for (int row = gw; row < M; row += ngw) {
        const int grp = lane >> 5; const float* s8 = stats + (size_t)row * 16 + grp * 8;
        const float ss = ((s8[0] + s8[1]) + (s8[2] + s8[3])) + ((s8[4] + s8[5]) + (s8[6] + s8[7]));
        const float r = rsqrtf(ss * (1.f / 512.f) + EPS);
        GAS v4u* zp = (GAS v4u*)(ZQ + (size_t)row * 2048 + lane * 16);
#pragma unroll
        for (int q = 0; q < 2; ++q) { float x8[8]; unpack8(zp[q], x8); const float* g8 = sng + lane * 16 + q * 8;
            v4u o; o.x = pk2(x8[0] * r * g8[0], x8[1] * r * g8[1]); o.y = pk2(x8[2] * r * g8[2], x8[3] * r * g8[3]); o.z = pk2(x8[4] * r * g8[4], x8[5] * r * g8[5]); o.w = pk2(x8[6] * r * g8[6], x8[7] * r * g8[7]); zp[q] = o; }
    }
    LAS float* scr = (LAS float*)(lds + wave * 16384); unsigned char* wr = ws + WS_WREST;
    tr_job(p.in[I_EVOUT], 2048, 1024, 1, (bf16*)(wr + WO_OUT), scr, gw, ngw, lane);
    tr_job(p.in[I_WGATE], 1024, DFF, 2, (bf16*)(wr + WO_UP0), scr, gw, ngw, lane);
    tr_job(p.in[I_WUP], 1024, DFF, 3, (bf16*)(wr + WO_UP0), scr, gw, ngw, lane);
    tr_job(p.in[I_WDOWN], DFF, 1024, 1, (bf16*)(wr + WO_DOWN0), scr, gw, ngw, lane);
    tr_job(p.in[I_ODIN], 1024, 512, 1, (bf16*)(wr + WO_OD), scr, gw, ngw, lane);
}

struct S5Ptrs { const bf16* U; float* YS; bf16* A2; const float* LAM; const float* LAMP; const bf16* BBH; const bf16* CMH; const float* S5D; float* ST; };
template <int MODE, int D>
__device__ __forceinline__ void s5_wave(const S5Ptrs& sp, LAS unsigned char* SI  , int row0  , int g, int slot0, int lane) {
    const int n = lane & 31, hs = lane >> 5, dg = D * 32 + g;
    bf16x8 bq[4];
#pragma unroll
    for (int q = 0; q < 4; ++q) bq[q] = *(const GAS bf16x8*)(sp.BBH + ((size_t)(dg * 64 + (q & 1) * 32 + n) * 2 + (q >> 1)) * 16 + 8 * hs);
    bf16x8 cm[8];
    if (MODE != 0) {
#pragma unroll
        for (int ks = 0; ks < 8; ++ks) cm[ks] = n < 16 ? *(const GAS bf16x8*)(sp.CMH + ((size_t)(dg * 16 + n) * 128 + 16 * ks + 8 * hs)) : (bf16x8){0, 0, 0, 0, 0, 0, 0, 0}; }
    const float lr0 = sp.LAM[2 * (dg * 64 + n)], li0 = sp.LAM[2 * (dg * 64 + n) + 1], lr1 = sp.LAM[2 * (dg * 64 + 32 + n)], li1 = sp.LAM[2 * (dg * 64 + 32 + n) + 1];
    float hr0 = 0.f, hi0 = 0.f, hr1 = 0.f, hi1 = 0.f;
    float* stp = sp.ST + ((size_t)((slot0 + hs) * 2 + D) * 2048 + g * 64 + n) * 2;
    if (MODE != 0) { const f32x2 a = *(const GAS f32x2*)stp, b = *(const GAS f32x2*)(stp + 64); hr0 = a.x; hi0 = a.y; hr1 = b.x; hi1 = b.y; }
    const int astream = (n >> 2) & 1, aidx = 4 * (n >> 3) + (n & 3);
    const bf16* ua = sp.U + (size_t)(row0 + 128 * astream) * 512 + g * 16 + 8 * hs;
    bf16x8 afr = *(const GAS bf16x8*)(ua + (size_t)(D == 0 ? aidx : 127 - aidx) * 512);
#pragma unroll 1
    for (int i = 0; i < 8; ++i) {
        f32x16 acc[4];
#pragma unroll
        for (int q = 0; q < 4; ++q) {
#pragma unroll
            for (int r = 0; r < 16; ++r) acc[q][r] = 0.f;
            acc[q] = MFMA32(afr, bq[q], acc[q]); }
        if (i < 7) afr = *(const GAS bf16x8*)(ua + (size_t)(D == 0 ? 16 * (i + 1) + aidx : 127 - 16 * (i + 1) - aidx) * 512);
#pragma unroll
        for (int j = 0; j < 16; ++j) {
            const float nr0 = lr0 * hr0 - li0 * hi0 + acc[0][j], ni0 = lr0 * hi0 + li0 * hr0 + acc[2][j]; hr0 = nr0; hi0 = ni0; acc[0][j] = nr0; acc[2][j] = ni0;
            const float nr1 = lr1 * hr1 - li1 * hi1 + acc[1][j], ni1 = lr1 * hi1 + li1 * hr1 + acc[3][j]; hr1 = nr1; hi1 = ni1; acc[1][j] = nr1; acc[3][j] = ni1; }
        if (MODE != 0) {
            store_acc_nat(acc[0], SI, 72, 0, 0, lane); store_acc_nat(acc[1], SI, 72, 32, 0, lane); store_acc_nat(acc[2], SI, 72, 64, 0, lane); store_acc_nat(acc[3], SI, 72, 96, 0, lane);
            asm volatile("s_waitcnt lgkmcnt(0)" ::: "memory");
            f32x16 y;
#pragma unroll
            for (int r = 0; r < 16; ++r) y[r] = 0.f;
#pragma unroll
            for (int ks = 0; ks < 8; ++ks) y = MFMA32(frag_tr(SI, 72, 16 * ks, 0, lane), cm[ks], y);
            asm volatile("" ::: "memory");
            LAS float* YT = (LAS float*)(SI + 9216);
            if (n < 16) {
#pragma unroll
                for (int j = 0; j < 16; ++j) YT[arow(j, hs) * 20 + n] = y[j]; }
            asm volatile("s_waitcnt lgkmcnt(0)" ::: "memory");
            { const int m = lane >> 1, c8 = (lane & 1) * 8, ms = (m >> 2) & 1, mi = 4 * (m >> 3) + (m & 3);
              const int pos = D == 0 ? 16 * i + mi : 127 - 16 * i - mi, row = row0 + 128 * ms + pos;
              const f32x4 ya = *(const LAS f32x4*)(YT + m * 20 + c8), yb2 = *(const LAS f32x4*)(YT + m * 20 + c8 + 4);
              LAS v4u* yfp = (LAS v4u*)(SI + 11776 + (128 * ms + pos) * 32 + c8 * 2);
              if (MODE == 1) { v4u w; w.x = pk2(ya.x, ya.y); w.y = pk2(ya.z, ya.w); w.z = pk2(yb2.x, yb2.y); w.w = pk2(yb2.z, yb2.w); *yfp = w; }
              else { float f8[8]; unpack8(*yfp, f8); const f32x4 fa = {f8[0], f8[1], f8[2], f8[3]}, fb = {f8[4], f8[5], f8[6], f8[7]}; float u8[8]; unpack8(*(const GAS v4u*)(sp.U + (size_t)row * 512 + g * 16 + c8), u8);
                  const f32x4 d0 = *(const GAS f32x4*)(sp.S5D + g * 16 + c8), d1 = *(const GAS f32x4*)(sp.S5D + g * 16 + c8 + 4);
                  float v[8] = {ya.x + fa.x + d0.x * u8[0], ya.y + fa.y + d0.y * u8[1], ya.z + fa.z + d0.z * u8[2], ya.w + fa.w + d0.w * u8[3], yb2.x + fb.x + d1.x * u8[4], yb2.y + fb.y + d1.y * u8[5], yb2.z + fb.z + d1.z * u8[6], yb2.w + fb.w + d1.w * u8[7]};
#pragma unroll
                  for (int q = 0; q < 8; ++q) { const float tt = 0.7978845608f * (v[q] + 0.044715f * v[q] * v[q] * v[q]); v[q] = v[q] * (1.f - __builtin_amdgcn_rcpf(__expf(2.f * tt) + 1.f)); }
                  v4u w; w.x = pk2(v[0], v[1]); w.y = pk2(v[2], v[3]); w.z = pk2(v[4], v[5]); w.w = pk2(v[6], v[7]);
                  *(GAS v4u*)(sp.A2 + (size_t)row * 512 + g * 16 + c8) = w; } }
        }
    }
    if (MODE == 0) { *(GAS f32x2*)stp = (f32x2){hr0, hi0}; *(GAS f32x2*)(stp + 64) = (f32x2){hr1, hi1}; }
}
__device__ __forceinline__ void phase_s5A(const S5Ptrs& sp, LAS unsigned char* lds, int bid, int G, int wave, int lane) {
    LAS unsigned char* SI = lds + wave * 19968;
    for (int it = bid; it < 65 * 8; it += G) { const int col = it >> 3, gb = (it >> 1) & 3, d = it & 1, g = gb * 8 + wave;
        const int row0 = col < 64 ? col * 256 : ML, slot0 = col < 64 ? 2 * col : 128;
        if (d == 0) s5_wave<0, 0>(sp, SI, row0, g, slot0, lane); else s5_wave<0, 1>(sp, SI, row0, g, slot0, lane); }
}
__device__ __forceinline__ void phase_s5B(const S5Ptrs& sp, const Params& p, LAS unsigned char* lds, int bid, int G, int tid, int wave, int lane) {
    const int gt = bid * 512 + tid;
    if (bid >= 8 && G > 8) {
        const int gw = (bid - 8) * NWAVES + wave, ngw = (G - 8) * NWAVES; LAS float* scr = (LAS float*)(lds + wave * 16384); unsigned char* wr = p.ws + WS_WREST;
        tr_job(p.in[I_WVAL], 512, 1024, 2, (bf16*)(wr + WO_VG), scr, gw, ngw, lane);
        tr_job(p.in[I_WGATE2], 512, 1024, 3, (bf16*)(wr + WO_VG), scr, gw, ngw, lane);
        tr_job(p.in[I_WGATE] + (size_t)1024 * DFF, 1024, DFF, 2, (bf16*)(wr + WO_UP1), scr, gw, ngw, lane);
        tr_job(p.in[I_WUP] + (size_t)1024 * DFF, 1024, DFF, 3, (bf16*)(wr + WO_UP1), scr, gw, ngw, lane);
        tr_job(p.in[I_WDOWN] + (size_t)DFF * 1024, DFF, 1024, 1, (bf16*)(wr + WO_DOWN1), scr, gw, ngw, lane);
    }
    if (gt < 4096) { const int d = gt >> 11, gp = gt & 2047, s = d * 2048 + gp; const float pr = sp.LAMP[2 * s], pi = sp.LAMP[2 * s + 1];
        GAS f32x2* st = (GAS f32x2*)sp.ST; f32x2 run = {0.f, 0.f};
        for (int i0 = 0; i0 < 130; i0 += 10) { f32x2 loc[10];
#pragma unroll
            for (int j = 0; j < 10; ++j) { const int q = i0 + j, slot = d == 0 ? (q < 2 ? 128 + q : q - 2) : (q < 2 ? 129 - q : 129 - q); loc[j] = st[(size_t)(slot * 2 + d) * 2048 + gp]; }
#pragma unroll
            for (int j = 0; j < 10; ++j) { const int q = i0 + j, slot = d == 0 ? (q < 2 ? 128 + q : q - 2) : (q < 2 ? 129 - q : 129 - q); st[(size_t)(slot * 2 + d) * 2048 + gp] = run;
                const float nr = pr * run.x - pi * run.y + loc[j].x, ni = pr * run.y + pi * run.x + loc[j].y; run.x = nr; run.y = ni; } }
    }
}
__device__ __forceinline__ void phase_s5C(const S5Ptrs& sp, LAS unsigned char* lds, int bid, int G, int wave, int lane) {
    LAS unsigned char* SI = lds + wave * 19968;
    for (int it = bid; it < 256; it += G) { const int col = it >> 2, g = (it & 3) * 8 + wave;
        s5_wave<1, 0>(sp, SI, col * 256, g, 2 * col, lane);
        asm volatile("s_waitcnt lgkmcnt(0)" ::: "memory");
        s5_wave<2, 1>(sp, SI, col * 256, g, 2 * col, lane); }
}
__device__ __forceinline__ void phase_final(const Params& p, int bid, int G, int wave, int lane) {
    const int gw = bid * NWAVES + wave, ngw = G * NWAVES; const float* fg = p.in[I_FNORM];
    for (int row = gw; row < ML; row += ngw) { float* xr = p.out + (size_t)row * 1024;
        f32x4 v[4]; float ss = 0.f;
#pragma unroll
        for (int j = 0; j < 4; ++j) { v[j] = *(const GAS f32x4*)(xr + 4 * lane + 256 * j); ss += (v[j].x * v[j].x + v[j].y * v[j].y) + (v[j].z * v[j].z + v[j].w * v[j].w); }
        const float r = rsqrtf(wave_sum(ss) * (1.f / 1024.f) + EPS);
#pragma unroll
        for (int j = 0; j < 4; ++j) { const f32x4 g4 = *(const GAS f32x4*)(fg + 4 * lane + 256 * j); *(GAS f32x4*)(xr + 4 * lane + 256 * j) = (f32x4){v[j].x * r * g4.x, v[j].y * r * g4.y, v[j].z * r * g4.z, v[j].w * r * g4.w}; }
    }
}

__device__ __forceinline__ void ctx_mini_gemm(LAS unsigned char* lds, const bf16* A, const bf16* Bt, int K, const float* base, float* out, const float* gate, int bid, int G, int tid) {
    const int lane = tid & 63, wave = __builtin_amdgcn_readfirstlane(tid >> 6), hf = lane >> 5;
    LAS float* red = (LAS float*)lds;
    for (int t = bid; t < 256; t += G) {
        const int rb = t >> 5, cb = t & 31, kw = K >> 3;
        const bf16* ap = A + (size_t)(32 * rb + (lane & 31)) * K + wave * kw + 8 * hf;
        const bf16* bp = Bt + (size_t)(32 * cb + (lane & 31)) * K + wave * kw + 8 * hf;
        f32x16 acc;
#pragma unroll
        for (int r = 0; r < 16; ++r) acc[r] = 0.f;
        for (int k0 = 0; k0 < kw; k0 += 64) {
            bf16x8 af[4], bfr[4];
#pragma unroll
            for (int q = 0; q < 4; ++q) if (k0 + 16 * q < kw) { af[q] = *(const GAS bf16x8*)(ap + k0 + 16 * q); bfr[q] = *(const GAS bf16x8*)(bp + k0 + 16 * q); }
#pragma unroll
            for (int q = 0; q < 4; ++q) if (k0 + 16 * q < kw) acc = MFMA32(af[q], bfr[q], acc);
        }
#pragma unroll
        for (int r = 0; r < 16; ++r) red[(wave * 32 + arow(r, hf)) * 33 + (lane & 31)] = acc[r];
        __syncthreads();
#pragma unroll
        for (int q = 0; q < 2; ++q) { const int e = tid + 512 * q, r = e >> 5, c = e & 31; float v = 0.f;
#pragma unroll
            for (int w = 0; w < 8; ++w) v += red[(w * 32 + r) * 33 + c];
            const size_t o = (size_t)(32 * rb + r) * 1024 + 32 * cb + c; out[o] = base[o] + gate[32 * cb + c] * v; }
        __syncthreads();
    }
}
constexpr int N_PHASES = 22;
__device__ __forceinline__ void run_gmix(const Params& p, LAS unsigned char* lds, int bid, int G) {
    unsigned char* ws = p.ws;
    pg8::Gemm g{(const bf16*)(ws + WS_RX), (const bf16*)(ws + WS_WIN), M, NINP, 1024}; pg8::StaticOrder S; S.init(M, NINP, G, bid);
    pg8::EpiMix1 E{(bf16*)(ws + WS_ZQ), (bf16*)(ws + WS_XBC), (bf16*)(ws + WS_V), (bf16*)(ws + WS_G), (f16*)p.out, (f16*)(ws + WS_FCTX), (float*)(ws + WS_DT), (const float*)(ws + WS_SMALL + SM_LB), p.in[I_DTB], p.in[I_ALOG]};
    pg8::gemm_phase<pg8::EpiMix1, pg8::StaticOrder, true, true>(lds + RING_OFF, g, S, E);
}
__device__ __forceinline__ void run_gout(const Params& p, LAS unsigned char* lds, int bid, int G, int tid) {
    unsigned char* ws = p.ws; const float* mods = (const float*)(ws + WS_SMALL + SM_MODS);
    pg8::Gemm g{(const bf16*)(ws + WS_ZQ), (const bf16*)(ws + WS_WREST + WO_OUT), ML, 1024, 2048}; pg8::StaticOrder S; S.init(ML, 1024, G, bid);
    pg8::EpiResid E{p.in[I_X], p.in[I_CTX], p.out, (float*)(ws + WS_HCTX), mods + (0 * 2 + 0) * 6144 + 2 * 1024, mods + (0 * 2 + 1) * 6144 + 2 * 1024};
    pg8::gemm_phase<pg8::EpiResid, pg8::StaticOrder, true, true>(lds + RING_OFF, g, S, E);
    ctx_mini_gemm(lds, (const bf16*)(ws + WS_ZQ) + (size_t)ML * 2048, (const bf16*)(ws + WS_WREST + WO_OUT), 2048, p.in[I_CTX], (float*)(ws + WS_HCTX), mods + (0 * 2 + 1) * 6144 + 2 * 1024, bid, G, tid);
}
__device__ __forceinline__ void run_gup(const Params& p, LAS unsigned char* lds, int bid, int G, int layer) {
    unsigned char* ws = p.ws; const int rows = layer ? ML : M;
    pg8::Gemm g{(const bf16*)(ws + WS_RX), (const bf16*)(ws + WS_WREST + (layer ? WO_UP1 : WO_UP0)), rows, 2 * DFF, 1024}; pg8::StaticOrder S; S.init(rows, 2 * DFF, G, bid);
    pg8::EpiSwiglu E{(bf16*)(ws + WS_HID)};
    pg8::gemm_phase<pg8::EpiSwiglu, pg8::StaticOrder, true, true>(lds + RING_OFF, g, S, E);
}
__device__ __forceinline__ void run_gdown(const Params& p, LAS unsigned char* lds, int bid, int G, int layer, int tid) {
    unsigned char* ws = p.ws; const float* mods = (const float*)(ws + WS_SMALL + SM_MODS); float* Hctx = (float*)(ws + WS_HCTX);
    pg8::Gemm g{(const bf16*)(ws + WS_HID), (const bf16*)(ws + WS_WREST + (layer ? WO_DOWN1 : WO_DOWN0)), ML, 1024, DFF}; pg8::StaticOrder S; S.init(ML, 1024, G, bid);
    pg8::EpiResid E{p.out, Hctx, p.out, Hctx, mods + (layer * 2 + 0) * 6144 + 5 * 1024, mods + (layer * 2 + 1) * 6144 + 5 * 1024};
    pg8::gemm_phase<pg8::EpiResid, pg8::StaticOrder, true, true>(lds + RING_OFF, g, S, E);
    if (layer == 0) ctx_mini_gemm(lds, (const bf16*)(ws + WS_HID) + (size_t)ML * DFF, (const bf16*)(ws + WS_WREST + WO_DOWN0), DFF, Hctx, Hctx, mods + (0 * 2 + 1) * 6144 + 5 * 1024, bid, G, tid);
}
__device__ __forceinline__ void run_god(const Params& p, LAS unsigned char* lds, int bid, int G) {
    unsigned char* ws = p.ws;
    pg8::Gemm g{(const bf16*)(ws + WS_RX), (const bf16*)(ws + WS_WREST + WO_OD), M, 512, 1024}; pg8::StaticOrder S; S.init(M, 512, G, bid);
    pg8::EpiU E{(bf16*)(ws + WS_U)};
    pg8::gemm_phase<pg8::EpiU, pg8::StaticOrder, true, true>(lds + RING_OFF, g, S, E);
}
__device__ __forceinline__ void run_gvg(const Params& p, LAS unsigned char* lds, int bid, int G) {
    unsigned char* ws = p.ws; const float* mods = (const float*)(ws + WS_SMALL + SM_MODS);
    pg8::Gemm g{(const bf16*)(ws + WS_A2), (const bf16*)(ws + WS_WREST + WO_VG), ML, 2048, 512}; pg8::StaticOrder S; S.init(ML, 2048, G, bid);
    pg8::EpiValGate E{p.out, mods + (1 * 2 + 0) * 6144 + 2 * 1024};
    pg8::gemm_phase<pg8::EpiValGate, pg8::StaticOrder, true, true>(lds + RING_OFF, g, S, E);
}
__device__ __forceinline__ ScanPtrs make_scanptrs(const Params& p) {
    unsigned char* ws = p.ws; ScanPtrs sp; sp.XBC = (const bf16*)(ws + WS_XBC); sp.DT = (const float*)(ws + WS_DT); sp.ZQ = (bf16*)(ws + WS_ZQ); sp.V = (const bf16*)(ws + WS_V); sp.G = (const bf16*)(ws + WS_G); sp.Flat = (f16*)p.out; sp.Fctx = (f16*)(ws + WS_FCTX);
    sp.STATS = (float*)(ws + WS_SMALL + SM_STATS); sp.convw = p.in[I_CONVW]; sp.convb = p.in[I_CONVB]; sp.ssdd = p.in[I_SSDD]; sp.hgn = p.in[I_HGN];
    sp.SSD_ST = (bf16*)(ws + WS_RX); sp.HG_ST = (bf16*)(ws + WS_RX + SSD_ST_BYTES); sp.SSD_DEC = (float*)(ws + WS_SMALL + SM_SSDDEC); sp.HG_DEC = (float*)(ws + WS_SMALL + SM_HGDEC); sp.BCC = (const bf16*)(ws + WS_BCC); return sp;
}
__device__ __forceinline__ S5Ptrs make_s5ptrs(const Params& p) {
    unsigned char* ws = p.ws; S5Ptrs s5; s5.U = (const bf16*)(ws + WS_U); s5.YS = (float*)(ws + WS_YS); s5.A2 = (bf16*)(ws + WS_A2); s5.LAM = (const float*)(ws + WS_SMALL + SM_LAM); s5.LAMP = (const float*)(ws + WS_SMALL + SM_LAMP);
    s5.BBH = (const bf16*)(ws + WS_SMALL + SM_BB); s5.CMH = (const bf16*)(ws + WS_SMALL + SM_BB + 262144); s5.S5D = p.in[I_S5D]; s5.ST = (float*)(ws + WS_SMALL + SM_S5ST); return s5;
}
__global__ void __launch_bounds__(NWAVES * 64, 2) mk_fwd(Params p) {
    extern __shared__ __attribute__((aligned(16))) unsigned char lds_raw[];
    LAS unsigned char* lds = (LAS unsigned char*)lds_raw;
    volatile LAS unsigned* MISC = (volatile LAS unsigned*)(lds + MISC_OFF);
    const int tid = threadIdx.x, lane = tid & 63, wave = __builtin_amdgcn_readfirstlane(tid >> 6), G = gridDim.x, bid = blockIdx.x;
    gu32* ctl = (gu32*)(p.ws + WS_CTL);
    for (int u = tid; u < (LDS_BYTES - LDSCTL_OFF) / 4; u += NWAVES * 64) ((LAS unsigned*)(lds + LDSCTL_OFF))[u] = 0u;
    __syncthreads();
    XcdBarrier bar; bar.bar = (unsigned*)(ctl + CW_BAR); bar.x = 0; bar.st = nullptr;
    if (p.use_bar) bar = xcd_barrier_post((unsigned*)(ctl + CW_BAR), MISC + 8);
    const int lo = p.ph_lo, hi = p.ph_hi;
#ifndef MK_ONLYPH
#define MK_ONLYPH -1
#endif
#define IN(k) ((MK_ONLYPH < 0 || MK_ONLYPH == (k)) && lo <= (k) && (k) < hi)
#define SEAM(k) do { if ((k) + 1 < hi) xcd_barrier(bar); } while (0)
    if (IN(0)) { phase_prologue(p, lds, bid, G, tid, wave, lane); SEAM(0); }
    if (IN(1)) { phase_rownorm(p, lds, bid, G, tid, wave, lane, 0, 0, M, p.in[I_X], p.in[I_CTX], true); SEAM(1); }
    if (IN(2)) { run_gmix(p, lds, bid, G); SEAM(2); }
    if (IN(3)) { phase_convbc(p, bid, G, tid); const ScanPtrs sp = make_scanptrs(p); phase_scanA1(sp, lds, bid, G, tid); SEAM(3); }
    if (IN(4)) { const ScanPtrs sp = make_scanptrs(p); phase_scanA2(sp, lds, bid, G, tid); SEAM(4); }
    if (IN(5)) { const ScanPtrs sp = make_scanptrs(p); phase_scanB(sp, bid, G, tid); SEAM(5); }
    if (IN(6)) { const ScanPtrs sp = make_scanptrs(p); phase_scanC(sp, lds, bid, G, tid); SEAM(6); }
    if (IN(7)) { phase_finish(p, lds, bid, G, tid, wave, lane); SEAM(7); }
    if (IN(8)) { run_gout(p, lds, bid, G, tid); SEAM(8); }
    if (IN(9)) { phase_rownorm(p, lds, bid, G, tid, wave, lane, 0, 1, M, p.out, (const float*)(p.ws + WS_HCTX), false); SEAM(9); }
    if (IN(10)) { run_gup(p, lds, bid, G, 0); SEAM(10); }
    if (IN(11)) { run_gdown(p, lds, bid, G, 0, tid); SEAM(11); }
    if (IN(12)) { phase_rownorm(p, lds, bid, G, tid, wave, lane, 1, 0, M, p.out, (const float*)(p.ws + WS_HCTX), false); SEAM(12); }
    if (IN(13)) { run_god(p, lds, bid, G); SEAM(13); }
    if (IN(14)) { const S5Ptrs s5 = make_s5ptrs(p); phase_s5A(s5, lds, bid, G, wave, lane); SEAM(14); }
    if (IN(15)) { const S5Ptrs s5 = make_s5ptrs(p); phase_s5B(s5, p, lds, bid, G, tid, wave, lane); SEAM(15); }
    if (IN(16)) { const S5Ptrs s5 = make_s5ptrs(p); phase_s5C(s5, lds, bid, G, wave, lane); SEAM(16); }
    if (IN(17)) { run_gvg(p, lds, bid, G); SEAM(17); }
    if (IN(18)) { phase_rownorm(p, lds, bid, G, tid, wave, lane, 1, 1, ML, p.out, (const float*)(p.ws + WS_HCTX), false); SEAM(18); }
    if (IN(19)) { run_gup(p, lds, bid, G, 1); SEAM(19); }
    if (IN(20)) { run_gdown(p, lds, bid, G, 1, tid); SEAM(20); }
    if (IN(21)) { phase_final(p, bid, G, wave, lane); }
#undef IN
#undef SEAM
}

extern "C" void kernel_launch(void* const* d_in, const int* in_sizes, int n_in, void* d_out, int out_size, void* d_ws, size_t ws_size, hipStream_t stream) {
    static int grid = 0;
    if (grid == 0) {
        if (n_in != 33 || out_size != ML * D || ws_size < 256 * MiB) { fprintf(stderr, "kernel_launch: unexpected shapes (n_in %d, out %d, ws %zu); nothing launched\n", n_in, out_size, ws_size); grid = -1; return; }
        int dev = 0, cus = 0, per_cu = 0;
        if (hipGetDevice(&dev) != hipSuccess || hipDeviceGetAttribute(&cus, hipDeviceAttributeMultiprocessorCount, dev) != hipSuccess) { grid = -1; return; }
        if (hipFuncSetAttribute((const void*)mk_fwd, hipFuncAttributeMaxDynamicSharedMemorySize, LDS_BYTES) != hipSuccess) { fprintf(stderr, "kernel_launch: hipFuncSetAttribute failed\n"); grid = -1; return; }
        if (hipOccupancyMaxActiveBlocksPerMultiprocessor(&per_cu, (const void*)mk_fwd, NWAVES * 64, LDS_BYTES) != hipSuccess || per_cu < 1) fprintf(stderr, "kernel_launch: occupancy query reports %d\n", per_cu);
        (void)hipGetLastError();
        grid = cus;
    }
    if (grid < 0) return;
    (void)hipMemsetAsync((char*)d_ws + WS_CTL, 0, CTL_ZERO_BYTES, stream);
    Params a{};
    for (int i = 0; i < 33; ++i) a.in[i] = (const float*)d_in[i];
    a.out = (float*)d_out; a.ws = (unsigned char*)d_ws;
#if MK_N_LAUNCHES == 1
    a.ph_lo = 0; a.ph_hi = N_PHASES; a.use_bar = 1;
    hipLaunchKernelGGL(mk_fwd, dim3(grid), dim3(NWAVES * 64), LDS_BYTES, stream, a);
#else
    for (int ph = 0; ph < N_PHASES; ++ph) { a.ph_lo = ph; a.ph_hi = ph + 1; a.use_bar = 0; hipLaunchKernelGGL(mk_fwd, dim3(grid), dim3(NWAVES * 64), LDS_BYTES, stream, a); }
#endif
}
```

```cpp
#include <hip/hip_runtime.h>
#include <cstdio>
#include <cstdint>

#ifndef MK_N_LAUNCHES
#define MK_N_LAUNCHES 1
#endif
namespace pg8 {
#define PG8_LAS __attribute__((address_space(3)))
typedef unsigned short bf16_t;
typedef short bf16x8 __attribute__((ext_vector_type(8)));
typedef float f32x4 __attribute__((ext_vector_type(4)));
typedef unsigned u32x4 __attribute__((ext_vector_type(4)));
constexpr int BM = 256, BK = 64, HALF = 128, HTB = HALF * BK * 2  , STAGE_BYTES = 8 * HTB, NXCD = 8, WGM = 8;

__host__ __device__ __forceinline__ int lds_byte(int r, int c) { const int st = (r >> 4) * 2 + (c >> 5), rr = r & 15, cc = c & 31, ob = rr * 64 + cc * 2; return st * 1024 + (ob ^ (((ob >> 9) & 1) << 5)); }
__host__ __device__ __forceinline__ void stage_rc(int b, int& R, int& C) { const int st = b / 1024, sb = b % 1024, swz = sb ^ (((sb >> 9) & 1) << 5); R = (st >> 1) * 16 + swz / 64; C = (st & 1) * 32 + (swz % 64) / 2; }
__host__ __device__ __forceinline__ int perm32(int rho) { const int n = rho >> 4, i = rho & 15; return 8 * (i >> 2) + 4 * n + (i & 3); }

struct Unit { int pm, pn; };
struct Gemm { const bf16_t* A; const bf16_t* Bt; int M, N, K; };

struct StaticOrder {
    int nM, nN, nwg, G, c;
    __host__ __device__ void init(int M, int N, int G_, int c_) { nM = M / BM; nN = N / BM; nwg = nM * nN; G = G_; c = c_; }
    __host__ __device__ bool next(int i, Unit& u) const {
        const long L = (long)i * G + c; if (L >= nwg) return false;
        int wgid = (int)L; { const int q = nwg / NXCD, r = nwg % NXCD, xcd = wgid % NXCD, off = wgid / NXCD; wgid = (xcd < r ? xcd * (q + 1) : r * (q + 1) + (xcd - r) * q) + off; }
        const int nig = WGM * nN, gid = wgid / nig, fm = gid * WGM, gsz = (nM - fm) < WGM ? (nM - fm) : WGM;
        u.pm = fm + ((wgid % nig) % gsz); u.pn = (wgid % nig) / gsz; return true;
    }
    __device__ __forceinline__ void a_ready(const Unit&) const {}
    __device__ __forceinline__ void done(const Unit&) const {}
};

__device__ __forceinline__ unsigned cvt_pk_bf16(float lo, float hi) { unsigned r; asm volatile("v_cvt_pk_bf16_f32 %0, %1, %2" : "=v"(r) : "v"(lo), "v"(hi)); return r; }
typedef float f32x2 __attribute__((ext_vector_type(2)));
typedef _Float16 f16x8 __attribute__((ext_vector_type(8)));
__device__ __forceinline__ float siluf(float x) { return x * __builtin_amdgcn_rcpf(1.f + __expf(-x)); }
__device__ __forceinline__ float sigmf(float x) { return __builtin_amdgcn_rcpf(1.f + __expf(-x)); }
__device__ __forceinline__ u32x4 pack8_bf16(const float (&x)[8]) { u32x4 w; w.x = cvt_pk_bf16(x[0], x[1]); w.y = cvt_pk_bf16(x[2], x[3]); w.z = cvt_pk_bf16(x[4], x[5]); w.w = cvt_pk_bf16(x[6], x[7]); return w; }
constexpr int EP_ML = 16384;

struct EpiMix1 {
    static constexpr bool PERM = true, AFTER_DRAIN = false;
    bf16_t* ZQ; bf16_t* XBC; bf16_t* V; bf16_t* G; _Float16* Flat; _Float16* Fctx; float* DT; const float* lb; const float* dt_bias; const float* a_log;
    template <int KIND> __device__ __forceinline__ void tile(const f32x4 (&acc)[2][2][4][2], const Unit& u, int wr, int wc, int fr, int fq, int seg_tile) const {
        const int row0 = u.pm * BM + wr * 64 + fr, cw = wc * 32 + 8 * fq;
#pragma unroll
        for (int ai = 0; ai < 2; ++ai)
#pragma unroll
            for (int m = 0; m < 4; ++m) { const int row = row0 + ai * HALF + m * 16;
#pragma unroll
                for (int bj = 0; bj < 2; ++bj) { const f32x4 v0 = acc[ai][bj][m][0], v1 = acc[ai][bj][m][1]; const int c = seg_tile * 256 + bj * HALF + cw;
                    float x[8] = {v0[0], v0[1], v0[2], v0[3], v1[0], v1[1], v1[2], v1[3]};
                    if constexpr (KIND == 0) {
#pragma unroll
                        for (int i = 0; i < 8; ++i) x[i] = siluf(x[i]);
                        *(u32x4*)(ZQ + (size_t)row * 2048 + c) = pack8_bf16(x);
                    } else if constexpr (KIND == 1) {
                        *(u32x4*)(XBC + (size_t)row * 1536 + c) = pack8_bf16(x);
                    } else if constexpr (KIND == 2) {
#pragma unroll
                        for (int i = 0; i < 8; ++i) x[i] = siluf(x[i]);
                        *(u32x4*)(ZQ + (size_t)row * 2048 + 1024 + c) = pack8_bf16(x);
                    } else if constexpr (KIND == 3) {
                        f16x8 h;
#pragma unroll
                        for (int i = 0; i < 8; ++i) { const float l = lb[(c + i) & 1023]; const float f = l + (1.f - l) * sigmf(x[i]); h[i] = (_Float16)__logf(f); }
                        _Float16* dst = (row < EP_ML) ? Flat + (size_t)row * 2048 : Fctx + (size_t)(row - EP_ML) * 2048;
                        *(f16x8*)(dst + c) = h;
                    } else if constexpr (KIND == 4) {
                        *(u32x4*)(V + (size_t)row * 1024 + c) = pack8_bf16(x);
                    } else if constexpr (KIND == 5) {
#pragma unroll
                        for (int i = 0; i < 8; ++i) x[i] = siluf(x[i]);
                        *(u32x4*)(G + (size_t)row * 1024 + c) = pack8_bf16(x);
                    } else {
                        if (bj == 0 && wc == 0) {
                            float dtv[8], la[8];
#pragma unroll
                            for (int i = 0; i < 8; ++i) { const int j = 8 * fq + i; const float r = x[i] + dt_bias[j]; dtv[i] = r > 20.f ? r : log1pf(__expf(r)); la[i] = -dtv[i] * __expf(a_log[j]); }
                            float* d = DT + (size_t)row * 64 + 8 * fq;
                            *(f32x4*)(d) = (f32x4){dtv[0], dtv[1], dtv[2], dtv[3]}; *(f32x4*)(d + 4) = (f32x4){dtv[4], dtv[5], dtv[6], dtv[7]};
                            *(f32x4*)(d + 32) = (f32x4){la[0], la[1], la[2], la[3]}; *(f32x4*)(d + 36) = (f32x4){la[4], la[5], la[6], la[7]};
                        }
                    } } }
    }
    __device__ __forceinline__ void operator()(const f32x4 (&acc)[2][2][4][2], const Unit& u, int wr, int wc, int fr, int fq) const {
        const int pn = u.pn;
        if (pn < 4) tile<0>(acc, u, wr, wc, fr, fq, pn);
        else if (pn < 10) tile<1>(acc, u, wr, wc, fr, fq, pn - 4);
        else if (pn < 14) tile<2>(acc, u, wr, wc, fr, fq, pn - 10);
        else if (pn < 22) tile<3>(acc, u, wr, wc, fr, fq, pn - 14);
        else if (pn < 26) tile<4>(acc, u, wr, wc, fr, fq, pn - 22);
        else if (pn < 30) tile<5>(acc, u, wr, wc, fr, fq, pn - 26);
        else tile<6>(acc, u, wr, wc, fr, fq, 0);
    }
};
struct EpiResid {
    static constexpr bool PERM = false, AFTER_DRAIN = false;
    const float* base_lat; const float* base_ctx; float* out_lat; float* out_ctx; const float* gate_lat; const float* gate_ctx;
    __device__ __forceinline__ void operator()(const f32x4 (&acc)[2][2][4][2], const Unit& u, int wr, int wc, int fr, int fq) const {
        const bool isc = u.pm >= 64; const float* base = isc ? base_ctx : base_lat; float* out = isc ? out_ctx : out_lat; const float* gate = isc ? gate_ctx : gate_lat;
        const int row0 = (isc ? 0 : u.pm * BM) + wr * 64 + fr, col0 = u.pn * BM + wc * 32 + 4 * fq;
        f32x4 gv[2][2];
#pragma unroll
        for (int bj = 0; bj < 2; ++bj)
#pragma unroll
            for (int n = 0; n < 2; ++n) gv[bj][n] = *(const f32x4*)(gate + col0 + bj * HALF + n * 16);
#pragma unroll
        for (int ai = 0; ai < 2; ++ai)
#pragma unroll
            for (int m = 0; m < 4; ++m) { const size_t off = (size_t)(row0 + ai * HALF + m * 16) * 1024 + col0;
#pragma unroll
                for (int bj = 0; bj < 2; ++bj)
#pragma unroll
                    for (int n = 0; n < 2; ++n) { const f32x4 b = *(const f32x4*)(base + off + bj * HALF + n * 16); *(f32x4*)(out + off + bj * HALF + n * 16) = b + gv[bj][n] * acc[ai][bj][m][n]; } }
    }
};
struct EpiSwiglu {
    static constexpr bool PERM = true, AFTER_DRAIN = false;
    bf16_t* HID;
    __device__ __forceinline__ void operator()(const f32x4 (&acc)[2][2][4][2], const Unit& u, int wr, int wc, int fr, int fq) const {
        const int row0 = u.pm * BM + wr * 64 + fr, c = u.pn * HALF + wc * 32 + 8 * fq;
#pragma unroll
        for (int ai = 0; ai < 2; ++ai)
#pragma unroll
            for (int m = 0; m < 4; ++m) { const f32x4 g0 = acc[ai][0][m][0], g1 = acc[ai][0][m][1], u0 = acc[ai][1][m][0], u1 = acc[ai][1][m][1];
                float x[8] = {siluf(g0[0]) * u0[0], siluf(g0[1]) * u0[1], siluf(g0[2]) * u0[2], siluf(g0[3]) * u0[3], siluf(g1[0]) * u1[0], siluf(g1[1]) * u1[1], siluf(g1[2]) * u1[2], siluf(g1[3]) * u1[3]};
                *(u32x4*)(HID + (size_t)(row0 + ai * HALF + m * 16) * 2816 + c) = pack8_bf16(x); }
    }
};
struct EpiU {
    static constexpr bool PERM = true, AFTER_DRAIN = false;
    bf16_t* U;
    __device__ __forceinline__ void operator()(const f32x4 (&acc)[2][2][4][2], const Unit& u, int wr, int wc, int fr, int fq) const {
        const int row0 = u.pm * BM + wr * 64 + fr, col0 = u.pn * BM + wc * 32 + 8 * fq;
#pragma unroll
        for (int ai = 0; ai < 2; ++ai)
#pragma unroll
            for (int m = 0; m < 4; ++m) { const int row = row0 + ai * HALF + m * 16; const int srow = row < EP_ML ? (row & 63) * 256 + (row >> 6) : row;
#pragma unroll
                for (int bj = 0; bj < 2; ++bj) { const f32x4 v0 = acc[ai][bj][m][0], v1 = acc[ai][bj][m][1]; float x[8] = {v0[0], v0[1], v0[2], v0[3], v1[0], v1[1], v1[2], v1[3]};
                    *(u32x4*)(U + (size_t)srow * 512 + col0 + bj * HALF) = pack8_bf16(x); } }
    }
};
struct EpiValGate {
    static constexpr bool PERM = false, AFTER_DRAIN = false;
    float* H; const float* gate;
    __device__ __forceinline__ void operator()(const f32x4 (&acc)[2][2][4][2], const Unit& u, int wr, int wc, int fr, int fq) const {
        const int row0 = u.pm * BM + wr * 64 + fr, col0 = u.pn * HALF + wc * 32 + 4 * fq;
#pragma unroll
        for (int ai = 0; ai < 2; ++ai)
#pragma unroll
            for (int m = 0; m < 4; ++m) { const int srow = row0 + ai * HALF + m * 16, token = (srow & 255) * 64 + (srow >> 8); float* hp = H + (size_t)token * 1024 + col0;
#pragma unroll
                for (int n = 0; n < 2; ++n) { const f32x4 v = acc[ai][0][m][n], g = acc[ai][1][m][n]; const f32x4 gm = *(const f32x4*)(gate + col0 + n * 16); f32x4 h = *(const f32x4*)(hp + n * 16);
                    h[0] += gm[0] * v[0] * sigmf(g[0]); h[1] += gm[1] * v[1] * sigmf(g[1]); h[2] += gm[2] * v[2] * sigmf(g[2]); h[3] += gm[3] * v[3] * sigmf(g[3]); *(f32x4*)(hp + n * 16) = h; } }
    }
};
template <class Epi, class Sched, bool ALIGN_EPI = false, bool SP2 = false>
__device__ __forceinline__ void gemm_phase(PG8_LAS unsigned char* lds, const Gemm g, const Sched& S, const Epi& E) {
    const int tid = threadIdx.x, wid = __builtin_amdgcn_readfirstlane(tid >> 6), lane = tid & 63, wr = wid >> 2, wc = wid & 3, fr = lane & 15, fq = lane >> 4;
    const int K = g.K, nt = K / BK;
    unsigned voffA[2], voffB[2];
#pragma unroll
    for (int i = 0; i < 2; ++i) { int R, C; stage_rc(tid * 16 + i * 8192, R, C); const int Rb = Epi::PERM ? ((R & ~31) + perm32(R & 31)) : R;
        voffA[i] = (unsigned)(R * K + C) * 2u; voffB[i] = (unsigned)(Rb * K + C) * 2u; }
    const size_t kstep = (size_t)(BK * 2);
    const size_t hstep = (size_t)HALF * K * 2;
    const size_t tstep = 2 * hstep;
    const unsigned ldsw = (unsigned)wid * 1024u;
    const int aoff = lds_byte(wr * 64 + fr, fq * 8), boff = lds_byte(wc * 32 + fr, fq * 8);
#define PG8_SA(b, h) (((b) * 2 + (h)) * HTB)
#define PG8_SB(b, h) ((4 + (b) * 2 + (h)) * HTB)
#define PG8_STAGE(bufoff, gbase, voff) do { _Pragma("unroll") for (int _i = 0; _i < 2; ++_i) \
        __builtin_amdgcn_global_load_lds((const unsigned*)((const char*)(gbase) + (voff)[_i]), (PG8_LAS unsigned*)(lds + (bufoff) + ldsw + _i * 8192), 16, 0, 0); } while (0)
#define PG8_LDA(dst, b, h) do { _Pragma("unroll") for (int m = 0; m < 4; ++m) _Pragma("unroll") for (int k = 0; k < 2; ++k) dst[m][k] = *(const PG8_LAS bf16x8*)(lds + PG8_SA(b, h) + aoff + m * 2048 + k * 1024); } while (0)
#define PG8_LDB(dst, b, h) do { _Pragma("unroll") for (int n = 0; n < 2; ++n) _Pragma("unroll") for (int k = 0; k < 2; ++k) dst[n][k] = *(const PG8_LAS bf16x8*)(lds + PG8_SB(b, h) + boff + n * 2048 + k * 1024); } while (0)
#define PG8_MMA(ai, bj, At, Bt) do { __builtin_amdgcn_s_setprio(1); _Pragma("unroll") for (int m = 0; m < 4; ++m) _Pragma("unroll") for (int n = 0; n < 2; ++n) _Pragma("unroll") for (int k = 0; k < 2; ++k) \
        acc[ai][bj][m][n] = __builtin_amdgcn_mfma_f32_16x16x32_bf16(Bt[n][k], At[m][k], acc[ai][bj][m][n], 0, 0, 0); __builtin_amdgcn_s_setprio(0); } while (0)
#define PG8_WAIT_V(n) asm volatile("s_waitcnt vmcnt(" #n ")" ::: "memory")
#define PG8_WAIT_L(n) asm volatile("s_waitcnt lgkmcnt(" #n ")" ::: "memory")
#define PG8_BAR __builtin_amdgcn_s_barrier()
#define PG8_SCHED __builtin_amdgcn_sched_barrier(0)
    Unit cur, nxt; int ui = 0;
    if (!S.next(0, cur)) return;
    f32x4 acc[2][2][4][2];
#pragma unroll
    for (int a = 0; a < 2; ++a)
#pragma unroll
        for (int b = 0; b < 2; ++b)
#pragma unroll
            for (int m = 0; m < 4; ++m)
#pragma unroll
                for (int n = 0; n < 2; ++n) acc[a][b][m][n] = (f32x4){0.f, 0.f, 0.f, 0.f};
    bf16x8 At[4][2], B0[2][2], B1[2][2];
    const char* cA = (const char*)g.A + (size_t)cur.pm * tstep; const char* cB = (const char*)g.Bt + (size_t)cur.pn * tstep;
    S.a_ready(cur);
    if constexpr (SP2) {
        PG8_STAGE(PG8_SB(0, 0), cB, voffB); PG8_STAGE(PG8_SB(0, 1), cB + hstep, voffB); PG8_STAGE(PG8_SA(0, 0), cA, voffA); PG8_STAGE(PG8_SA(0, 1), cA + hstep, voffA);
        if (wr == 1) PG8_BAR;
        PG8_WAIT_V(2); PG8_BAR;
        PG8_STAGE(PG8_SB(1, 0), cB + kstep, voffB); PG8_STAGE(PG8_SA(1, 0), cA + kstep, voffA); PG8_STAGE(PG8_SB(1, 1), cB + hstep + kstep, voffB);
        PG8_WAIT_V(6); PG8_BAR;
    } else {
        PG8_STAGE(PG8_SB(0, 0), cB, voffB); PG8_STAGE(PG8_SA(0, 0), cA, voffA); PG8_STAGE(PG8_SB(0, 1), cB + hstep, voffB); PG8_STAGE(PG8_SA(0, 1), cA + hstep, voffA);
        if (wr == 1) PG8_BAR;
        PG8_WAIT_V(4); PG8_BAR;
        PG8_STAGE(PG8_SB(1, 0), cB + kstep, voffB); PG8_STAGE(PG8_SA(1, 0), cA + kstep, voffA); PG8_STAGE(PG8_SB(1, 1), cB + hstep + kstep, voffB);
        PG8_WAIT_V(6); PG8_BAR;
    }
    for (;;) {
        const bool has_next = S.next(ui + 1, nxt);
        const char* nA = has_next ? (const char*)g.A + (size_t)nxt.pm * tstep : cA; const char* nB = has_next ? (const char*)g.Bt + (size_t)nxt.pn * tstep : cB;
        for (int t = 0; t < nt; t += 2) {
            const bool last = (t == nt - 2);
            const char* a1 = cA + (size_t)(t + 1) * kstep;
            const char* a2 = last ? nA : cA + (size_t)(t + 2) * kstep; const char* b2 = last ? nB : cB + (size_t)(t + 2) * kstep;
            const char* a3 = a2 + kstep; const char* b3 = b2 + kstep;
            if (last && has_next) S.a_ready(nxt);
            if constexpr (SP2) {
            PG8_LDB(B0, 0, 0); PG8_LDB(B1, 0, 1); PG8_SCHED; PG8_LDA(At, 0, 0); PG8_STAGE(PG8_SA(1, 1), a1 + hstep, voffA);
            PG8_WAIT_V(8); PG8_WAIT_L(0); PG8_BAR; PG8_MMA(0, 0, At, B0); PG8_MMA(0, 1, At, B1); PG8_BAR; PG8_SCHED;
            PG8_LDA(At, 0, 1); PG8_STAGE(PG8_SB(0, 0), b2, voffB); PG8_STAGE(PG8_SB(0, 1), b2 + hstep, voffB); PG8_STAGE(PG8_SA(0, 0), a2, voffA);
            PG8_WAIT_V(8); PG8_WAIT_L(0); PG8_BAR; PG8_MMA(1, 0, At, B0); PG8_MMA(1, 1, At, B1); PG8_BAR; PG8_SCHED;
            PG8_LDB(B0, 1, 0); PG8_LDB(B1, 1, 1); PG8_SCHED; PG8_LDA(At, 1, 0); PG8_STAGE(PG8_SA(0, 1), a2 + hstep, voffA);
            PG8_WAIT_V(8); PG8_WAIT_L(0); PG8_BAR; PG8_MMA(0, 0, At, B0); PG8_MMA(0, 1, At, B1); PG8_BAR; PG8_SCHED;
            PG8_LDA(At, 1, 1); PG8_STAGE(PG8_SB(1, 0), b3, voffB); PG8_STAGE(PG8_SB(1, 1), b3 + hstep, voffB); PG8_STAGE(PG8_SA(1, 0), a3, voffA);
            PG8_WAIT_V(8); PG8_WAIT_L(0); PG8_BAR; PG8_MMA(1, 0, At, B0); PG8_MMA(1, 1, At, B1); PG8_BAR; PG8_SCHED;
            } else {
            PG8_LDB(B0, 0, 0); PG8_SCHED; PG8_LDA(At, 0, 0); PG8_STAGE(PG8_SA(1, 1), a1 + hstep, voffA);
            PG8_WAIT_L(8); PG8_BAR; PG8_WAIT_L(0); PG8_MMA(0, 0, At, B0); PG8_BAR; PG8_SCHED;
            PG8_LDB(B1, 0, 1); PG8_STAGE(PG8_SB(0, 0), b2, voffB);
            PG8_BAR; PG8_WAIT_L(0); PG8_MMA(0, 1, At, B1); PG8_BAR;
            PG8_LDA(At, 0, 1); PG8_STAGE(PG8_SA(0, 0), a2, voffA);
            PG8_BAR; PG8_WAIT_L(0); PG8_MMA(1, 0, At, B0); PG8_BAR; PG8_SCHED;
            PG8_STAGE(PG8_SB(0, 1), b2 + hstep, voffB);
            PG8_WAIT_V(6); PG8_BAR; PG8_MMA(1, 1, At, B1); PG8_BAR;
            PG8_LDB(B0, 1, 0); PG8_SCHED; PG8_LDA(At, 1, 0); PG8_STAGE(PG8_SA(0, 1), a2 + hstep, voffA);
            PG8_WAIT_L(8); PG8_BAR; PG8_WAIT_L(0); PG8_MMA(0, 0, At, B0); PG8_BAR; PG8_SCHED;
            PG8_LDB(B1, 1, 1); PG8_STAGE(PG8_SB(1, 0), b3, voffB);
            PG8_BAR; PG8_WAIT_L(0); PG8_MMA(0, 1, At, B1); PG8_BAR;
            PG8_LDA(At, 1, 1); PG8_STAGE(PG8_SA(1, 0), a3, voffA);
            PG8_BAR; PG8_WAIT_L(0); PG8_MMA(1, 0, At, B0); PG8_BAR; PG8_SCHED;
            PG8_STAGE(PG8_SB(1, 1), b3 + hstep, voffB);
            PG8_WAIT_V(6); PG8_BAR; PG8_MMA(1, 1, At, B1); PG8_BAR;
            }
        }
        if constexpr (ALIGN_EPI) { if (wr == 0) PG8_BAR; }
        if constexpr (!Epi::AFTER_DRAIN) { E(acc, cur, wr, wc, fr, fq); S.done(cur); }
        if (!has_next) break;
#pragma unroll
        for (int a = 0; a < 2; ++a)
#pragma unroll
            for (int b = 0; b < 2; ++b)
#pragma unroll
                for (int m = 0; m < 4; ++m)
#pragma unroll
                    for (int n = 0; n < 2; ++n) acc[a][b][m][n] = (f32x4){0.f, 0.f, 0.f, 0.f};
        cur = nxt; cA = nA; cB = nB; ++ui;
        if constexpr (ALIGN_EPI) { if (wr == 1) PG8_BAR; }
    }
    PG8_WAIT_V(0);
    if constexpr (!ALIGN_EPI) { if (wr == 0) PG8_BAR; }
    PG8_BAR;
    if constexpr (Epi::AFTER_DRAIN) { E.fused(acc, cur, wr, wc, fr, fq, lds, wid, lane); S.done(cur); }
#undef PG8_SA
#undef PG8_SB
#undef PG8_STAGE
#undef PG8_LDA
#undef PG8_LDB
#undef PG8_MMA
#undef PG8_WAIT_V
#undef PG8_WAIT_L
#undef PG8_BAR
#undef PG8_SCHED
}
}
#define GAS __attribute__((address_space(1)))
#define LAS __attribute__((address_space(3)))
typedef unsigned short bf16;
typedef unsigned v4u __attribute__((ext_vector_type(4)));
typedef float f32x4 __attribute__((ext_vector_type(4)));
typedef short bf16x8 __attribute__((ext_vector_type(8)));
typedef GAS unsigned gu32;
typedef GAS unsigned long long gu64;
#define RLX_AGENT __ATOMIC_RELAXED, __HIP_MEMORY_SCOPE_AGENT
#define LDS_WAIT() asm volatile("s_waitcnt lgkmcnt(0)" ::: "memory")
#define VM_WAIT() asm volatile("s_waitcnt vmcnt(0)" ::: "memory")
__device__ __forceinline__ unsigned long long rt() { return __builtin_amdgcn_s_memrealtime(); }
typedef __bf16 bf16x2_t __attribute__((ext_vector_type(2)));
__device__ __forceinline__ unsigned f2bf(float f) { return (unsigned)__builtin_bit_cast(unsigned short, (__bf16)f); }
__device__ __forceinline__ unsigned pk2(float lo, float hi) { const bf16x2_t v = {(__bf16)lo, (__bf16)hi}; return __builtin_bit_cast(unsigned, v); }

#define XB_TMO      128
#define XB_XCNT(j)  (256  + 64 * (j))
#define XB_XSUB(j)  (1280 + 64 * (j))
#define XB_XGEN(j)  (2304 + 64 * (j))
#define XB_TOP      3328
#define XB_TOPGEN   3392
#define XCD_BAR_WORDS 3456
#define XB_SPIN_CAP (1u << 18)

__device__ __forceinline__ unsigned xb_ld(unsigned* p)              { return __hip_atomic_load(p, __ATOMIC_RELAXED, __HIP_MEMORY_SCOPE_AGENT); }
__device__ __forceinline__ unsigned xb_add(unsigned* p, unsigned v) { return __hip_atomic_fetch_add(p, v, __ATOMIC_RELAXED, __HIP_MEMORY_SCOPE_AGENT); }
__device__ __forceinline__ unsigned xb_xcc_id() { return (unsigned)__builtin_amdgcn_s_getreg((3 << 11) | 20) & 0xFu; }
#define XB_SPIN(cond, bar) do { unsigned _sp = 0; while (cond) { __builtin_amdgcn_s_sleep(1); \
    if ((++_sp & 255u) == 0u) { if (xb_ld(&(bar)[XB_TMO])) break; if (_sp > XB_SPIN_CAP) { atomicAdd(&(bar)[XB_TMO], 1u); break; } } } } while (0)

struct XcdBarrier {
    unsigned* bar; unsigned x;
    volatile LAS unsigned* st;
};

__device__ __forceinline__ XcdBarrier xcd_barrier_post(unsigned* bar, volatile LAS unsigned* st) {
    XcdBarrier b; b.bar = bar; b.x = xb_xcc_id(); b.st = st;
    if (threadIdx.x == 0) (void)xb_add(&bar[XB_XCNT(b.x)], 1u);
    return b;
}
__device__ __forceinline__ void xcd_barrier_complete(unsigned* bar, unsigned x, unsigned& nloc, unsigned& nx) {
    const unsigned G = gridDim.x * gridDim.y * gridDim.z;
    unsigned sum, cnt, mine, sp = 0u;
    for (;;) {
        sum = 0u; cnt = 0u; mine = 0u;
#pragma unroll
        for (unsigned j = 0; j < 16; ++j) { const unsigned c = xb_ld(&bar[XB_XCNT(j)]); sum += c; cnt += (c > 0u) ? 1u : 0u; mine = (j == x) ? c : mine; }
        if (sum == G) break;
        __builtin_amdgcn_s_sleep(1);
        if ((++sp & 255u) == 0u) { if (xb_ld(&bar[XB_TMO])) break; if (sp > XB_SPIN_CAP) { atomicAdd(&bar[XB_TMO], 1u); break; } }
    }
    nloc = mine > 0u ? mine : 1u; nx = cnt > 0u ? cnt : 1u;
}

__device__ __forceinline__ void xcd_barrier(const XcdBarrier& b) {
    asm volatile("s_waitcnt vmcnt(0)" ::: "memory");
    __syncthreads();
    if (threadIdx.x == 0) {
        unsigned* bar = b.bar;
        __builtin_amdgcn_s_waitcnt(0);
        unsigned nloc = b.st[0], nx = b.st[1];
        if (nloc == 0u) { xcd_barrier_complete(bar, b.x, nloc, nx); b.st[0] = nloc; b.st[1] = nx; }
        const unsigned old = xb_add(&bar[XB_XSUB(b.x)], 1u);
        const unsigned gen = old / nloc;
        if (old + 1u == (gen + 1u) * nloc) {
            __builtin_amdgcn_fence(__ATOMIC_RELEASE, "agent");
            asm volatile("s_waitcnt vmcnt(0)" ::: "memory");
            const unsigned og = xb_add(&bar[XB_TOP], 1u);
            const unsigned tg = og / nx;
            if (og + 1u == (tg + 1u) * nx) xb_add(&bar[XB_TOPGEN], 1u);
            else XB_SPIN(xb_ld(&bar[XB_TOPGEN]) == tg, bar);
            __builtin_amdgcn_fence(__ATOMIC_ACQUIRE, "agent");
            xb_add(&bar[XB_XGEN(b.x)], 1u);
            asm volatile("s_waitcnt vmcnt(0)" ::: "memory");
        } else {
            XB_SPIN(xb_ld(&bar[XB_XGEN(b.x)]) == gen, bar);
            __builtin_amdgcn_fence(__ATOMIC_ACQUIRE, "agent");
            asm volatile("s_waitcnt vmcnt(0)" ::: "memory");
        }
    }
    __syncthreads();
}


constexpr int NWAVES = 8;
constexpr int D = 1024, ML = 16384, MC = 256, M = ML + MC, DFF = 2816;
constexpr int NIN = 7712, NINP = 7936;
constexpr int NSC = 32, SCL = 512;
constexpr float EPS = 1e-6f;
static_assert(pg8::EP_ML == ML, "epilogue constant");

constexpr size_t MiB = 1u << 20, KiB = 1024;
constexpr size_t WS_CTL = 0, CTL_ZERO_BYTES = 1 * MiB;
constexpr size_t WS_SMALL = 1 * MiB;
constexpr size_t WS_HCTX = 9 * MiB;
constexpr size_t WS_FCTX = 10 * MiB;
constexpr size_t WS_RX = 11 * MiB;
constexpr size_t WS_ZQ = 44 * MiB;
constexpr size_t WS_XBC = 109 * MiB;
constexpr size_t WS_V = WS_XBC + (size_t)M * 1536 * 2;
constexpr size_t WS_G = WS_V + (size_t)M * 1024 * 2;
constexpr size_t WS_DT = WS_G + (size_t)M * 1024 * 2;
constexpr size_t WS_WIN = 227 * MiB;
constexpr size_t WS_BCC = WS_WIN;
static_assert(WS_BCC + (size_t)M * 512 * 2 <= 256 * MiB, "BCC");
static_assert(WS_DT + (size_t)M * 64 * 4 <= WS_WIN && WS_WIN + (size_t)NINP * 1024 * 2 <= 256 * MiB, "ws map (mixer phase)");
constexpr size_t WS_WREST = 216 * MiB;
constexpr size_t WO_OUT = 0, WO_UP0 = 4 * MiB, WO_DOWN0 = 15 * MiB, WO_OD = WO_DOWN0 + (size_t)DFF * 1024 * 2, WO_VG = WO_OD + 1 * MiB, WO_UP1 = WO_VG + 2 * MiB, WO_DOWN1 = WO_UP1 + 11 * MiB;
static_assert(WO_DOWN1 + (size_t)DFF * 1024 * 2 <= 40 * MiB, "weights overlay");
constexpr size_t WS_HID = WS_XBC;
static_assert(WS_HID + (size_t)M * DFF * 2 <= WS_WREST, "hidden overlay");
constexpr size_t WS_U = WS_ZQ;
constexpr size_t WS_A2 = WS_U + (size_t)M * 512 * 4;
static_assert(WS_A2 + (size_t)ML * 512 * 2 <= WS_XBC, "layer-1 overlay");
constexpr size_t WS_YS = WS_XBC;
constexpr size_t SM_ADAP = 0;
constexpr size_t SM_MODS = SM_ADAP + 2 * 2 * 8 * 6144 * 4;
constexpr size_t SM_LB = SM_MODS + 2 * 2 * 6144 * 4;
constexpr size_t SM_LAM = SM_LB + 4096;
constexpr size_t SM_LAMP = SM_LAM + 2 * 2048 * 2 * 4;
constexpr size_t SM_BB = SM_LAMP + 2 * 2048 * 2 * 4;
constexpr size_t SM_STATS = SM_BB + 2 * 2048 * 16 * 2 * 4;
constexpr size_t SM_SSDDEC = SM_STATS + (size_t)M * 16 * 4;
constexpr size_t SM_HGDEC = SM_SSDDEC + 33 * 32 * 4 + 128;
constexpr size_t SM_S5ST = ((SM_HGDEC + 33 * 16 * 128 * 4 + 255) / 256) * 256;
static_assert(SM_S5ST + 130 * 2 * 2048 * 2 * 4 <= 8 * MiB, "small tables");
constexpr size_t SSD_ST_BYTES = (size_t)33 * 32 * 8192 * 2;
static_assert(2 * SSD_ST_BYTES <= 33 * MiB && (size_t)M * 1024 * 2 <= 33 * MiB, "RX region");
constexpr int CW_BAR = 4096;
constexpr int CW_QUEUE = 16384;

constexpr int RING_OFF = 0, RING_BYTES = 131072;
constexpr int LDS_BYTES = 163840;
constexpr int LDSCTL_OFF = LDS_BYTES - 512, MISC_OFF = LDSCTL_OFF + 320;


struct Params { const float* in[33]; float* out; unsigned char* ws; int ph_lo, ph_hi, use_bar, pad; };
enum { I_X = 0, I_C, I_CTX, I_CCTX, I_ADAW, I_ADAB, I_NMIX, I_NFFN, I_WGATE, I_WUP, I_WDOWN, I_FNORM, I_EVIN, I_EVOUT, I_CONVW, I_CONVB, I_DTB, I_ALOG, I_SSDD, I_SSDN, I_LBL, I_HGN,
       I_ODIN, I_ARE, I_AIM, I_LOGDT, I_BRE, I_BIM, I_CRE, I_CIM, I_S5D, I_WVAL, I_WGATE2 };
typedef _Float16 f16x8 __attribute__((ext_vector_type(8)));
typedef _Float16 f16;
typedef _Float16 f16x2 __attribute__((ext_vector_type(2)));
typedef float f32x2 __attribute__((ext_vector_type(2)));
__device__ __forceinline__ float bf2f(unsigned b) { return __uint_as_float(b << 16); }
__device__ __forceinline__ float siluf(float x) { return x * __builtin_amdgcn_rcpf(1.f + __expf(-x)); }
__device__ __forceinline__ float wave_sum(float v) {
#pragma unroll
    for (int o = 1; o < 64; o <<= 1) v += __shfl_xor(v, o);
    return v;
}
__device__ __forceinline__ void unpack8(const v4u r, float (&x)[8]) {
    x[0] = bf2f(r.x & 0xffffu); x[1] = bf2f(r.x >> 16); x[2] = bf2f(r.y & 0xffffu); x[3] = bf2f(r.y >> 16);
    x[4] = bf2f(r.z & 0xffffu); x[5] = bf2f(r.z >> 16); x[6] = bf2f(r.w & 0xffffu); x[7] = bf2f(r.w >> 16);
}
__device__ __forceinline__ void tr_item(const float* W, int ldw, int col0, int K, bf16* WT, int dst_row0, LAS float* scr, int kb, int lane) {
    const int k0 = 64 * kb;
#pragma unroll 8
    for (int i = 0; i < 32; ++i) { const int kk = 2 * i + (lane >> 5); scr[kk * 33 + (lane & 31)] = W[(size_t)(k0 + kk) * ldw + col0 + (lane & 31)]; }
    LDS_WAIT(); asm volatile("" ::: "memory");
    const int c = lane & 7;
#pragma unroll
    for (int j = 0; j < 4; ++j) { const int n = (lane >> 3) + 8 * j; const LAS float* s = scr + (8 * c) * 33 + n;
        v4u o; o.x = pk2(s[0 * 33], s[1 * 33]); o.y = pk2(s[2 * 33], s[3 * 33]); o.z = pk2(s[4 * 33], s[5 * 33]); o.w = pk2(s[6 * 33], s[7 * 33]);
        *(GAS v4u*)(WT + (size_t)(dst_row0 + n) * K + k0 + 8 * c) = o; }
    LDS_WAIT(); asm volatile("" ::: "memory");
}
__device__ __forceinline__ int dst_row_of(int mode, int c0) {
    if (mode == 0) return c0 < 2560 ? c0 : (c0 < 2592 ? 7680 + (c0 - 2560) : c0 - 32);
    if (mode == 1) return c0;
    return (c0 >> 7) * 256 + (mode == 3 ? 128 : 0) + (c0 & 127);
}
__device__ __forceinline__ void tr_job(const float* W, int K, int N, int mode, bf16* WT, LAS float* scr, int gw, int ngw, int lane) {
    const int nblk = N / 32, nit = (K / 64) * nblk;
    for (int it = gw; it < nit; it += ngw) { const int kb = it / nblk, nb = it % nblk; tr_item(W, N, 32 * nb, K, WT, dst_row_of(mode, 32 * nb), scr, kb, lane); }
}

__device__ __forceinline__ void phase_prologue(const Params& p, LAS unsigned char* lds, int bid, int G, int tid, int wave, int lane) {
    unsigned char* ws = p.ws; float* sm_adap = (float*)(ws + WS_SMALL + SM_ADAP);
    for (int it = bid; it < 192; it += G) {
        const int layer = it / 96, rem = it % 96, cb = rem / 8, ks = rem % 8;
        LAS float* sl = (LAS float*)lds; LAS float* sc = sl + 128;
        if (tid < 128) { sl[tid] = siluf(p.in[I_C][ks * 128 + tid]); sc[tid] = siluf(p.in[I_CCTX][ks * 128 + tid]); }
        __syncthreads();
        const int col = cb * 512 + tid; const float* W = p.in[I_ADAW] + (size_t)layer * 1024 * 6144 + (size_t)(ks * 128) * 6144 + col;
        float a0 = 0.f, a1 = 0.f;
#pragma unroll 8
        for (int k = 0; k < 128; ++k) { const float w = W[(size_t)k * 6144]; a0 += sl[k] * w; a1 += sc[k] * w; }
        sm_adap[((layer * 2 + 0) * 8 + ks) * 6144 + col] = a0; sm_adap[((layer * 2 + 1) * 8 + ks) * 6144 + col] = a1;
        __syncthreads();
    }
    const int gw = bid * NWAVES + wave, ngw = G * NWAVES;
    LAS float* scr = (LAS float*)(lds + wave * 16384);
    bf16* win = (bf16*)(ws + WS_WIN);
    tr_job(p.in[I_EVIN], 1024, NIN, 0, win, scr, gw, ngw, lane);
    { const int gt = bid * 512 + tid, nt = G * 512; v4u z = {0u, 0u, 0u, 0u};
      for (int i = gt; i < (NINP - NIN) * 1024 / 8; i += nt) *(GAS v4u*)(win + (size_t)NIN * 1024 + (size_t)i * 8) = z; }
    const int gt = bid * 512 + tid;
    if (gt < 1024) { const float l0 = p.in[I_LBL][gt], l1 = p.in[I_LBL][1024 + gt]; const float mx = fmaxf(l0, l1), e0 = __expf(l0 - mx), e1 = __expf(l1 - mx); ((float*)(ws + WS_SMALL + SM_LB))[gt] = e0 / (e0 + e1); }
    if (gt >= 4096 && gt < 8192) {
        const int s = gt - 4096, dg = s >> 6;
        const float dt = expf(p.in[I_LOGDT][dg]), are = p.in[I_ARE][s], aim = p.in[I_AIM][s];
        const float mag = expf(are * dt); float sn, cs; sincosf(aim * dt, &sn, &cs);
        const float lr = mag * cs, li = mag * sn, den = are * are + aim * aim;
        const float cr = ((lr - 1.f) * are + li * aim) / den, ci = (li * are - (lr - 1.f) * aim) / den;
        float* lam = (float*)(ws + WS_SMALL + SM_LAM); lam[2 * s] = lr; lam[2 * s + 1] = li;
        float pr = lr, pi = li;
#pragma unroll
        for (int q = 0; q < 7; ++q) { const float nr = pr * pr - pi * pi, ni = 2.f * pr * pi; pr = nr; pi = ni; }
        float* lamp = (float*)(ws + WS_SMALL + SM_LAMP); lamp[2 * s] = pr; lamp[2 * s + 1] = pi;
        bf16* bbh = (bf16*)(ws + WS_SMALL + SM_BB) + (size_t)s * 32;
#pragma unroll
        for (int c = 0; c < 16; ++c) { const float br = p.in[I_BRE][(size_t)s * 16 + c], bi = p.in[I_BIM][(size_t)s * 16 + c]; bbh[c] = (bf16)f2bf(cr * br - ci * bi); bbh[16 + c] = (bf16)f2bf(cr * bi + ci * br); }
    }
    { bf16* cmh = (bf16*)(ws + WS_SMALL + SM_BB + 262144); const int nt = G * 512;
      for (int e = gt; e < 2 * 32 * 16 * 128; e += nt) { const int k = e & 127, dgc = e >> 7; cmh[e] = (bf16)f2bf(k < 64 ? p.in[I_CRE][(size_t)dgc * 64 + k] : -p.in[I_CIM][(size_t)dgc * 64 + k - 64]); } }
}

__device__ __forceinline__ void phase_rownorm(const Params& p, LAS unsigned char* lds, int bid, int G, int tid, int wave, int lane, int layer, int kind  , int nrows,
                                              const float* src_lat, const float* src_ctx, bool from_partials) {
    unsigned char* ws = p.ws; const float* adap = (const float*)(ws + WS_SMALL + SM_ADAP); float* mods = (float*)(ws + WS_SMALL + SM_MODS);
    LAS float* Gt = (LAS float*)lds; LAS float* St = Gt + 2048;
    const float* ng = p.in[kind == 0 ? I_NMIX : I_NFFN] + layer * 1024;
    for (int idx = tid; idx < 4096; idx += 512) {
        const int vec = idx >> 11, which = (idx >> 10) & 1, col = idx & 1023, j = (kind * 3 + which) * 1024 + col;
        float v;
        if (from_partials) { v = p.in[I_ADAB][layer * 6144 + j];
#pragma unroll
            for (int ks = 0; ks < 8; ++ks) v += adap[((layer * 2 + vec) * 8 + ks) * 6144 + j]; }
        else v = mods[(layer * 2 + vec) * 6144 + j];
        if (which == 0) St[vec * 1024 + col] = v; else Gt[vec * 1024 + col] = ng[col] * (1.f + v);
    }
    if (from_partials && bid < 48) {
        const int idx = bid * 512 + tid, lv = idx / 6144, j = idx % 6144, ly = lv >> 1;
        float v = p.in[I_ADAB][ly * 6144 + j];
#pragma unroll
        for (int ks = 0; ks < 8; ++ks) v += adap[(lv * 8 + ks) * 6144 + j];
        mods[idx] = v;
    }
    __syncthreads();
    bf16* XN = (bf16*)(ws + WS_RX);
    const int gw = bid * NWAVES + wave, ngw = G * NWAVES;
    for (int row = gw; row < nrows; row += ngw) {
        const int vec = row >= ML ? 1 : 0; const float* xr = vec ? src_ctx + (size_t)(row - ML) * 1024 : src_lat + (size_t)row * 1024;
        f32x4 v[4]; float ss = 0.f;
#pragma unroll
        for (int j = 0; j < 4; ++j) { v[j] = *(const GAS f32x4*)(xr + 4 * lane + 256 * j); ss += (v[j].x * v[j].x + v[j].y * v[j].y) + (v[j].z * v[j].z + v[j].w * v[j].w); }
        const float r = rsqrtf(wave_sum(ss) * (1.f / 1024.f) + EPS);
#pragma unroll
        for (int j = 0; j < 4; ++j) { const int c = 4 * lane + 256 * j; const LAS float* g4 = Gt + vec * 1024 + c; const LAS float* s4 = St + vec * 1024 + c;
            const unsigned lo = pk2(v[j].x * r * g4[0] + s4[0], v[j].y * r * g4[1] + s4[1]), hi = pk2(v[j].z * r * g4[2] + s4[2], v[j].w * r * g4[3] + s4[3]);
            *(GAS unsigned long long*)(XN + (size_t)row * 1024 + c) = (unsigned long long)lo | ((unsigned long long)hi << 32); }
    }
}

typedef float f32x16 __attribute__((ext_vector_type(16)));
typedef short s16x4 __attribute__((ext_vector_type(4)));
#define MFMA32(a, b, c) __builtin_amdgcn_mfma_f32_32x32x16_bf16((a), (b), (c), 0, 0, 0)
__device__ __forceinline__ bf16x8 frag_rows(LAS const unsigned char* img, int RS, int row0, int kbyte, int lane) { return *(const LAS bf16x8*)(img + (row0 + (lane & 31)) * RS + kbyte + (lane >> 5) * 16); }
__device__ __forceinline__ bf16x8 frag_tr(LAS const unsigned char* img, int RS, int k0, int col0, int lane) {
    const int h = lane >> 5, blk = (lane >> 4) & 1, q = (lane & 15) >> 2, p = lane & 3;
    LAS const unsigned char* a = img + (k0 + 8 * h + q) * RS + (col0 + 16 * blk + 4 * p) * 2;
    const s16x4 lo = __builtin_amdgcn_ds_read_tr16_b64_v4i16((LAS s16x4*)a), hi = __builtin_amdgcn_ds_read_tr16_b64_v4i16((LAS s16x4*)(a + 4 * RS));
    return (bf16x8){lo[0], lo[1], lo[2], lo[3], hi[0], hi[1], hi[2], hi[3]};
}
__device__ __forceinline__ int arow(int reg, int h) { return (reg & 3) + 8 * (reg >> 2) + 4 * h; }
__device__ __forceinline__ void store_acc_nat(const f32x16& acc, LAS unsigned char* img, int RS, int n0, int m0, int lane) {
    LAS unsigned char* base = img + (n0 + (lane & 31)) * RS + (m0 + 4 * (lane >> 5)) * 2;
#pragma unroll
    for (int g = 0; g < 4; ++g) *(LAS unsigned long long*)(base + 16 * g) = (unsigned long long)pk2(acc[4 * g], acc[4 * g + 1]) | ((unsigned long long)pk2(acc[4 * g + 2], acc[4 * g + 3]) << 32);
}

struct ScanPtrs { const bf16* XBC; const float* DT; bf16* ZQ; const bf16* V; const bf16* G; f16* Flat; f16* Fctx; float* STATS; const float* convw; const float* convb; const float* ssdd; const float* hgn;
                  bf16* SSD_ST; bf16* HG_ST; float* SSD_DEC; float* HG_DEC; const bf16* BCC; };
template <int MODE, int D>
__device__ __forceinline__ void ssd_scan(const ScanPtrs& sp, LAS unsigned char* lds, int row_begin, int nchunks, int seq_lo, int seq_hi, int h, const bf16* st_in, bf16* st_out, float* dec_out, int tid) {
    const int lane = tid & 63, wave = __builtin_amdgcn_readfirstlane(tid >> 6), hf = lane >> 5, g = h >> 3;
    LAS unsigned short* YF = (LAS unsigned short*)lds; LAS unsigned char* XI = lds + 65536; LAS unsigned char* XE = lds + 74752; LAS unsigned char* BI = lds + 83968; LAS unsigned char* CI = lds + 101376; LAS unsigned char* MI = lds + 118784;
    LAS unsigned char* SPI = lds + 128000; LAS float* YB = (LAS float*)(lds + 101376); LAS unsigned char* XR = lds + 145408; LAS float* WT = (LAS float*)(lds + 154112);
    LAS float* AC = (LAS float*)(lds + 155648); LAS float* EA = AC + 64; LAS float* ES = AC + 128; LAS float* DTS = AC + 192;
    asm volatile("" : "+s"(nchunks));
    if (tid < 384) { const int j = tid >> 6, col = h * 64 + (tid & 63); WT[tid] = j < 5 ? sp.convw[j * 1536 + col] : sp.convb[col]; }
    const int nb = wave >> 1, pb = wave & 1;
    f32x16 accS;
#pragma unroll
    for (int r = 0; r < 16; ++r) accS[r] = st_in ? bf2f(*(const GAS unsigned short*)(st_in + (32 * nb + arow(r, hf)) * 64 + 32 * pb + (lane & 31))) : 0.f;
    if (MODE != 0) store_acc_nat(accS, SPI, 272, 32 * pb, 32 * nb, lane);
    float ltot = 0.f; const float dsk = sp.ssdd[h];
    v4u px0, px1, pb0, pb1, pc0, pc1; float pdt = 0.f, pla = 0.f;
    const v4u zero4 = {0u, 0u, 0u, 0u};
    px1 = zero4; pc0 = zero4; pc1 = zero4;
#define SSD_LDX(row_, col_) (((row_) >= seq_lo && (row_) < seq_hi) ? *(const GAS v4u*)(sp.XBC + (size_t)(row_) * 1536 + (col_)) : zero4)
#define SSD_LOAD(c_, tid) do { const int rb_ = row_begin + 64 * (c_); \
        px0 = SSD_LDX(rb_ - 2 + (tid >> 3), h * 64 + (tid & 7) * 8); if (tid < 32) px1 = SSD_LDX(rb_ + 62 + (tid >> 3), h * 64 + (tid & 7) * 8); \
        { const GAS v4u* bp_ = (const GAS v4u*)(sp.BCC + (size_t)(rb_ + (tid >> 4)) * 512 + g * 128 + (tid & 15) * 8); pb0 = bp_[0]; pb1 = bp_[32 * 64]; \
          if (MODE != 0) { pc0 = bp_[32]; pc1 = bp_[32 * 64 + 32]; } } \
        if (tid < 64) { pdt = sp.DT[(size_t)(rb_ + tid) * 64 + D * 16 + h]; pla = sp.DT[(size_t)(rb_ + tid) * 64 + 32 + D * 16 + h]; } } while (0)
    SSD_LOAD(D == 0 ? 0 : nchunks - 1, tid);
#pragma unroll 1
    for (int ci = 0; ci < nchunks; ++ci) {
        const int c = D == 0 ? ci : nchunks - 1 - ci, r0 = row_begin + 64 * c;
        int tl = tid; asm volatile("" : "+v"(tl));
        *(LAS v4u*)(XR + (tl >> 3) * 128 + (tl & 7) * 16) = px0; if (tl < 32) *(LAS v4u*)(XR + (64 + (tl >> 3)) * 128 + (tl & 7) * 16) = px1;
        if (wave == 0) {
            float x = pla;
#pragma unroll
            for (int o = 1; o < 64; o <<= 1) { const float v = D == 0 ? __shfl_up(x, o) : __shfl_down(x, o); if (D == 0 ? (lane >= o) : (lane + o < 64)) x += v; }
            const float last = __shfl(x, D == 0 ? 63 : 0);
            AC[lane] = x; EA[lane] = __expf(x); ES[lane] = pdt * __expf(last - x); DTS[lane] = pdt;
            if (lane == 0) AC[256] = __expf(last);
            ltot += last;
        }
        __syncthreads();
        { const int t = tl >> 3, o8 = (tl & 7) * 8; float a8[8];
#pragma unroll
          for (int i = 0; i < 8; ++i) a8[i] = WT[320 + o8 + i];
#pragma unroll
          for (int j = 0; j < 5; ++j) { float x8[8]; unpack8(*(const LAS v4u*)(XR + (t + j) * 128 + o8 * 2), x8);
#pragma unroll
              for (int i = 0; i < 8; ++i) a8[i] += WT[j * 64 + o8 + i] * x8[i]; }
          const float es = ES[t]; v4u w, we;
#pragma unroll
          for (int i = 0; i < 8; ++i) a8[i] = siluf(a8[i]);
          w.x = pk2(a8[0], a8[1]); w.y = pk2(a8[2], a8[3]); w.z = pk2(a8[4], a8[5]); w.w = pk2(a8[6], a8[7]);
          we.x = pk2(a8[0] * es, a8[1] * es); we.y = pk2(a8[2] * es, a8[3] * es); we.z = pk2(a8[4] * es, a8[5] * es); we.w = pk2(a8[6] * es, a8[7] * es);
          *(LAS v4u*)(XI + t * 144 + o8 * 2) = w; *(LAS v4u*)(XE + t * 144 + o8 * 2) = we; }
        { const int t = tl >> 4, o16 = (tl & 15) * 16;
          *(LAS v4u*)(BI + t * 272 + o16) = pb0; *(LAS v4u*)(BI + (32 + t) * 272 + o16) = pb1;
          if (MODE != 0) { *(LAS v4u*)(CI + t * 272 + o16) = pc0; *(LAS v4u*)(CI + (32 + t) * 272 + o16) = pc1; } }
        if (ci + 1 < nchunks) SSD_LOAD(D == 0 ? ci + 1 : nchunks - 2 - ci, tl);
        __syncthreads();
        f32x16 accY;
        const int tb = (wave & 3) >> 1, qb = wave & 1;
        if (MODE != 0) {
            if (wave >= 4) { const int sb = tb; f32x16 a;
#pragma unroll
                for (int r = 0; r < 16; ++r) a[r] = 0.f;
#pragma unroll
                for (int ks = 0; ks < 8; ++ks) a = MFMA32(frag_rows(BI, 272, 32 * sb, 32 * ks, lane), frag_rows(CI, 272, 32 * qb, 32 * ks, lane), a);
                const int t = 32 * qb + (lane & 31); const float act = AC[t];
#pragma unroll
                for (int r = 0; r < 16; ++r) { const int s2 = 32 * sb + arow(r, hf); const bool keep = D == 0 ? (s2 <= t) : (s2 >= t); a[r] = keep ? a[r] * __expf(act - AC[s2]) * DTS[s2] : 0.f; }
                store_acc_nat(a, MI, 144, 32 * qb, 32 * sb, lane);
            } else {
#pragma unroll
                for (int r = 0; r < 16; ++r) accY[r] = 0.f;
#pragma unroll
                for (int ks = 0; ks < 8; ++ks) accY = MFMA32(frag_rows(CI, 272, 32 * tb, 32 * ks, lane), frag_rows(SPI, 272, 32 * qb, 32 * ks, lane), accY);
#pragma unroll
                for (int r = 0; r < 16; ++r) accY[r] *= EA[32 * tb + arow(r, hf)];
            }
            __syncthreads();
            if (wave < 4) {
#pragma unroll
                for (int ks = 0; ks < 4; ++ks) accY = MFMA32(frag_rows(MI, 144, 32 * tb, 32 * ks, lane), frag_tr(XI, 144, 16 * ks, 32 * qb, lane), accY);
#pragma unroll
                for (int r = 0; r < 16; ++r) YB[(32 * tb + arow(r, hf)) * 68 + 32 * qb + (lane & 31)] = accY[r];
            }
        }
        { const float el = AC[256];
#pragma unroll
          for (int r = 0; r < 16; ++r) accS[r] *= el;
#pragma unroll
          for (int ks = 0; ks < 4; ++ks) accS = MFMA32(frag_tr(BI, 272, 16 * ks, 32 * nb, lane), frag_tr(XE, 144, 16 * ks, 32 * pb, lane), accS);
          if (MODE != 0) store_acc_nat(accS, SPI, 272, 32 * pb, 32 * nb, lane); }
        __syncthreads();
        if (MODE != 0) {
            int t3 = tid; asm volatile("" : "+v"(t3)); const int t = t3 >> 3, p8 = (t3 & 7) * 8, row = r0 + t;
            const f32x4 y0 = *(const LAS f32x4*)(YB + t * 68 + p8), y1 = *(const LAS f32x4*)(YB + t * 68 + p8 + 4);
            LAS v4u* yp = (LAS v4u*)(YF + (row - row_begin) * 64 + p8);
            if (MODE == 1) { v4u w; w.x = pk2(y0.x, y0.y); w.y = pk2(y0.z, y0.w); w.z = pk2(y1.x, y1.y); w.w = pk2(y1.z, y1.w); *yp = w; }
            else { float yf[8], x8[8], z8[8]; unpack8(*yp, yf); unpack8(*(const LAS v4u*)(XI + t * 144 + p8 * 2), x8);
                GAS v4u* zp = (GAS v4u*)(sp.ZQ + (size_t)row * 2048 + h * 64 + p8); unpack8(*zp, z8);
                float o[8] = {y0.x, y0.y, y0.z, y0.w, y1.x, y1.y, y1.z, y1.w}; float ss = 0.f;
#pragma unroll
                for (int i = 0; i < 8; ++i) { o[i] = (o[i] + yf[i] + dsk * x8[i]) * z8[i]; ss += o[i] * o[i]; }
                v4u w; w.x = pk2(o[0], o[1]); w.y = pk2(o[2], o[3]); w.z = pk2(o[4], o[5]); w.w = pk2(o[6], o[7]); *zp = w;
                ss += __shfl_xor(ss, 1); ss += __shfl_xor(ss, 2); ss += __shfl_xor(ss, 4);
                if ((t3 & 7) == 0) sp.STATS[(size_t)row * 16 + h] = ss; }
        }
    }
#undef SSD_LOAD
#undef SSD_LDX
    if (st_out) {
#pragma unroll
        for (int r = 0; r < 16; ++r) *(GAS unsigned short*)(st_out + (32 * nb + arow(r, hf)) * 64 + 32 * pb + (lane & 31)) = (unsigned short)f2bf(accS[r]); }
    if (dec_out && tid == 0) *dec_out = __expf(ltot);
    __syncthreads();
}
__device__ __forceinline__ void phase_convbc(const Params& p, int bid, int G, int tid) {
    const bf16* XBC = (const bf16*)(p.ws + WS_XBC); bf16* BCC = (bf16*)(p.ws + WS_BCC);
    const int gt = bid * 512 + tid, nt = G * 512;
    for (int u = gt; u < (M / 8) * 64; u += nt) {
        const int oct = u & 63, col = 1024 + oct * 8, r0 = (u >> 6) * 8, lo = r0 < ML ? 0 : ML, hi = r0 < ML ? ML : M;
        v4u raw[12]; const v4u zero4 = {0u, 0u, 0u, 0u};
#pragma unroll
        for (int i = 0; i < 12; ++i) { const int rr = r0 - 2 + i; raw[i] = (rr >= lo && rr < hi) ? *(const GAS v4u*)(XBC + (size_t)rr * 1536 + col) : zero4; }
        float w[5][8], b8[8];
#pragma unroll
        for (int j = 0; j < 5; ++j) { const f32x4 w0 = *(const GAS f32x4*)(p.in[I_CONVW] + j * 1536 + col), w1 = *(const GAS f32x4*)(p.in[I_CONVW] + j * 1536 + col + 4);
            w[j][0] = w0.x; w[j][1] = w0.y; w[j][2] = w0.z; w[j][3] = w0.w; w[j][4] = w1.x; w[j][5] = w1.y; w[j][6] = w1.z; w[j][7] = w1.w; }
        { const f32x4 b0 = *(const GAS f32x4*)(p.in[I_CONVB] + col), b1 = *(const GAS f32x4*)(p.in[I_CONVB] + col + 4); b8[0] = b0.x; b8[1] = b0.y; b8[2] = b0.z; b8[3] = b0.w; b8[4] = b1.x; b8[5] = b1.y; b8[6] = b1.z; b8[7] = b1.w; }
        float acc[8][8];
#pragma unroll
        for (int t = 0; t < 8; ++t)
#pragma unroll
            for (int i = 0; i < 8; ++i) acc[t][i] = b8[i];
#pragma unroll
        for (int i2 = 0; i2 < 12; ++i2) { float x8[8]; unpack8(raw[i2], x8);
#pragma unroll
            for (int t = 0; t < 8; ++t) { const int j = i2 - t; if (j >= 0 && j < 5) {
#pragma unroll
                for (int i = 0; i < 8; ++i) acc[t][i] += w[j][i] * x8[i]; } } }
#pragma unroll
        for (int t = 0; t < 8; ++t) { v4u o; o.x = pk2(siluf(acc[t][0]), siluf(acc[t][1])); o.y = pk2(siluf(acc[t][2]), siluf(acc[t][3])); o.z = pk2(siluf(acc[t][4]), siluf(acc[t][5])); o.w = pk2(siluf(acc[t][6]), siluf(acc[t][7]));
            *(GAS v4u*)(BCC + (size_t)(r0 + t) * 512 + oct * 8) = o; }
    }
}
template <int MODE, int D>
__device__ __forceinline__ void hg_scan(const ScanPtrs& sp, LAS unsigned char* lds, int row_begin, int nchunks, int hh, const bf16* st_in, bf16* st_out, float* dec_out, int tid) {
    const int lane = tid & 63, wave = __builtin_amdgcn_readfirstlane(tid >> 6), h = lane >> 5;
    LAS unsigned char* QP = lds; LAS unsigned char* KP = lds + 17408; LAS unsigned char* VI = lds + 34816; LAS unsigned char* ATT = lds + 52224; LAS unsigned char* STI = lds + 61440;
    LAS float* OB = (LAS float*)(lds + 96256); LAS float* PAR = (LAS float*)(lds + 132096); LAS float* EL = (LAS float*)(lds + 136192);
    f16* Fit = (row_begin < ML) ? sp.Flat + (size_t)row_begin * 2048 : sp.Fctx + (size_t)(row_begin - ML) * 2048;
    const int k0 = (tid & 63) * 2, tg = wave, kb = wave >> 1, vb0 = (wave & 1) * 2;
    asm volatile("" : "+s"(nchunks));
    f32x16 accS[2];
#pragma unroll
    for (int i = 0; i < 2; ++i)
#pragma unroll
        for (int r = 0; r < 16; ++r) accS[i][r] = st_in ? bf2f(*(const GAS unsigned short*)(st_in + (32 * kb + arow(r, h)) * 128 + 32 * (vb0 + i) + (lane & 31))) : 0.f;
    if (MODE != 0) { store_acc_nat(accS[0], STI, 272, 32 * vb0, 32 * kb, lane); store_acc_nat(accS[1], STI, 272, 32 * (vb0 + 1), 32 * kb, lane); }
    float ltot0 = 0.f, ltot1 = 0.f;
    unsigned plf[8], pq[8]; v4u pv0, pv1;
    const int vr = tid >> 3, vc = (tid & 7) * 16;
#define HG_LOAD(c_) do { const int rr_ = 64 * (c_); \
        _Pragma("unroll") for (int i = 0; i < 8; ++i) { plf[i] = *(const GAS unsigned*)(Fit + (size_t)(rr_ + 8 * tg + i) * 2048 + D * 1024 + hh * 128 + k0); \
            if (MODE != 0) pq[i] = *(const GAS unsigned*)(sp.ZQ + (size_t)(row_begin + rr_ + 8 * tg + i) * 2048 + 1024 + hh * 128 + k0); } \
        const GAS v4u* vp_ = (const GAS v4u*)(sp.V + (size_t)(row_begin + rr_ + vr) * 1024 + hh * 128 + vc); pv0 = vp_[0]; pv1 = vp_[1]; } while (0)
    HG_LOAD(D == 0 ? 0 : nchunks - 1);
#pragma unroll 1
    for (int ci = 0; ci < nchunks; ++ci) {
        const int c = D == 0 ? ci : nchunks - 1 - ci, r0 = 64 * c;
        v4u pof0, pof1, pg0, pg1;
        if (MODE == 2) { int t3 = tid; asm volatile("" : "+v"(t3)); const int t = t3 >> 3, c16 = (t3 & 7) * 16;
            const v4u* fp = (const v4u*)(Fit + (size_t)(r0 + t) * 2048 + hh * 128 + c16); pof0 = __builtin_nontemporal_load(fp); pof1 = __builtin_nontemporal_load(fp + 1);
            const GAS v4u* gp = (const GAS v4u*)(sp.G + (size_t)(row_begin + r0 + t) * 1024 + hh * 128 + c16); pg0 = gp[0]; pg1 = gp[1]; }
        float lf0[8], lf1[8], cs0[8], cs1[8]; float run0 = 0.f, run1 = 0.f;
#pragma unroll
        for (int i = 0; i < 8; ++i) { const f16x2 hr = __builtin_bit_cast(f16x2, plf[i]); lf0[i] = (float)hr.x; lf1[i] = (float)hr.y; }
#pragma unroll
        for (int ii = 0; ii < 8; ++ii) { const int i = D == 0 ? ii : 7 - ii; run0 += lf0[i]; run1 += lf1[i]; cs0[i] = run0; cs1[i] = run1; }
        *(LAS f32x2*)(PAR + tg * 128 + k0) = (f32x2){run0, run1};
        __syncthreads();
        float off0 = 0.f, off1 = 0.f, tot0 = 0.f, tot1 = 0.f;
#pragma unroll
        for (int j = 0; j < 8; ++j) { const f32x2 pj = *(const LAS f32x2*)(PAR + j * 128 + k0); tot0 += pj.x; tot1 += pj.y; if (D == 0 ? (j < tg) : (j > tg)) { off0 += pj.x; off1 += pj.y; } }
#pragma unroll
        for (int i = 0; i < 8; ++i) { const float bc0 = off0 + cs0[i], bc1 = off1 + cs1[i], kk0 = 1.f - __expf(lf0[i]), kk1 = 1.f - __expf(lf1[i]); const int t = 8 * tg + i;
            if (MODE != 0) *(LAS unsigned*)(QP + t * 272 + k0 * 2) = pk2(bf2f(pq[i] & 0xffffu) * __expf(bc0), bf2f(pq[i] >> 16) * __expf(bc1));
            *(LAS unsigned*)(KP + t * 272 + k0 * 2) = pk2(kk0 * __expf(-bc0), kk1 * __expf(-bc1)); }
        if (tg == 0) { *(LAS f32x2*)(EL + k0) = (f32x2){__expf(tot0), __expf(tot1)}; ltot0 += tot0; ltot1 += tot1; }
        *(LAS v4u*)(VI + vr * 272 + vc * 2) = pv0; *(LAS v4u*)(VI + vr * 272 + vc * 2 + 16) = pv1;
        if (ci + 1 < nchunks) HG_LOAD(D == 0 ? ci + 1 : nchunks - 2 - ci);
        __syncthreads();
        f32x16 accO;
        if (MODE != 0) {
            if (wave < 4) { const int sb = wave >> 1, tb = wave & 1; f32x16 a;
#pragma unroll
                for (int r = 0; r < 16; ++r) a[r] = 0.f;
#pragma unroll
                for (int ks = 0; ks < 8; ++ks) a = MFMA32(frag_rows(KP, 272, 32 * sb, 32 * ks, lane), frag_rows(QP, 272, 32 * tb, 32 * ks, lane), a);
                const int t = 32 * tb + (lane & 31);
#pragma unroll
                for (int r = 0; r < 16; ++r) { const int s = 32 * sb + arow(r, h); if (D == 0 ? (s > t) : (s < t)) a[r] = 0.f; }
                store_acc_nat(a, ATT, 144, 32 * tb, 32 * sb, lane); }
            const int tb = wave >> 2, vb = wave & 3;
#pragma unroll
            for (int r = 0; r < 16; ++r) accO[r] = 0.f;
#pragma unroll
            for (int ks = 0; ks < 8; ++ks) accO = MFMA32(frag_rows(QP, 272, 32 * tb, 32 * ks, lane), frag_rows(STI, 272, 32 * vb, 32 * ks, lane), accO);
            __syncthreads();
#pragma unroll
            for (int ks = 0; ks < 4; ++ks) accO = MFMA32(frag_rows(ATT, 144, 32 * tb, 32 * ks, lane), frag_tr(VI, 272, 16 * ks, 32 * vb, lane), accO);
#pragma unroll
            for (int r = 0; r < 16; ++r) OB[(32 * tb + arow(r, h)) * 132 + 32 * vb + (lane & 31)] = accO[r];
        }
#pragma unroll
        for (int ks = 0; ks < 4; ++ks) { const bf16x8 a = frag_tr(KP, 272, 16 * ks, 32 * kb, lane);
            accS[0] = MFMA32(a, frag_tr(VI, 272, 16 * ks, 32 * vb0, lane), accS[0]); accS[1] = MFMA32(a, frag_tr(VI, 272, 16 * ks, 32 * (vb0 + 1), lane), accS[1]); }
#pragma unroll
        for (int r = 0; r < 16; ++r) { const float e = EL[32 * kb + arow(r, h)]; accS[0][r] *= e; accS[1][r] *= e; }
        if (MODE != 0) { store_acc_nat(accS[0], STI, 272, 32 * vb0, 32 * kb, lane); store_acc_nat(accS[1], STI, 272, 32 * (vb0 + 1), 32 * kb, lane); }
        __syncthreads();
        if (MODE != 0) {
            const int t = tid >> 3, c16 = (tid & 7) * 16, row = row_begin + r0 + t;
            float o[16];
#pragma unroll
            for (int j = 0; j < 4; ++j) { const f32x4 x = *(const LAS f32x4*)(OB + t * 132 + c16 + 4 * j); o[4 * j] = x.x; o[4 * j + 1] = x.y; o[4 * j + 2] = x.z; o[4 * j + 3] = x.w; }
            f16* fp = Fit + (size_t)(r0 + t) * 2048 + hh * 128 + c16;
            if (MODE == 1) { f16x8 a, b;
#pragma unroll
                for (int j = 0; j < 8; ++j) { a[j] = (f16)o[j]; b[j] = (f16)o[8 + j]; }
                *(GAS f16x8*)fp = a; *(GAS f16x8*)(fp + 8) = b; }
            else { const f16x8 a = __builtin_bit_cast(f16x8, pof0), b = __builtin_bit_cast(f16x8, pof1); float ss = 0.f;
#pragma unroll
                for (int j = 0; j < 8; ++j) { o[j] += (float)a[j]; o[8 + j] += (float)b[j]; }
#pragma unroll
                for (int j = 0; j < 16; ++j) ss += o[j] * o[j];
                ss += __shfl_xor(ss, 1); ss += __shfl_xor(ss, 2); ss += __shfl_xor(ss, 4);
                const float rn = rsqrtf(ss * (1.f / 128.f) + EPS);
                float g8[8], g9[8]; unpack8(pg0, g8); unpack8(pg1, g9);
                const float* hn = sp.hgn + c16;
                v4u w0, w1;
                w0.x = pk2(o[0] * rn * hn[0] * g8[0], o[1] * rn * hn[1] * g8[1]); w0.y = pk2(o[2] * rn * hn[2] * g8[2], o[3] * rn * hn[3] * g8[3]); w0.z = pk2(o[4] * rn * hn[4] * g8[4], o[5] * rn * hn[5] * g8[5]); w0.w = pk2(o[6] * rn * hn[6] * g8[6], o[7] * rn * hn[7] * g8[7]);
                w1.x = pk2(o[8] * rn * hn[8] * g9[0], o[9] * rn * hn[9] * g9[1]); w1.y = pk2(o[10] * rn * hn[10] * g9[2], o[11] * rn * hn[11] * g9[3]); w1.z = pk2(o[12] * rn * hn[12] * g9[4], o[13] * rn * hn[13] * g9[5]); w1.w = pk2(o[14] * rn * hn[14] * g9[6], o[15] * rn * hn[15] * g9[7]);
                GAS v4u* zp = (GAS v4u*)(sp.ZQ + (size_t)row * 2048 + 1024 + hh * 128 + c16); zp[0] = w0; zp[1] = w1; }
        }
    }
#undef HG_LOAD
    if (st_out) {
#pragma unroll
        for (int i = 0; i < 2; ++i)
#pragma unroll
            for (int r = 0; r < 16; ++r) *(GAS unsigned short*)(st_out + (32 * kb + arow(r, h)) * 128 + 32 * (vb0 + i) + (lane & 31)) = (unsigned short)f2bf(accS[i][r]); }
    if (dec_out && tg == 0) { dec_out[k0] = __expf(ltot0); dec_out[k0 + 1] = __expf(ltot1); }
    __syncthreads();
}
__device__ __forceinline__ void wg_fence() { asm volatile("s_waitcnt vmcnt(0)" ::: "memory"); __syncthreads(); }

__device__ __forceinline__ int queue_next(gu32* ctr, volatile LAS unsigned* slot, int tid) {
    if (tid == 0) *slot = __hip_atomic_fetch_add(ctr, 1u, __ATOMIC_RELAXED, __HIP_MEMORY_SCOPE_AGENT);
    __syncthreads(); const int v = (int)*slot; __syncthreads(); return v;
}
__device__ __forceinline__ void phase_scanA1(const ScanPtrs& sp, LAS unsigned char* lds, gu32* qctr, volatile LAS unsigned* slot, int bid_hw, int tid) {
    const int q = bid_hw & 7;
    for (;;) { const int j = queue_next(qctr + 64 * q, slot, tid);
        if (j >= 65) break;
        if (j == 0) { const int hh = q;
            hg_scan<1, 0>(sp, lds, ML, MC / 64, hh, nullptr, sp.HG_ST + ((size_t)NSC * 16 + hh * 2 + 0) * 16384, nullptr, tid);
            wg_fence();
            hg_scan<2, 1>(sp, lds, ML, MC / 64, hh, nullptr, sp.HG_ST + ((size_t)NSC * 16 + hh * 2 + 1) * 16384, nullptr, tid);
        } else { const int it = (j - 1) * 8 + q, sc = it >> 4, chain = it & 15, hh = chain >> 1, d = chain & 1;
            bf16* so = sp.HG_ST + ((size_t)sc * 16 + chain) * 16384; float* dc = sp.HG_DEC + (sc * 16 + chain) * 128;
            if (d == 0) hg_scan<0, 0>(sp, lds, sc * SCL, SCL / 64, hh, nullptr, so, dc, tid); else hg_scan<0, 1>(sp, lds, sc * SCL, SCL / 64, hh, nullptr, so, dc, tid); }
    }
}
__device__ __forceinline__ void phase_scanA2(const ScanPtrs& sp, LAS unsigned char* lds, gu32* qctr, volatile LAS unsigned* slot, int bid_hw, int tid) {
    const int q = bid_hw & 7;
    for (;;) { const int j = queue_next(qctr + 64 * q, slot, tid);
        if (j >= 130) break;
        if (j < 2) { const int h = q + 8 * j;
            ssd_scan<1, 0>(sp, lds, ML, MC / 64, ML, M, h, nullptr, sp.SSD_ST + ((size_t)NSC * 32 + h * 2 + 0) * 8192, nullptr, tid);
            ssd_scan<2, 1>(sp, lds, ML, MC / 64, ML, M, h, nullptr, sp.SSD_ST + ((size_t)NSC * 32 + h * 2 + 1) * 8192, nullptr, tid);
        } else { const int j2 = j - 2, grp = (j2 >> 4) * 8 + q, sc = grp >> 1, g = grp & 1, h = g * 8 + ((j2 & 15) >> 1), d = j2 & 1, chain = h * 2 + d;
            bf16* so = sp.SSD_ST + ((size_t)sc * 32 + chain) * 8192; float* dc = sp.SSD_DEC + sc * 32 + chain;
            if (d == 0) ssd_scan<0, 0>(sp, lds, sc * SCL, SCL / 64, 0, ML, h, nullptr, so, dc, tid); else ssd_scan<0, 1>(sp, lds, sc * SCL, SCL / 64, 0, ML, h, nullptr, so, dc, tid); }
    }
}
__device__ __forceinline__ void phase_scanB(const ScanPtrs& sp, int bid, int G, int tid) {
    const int gt = bid * 512 + tid, nt = G * 512;
    for (int e = gt; e < 2 * 131072; e += nt) {
        const bool hg = e >= 131072; const int e2 = hg ? e - 131072 : e;
        const int chain = hg ? (e2 >> 13) : (e2 >> 12), pr = hg ? (e2 & 8191) : (e2 & 4095), d = chain & 1;
        const int nch = hg ? 16 : 32, ppc = hg ? 8192 : 4096;
        GAS unsigned* base = (GAS unsigned*)(hg ? sp.HG_ST : sp.SSD_ST);
        const unsigned w0 = base[((size_t)NSC * nch + chain) * ppc + pr];
        float r0 = bf2f(w0 & 0xffffu), r1 = bf2f(w0 >> 16);
        for (int i0 = 0; i0 < NSC; i0 += 8) {
            unsigned loc[8]; float dec[8];
#pragma unroll
            for (int j = 0; j < 8; ++j) { const int sc = d == 0 ? i0 + j : NSC - 1 - (i0 + j); loc[j] = base[((size_t)sc * nch + chain) * ppc + pr];
                dec[j] = hg ? sp.HG_DEC[(sc * 16 + chain) * 128 + (pr >> 6)] : sp.SSD_DEC[sc * 32 + chain]; }
#pragma unroll
            for (int j = 0; j < 8; ++j) { const int sc = d == 0 ? i0 + j : NSC - 1 - (i0 + j); base[((size_t)sc * nch + chain) * ppc + pr] = pk2(r0, r1);
                r0 = r0 * dec[j] + bf2f(loc[j] & 0xffffu); r1 = r1 * dec[j] + bf2f(loc[j] >> 16); }
        }
    }
}
__device__ __forceinline__ void phase_scanC(const ScanPtrs& sp, LAS unsigned char* lds, gu32* qctr, volatile LAS unsigned* slot, int bid_hw, int tid) {
    const int q = bid_hw & 7;
    for (;;) { const int j = queue_next(qctr + 64 * q, slot, tid);
        if (j >= 96) break;
        if (j < 32) { const int it = j * 8 + q, sc = it >> 3, hh = it & 7;
            hg_scan<1, 0>(sp, lds, sc * SCL, SCL / 64, hh, sp.HG_ST + ((size_t)sc * 16 + hh * 2 + 0) * 16384, nullptr, nullptr, tid);
            wg_fence();
            hg_scan<2, 1>(sp, lds, sc * SCL, SCL / 64, hh, sp.HG_ST + ((size_t)sc * 16 + hh * 2 + 1) * 16384, nullptr, nullptr, tid);
        } else { const int j2 = j - 32, grp = (j2 >> 3) * 8 + q, sc = grp >> 1, g = grp & 1, h = g * 8 + (j2 & 7);
            ssd_scan<1, 0>(sp, lds, sc * SCL, SCL / 64, 0, ML, h, sp.SSD_ST + ((size_t)sc * 32 + h * 2 + 0) * 8192, nullptr, nullptr, tid);
            ssd_scan<2, 1>(sp, lds, sc * SCL, SCL / 64, 0, ML, h, sp.SSD_ST + ((size_t)sc * 32 + h * 2 + 1) * 8192, nullptr, nullptr, tid); }
    }
}
__device__ __forceinline__ void phase_finish(const Params& p, LAS unsigned char* lds, int bid, int G, int tid, int wave, int lane) {
    unsigned char* ws = p.ws; bf16* ZQ = (bf16*)(ws + WS_ZQ); const float* stats = (const float*)(ws + WS_SMALL + SM_STATS); const float* sng = p.in[I_SSDN];
    const int gw = bid * NWAVES + wave, ngw = G * NWAVES;
    for (int row = gw; row < M; row += ngw) {
        const int grp = lane >> 5; const float* s8 = stats + (size_t)row * 16 + grp * 8;
        const float ss = ((s8[0] + s8[1]) + (s8[2] + s8[3])) + ((s8[4] + s8[5]) + (s8[6] + s8[7]));
        const float r = rsqrtf(ss * (1.f / 512.f) + EPS);
        GAS v4u* zp = (GAS v4u*)(ZQ + (size_t)row * 2048 + lane * 16);
#pragma unroll
        for (int q = 0; q < 2; ++q) { float x8[8]; unpack8(zp[q], x8); const float* g8 = sng + lane * 16 + q * 8;
            v4u o; o.x = pk2(x8[0] * r * g8[0], x8[1] * r * g8[1]); o.y = pk2(x8[2] * r * g8[2], x8[3] * r * g8[3]); o.z = pk2(x8[4] * r * g8[4], x8[5] * r * g8[5]); o.w = pk2(x8[6] * r * g8[6], x8[7] * r * g8[7]); zp[q] = o; }
    }
    LAS float* scr = (LAS float*)(lds + wave * 16384); unsigned char* wr = ws + WS_WREST;
    tr_job(p.in[I_EVOUT], 2048, 1024, 1, (bf16*)(wr + WO_OUT), scr, gw, ngw, lane);
    tr_job(p.in[I_WGATE], 1024, DFF, 2, (bf16*)(wr + WO_UP0), scr, gw, ngw, lane);
    tr_job(p.in[I_WUP], 1024, DFF, 3, (bf16*)(wr + WO_UP0), scr, gw, ngw, lane);
    tr_job(p.in[I_WDOWN], DFF, 1024, 1, (bf16*)(wr + WO_DOWN0), scr, gw, ngw, lane);
    tr_job(p.in[I_ODIN], 1024, 512, 1, (bf16*)(wr + WO_OD), scr, gw, ngw, lane);
}

struct S5Ptrs { const bf16* U; float* YS; bf16* A2; const float* LAM; const float* LAMP; const bf16* BBH; const bf16* CMH; const float* S5D; float* ST; };
template <int MODE, int D>
__device__ __forceinline__ void s5_wave(const S5Ptrs& sp, LAS unsigned char* SI  , int row0  , int g, int slot0, int lane) {
    const int n = lane & 31, hs = lane >> 5, dg = D * 32 + g;
    bf16x8 bq[4];
#pragma unroll
    for (int q = 0; q < 4; ++q) bq[q] = *(const GAS bf16x8*)(sp.BBH + ((size_t)(dg * 64 + (q & 1) * 32 + n) * 2 + (q >> 1)) * 16 + 8 * hs);
    bf16x8 cm[8];
    if (MODE != 0) {
#pragma unroll
        for (int ks = 0; ks < 8; ++ks) cm[ks] = n < 16 ? *(const GAS bf16x8*)(sp.CMH + ((size_t)(dg * 16 + n) * 128 + 16 * ks + 8 * hs)) : (bf16x8){0, 0, 0, 0, 0, 0, 0, 0}; }
    const float lr0 = sp.LAM[2 * (dg * 64 + n)], li0 = sp.LAM[2 * (dg * 64 + n) + 1], lr1 = sp.LAM[2 * (dg * 64 + 32 + n)], li1 = sp.LAM[2 * (dg * 64 + 32 + n) + 1];
    float hr0 = 0.f, hi0 = 0.f, hr1 = 0.f, hi1 = 0.f;
    float* stp = sp.ST + ((size_t)((slot0 + hs) * 2 + D) * 2048 + g * 64 + n) * 2;
    if (MODE != 0) { const f32x2 a = *(const GAS f32x2*)stp, b = *(const GAS f32x2*)(stp + 64); hr0 = a.x; hi0 = a.y; hr1 = b.x; hi1 = b.y; }
    const int astream = (n >> 2) & 1, aidx = 4 * (n >> 3) + (n & 3);
    const bf16* ua = sp.U + (size_t)(row0 + 128 * astream) * 512 + g * 16 + 8 * hs;
    bf16x8 afr = *(const GAS bf16x8*)(ua + (size_t)(D == 0 ? aidx : 127 - aidx) * 512);
#pragma unroll 1
    for (int i = 0; i < 8; ++i) {
        f32x16 acc[4];
#pragma unroll
        for (int q = 0; q < 4; ++q) {
#pragma unroll
            for (int r = 0; r < 16; ++r) acc[q][r] = 0.f;
            acc[q] = MFMA32(afr, bq[q], acc[q]); }
        if (i < 7) afr = *(const GAS bf16x8*)(ua + (size_t)(D == 0 ? 16 * (i + 1) + aidx : 127 - 16 * (i + 1) - aidx) * 512);
#pragma unroll
        for (int j = 0; j < 16; ++j) {
            const float nr0 = lr0 * hr0 - li0 * hi0 + acc[0][j], ni0 = lr0 * hi0 + li0 * hr0 + acc[2][j]; hr0 = nr0; hi0 = ni0; acc[0][j] = nr0; acc[2][j] = ni0;
            const float nr1 = lr1 * hr1 - li1 * hi1 + acc[1][j], ni1 = lr1 * hi1 + li1 * hr1 + acc[3][j]; hr1 = nr1; hi1 = ni1; acc[1][j] = nr1; acc[3][j] = ni1; }
        if (MODE != 0) {
            store_acc_nat(acc[0], SI, 72, 0, 0, lane); store_acc_nat(acc[1], SI, 72, 32, 0, lane); store_acc_nat(acc[2], SI, 72, 64, 0, lane); store_acc_nat(acc[3], SI, 72, 96, 0, lane);
            asm volatile("s_waitcnt lgkmcnt(0)" ::: "memory");
            f32x16 y;
#pragma unroll
            for (int r = 0; r < 16; ++r) y[r] = 0.f;
#pragma unroll
            for (int ks = 0; ks < 8; ++ks) y = MFMA32(frag_tr(SI, 72, 16 * ks, 0, lane), cm[ks], y);
            asm volatile("" ::: "memory");
            LAS float* YT = (LAS float*)(SI + 9216);
            if (n < 16) {
#pragma unroll
                for (int j = 0; j < 16; ++j) YT[arow(j, hs) * 20 + n] = y[j]; }
            asm volatile("s_waitcnt lgkmcnt(0)" ::: "memory");
            { const int m = lane >> 1, c8 = (lane & 1) * 8, ms = (m >> 2) & 1, mi = 4 * (m >> 3) + (m & 3);
              const int pos = D == 0 ? 16 * i + mi : 127 - 16 * i - mi, row = row0 + 128 * ms + pos;
              const f32x4 ya = *(const LAS f32x4*)(YT + m * 20 + c8), yb2 = *(const LAS f32x4*)(YT + m * 20 + c8 + 4);
              LAS v4u* yfp = (LAS v4u*)(SI + 11776 + (128 * ms + pos) * 32 + c8 * 2);
              if (MODE == 1) { v4u w; w.x = pk2(ya.x, ya.y); w.y = pk2(ya.z, ya.w); w.z = pk2(yb2.x, yb2.y); w.w = pk2(yb2.z, yb2.w); *yfp = w; }
              else { float f8[8]; unpack8(*yfp, f8); const f32x4 fa = {f8[0], f8[1], f8[2], f8[3]}, fb = {f8[4], f8[5], f8[6], f8[7]}; float u8[8]; unpack8(*(const GAS v4u*)(sp.U + (size_t)row * 512 + g * 16 + c8), u8);
                  const f32x4 d0 = *(const GAS f32x4*)(sp.S5D + g * 16 + c8), d1 = *(const GAS f32x4*)(sp.S5D + g * 16 + c8 + 4);
                  float v[8] = {ya.x + fa.x + d0.x * u8[0], ya.y + fa.y + d0.y * u8[1], ya.z + fa.z + d0.z * u8[2], ya.w + fa.w + d0.w * u8[3], yb2.x + fb.x + d1.x * u8[4], yb2.y + fb.y + d1.y * u8[5], yb2.z + fb.z + d1.z * u8[6], yb2.w + fb.w + d1.w * u8[7]};
#pragma unroll
                  for (int q = 0; q < 8; ++q) { const float tt = 0.7978845608f * (v[q] + 0.044715f * v[q] * v[q] * v[q]); v[q] = v[q] * (1.f - __builtin_amdgcn_rcpf(__expf(2.f * tt) + 1.f)); }
                  v4u w; w.x = pk2(v[0], v[1]); w.y = pk2(v[2], v[3]); w.z = pk2(v[4], v[5]); w.w = pk2(v[6], v[7]);
                  *(GAS v4u*)(sp.A2 + (size_t)row * 512 + g * 16 + c8) = w; } }
        }
    }
    if (MODE == 0) { *(GAS f32x2*)stp = (f32x2){hr0, hi0}; *(GAS f32x2*)(stp + 64) = (f32x2){hr1, hi1}; }
}
__device__ __forceinline__ void phase_s5A(const S5Ptrs& sp, LAS unsigned char* lds, int bid, int G, int wave, int lane) {
    LAS unsigned char* SI = lds + wave * 19968;
    for (int it = bid; it < 65 * 8; it += G) { const int col = it >> 3, gb = (it >> 1) & 3, d = it & 1, g = gb * 8 + wave;
        const int row0 = col < 64 ? col * 256 : ML, slot0 = col < 64 ? 2 * col : 128;
        if (d == 0) s5_wave<0, 0>(sp, SI, row0, g, slot0, lane); else s5_wave<0, 1>(sp, SI, row0, g, slot0, lane); }
}
__device__ __forceinline__ void phase_s5B(const S5Ptrs& sp, const Params& p, LAS unsigned char* lds, int bid, int G, int tid, int wave, int lane) {
    const int gt = bid * 512 + tid;
    if (bid >= 8 && G > 8) {
        const int gw = (bid - 8) * NWAVES + wave, ngw = (G - 8) * NWAVES; LAS float* scr = (LAS float*)(lds + wave * 16384); unsigned char* wr = p.ws + WS_WREST;
        tr_job(p.in[I_WVAL], 512, 1024, 2, (bf16*)(wr + WO_VG), scr, gw, ngw, lane);
        tr_job(p.in[I_WGATE2], 512, 1024, 3, (bf16*)(wr + WO_VG), scr, gw, ngw, lane);
        tr_job(p.in[I_WGATE] + (size_t)1024 * DFF, 1024, DFF, 2, (bf16*)(wr + WO_UP1), scr, gw, ngw, lane);
        tr_job(p.in[I_WUP] + (size_t)1024 * DFF, 1024, DFF, 3, (bf16*)(wr + WO_UP1), scr, gw, ngw, lane);
        tr_job(p.in[I_WDOWN] + (size_t)DFF * 1024, DFF, 1024, 1, (bf16*)(wr + WO_DOWN1), scr, gw, ngw, lane);
    }
    if (gt < 4096) { const int d = gt >> 11, gp = gt & 2047, s = d * 2048 + gp; const float pr = sp.LAMP[2 * s], pi = sp.LAMP[2 * s + 1];
        GAS f32x2* st = (GAS f32x2*)sp.ST; f32x2 run = {0.f, 0.f};
        for (int i0 = 0; i0 < 130; i0 += 10) { f32x2 loc[10];
#pragma unroll
            for (int j = 0; j < 10; ++j) { const int q = i0 + j, slot = d == 0 ? (q < 2 ? 128 + q : q - 2) : (q < 2 ? 129 - q : 129 - q); loc[j] = st[(size_t)(slot * 2 + d) * 2048 + gp]; }
#pragma unroll
            for (int j = 0; j < 10; ++j) { const int q = i0 + j, slot = d == 0 ? (q < 2 ? 128 + q : q - 2) : (q < 2 ? 129 - q : 129 - q); st[(size_t)(slot * 2 + d) * 2048 + gp] = run;
                const float nr = pr * run.x - pi * run.y + loc[j].x, ni = pr * run.y + pi * run.x + loc[j].y; run.x = nr; run.y = ni; } }
    }
}
__device__ __forceinline__ void phase_s5C(const S5Ptrs& sp, LAS unsigned char* lds, int bid, int G, int wave, int lane) {
    LAS unsigned char* SI = lds + wave * 19968;
    for (int it = bid; it < 256; it += G) { const int col = it >> 2, g = (it & 3) * 8 + wave;
        s5_wave<1, 0>(sp, SI, col * 256, g, 2 * col, lane);
        asm volatile("s_waitcnt lgkmcnt(0)" ::: "memory");
        s5_wave<2, 1>(sp, SI, col * 256, g, 2 * col, lane); }
}
__device__ __forceinline__ void phase_final(const Params& p, int bid, int G, int wave, int lane) {
    const int gw = bid * NWAVES + wave, ngw = G * NWAVES; const float* fg = p.in[I_FNORM];
    for (int row = gw; row < ML; row += ngw) { float* xr = p.out + (size_t)row * 1024;
        f32x4 v[4]; float ss = 0.f;
#pragma unroll
        for (int j = 0; j < 4; ++j) { v[j] = *(const GAS f32x4*)(xr + 4 * lane + 256 * j); ss += (v[j].x * v[j].x + v[j].y * v[j].y) + (v[j].z * v[j].z + v[j].w * v[j].w); }
        const float r = rsqrtf(wave_sum(ss) * (1.f / 1024.f) + EPS);
#pragma unroll
        for (int j = 0; j < 4; ++j) { const f32x4 g4 = *(const GAS f32x4*)(fg + 4 * lane + 256 * j); *(GAS f32x4*)(xr + 4 * lane + 256 * j) = (f32x4){v[j].x * r * g4.x, v[j].y * r * g4.y, v[j].z * r * g4.z, v[j].w * r * g4.w}; }
    }
}

__device__ __forceinline__ void ctx_mini_gemm(LAS unsigned char* lds, const bf16* A, const bf16* Bt, int K, const float* base, float* out, const float* gate, int bid, int G, int tid) {
    const int lane = tid & 63, wave = __builtin_amdgcn_readfirstlane(tid >> 6), hf = lane >> 5;
    LAS float* red = (LAS float*)lds;
    for (int t = bid; t < 256; t += G) {
        const int rb = t >> 5, cb = t & 31, kw = K >> 3;
        const bf16* ap = A + (size_t)(32 * rb + (lane & 31)) * K + wave * kw + 8 * hf;
        const bf16* bp = Bt + (size_t)(32 * cb + (lane & 31)) * K + wave * kw + 8 * hf;
        f32x16 acc;
#pragma unroll
        for (int r = 0; r < 16; ++r) acc[r] = 0.f;
        for (int k0 = 0; k0 < kw; k0 += 64) {
            bf16x8 af[4], bfr[4];
#pragma unroll
            for (int q = 0; q < 4; ++q) if (k0 + 16 * q < kw) { af[q] = *(const GAS bf16x8*)(ap + k0 + 16 * q); bfr[q] = *(const GAS bf16x8*)(bp + k0 + 16 * q); }
#pragma unroll
            for (int q = 0; q < 4; ++q) if (k0 + 16 * q < kw) acc = MFMA32(af[q], bfr[q], acc);
        }
#pragma unroll
        for (int r = 0; r < 16; ++r) red[(wave * 32 + arow(r, hf)) * 33 + (lane & 31)] = acc[r];
        __syncthreads();
#pragma unroll
        for (int q = 0; q < 2; ++q) { const int e = tid + 512 * q, r = e >> 5, c = e & 31; float v = 0.f;
#pragma unroll
            for (int w = 0; w < 8; ++w) v += red[(w * 32 + r) * 33 + c];
            const size_t o = (size_t)(32 * rb + r) * 1024 + 32 * cb + c; out[o] = base[o] + gate[32 * cb + c] * v; }
        __syncthreads();
    }
}
constexpr int N_PHASES = 22;
__device__ __forceinline__ void run_gmix(const Params& p, LAS unsigned char* lds, int bid, int G) {
    unsigned char* ws = p.ws;
    pg8::Gemm g{(const bf16*)(ws + WS_RX), (const bf16*)(ws + WS_WIN), M, NINP, 1024}; pg8::StaticOrder S; S.init(M, NINP, G, bid);
    pg8::EpiMix1 E{(bf16*)(ws + WS_ZQ), (bf16*)(ws + WS_XBC), (bf16*)(ws + WS_V), (bf16*)(ws + WS_G), (f16*)p.out, (f16*)(ws + WS_FCTX), (float*)(ws + WS_DT), (const float*)(ws + WS_SMALL + SM_LB), p.in[I_DTB], p.in[I_ALOG]};
    pg8::gemm_phase<pg8::EpiMix1, pg8::StaticOrder, true, true>(lds + RING_OFF, g, S, E);
}
__device__ __forceinline__ void run_gout(const Params& p, LAS unsigned char* lds, int bid, int G, int tid) {
    unsigned char* ws = p.ws; const float* mods = (const float*)(ws + WS_SMALL + SM_MODS);
    pg8::Gemm g{(const bf16*)(ws + WS_ZQ), (const bf16*)(ws + WS_WREST + WO_OUT), ML, 1024, 2048}; pg8::StaticOrder S; S.init(ML, 1024, G, bid);
    pg8::EpiResid E{p.in[I_X], p.in[I_CTX], p.out, (float*)(ws + WS_HCTX), mods + (0 * 2 + 0) * 6144 + 2 * 1024, mods + (0 * 2 + 1) * 6144 + 2 * 1024};
    pg8::gemm_phase<pg8::EpiResid, pg8::StaticOrder, true, true>(lds + RING_OFF, g, S, E);
    ctx_mini_gemm(lds, (const bf16*)(ws + WS_ZQ) + (size_t)ML * 2048, (const bf16*)(ws + WS_WREST + WO_OUT), 2048, p.in[I_CTX], (float*)(ws + WS_HCTX), mods + (0 * 2 + 1) * 6144 + 2 * 1024, bid, G, tid);
}
__device__ __forceinline__ void run_gup(const Params& p, LAS unsigned char* lds, int bid, int G, int layer) {
    unsigned char* ws = p.ws; const int rows = layer ? ML : M;
    pg8::Gemm g{(const bf16*)(ws + WS_RX), (const bf16*)(ws + WS_WREST + (layer ? WO_UP1 : WO_UP0)), rows, 2 * DFF, 1024}; pg8::StaticOrder S; S.init(rows, 2 * DFF, G, bid);
    pg8::EpiSwiglu E{(bf16*)(ws + WS_HID)};
    pg8::gemm_phase<pg8::EpiSwiglu, pg8::StaticOrder, true, true>(lds + RING_OFF, g, S, E);
}
__device__ __forceinline__ void run_gdown(const Params& p, LAS unsigned char* lds, int bid, int G, int layer, int tid) {
    unsigned char* ws = p.ws; const float* mods = (const float*)(ws + WS_SMALL + SM_MODS); float* Hctx = (float*)(ws + WS_HCTX);
    pg8::Gemm g{(const bf16*)(ws + WS_HID), (const bf16*)(ws + WS_WREST + (layer ? WO_DOWN1 : WO_DOWN0)), ML, 1024, DFF}; pg8::StaticOrder S; S.init(ML, 1024, G, bid);
    pg8::EpiResid E{p.out, Hctx, p.out, Hctx, mods + (layer * 2 + 0) * 6144 + 5 * 1024, mods + (layer * 2 + 1) * 6144 + 5 * 1024};
    pg8::gemm_phase<pg8::EpiResid, pg8::StaticOrder, true, true>(lds + RING_OFF, g, S, E);
    if (layer == 0) ctx_mini_gemm(lds, (const bf16*)(ws + WS_HID) + (size_t)ML * DFF, (const bf16*)(ws + WS_WREST + WO_DOWN0), DFF, Hctx, Hctx, mods + (0 * 2 + 1) * 6144 + 5 * 1024, bid, G, tid);
}
__device__ __forceinline__ void run_god(const Params& p, LAS unsigned char* lds, int bid, int G) {
    unsigned char* ws = p.ws;
    pg8::Gemm g{(const bf16*)(ws + WS_RX), (const bf16*)(ws + WS_WREST + WO_OD), M, 512, 1024}; pg8::StaticOrder S; S.init(M, 512, G, bid);
    pg8::EpiU E{(bf16*)(ws + WS_U)};
    pg8::gemm_phase<pg8::EpiU, pg8::StaticOrder, true, true>(lds + RING_OFF, g, S, E);
}
__device__ __forceinline__ void run_gvg(const Params& p, LAS unsigned char* lds, int bid, int G) {
    unsigned char* ws = p.ws; const float* mods = (const float*)(ws + WS_SMALL + SM_MODS);
    pg8::Gemm g{(const bf16*)(ws + WS_A2), (const bf16*)(ws + WS_WREST + WO_VG), ML, 2048, 512}; pg8::StaticOrder S; S.init(ML, 2048, G, bid);
    pg8::EpiValGate E{p.out, mods + (1 * 2 + 0) * 6144 + 2 * 1024};
    pg8::gemm_phase<pg8::EpiValGate, pg8::StaticOrder, true, true>(lds + RING_OFF, g, S, E);
}
__device__ __forceinline__ ScanPtrs make_scanptrs(const Params& p) {
    unsigned char* ws = p.ws; ScanPtrs sp; sp.XBC = (const bf16*)(ws + WS_XBC); sp.DT = (const float*)(ws + WS_DT); sp.ZQ = (bf16*)(ws + WS_ZQ); sp.V = (const bf16*)(ws + WS_V); sp.G = (const bf16*)(ws + WS_G); sp.Flat = (f16*)p.out; sp.Fctx = (f16*)(ws + WS_FCTX);
    sp.STATS = (float*)(ws + WS_SMALL + SM_STATS); sp.convw = p.in[I_CONVW]; sp.convb = p.in[I_CONVB]; sp.ssdd = p.in[I_SSDD]; sp.hgn = p.in[I_HGN];
    sp.SSD_ST = (bf16*)(ws + WS_RX); sp.HG_ST = (bf16*)(ws + WS_RX + SSD_ST_BYTES); sp.SSD_DEC = (float*)(ws + WS_SMALL + SM_SSDDEC); sp.HG_DEC = (float*)(ws + WS_SMALL + SM_HGDEC); sp.BCC = (const bf16*)(ws + WS_BCC); return sp;
}
__device__ __forceinline__ S5Ptrs make_s5ptrs(const Params& p) {
    unsigned char* ws = p.ws; S5Ptrs s5; s5.U = (const bf16*)(ws + WS_U); s5.YS = (float*)(ws + WS_YS); s5.A2 = (bf16*)(ws + WS_A2); s5.LAM = (const float*)(ws + WS_SMALL + SM_LAM); s5.LAMP = (const float*)(ws + WS_SMALL + SM_LAMP);
    s5.BBH = (const bf16*)(ws + WS_SMALL + SM_BB); s5.CMH = (const bf16*)(ws + WS_SMALL + SM_BB + 262144); s5.S5D = p.in[I_S5D]; s5.ST = (float*)(ws + WS_SMALL + SM_S5ST); return s5;
}
__global__ void __launch_bounds__(NWAVES * 64, 2) mk_fwd(Params p) {
    extern __shared__ __attribute__((aligned(16))) unsigned char lds_raw[];
    LAS unsigned char* lds = (LAS unsigned char*)lds_raw;
    volatile LAS unsigned* MISC = (volatile LAS unsigned*)(lds + MISC_OFF);
    const int tid = threadIdx.x, lane = tid & 63, wave = __builtin_amdgcn_readfirstlane(tid >> 6), G = gridDim.x, bid = blockIdx.x;
    gu32* ctl = (gu32*)(p.ws + WS_CTL);
    for (int u = tid; u < (LDS_BYTES - LDSCTL_OFF) / 4; u += NWAVES * 64) ((LAS unsigned*)(lds + LDSCTL_OFF))[u] = 0u;
    __syncthreads();
    XcdBarrier bar; bar.bar = (unsigned*)(ctl + CW_BAR); bar.x = 0; bar.st = nullptr;
    if (p.use_bar) bar = xcd_barrier_post((unsigned*)(ctl + CW_BAR), MISC + 8);
    const int lo = p.ph_lo, hi = p.ph_hi;
#ifndef MK_ONLYPH
#define MK_ONLYPH -1
#endif
#define IN(k) ((MK_ONLYPH < 0 || MK_ONLYPH == (k)) && lo <= (k) && (k) < hi)
#define SEAM(k) do { if ((k) + 1 < hi) xcd_barrier(bar); } while (0)
    if (IN(0)) { phase_prologue(p, lds, bid, G, tid, wave, lane); SEAM(0); }
    if (IN(1)) { phase_rownorm(p, lds, bid, G, tid, wave, lane, 0, 0, M, p.in[I_X], p.in[I_CTX], true); SEAM(1); }
    if (IN(2)) { run_gmix(p, lds, bid, G); SEAM(2); }
    if (IN(3)) { phase_convbc(p, bid, G, tid); const ScanPtrs sp = make_scanptrs(p); phase_scanA1(sp, lds, ctl + CW_QUEUE + 0 * 512, MISC + 12, bid, tid); SEAM(3); }
    if (IN(4)) { const ScanPtrs sp = make_scanptrs(p); phase_scanA2(sp, lds, ctl + CW_QUEUE + 1 * 512, MISC + 12, bid, tid); SEAM(4); }
    if (IN(5)) { const ScanPtrs sp = make_scanptrs(p); phase_scanB(sp, bid, G, tid); SEAM(5); }
    if (IN(6)) { const ScanPtrs sp = make_scanptrs(p); phase_scanC(sp, lds, ctl + CW_QUEUE + 2 * 512, MISC + 12, bid, tid); SEAM(6); }
    if (IN(7)) { phase_finish(p, lds, bid, G, tid, wave, lane); SEAM(7); }
    if (IN(8)) { run_gout(p, lds, bid, G, tid); SEAM(8); }
    if (IN(9)) { phase_rownorm(p, lds, bid, G, tid, wave, lane, 0, 1, M, p.out, (const float*)(p.ws + WS_HCTX), false); SEAM(9); }
    if (IN(10)) { run_gup(p, lds, bid, G, 0); SEAM(10); }
    if (IN(11)) { run_gdown(p, lds, bid, G, 0, tid); SEAM(11); }
    if (IN(12)) { phase_rownorm(p, lds, bid, G, tid, wave, lane, 1, 0, M, p.out, (const float*)(p.ws + WS_HCTX), false); SEAM(12); }
    if (IN(13)) { run_god(p, lds, bid, G); SEAM(13); }
    if (IN(14)) { const S5Ptrs s5 = make_s5ptrs(p); phase_s5A(s5, lds, bid, G, wave, lane); SEAM(14); }
    if (IN(15)) { const S5Ptrs s5 = make_s5ptrs(p); phase_s5B(s5, p, lds, bid, G, tid, wave, lane); SEAM(15); }
    if (IN(16)) { const S5Ptrs s5 = make_s5ptrs(p); phase_s5C(s5, lds, bid, G, wave, lane); SEAM(16); }
    if (IN(17)) { run_gvg(p, lds, bid, G); SEAM(17); }
    if (IN(18)) { phase_rownorm(p, lds, bid, G, tid, wave, lane, 1, 1, ML, p.out, (const float*)(p.ws + WS_HCTX), false); SEAM(18); }
    if (IN(19)) { run_gup(p, lds, bid, G, 1); SEAM(19); }
    if (IN(20)) { run_gdown(p, lds, bid, G, 1, tid); SEAM(20); }
    if (IN(21)) { phase_final(p, bid, G, wave, lane); }
#undef IN
#undef SEAM
}

extern "C" void kernel_launch(void* const* d_in, const int* in_sizes, int n_in, void* d_out, int out_size, void* d_ws, size_t ws_size, hipStream_t stream) {
    static int grid = 0;
    if (grid == 0) {
        if (n_in != 33 || out_size != ML * D || ws_size < 256 * MiB) { fprintf(stderr, "kernel_launch: unexpected shapes (n_in %d, out %d, ws %zu); nothing launched\n", n_in, out_size, ws_size); grid = -1; return; }
        int dev = 0, cus = 0, per_cu = 0;
        if (hipGetDevice(&dev) != hipSuccess || hipDeviceGetAttribute(&cus, hipDeviceAttributeMultiprocessorCount, dev) != hipSuccess) { grid = -1; return; }
        if (hipFuncSetAttribute((const void*)mk_fwd, hipFuncAttributeMaxDynamicSharedMemorySize, LDS_BYTES) != hipSuccess) { fprintf(stderr, "kernel_launch: hipFuncSetAttribute failed\n"); grid = -1; return; }
        if (hipOccupancyMaxActiveBlocksPerMultiprocessor(&per_cu, (const void*)mk_fwd, NWAVES * 64, LDS_BYTES) != hipSuccess || per_cu < 1) fprintf(stderr, "kernel_launch: occupancy query reports %d\n", per_cu);
        (void)hipGetLastError();
        grid = cus;
    }
    if (grid < 0) return;
    (void)hipMemsetAsync((char*)d_ws + WS_CTL, 0, CTL_ZERO_BYTES, stream);
    Params a{};
    for (int i = 0; i < 33; ++i) a.in[i] = (const float*)d_in[i];
    a.out = (float*)d_out; a.ws = (unsigned char*)d_ws;
#if MK_N_LAUNCHES == 1
    a.ph_lo = 0; a.ph_hi = N_PHASES; a.use_bar = 1;
    hipLaunchKernelGGL(mk_fwd, dim3(grid), dim3(NWAVES * 64), LDS_BYTES, stream, a);
#else
    for (int ph = 0; ph < N_PHASES; ++ph) { a.ph_lo = ph; a.ph_hi = ph + 1; a.use_bar = 0; hipLaunchKernelGGL(mk_fwd, dim3(grid), dim3(NWAVES * 64), LDS_BYTES, stream, a); }
#endif
}
```

```cpp
#include <hip/hip_runtime.h>
#include <cstdio>
#include <cstdint>

#ifndef MK_N_LAUNCHES
#define MK_N_LAUNCHES 1
#endif
namespace pg8 {
#define PG8_LAS __attribute__((address_space(3)))
typedef unsigned short bf16_t;
typedef short bf16x8 __attribute__((ext_vector_type(8)));
typedef float f32x4 __attribute__((ext_vector_type(4)));
typedef unsigned u32x4 __attribute__((ext_vector_type(4)));
constexpr int BM = 256, BK = 64, HALF = 128, HTB = HALF * BK * 2  , STAGE_BYTES = 8 * HTB, NXCD = 8, WGM = 8;

__host__ __device__ __forceinline__ int lds_byte(int r, int c) { const int st = (r >> 4) * 2 + (c >> 5), rr = r & 15, cc = c & 31, ob = rr * 64 + cc * 2; return st * 1024 + (ob ^ (((ob >> 9) & 1) << 5)); }
__host__ __device__ __forceinline__ void stage_rc(int b, int& R, int& C) { const int st = b / 1024, sb = b % 1024, swz = sb ^ (((sb >> 9) & 1) << 5); R = (st >> 1) * 16 + swz / 64; C = (st & 1) * 32 + (swz % 64) / 2; }
__host__ __device__ __forceinline__ int perm32(int rho) { const int n = rho >> 4, i = rho & 15; return 8 * (i >> 2) + 4 * n + (i & 3); }

struct Unit { int pm, pn; };
struct Gemm { const bf16_t* A; const bf16_t* Bt; int M, N, K; };

struct StaticOrder {
    int nM, nN, nwg, G, c;
    __host__ __device__ void init(int M, int N, int G_, int c_) { nM = M / BM; nN = N / BM; nwg = nM * nN; G = G_; c = c_; }
    __host__ __device__ bool next(int i, Unit& u) const {
        const long L = (long)i * G + c; if (L >= nwg) return false;
        int wgid = (int)L; { const int q = nwg / NXCD, r = nwg % NXCD, xcd = wgid % NXCD, off = wgid / NXCD; wgid = (xcd < r ? xcd * (q + 1) : r * (q + 1) + (xcd - r) * q) + off; }
        const int nig = WGM * nN, gid = wgid / nig, fm = gid * WGM, gsz = (nM - fm) < WGM ? (nM - fm) : WGM;
        u.pm = fm + ((wgid % nig) % gsz); u.pn = (wgid % nig) / gsz; return true;
    }
    __device__ __forceinline__ void a_ready(const Unit&) const {}
    __device__ __forceinline__ void done(const Unit&) const {}
};

__device__ __forceinline__ unsigned cvt_pk_bf16(float lo, float hi) { unsigned r; asm volatile("v_cvt_pk_bf16_f32 %0, %1, %2" : "=v"(r) : "v"(lo), "v"(hi)); return r; }
typedef float f32x2 __attribute__((ext_vector_type(2)));
typedef _Float16 f16x8 __attribute__((ext_vector_type(8)));
__device__ __forceinline__ float siluf(float x) { return x * __builtin_amdgcn_rcpf(1.f + __expf(-x)); }
__device__ __forceinline__ float sigmf(float x) { return __builtin_amdgcn_rcpf(1.f + __expf(-x)); }
__device__ __forceinline__ u32x4 pack8_bf16(const float (&x)[8]) { u32x4 w; w.x = cvt_pk_bf16(x[0], x[1]); w.y = cvt_pk_bf16(x[2], x[3]); w.z = cvt_pk_bf16(x[4], x[5]); w.w = cvt_pk_bf16(x[6], x[7]); return w; }
constexpr int EP_ML = 16384;

struct EpiMix1 {
    static constexpr bool PERM = true, AFTER_DRAIN = false;
    bf16_t* ZQ; bf16_t* XBC; bf16_t* V; bf16_t* G; _Float16* Flat; _Float16* Fctx; float* DT; const float* lb; const float* dt_bias; const float* a_log;
    template <int KIND> __device__ __forceinline__ void tile(const f32x4 (&acc)[2][2][4][2], const Unit& u, int wr, int wc, int fr, int fq, int seg_tile) const {
        const int row0 = u.pm * BM + wr * 64 + fr, cw = wc * 32 + 8 * fq;
#pragma unroll
        for (int ai = 0; ai < 2; ++ai)
#pragma unroll
            for (int m = 0; m < 4; ++m) { const int row = row0 + ai * HALF + m * 16;
#pragma unroll
                for (int bj = 0; bj < 2; ++bj) { const f32x4 v0 = acc[ai][bj][m][0], v1 = acc[ai][bj][m][1]; const int c = seg_tile * 256 + bj * HALF + cw;
                    float x[8] = {v0[0], v0[1], v0[2], v0[3], v1[0], v1[1], v1[2], v1[3]};
                    if constexpr (KIND == 0) {
#pragma unroll
                        for (int i = 0; i < 8; ++i) x[i] = siluf(x[i]);
                        *(u32x4*)(ZQ + (size_t)row * 2048 + c) = pack8_bf16(x);
                    } else if constexpr (KIND == 1) {
                        *(u32x4*)(XBC + (size_t)row * 1536 + c) = pack8_bf16(x);
                    } else if constexpr (KIND == 2) {
#pragma unroll
                        for (int i = 0; i < 8; ++i) x[i] = siluf(x[i]);
                        *(u32x4*)(ZQ + (size_t)row * 2048 + 1024 + c) = pack8_bf16(x);
                    } else if constexpr (KIND == 3) {
                        f16x8 h;
#pragma unroll
                        for (int i = 0; i < 8; ++i) { const float l = lb[(c + i) & 1023]; const float f = l + (1.f - l) * sigmf(x[i]); h[i] = (_Float16)__logf(f); }
                        _Float16* dst = (row < EP_ML) ? Flat + (size_t)row * 2048 : Fctx + (size_t)(row - EP_ML) * 2048;
                        *(f16x8*)(dst + c) = h;
                    } else if constexpr (KIND == 4) {
                        *(u32x4*)(V + (size_t)row * 1024 + c) = pack8_bf16(x);
                    } else if constexpr (KIND == 5) {
#pragma unroll
                        for (int i = 0; i < 8; ++i) x[i] = siluf(x[i]);
                        *(u32x4*)(G + (size_t)row * 1024 + c) = pack8_bf16(x);
                    } else {
                        if (bj == 0 && wc == 0) {
                            float dtv[8], la[8];
#pragma unroll
                            for (int i = 0; i < 8; ++i) { const int j = 8 * fq + i; const float r = x[i] + dt_bias[j]; dtv[i] = r > 20.f ? r : log1pf(__expf(r)); la[i] = -dtv[i] * __expf(a_log[j]); }
                            float* d = DT + (size_t)row * 64 + 8 * fq;
                            *(f32x4*)(d) = (f32x4){dtv[0], dtv[1], dtv[2], dtv[3]}; *(f32x4*)(d + 4) = (f32x4){dtv[4], dtv[5], dtv[6], dtv[7]};
                            *(f32x4*)(d + 32) = (f32x4){la[0], la[1], la[2], la[3]}; *(f32x4*)(d + 36) = (f32x4){la[4], la[5], la[6], la[7]};
                        }
                    } } }
    }
    __device__ __forceinline__ void operator()(const f32x4 (&acc)[2][2][4][2], const Unit& u, int wr, int wc, int fr, int fq) const {
        const int pn = u.pn;
        if (pn < 4) tile<0>(acc, u, wr, wc, fr, fq, pn);
        else if (pn < 10) tile<1>(acc, u, wr, wc, fr, fq, pn - 4);
        else if (pn < 14) tile<2>(acc, u, wr, wc, fr, fq, pn - 10);
        else if (pn < 22) tile<3>(acc, u, wr, wc, fr, fq, pn - 14);
        else if (pn < 26) tile<4>(acc, u, wr, wc, fr, fq, pn - 22);
        else if (pn < 30) tile<5>(acc, u, wr, wc, fr, fq, pn - 26);
        else tile<6>(acc, u, wr, wc, fr, fq, 0);
    }
};
struct EpiResid {
    static constexpr bool PERM = false, AFTER_DRAIN = false;
    const float* base_lat; const float* base_ctx; float* out_lat; float* out_ctx; const float* gate_lat; const float* gate_ctx;
    __device__ __forceinline__ void operator()(const f32x4 (&acc)[2][2][4][2], const Unit& u, int wr, int wc, int fr, int fq) const {
        const bool isc = u.pm >= 64; const float* base = isc ? base_ctx : base_lat; float* out = isc ? out_ctx : out_lat; const float* gate = isc ? gate_ctx : gate_lat;
        const int row0 = (isc ? 0 : u.pm * BM) + wr * 64 + fr, col0 = u.pn * BM + wc * 32 + 4 * fq;
        f32x4 gv[2][2];
#pragma unroll
        for (int bj = 0; bj < 2; ++bj)
#pragma unroll
            for (int n = 0; n < 2; ++n) gv[bj][n] = *(const f32x4*)(gate + col0 + bj * HALF + n * 16);
#pragma unroll
        for (int ai = 0; ai < 2; ++ai)
#pragma unroll
            for (int m = 0; m < 4; ++m) { const size_t off = (size_t)(row0 + ai * HALF + m * 16) * 1024 + col0;
#pragma unroll
                for (int bj = 0; bj < 2; ++bj)
#pragma unroll
                    for (int n = 0; n < 2; ++n) { const f32x4 b = *(const f32x4*)(base + off + bj * HALF + n * 16); *(f32x4*)(out + off + bj * HALF + n * 16) = b + gv[bj][n] * acc[ai][bj][m][n]; } }
    }
};
struct EpiSwiglu {
    static constexpr bool PERM = true, AFTER_DRAIN = false;
    bf16_t* HID;
    __device__ __forceinline__ void operator()(const f32x4 (&acc)[2][2][4][2], const Unit& u, int wr, int wc, int fr, int fq) const {
        const int row0 = u.pm * BM + wr * 64 + fr, c = u.pn * HALF + wc * 32 + 8 * fq;
#pragma unroll
        for (int ai = 0; ai < 2; ++ai)
#pragma unroll
            for (int m = 0; m < 4; ++m) { const f32x4 g0 = acc[ai][0][m][0], g1 = acc[ai][0][m][1], u0 = acc[ai][1][m][0], u1 = acc[ai][1][m][1];
                float x[8] = {siluf(g0[0]) * u0[0], siluf(g0[1]) * u0[1], siluf(g0[2]) * u0[2], siluf(g0[3]) * u0[3], siluf(g1[0]) * u1[0], siluf(g1[1]) * u1[1], siluf(g1[2]) * u1[2], siluf(g1[3]) * u1[3]};
                *(u32x4*)(HID + (size_t)(row0 + ai * HALF + m * 16) * 2816 + c) = pack8_bf16(x); }
    }
};
struct EpiU {
    static constexpr bool PERM = true, AFTER_DRAIN = false;
    bf16_t* U;
    __device__ __forceinline__ void operator()(const f32x4 (&acc)[2][2][4][2], const Unit& u, int wr, int wc, int fr, int fq) const {
        const int row0 = u.pm * BM + wr * 64 + fr, col0 = u.pn * BM + wc * 32 + 8 * fq;
#pragma unroll
        for (int ai = 0; ai < 2; ++ai)
#pragma unroll
            for (int m = 0; m < 4; ++m) { const int row = row0 + ai * HALF + m * 16; const int srow = row < EP_ML ? (row & 63) * 256 + (row >> 6) : row;
#pragma unroll
                for (int bj = 0; bj < 2; ++bj) { const f32x4 v0 = acc[ai][bj][m][0], v1 = acc[ai][bj][m][1]; float x[8] = {v0[0], v0[1], v0[2], v0[3], v1[0], v1[1], v1[2], v1[3]};
                    *(u32x4*)(U + (size_t)srow * 512 + col0 + bj * HALF) = pack8_bf16(x); } }
    }
};
struct EpiValGate {
    static constexpr bool PERM = false, AFTER_DRAIN = false;
    float* H; const float* gate;
    __device__ __forceinline__ void operator()(const f32x4 (&acc)[2][2][4][2], const Unit& u, int wr, int wc, int fr, int fq) const {
        const int row0 = u.pm * BM + wr * 64 + fr, col0 = u.pn * HALF + wc * 32 + 4 * fq;
#pragma unroll
        for (int ai = 0; ai < 2; ++ai)
#pragma unroll
            for (int m = 0; m < 4; ++m) { const int srow = row0 + ai * HALF + m * 16, token = (srow & 255) * 64 + (srow >> 8); float* hp = H + (size_t)token * 1024 + col0;
#pragma unroll
                for (int n = 0; n < 2; ++n) { const f32x4 v = acc[ai][0][m][n], g = acc[ai][1][m][n]; const f32x4 gm = *(const f32x4*)(gate + col0 + n * 16); f32x4 h = *(const f32x4*)(hp + n * 16);
                    h[0] += gm[0] * v[0] * sigmf(g[0]); h[1] += gm[1] * v[1] * sigmf(g[1]); h[2] += gm[2] * v[2] * sigmf(g[2]); h[3] += gm[3] * v[3] * sigmf(g[3]); *(f32x4*)(hp + n * 16) = h; } }
    }
};
template <class Epi, class Sched, bool ALIGN_EPI = false, bool SP2 = false>
__device__ __forceinline__ void gemm_phase(PG8_LAS unsigned char* lds, const Gemm g, const Sched& S, const Epi& E) {
    const int tid = threadIdx.x, wid = __builtin_amdgcn_readfirstlane(tid >> 6), lane = tid & 63, wr = wid >> 2, wc = wid & 3, fr = lane & 15, fq = lane >> 4;
    const int K = g.K, nt = K / BK;
    unsigned voffA[2], voffB[2];
#pragma unroll
    for (int i = 0; i < 2; ++i) { int R, C; stage_rc(tid * 16 + i * 8192, R, C); const int Rb = Epi::PERM ? ((R & ~31) + perm32(R & 31)) : R;
        voffA[i] = (unsigned)(R * K + C) * 2u; voffB[i] = (unsigned)(Rb * K + C) * 2u; }
    const size_t kstep = (size_t)(BK * 2);
    const size_t hstep = (size_t)HALF * K * 2;
    const size_t tstep = 2 * hstep;
    const unsigned ldsw = (unsigned)wid * 1024u;
    const int aoff = lds_byte(wr * 64 + fr, fq * 8), boff = lds_byte(wc * 32 + fr, fq * 8);
#define PG8_SA(b, h) (((b) * 2 + (h)) * HTB)
#define PG8_SB(b, h) ((4 + (b) * 2 + (h)) * HTB)
#define PG8_STAGE(bufoff, gbase, voff) do { _Pragma("unroll") for (int _i = 0; _i < 2; ++_i) \
        __builtin_amdgcn_global_load_lds((const unsigned*)((const char*)(gbase) + (voff)[_i]), (PG8_LAS unsigned*)(lds + (bufoff) + ldsw + _i * 8192), 16, 0, 0); } while (0)
#define PG8_LDA(dst, b, h) do { _Pragma("unroll") for (int m = 0; m < 4; ++m) _Pragma("unroll") for (int k = 0; k < 2; ++k) dst[m][k] = *(const PG8_LAS bf16x8*)(lds + PG8_SA(b, h) + aoff + m * 2048 + k * 1024); } while (0)
#define PG8_LDB(dst, b, h) do { _Pragma("unroll") for (int n = 0; n < 2; ++n) _Pragma("unroll") for (int k = 0; k < 2; ++k) dst[n][k] = *(const PG8_LAS bf16x8*)(lds + PG8_SB(b, h) + boff + n * 2048 + k * 1024); } while (0)
#define PG8_MMA(ai, bj, At, Bt) do { __builtin_amdgcn_s_setprio(1); _Pragma("unroll") for (int m = 0; m < 4; ++m) _Pragma("unroll") for (int n = 0; n < 2; ++n) _Pragma("unroll") for (int k = 0; k < 2; ++k) \
        acc[ai][bj][m][n] = __builtin_amdgcn_mfma_f32_16x16x32_bf16(Bt[n][k], At[m][k], acc[ai][bj][m][n], 0, 0, 0); __builtin_amdgcn_s_setprio(0); } while (0)
#define PG8_WAIT_V(n) asm volatile("s_waitcnt vmcnt(" #n ")" ::: "memory")
#define PG8_WAIT_L(n) asm volatile("s_waitcnt lgkmcnt(" #n ")" ::: "memory")
#define PG8_BAR __builtin_amdgcn_s_barrier()
#define PG8_SCHED __builtin_amdgcn_sched_barrier(0)
    Unit cur, nxt; int ui = 0;
    if (!S.next(0, cur)) return;
    f32x4 acc[2][2][4][2];
#pragma unroll
    for (int a = 0; a < 2; ++a)
#pragma unroll
        for (int b = 0; b < 2; ++b)
#pragma unroll
            for (int m = 0; m < 4; ++m)
#pragma unroll
                for (int n = 0; n < 2; ++n) acc[a][b][m][n] = (f32x4){0.f, 0.f, 0.f, 0.f};
    bf16x8 At[4][2], B0[2][2], B1[2][2];
    const char* cA = (const char*)g.A + (size_t)cur.pm * tstep; const char* cB = (const char*)g.Bt + (size_t)cur.pn * tstep;
    S.a_ready(cur);
    if constexpr (SP2) {
        PG8_STAGE(PG8_SB(0, 0), cB, voffB); PG8_STAGE(PG8_SB(0, 1), cB + hstep, voffB); PG8_STAGE(PG8_SA(0, 0), cA, voffA); PG8_STAGE(PG8_SA(0, 1), cA + hstep, voffA);
        if (wr == 1) PG8_BAR;
        PG8_WAIT_V(2); PG8_BAR;
        PG8_STAGE(PG8_SB(1, 0), cB + kstep, voffB); PG8_STAGE(PG8_SA(1, 0), cA + kstep, voffA); PG8_STAGE(PG8_SB(1, 1), cB + hstep + kstep, voffB);
        PG8_WAIT_V(6); PG8_BAR;
    } else {
        PG8_STAGE(PG8_SB(0, 0), cB, voffB); PG8_STAGE(PG8_SA(0, 0), cA, voffA); PG8_STAGE(PG8_SB(0, 1), cB + hstep, voffB); PG8_STAGE(PG8_SA(0, 1), cA + hstep, voffA);
        if (wr == 1) PG8_BAR;
        PG8_WAIT_V(4); PG8_BAR;
        PG8_STAGE(PG8_SB(1, 0), cB + kstep, voffB); PG8_STAGE(PG8_SA(1, 0), cA + kstep, voffA); PG8_STAGE(PG8_SB(1, 1), cB + hstep + kstep, voffB);
        PG8_WAIT_V(6); PG8_BAR;
    }
    for (;;) {
        const bool has_next = S.next(ui + 1, nxt);
        const char* nA = has_next ? (const char*)g.A + (size_t)nxt.pm * tstep : cA; const char* nB = has_next ? (const char*)g.Bt + (size_t)nxt.pn * tstep : cB;
        for (int t = 0; t < nt; t += 2) {
            const bool last = (t == nt - 2);
            const char* a1 = cA + (size_t)(t + 1) * kstep;
            const char* a2 = last ? nA : cA + (size_t)(t + 2) * kstep; const char* b2 = last ? nB : cB + (size_t)(t + 2) * kstep;
            const char* a3 = a2 + kstep; const char* b3 = b2 + kstep;
            if (last && has_next) S.a_ready(nxt);
            if constexpr (SP2) {
            PG8_LDB(B0, 0, 0); PG8_LDB(B1, 0, 1); PG8_SCHED; PG8_LDA(At, 0, 0); PG8_STAGE(PG8_SA(1, 1), a1 + hstep, voffA);
            PG8_WAIT_V(8); PG8_WAIT_L(0); PG8_BAR; PG8_MMA(0, 0, At, B0); PG8_MMA(0, 1, At, B1); PG8_BAR; PG8_SCHED;
            PG8_LDA(At, 0, 1); PG8_STAGE(PG8_SB(0, 0), b2, voffB); PG8_STAGE(PG8_SB(0, 1), b2 + hstep, voffB); PG8_STAGE(PG8_SA(0, 0), a2, voffA);
            PG8_WAIT_V(8); PG8_WAIT_L(0); PG8_BAR; PG8_MMA(1, 0, At, B0); PG8_MMA(1, 1, At, B1); PG8_BAR; PG8_SCHED;
            PG8_LDB(B0, 1, 0); PG8_LDB(B1, 1, 1); PG8_SCHED; PG8_LDA(At, 1, 0); PG8_STAGE(PG8_SA(0, 1), a2 + hstep, voffA);
            PG8_WAIT_V(8); PG8_WAIT_L(0); PG8_BAR; PG8_MMA(0, 0, At, B0); PG8_MMA(0, 1, At, B1); PG8_BAR; PG8_SCHED;
            PG8_LDA(At, 1, 1); PG8_STAGE(PG8_SB(1, 0), b3, voffB); PG8_STAGE(PG8_SB(1, 1), b3 + hstep, voffB); PG8_STAGE(PG8_SA(1, 0), a3, voffA);
            PG8_WAIT_V(8); PG8_WAIT_L(0); PG8_BAR; PG8_MMA(1, 0, At, B0); PG8_MMA(1, 1, At, B1); PG8_BAR; PG8_SCHED;
            } else {
            PG8_LDB(B0, 0, 0); PG8_SCHED; PG8_LDA(At, 0, 0); PG8_STAGE(PG8_SA(1, 1), a1 + hstep, voffA);
            PG8_WAIT_L(8); PG8_BAR; PG8_WAIT_L(0); PG8_MMA(0, 0, At, B0); PG8_BAR; PG8_SCHED;
            PG8_LDB(B1, 0, 1); PG8_STAGE(PG8_SB(0, 0), b2, voffB);
            PG8_BAR; PG8_WAIT_L(0); PG8_MMA(0, 1, At, B1); PG8_BAR;
            PG8_LDA(At, 0, 1); PG8_STAGE(PG8_SA(0, 0), a2, voffA);
            PG8_BAR; PG8_WAIT_L(0); PG8_MMA(1, 0, At, B0); PG8_BAR; PG8_SCHED;
            PG8_STAGE(PG8_SB(0, 1), b2 + hstep, voffB);
            PG8_WAIT_V(6); PG8_BAR; PG8_MMA(1, 1, At, B1); PG8_BAR;
            PG8_LDB(B0, 1, 0); PG8_SCHED; PG8_LDA(At, 1, 0); PG8_STAGE(PG8_SA(0, 1), a2 + hstep, voffA);
            PG8_WAIT_L(8); PG8_BAR; PG8_WAIT_L(0); PG8_MMA(0, 0, At, B0); PG8_BAR; PG8_SCHED;
            PG8_LDB(B1, 1, 1); PG8_STAGE(PG8_SB(1, 0), b3, voffB);
            PG8_BAR; PG8_WAIT_L(0); PG8_MMA(0, 1, At, B1); PG8_BAR;
            PG8_LDA(At, 1, 1); PG8_STAGE(PG8_SA(1, 0), a3, voffA);
            PG8_BAR; PG8_WAIT_L(0); PG8_MMA(1, 0, At, B0); PG8_BAR; PG8_SCHED;
            PG8_STAGE(PG8_SB(1, 1), b3 + hstep, voffB);
            PG8_WAIT_V(6); PG8_BAR; PG8_MMA(1, 1, At, B1); PG8_BAR;
            }
        }
        if constexpr (ALIGN_EPI) { if (wr == 0) PG8_BAR; }
        if constexpr (!Epi::AFTER_DRAIN) { E(acc, cur, wr, wc, fr, fq); S.done(cur); }
        if (!has_next) break;
#pragma unroll
        for (int a = 0; a < 2; ++a)
#pragma unroll
            for (int b = 0; b < 2; ++b)
#pragma unroll
                for (int m = 0; m < 4; ++m)
#pragma unroll
                    for (int n = 0; n < 2; ++n) acc[a][b][m][n] = (f32x4){0.f, 0.f, 0.f, 0.f};
        cur = nxt; cA = nA; cB = nB; ++ui;
        if constexpr (ALIGN_EPI) { if (wr == 1) PG8_BAR; }
    }
    PG8_WAIT_V(0);
    if constexpr (!ALIGN_EPI) { if (wr == 0) PG8_BAR; }
    PG8_BAR;
    if constexpr (Epi::AFTER_DRAIN) { E.fused(acc, cur, wr, wc, fr, fq, lds, wid, lane); S.done(cur); }
#undef PG8_SA
#undef PG8_SB
#undef PG8_STAGE
#undef PG8_LDA
#undef PG8_LDB
#undef PG8_MMA
#undef PG8_WAIT_V
#undef PG8_WAIT_L
#undef PG8_BAR
#undef PG8_SCHED
}
}
#define GAS __attribute__((address_space(1)))
#define LAS __attribute__((address_space(3)))
typedef unsigned short bf16;
typedef unsigned v4u __attribute__((ext_vector_type(4)));
typedef float f32x4 __attribute__((ext_vector_type(4)));
typedef short bf16x8 __attribute__((ext_vector_type(8)));
typedef GAS unsigned gu32;
typedef GAS unsigned long long gu64;
#define RLX_AGENT __ATOMIC_RELAXED, __HIP_MEMORY_SCOPE_AGENT
#define LDS_WAIT() asm volatile("s_waitcnt lgkmcnt(0)" ::: "memory")
#define VM_WAIT() asm volatile("s_waitcnt vmcnt(0)" ::: "memory")
__device__ __forceinline__ unsigned long long rt() { return __builtin_amdgcn_s_memrealtime(); }
typedef __bf16 bf16x2_t __attribute__((ext_vector_type(2)));
__device__ __forceinline__ unsigned f2bf(float f) { return (unsigned)__builtin_bit_cast(unsigned short, (__bf16)f); }
__device__ __forceinline__ unsigned pk2(float lo, float hi) { const bf16x2_t v = {(__bf16)lo, (__bf16)hi}; return __builtin_bit_cast(unsigned, v); }

#define XB_TMO      128
#define XB_XCNT(j)  (256  + 64 * (j))
#define XB_XSUB(j)  (1280 + 64 * (j))
#define XB_XGEN(j)  (2304 + 64 * (j))
#define XB_TOP      3328
#define XB_TOPGEN   3392
#define XCD_BAR_WORDS 3456
#define XB_SPIN_CAP (1u << 18)

__device__ __forceinline__ unsigned xb_ld(unsigned* p)              { return __hip_atomic_load(p, __ATOMIC_RELAXED, __HIP_MEMORY_SCOPE_AGENT); }
__device__ __forceinline__ unsigned xb_add(unsigned* p, unsigned v) { return __hip_atomic_fetch_add(p, v, __ATOMIC_RELAXED, __HIP_MEMORY_SCOPE_AGENT); }
__device__ __forceinline__ unsigned xb_xcc_id() { return (unsigned)__builtin_amdgcn_s_getreg((3 << 11) | 20) & 0xFu; }
#define XB_SPIN(cond, bar) do { unsigned _sp = 0; while (cond) { __builtin_amdgcn_s_sleep(1); \
    if ((++_sp & 255u) == 0u) { if (xb_ld(&(bar)[XB_TMO])) break; if (_sp > XB_SPIN_CAP) { atomicAdd(&(bar)[XB_TMO], 1u); break; } } } } while (0)

struct XcdBarrier {
    unsigned* bar; unsigned x;
    volatile LAS unsigned* st;
};

__device__ __forceinline__ XcdBarrier xcd_barrier_post(unsigned* bar, volatile LAS unsigned* st) {
    XcdBarrier b; b.bar = bar; b.x = xb_xcc_id(); b.st = st;
    if (threadIdx.x == 0) (void)xb_add(&bar[XB_XCNT(b.x)], 1u);
    return b;
}
__device__ __forceinline__ void xcd_barrier_complete(unsigned* bar, unsigned x, unsigned& nloc, unsigned& nx) {
    const unsigned G = gridDim.x * gridDim.y * gridDim.z;
    unsigned sum, cnt, mine, sp = 0u;
    for (;;) {
        sum = 0u; cnt = 0u; mine = 0u;
#pragma unroll
        for (unsigned j = 0; j < 16; ++j) { const unsigned c = xb_ld(&bar[XB_XCNT(j)]); sum += c; cnt += (c > 0u) ? 1u : 0u; mine = (j == x) ? c : mine; }
        if (sum == G) break;
        __builtin_amdgcn_s_sleep(1);
        if ((++sp & 255u) == 0u) { if (xb_ld(&bar[XB_TMO])) break; if (sp > XB_SPIN_CAP) { atomicAdd(&bar[XB_TMO], 1u); break; } }
    }
    nloc = mine > 0u ? mine : 1u; nx = cnt > 0u ? cnt : 1u;
}

__device__ __forceinline__ void xcd_barrier(const XcdBarrier& b) {
    asm volatile("s_waitcnt vmcnt(0)" ::: "memory");
    __syncthreads();
    if (threadIdx.x == 0) {
        unsigned* bar = b.bar;
        __builtin_amdgcn_s_waitcnt(0);
        unsigned nloc = b.st[0], nx = b.st[1];
        if (nloc == 0u) { xcd_barrier_complete(bar, b.x, nloc, nx); b.st[0] = nloc; b.st[1] = nx; }
        const unsigned old = xb_add(&bar[XB_XSUB(b.x)], 1u);
        const unsigned gen = old / nloc;
        if (old + 1u == (gen + 1u) * nloc) {
            __builtin_amdgcn_fence(__ATOMIC_RELEASE, "agent");
            asm volatile("s_waitcnt vmcnt(0)" ::: "memory");
            const unsigned og = xb_add(&bar[XB_TOP], 1u);
            const unsigned tg = og / nx;
            if (og + 1u == (tg + 1u) * nx) xb_add(&bar[XB_TOPGEN], 1u);
            else XB_SPIN(xb_ld(&bar[XB_TOPGEN]) == tg, bar);
            __builtin_amdgcn_fence(__ATOMIC_ACQUIRE, "agent");
            xb_add(&bar[XB_XGEN(b.x)], 1u);
            asm volatile("s_waitcnt vmcnt(0)" ::: "memory");
        } else {
            XB_SPIN(xb_ld(&bar[XB_XGEN(b.x)]) == gen, bar);
            __builtin_amdgcn_fence(__ATOMIC_ACQUIRE, "agent");
            asm volatile("s_waitcnt vmcnt(0)" ::: "memory");
        }
    }
    __syncthreads();
}


constexpr int NWAVES = 8;
constexpr int D = 1024, ML = 16384, MC = 256, M = ML + MC, DFF = 2816;
constexpr int NIN = 7712, NINP = 7936;
constexpr int NSC = 32, SCL = 512;
constexpr float EPS = 1e-6f;
static_assert(pg8::EP_ML == ML, "epilogue constant");

constexpr size_t MiB = 1u << 20, KiB = 1024;
constexpr size_t WS_CTL = 0, CTL_ZERO_BYTES = 1 * MiB;
constexpr size_t WS_SMALL = 1 * MiB;
constexpr size_t WS_HCTX = 9 * MiB;
constexpr size_t WS_FCTX = 10 * MiB;
constexpr size_t WS_RX = 11 * MiB;
constexpr size_t WS_ZQ = 44 * MiB;
constexpr size_t WS_XBC = 109 * MiB;
constexpr size_t WS_V = WS_XBC + (size_t)M * 1536 * 2;
constexpr size_t WS_G = WS_V + (size_t)M * 1024 * 2;
constexpr size_t WS_DT = WS_G + (size_t)M * 1024 * 2;
constexpr size_t WS_WIN = 227 * MiB;
constexpr size_t WS_BCC = WS_WIN;
static_assert(WS_BCC + (size_t)M * 512 * 2 <= 256 * MiB, "BCC");
static_assert(WS_DT + (size_t)M * 64 * 4 <= WS_WIN && WS_WIN + (size_t)NINP * 1024 * 2 <= 256 * MiB, "ws map (mixer phase)");
constexpr size_t WS_WREST = 216 * MiB;
constexpr size_t WO_OUT = 0, WO_UP0 = 4 * MiB, WO_DOWN0 = 15 * MiB, WO_OD = WO_DOWN0 + (size_t)DFF * 1024 * 2, WO_VG = WO_OD + 1 * MiB, WO_UP1 = WO_VG + 2 * MiB, WO_DOWN1 = WO_UP1 + 11 * MiB;
static_assert(WO_DOWN1 + (size_t)DFF * 1024 * 2 <= 40 * MiB, "weights overlay");
constexpr size_t WS_HID = WS_XBC;
static_assert(WS_HID + (size_t)M * DFF * 2 <= WS_WREST, "hidden overlay");
constexpr size_t WS_U = WS_ZQ;
constexpr size_t WS_A2 = WS_U + (size_t)M * 512 * 4;
static_assert(WS_A2 + (size_t)ML * 512 * 2 <= WS_XBC, "layer-1 overlay");
constexpr size_t WS_YS = WS_XBC;
constexpr size_t SM_ADAP = 0;
constexpr size_t SM_MODS = SM_ADAP + 2 * 2 * 8 * 6144 * 4;
constexpr size_t SM_LB = SM_MODS + 2 * 2 * 6144 * 4;
constexpr size_t SM_LAM = SM_LB + 4096;
constexpr size_t SM_LAMP = SM_LAM + 2 * 2048 * 2 * 4;
constexpr size_t SM_BB = SM_LAMP + 2 * 2048 * 2 * 4;
constexpr size_t SM_STATS = SM_BB + 2 * 2048 * 16 * 2 * 4;
constexpr size_t SM_SSDDEC = SM_STATS + (size_t)M * 16 * 4;
constexpr size_t SM_HGDEC = SM_SSDDEC + 33 * 32 * 4 + 128;
constexpr size_t SM_S5ST = ((SM_HGDEC + 33 * 16 * 128 * 4 + 255) / 256) * 256;
static_assert(SM_S5ST + 130 * 2 * 2048 * 2 * 4 <= 8 * MiB, "small tables");
constexpr size_t SSD_ST_BYTES = (size_t)33 * 32 * 8192 * 2;
static_assert(2 * SSD_ST_BYTES <= 33 * MiB && (size_t)M * 1024 * 2 <= 33 * MiB, "RX region");
constexpr int CW_BAR = 4096;
constexpr int CW_QUEUE = 16384;

constexpr int RING_OFF = 0, RING_BYTES = 131072;
constexpr int LDS_BYTES = 163840;
constexpr int LDSCTL_OFF = LDS_BYTES - 512, MISC_OFF = LDSCTL_OFF + 320;


struct Params { const float* in[33]; float* out; unsigned char* ws; int ph_lo, ph_hi, use_bar, pad; };
enum { I_X = 0, I_C, I_CTX, I_CCTX, I_ADAW, I_ADAB, I_NMIX, I_NFFN, I_WGATE, I_WUP, I_WDOWN, I_FNORM, I_EVIN, I_EVOUT, I_CONVW, I_CONVB, I_DTB, I_ALOG, I_SSDD, I_SSDN, I_LBL, I_HGN,
       I_ODIN, I_ARE, I_AIM, I_LOGDT, I_BRE, I_BIM, I_CRE, I_CIM, I_S5D, I_WVAL, I_WGATE2 };
typedef _Float16 f16x8 __attribute__((ext_vector_type(8)));
typedef _Float16 f16;
typedef _Float16 f16x2 __attribute__((ext_vector_type(2)));
typedef float f32x2 __attribute__((ext_vector_type(2)));
__device__ __forceinline__ float bf2f(unsigned b) { return __uint_as_float(b << 16); }
__device__ __forceinline__ float siluf(float x) { return x * __builtin_amdgcn_rcpf(1.f + __expf(-x)); }
__device__ __forceinline__ float wave_sum(float v) {
#pragma unroll
    for (int o = 1; o < 64; o <<= 1) v += __shfl_xor(v, o);
    return v;
}
__device__ __forceinline__ void unpack8(const v4u r, float (&x)[8]) {
    x[0] = bf2f(r.x & 0xffffu); x[1] = bf2f(r.x >> 16); x[2] = bf2f(r.y & 0xffffu); x[3] = bf2f(r.y >> 16);
    x[4] = bf2f(r.z & 0xffffu); x[5] = bf2f(r.z >> 16); x[6] = bf2f(r.w & 0xffffu); x[7] = bf2f(r.w >> 16);
}
__device__ __forceinline__ void tr_item(const float* W, int ldw, int col0, int K, bf16* WT, int dst_row0, LAS float* scr, int kb, int lane) {
    const int k0 = 64 * kb;
#pragma unroll 8
    for (int i = 0; i < 32; ++i) { const int kk = 2 * i + (lane >> 5); scr[kk * 33 + (lane & 31)] = W[(size_t)(k0 + kk) * ldw + col0 + (lane & 31)]; }
    LDS_WAIT(); asm volatile("" ::: "memory");
    const int c = lane & 7;
#pragma unroll
    for (int j = 0; j < 4; ++j) { const int n = (lane >> 3) + 8 * j; const LAS float* s = scr + (8 * c) * 33 + n;
        v4u o; o.x = pk2(s[0 * 33], s[1 * 33]); o.y = pk2(s[2 * 33], s[3 * 33]); o.z = pk2(s[4 * 33], s[5 * 33]); o.w = pk2(s[6 * 33], s[7 * 33]);
        *(GAS v4u*)(WT + (size_t)(dst_row0 + n) * K + k0 + 8 * c) = o; }
    LDS_WAIT(); asm volatile("" ::: "memory");
}
__device__ __forceinline__ int dst_row_of(int mode, int c0) {
    if (mode == 0) return c0 < 2560 ? c0 : (c0 < 2592 ? 7680 + (c0 - 2560) : c0 - 32);
    if (mode == 1) return c0;
    return (c0 >> 7) * 256 + (mode == 3 ? 128 : 0) + (c0 & 127);
}
__device__ __forceinline__ void tr_job(const float* W, int K, int N, int mode, bf16* WT, LAS float* scr, int gw, int ngw, int lane) {
    const int nblk = N / 32, nit = (K / 64) * nblk;
    for (int it = gw; it < nit; it += ngw) { const int kb = it / nblk, nb = it % nblk; tr_item(W, N, 32 * nb, K, WT, dst_row_of(mode, 32 * nb), scr, kb, lane); }
}

__device__ __forceinline__ void phase_prologue(const Params& p, LAS unsigned char* lds, int bid, int G, int tid, int wave, int lane) {
    unsigned char* ws = p.ws; float* sm_adap = (float*)(ws + WS_SMALL + SM_ADAP);
    for (int it = bid; it < 192; it += G) {
        const int layer = it / 96, rem = it % 96, cb = rem / 8, ks = rem % 8;
        LAS float* sl = (LAS float*)lds; LAS float* sc = sl + 128;
        if (tid < 128) { sl[tid] = siluf(p.in[I_C][ks * 128 + tid]); sc[tid] = siluf(p.in[I_CCTX][ks * 128 + tid]); }
        __syncthreads();
        const int col = cb * 512 + tid; const float* W = p.in[I_ADAW] + (size_t)layer * 1024 * 6144 + (size_t)(ks * 128) * 6144 + col;
        float a0 = 0.f, a1 = 0.f;
#pragma unroll 8
        for (int k = 0; k < 128; ++k) { const float w = W[(size_t)k * 6144]; a0 += sl[k] * w; a1 += sc[k] * w; }
        sm_adap[((layer * 2 + 0) * 8 + ks) * 6144 + col] = a0; sm_adap[((layer * 2 + 1) * 8 + ks) * 6144 + col] = a1;
        __syncthreads();
    }
    const int gw = bid * NWAVES + wave, ngw = G * NWAVES;
    LAS float* scr = (LAS float*)(lds + wave * 16384);
    bf16* win = (bf16*)(ws + WS_WIN);
    tr_job(p.in[I_EVIN], 1024, NIN, 0, win, scr, gw, ngw, lane);
    { const int gt = bid * 512 + tid, nt = G * 512; v4u z = {0u, 0u, 0u, 0u};
      for (int i = gt; i < (NINP - NIN) * 1024 / 8; i += nt) *(GAS v4u*)(win + (size_t)NIN * 1024 + (size_t)i * 8) = z; }
    const int gt = bid * 512 + tid;
    if (gt < 1024) { const float l0 = p.in[I_LBL][gt], l1 = p.in[I_LBL][1024 + gt]; const float mx = fmaxf(l0, l1), e0 = __expf(l0 - mx), e1 = __expf(l1 - mx); ((float*)(ws + WS_SMALL + SM_LB))[gt] = e0 / (e0 + e1); }
    if (gt >= 4096 && gt < 8192) {
        const int s = gt - 4096, dg = s >> 6;
        const float dt = expf(p.in[I_LOGDT][dg]), are = p.in[I_ARE][s], aim = p.in[I_AIM][s];
        const float mag = expf(are * dt); float sn, cs; sincosf(aim * dt, &sn, &cs);
        const float lr = mag * cs, li = mag * sn, den = are * are + aim * aim;
        const float cr = ((lr - 1.f) * are + li * aim) / den, ci = (li * are - (lr - 1.f) * aim) / den;
        float* lam = (float*)(ws + WS_SMALL + SM_LAM); lam[2 * s] = lr; lam[2 * s + 1] = li;
        float pr = lr, pi = li;
#pragma unroll
        for (int q = 0; q < 7; ++q) { const float nr = pr * pr - pi * pi, ni = 2.f * pr * pi; pr = nr; pi = ni; }
        float* lamp = (float*)(ws + WS_SMALL + SM_LAMP); lamp[2 * s] = pr; lamp[2 * s + 1] = pi;
        bf16* bbh = (bf16*)(ws + WS_SMALL + SM_BB) + (size_t)s * 32;
#pragma unroll
        for (int c = 0; c < 16; ++c) { const float br = p.in[I_BRE][(size_t)s * 16 + c], bi = p.in[I_BIM][(size_t)s * 16 + c]; bbh[c] = (bf16)f2bf(cr * br - ci * bi); bbh[16 + c] = (bf16)f2bf(cr * bi + ci * br); }
    }
    { bf16* cmh = (bf16*)(ws + WS_SMALL + SM_BB + 262144); const int nt = G * 512;
      for (int e = gt; e < 2 * 32 * 16 * 128; e += nt) { const int k = e & 127, dgc = e >> 7; cmh[e] = (bf16)f2bf(k < 64 ? p.in[I_CRE][(size_t)dgc * 64 + k] : -p.in[I_CIM][(size_t)dgc * 64 + k - 64]); } }
}

__device__ __forceinline__ void phase_rownorm(const Params& p, LAS unsigned char* lds, int bid, int G, int tid, int wave, int lane, int layer, int kind  , int nrows,
                                              const float* src_lat, const float* src_ctx, bool from_partials) {
    unsigned char* ws = p.ws; const float* adap = (const float*)(ws + WS_SMALL + SM_ADAP); float* mods = (float*)(ws + WS_SMALL + SM_MODS);
    LAS float* Gt = (LAS float*)lds; LAS float* St = Gt + 2048;
    const float* ng = p.in[kind == 0 ? I_NMIX : I_NFFN] + layer * 1024;
    for (int idx = tid; idx < 4096; idx += 512) {
        const int vec = idx >> 11, which = (idx >> 10) & 1, col = idx & 1023, j = (kind * 3 + which) * 1024 + col;
        float v;
        if (from_partials) { v = p.in[I_ADAB][layer * 6144 + j];
#pragma unroll
            for (int ks = 0; ks < 8; ++ks) v += adap[((layer * 2 + vec) * 8 + ks) * 6144 + j]; }
        else v = mods[(layer * 2 + vec) * 6144 + j];
        if (which == 0) St[vec * 1024 + col] = v; else Gt[vec * 1024 + col] = ng[col] * (1.f + v);
    }
    if (from_partials && bid < 48) {
        const int idx = bid * 512 + tid, lv = idx / 6144, j = idx % 6144, ly = lv >> 1;
        float v = p.in[I_ADAB][ly * 6144 + j];
#pragma unroll
        for (int ks = 0; ks < 8; ++ks) v += adap[(lv * 8 + ks) * 6144 + j];
        mods[idx] = v;
    }
    __syncthreads();
    bf16* XN = (bf16*)(ws + WS_RX);
    const int gw = bid * NWAVES + wave, ngw = G * NWAVES;
    for (int row = gw; row < nrows; row += ngw) {
        const int vec = row >= ML ? 1 : 0; const float* xr = vec ? src_ctx + (size_t)(row - ML) * 1024 : src_lat + (size_t)row * 1024;
        f32x4 v[4]; float ss = 0.f;
#pragma unroll
        for (int j = 0; j < 4; ++j) { v[j] = *(const GAS f32x4*)(xr + 4 * lane + 256 * j); ss += (v[j].x * v[j].x + v[j].y * v[j].y) + (v[j].z * v[j].z + v[j].w * v[j].w); }
        const float r = rsqrtf(wave_sum(ss) * (1.f / 1024.f) + EPS);
#pragma unroll
        for (int j = 0; j < 4; ++j) { const int c = 4 * lane + 256 * j; const LAS float* g4 = Gt + vec * 1024 + c; const LAS float* s4 = St + vec * 1024 + c;
            const unsigned lo = pk2(v[j].x * r * g4[0] + s4[0], v[j].y * r * g4[1] + s4[1]), hi = pk2(v[j].z * r * g4[2] + s4[2], v[j].w * r * g4[3] + s4[3]);
            *(GAS unsigned long long*)(XN + (size_t)row * 1024 + c) = (unsigned long long)lo | ((unsigned long long)hi << 32); }
    }
}

typedef float f32x16 __attribute__((ext_vector_type(16)));
typedef short s16x4 __attribute__((ext_vector_type(4)));
#define MFMA32(a, b, c) __builtin_amdgcn_mfma_f32_32x32x16_bf16((a), (b), (c), 0, 0, 0)
__device__ __forceinline__ bf16x8 frag_rows(LAS const unsigned char* img, int RS, int row0, int kbyte, int lane) { return *(const LAS bf16x8*)(img + (row0 + (lane & 31)) * RS + kbyte + (lane >> 5) * 16); }
__device__ __forceinline__ bf16x8 frag_tr(LAS const unsigned char* img, int RS, int k0, int col0, int lane) {
    const int h = lane >> 5, blk = (lane >> 4) & 1, q = (lane & 15) >> 2, p = lane & 3;
    LAS const unsigned char* a = img + (k0 + 8 * h + q) * RS + (col0 + 16 * blk + 4 * p) * 2;
    const s16x4 lo = __builtin_amdgcn_ds_read_tr16_b64_v4i16((LAS s16x4*)a), hi = __builtin_amdgcn_ds_read_tr16_b64_v4i16((LAS s16x4*)(a + 4 * RS));
    return (bf16x8){lo[0], lo[1], lo[2], lo[3], hi[0], hi[1], hi[2], hi[3]};
}
__device__ __forceinline__ int arow(int reg, int h) { return (reg & 3) + 8 * (reg >> 2) + 4 * h; }
__device__ __forceinline__ void store_acc_nat(const f32x16& acc, LAS unsigned char* img, int RS, int n0, int m0, int lane) {
    LAS unsigned char* base = img + (n0 + (lane & 31)) * RS + (m0 + 4 * (lane >> 5)) * 2;
#pragma unroll
    for (int g = 0; g < 4; ++g) *(LAS unsigned long long*)(base + 16 * g) = (unsigned long long)pk2(acc[4 * g], acc[4 * g + 1]) | ((unsigned long long)pk2(acc[4 * g + 2], acc[4 * g + 3]) << 32);
}

struct ScanPtrs { const bf16* XBC; const float* DT; bf16* ZQ; const bf16* V; const bf16* G; f16* Flat; f16* Fctx; float* STATS; const float* convw; const float* convb; const float* ssdd; const float* hgn;
                  bf16* SSD_ST; bf16* HG_ST; float* SSD_DEC; float* HG_DEC; const bf16* BCC; };
template <int MODE, int D>
__device__ __forceinline__ void ssd_scan(const ScanPtrs& sp, LAS unsigned char* lds, int row_begin, int nchunks, int seq_lo, int seq_hi, int h, const bf16* st_in, bf16* st_out, float* dec_out, int tid) {
    const int lane = tid & 63, wave = __builtin_amdgcn_readfirstlane(tid >> 6), hf = lane >> 5, g = h >> 3;
    LAS unsigned short* YF = (LAS unsigned short*)lds; LAS unsigned char* XI = lds + 65536; LAS unsigned char* XE = lds + 74752; LAS unsigned char* BI = lds + 83968; LAS unsigned char* CI = lds + 101376; LAS unsigned char* MI = lds + 118784;
    LAS unsigned char* SPI = lds + 128000; LAS float* YB = (LAS float*)(lds + 101376); LAS unsigned char* XR = lds + 145408; LAS float* WT = (LAS float*)(lds + 154112);
    LAS float* AC = (LAS float*)(lds + 155648); LAS float* EA = AC + 64; LAS float* ES = AC + 128; LAS float* DTS = AC + 192;
    asm volatile("" : "+s"(nchunks));
    if (tid < 384) { const int j = tid >> 6, col = h * 64 + (tid & 63); WT[tid] = j < 5 ? sp.convw[j * 1536 + col] : sp.convb[col]; }
    const int nb = wave >> 1, pb = wave & 1;
    f32x16 accS;
#pragma unroll
    for (int r = 0; r < 16; ++r) accS[r] = st_in ? bf2f(*(const GAS unsigned short*)(st_in + (32 * nb + arow(r, hf)) * 64 + 32 * pb + (lane & 31))) : 0.f;
    if (MODE != 0) store_acc_nat(accS, SPI, 272, 32 * pb, 32 * nb, lane);
    float ltot = 0.f; const float dsk = sp.ssdd[h];
    v4u px0, px1, pb0, pb1, pc0, pc1; float pdt = 0.f, pla = 0.f;
    const v4u zero4 = {0u, 0u, 0u, 0u};
    px1 = zero4; pc0 = zero4; pc1 = zero4;
#define SSD_LDX(row_, col_) (((row_) >= seq_lo && (row_) < seq_hi) ? *(const GAS v4u*)(sp.XBC + (size_t)(row_) * 1536 + (col_)) : zero4)
#define SSD_LOAD(c_, tid) do { const int rb_ = row_begin + 64 * (c_); \
        px0 = SSD_LDX(rb_ - 2 + (tid >> 3), h * 64 + (tid & 7) * 8); if (tid < 32) px1 = SSD_LDX(rb_ + 62 + (tid >> 3), h * 64 + (tid & 7) * 8); \
        { const GAS v4u* bp_ = (const GAS v4u*)(sp.BCC + (size_t)(rb_ + (tid >> 4)) * 512 + g * 128 + (tid & 15) * 8); pb0 = bp_[0]; pb1 = bp_[32 * 64]; \
          if (MODE != 0) { pc0 = bp_[32]; pc1 = bp_[32 * 64 + 32]; } } \
        if (tid < 64) { pdt = sp.DT[(size_t)(rb_ + tid) * 64 + D * 16 + h]; pla = sp.DT[(size_t)(rb_ + tid) * 64 + 32 + D * 16 + h]; } } while (0)
    SSD_LOAD(D == 0 ? 0 : nchunks - 1, tid);
#pragma unroll 1
    for (int ci = 0; ci < nchunks; ++ci) {
        const int c = D == 0 ? ci : nchunks - 1 - ci, r0 = row_begin + 64 * c;
        int tl = tid; asm volatile("" : "+v"(tl));
        v4u pz; if (MODE == 2) pz = *(const GAS v4u*)(sp.ZQ + (size_t)(r0 + (tl >> 3)) * 2048 + h * 64 + (tl & 7) * 8);
        *(LAS v4u*)(XR + (tl >> 3) * 128 + (tl & 7) * 16) = px0; if (tl < 32) *(LAS v4u*)(XR + (64 + (tl >> 3)) * 128 + (tl & 7) * 16) = px1;
        if (wave == 0) {
            float x = pla;
#pragma unroll
            for (int o = 1; o < 64; o <<= 1) { const float v = D == 0 ? __shfl_up(x, o) : __shfl_down(x, o); if (D == 0 ? (lane >= o) : (lane + o < 64)) x += v; }
            const float last = __shfl(x, D == 0 ? 63 : 0);
            AC[lane] = x; EA[lane] = __expf(x); ES[lane] = pdt * __expf(last - x); DTS[lane] = pdt;
            if (lane == 0) AC[256] = __expf(last);
            ltot += last;
        }
        __syncthreads();
        { const int t = tl >> 3, o8 = (tl & 7) * 8; float a8[8];
#pragma unroll
          for (int i = 0; i < 8; ++i) a8[i] = WT[320 + o8 + i];
#pragma unroll
          for (int j = 0; j < 5; ++j) { float x8[8]; unpack8(*(const LAS v4u*)(XR + (t + j) * 128 + o8 * 2), x8);
#pragma unroll
              for (int i = 0; i < 8; ++i) a8[i] += WT[j * 64 + o8 + i] * x8[i]; }
          const float es = ES[t]; v4u w, we;
#pragma unroll
          for (int i = 0; i < 8; ++i) a8[i] = siluf(a8[i]);
          w.x = pk2(a8[0], a8[1]); w.y = pk2(a8[2], a8[3]); w.z = pk2(a8[4], a8[5]); w.w = pk2(a8[6], a8[7]);
          we.x = pk2(a8[0] * es, a8[1] * es); we.y = pk2(a8[2] * es, a8[3] * es); we.z = pk2(a8[4] * es, a8[5] * es); we.w = pk2(a8[6] * es, a8[7] * es);
          *(LAS v4u*)(XI + t * 144 + o8 * 2) = w; *(LAS v4u*)(XE + t * 144 + o8 * 2) = we; }
        { const int t = tl >> 4, o16 = (tl & 15) * 16;
          *(LAS v4u*)(BI + t * 272 + o16) = pb0; *(LAS v4u*)(BI + (32 + t) * 272 + o16) = pb1;
          if (MODE != 0) { *(LAS v4u*)(CI + t * 272 + o16) = pc0; *(LAS v4u*)(CI + (32 + t) * 272 + o16) = pc1; } }
        if (ci + 1 < nchunks) SSD_LOAD(D == 0 ? ci + 1 : nchunks - 2 - ci, tl);
        __syncthreads();
        f32x16 accY;
        const int tb = (wave & 3) >> 1, qb = wave & 1;
        if (MODE != 0) {
            if (wave >= 4) { const int sb = tb; f32x16 a;
#pragma unroll
                for (int r = 0; r < 16; ++r) a[r] = 0.f;
#pragma unroll
                for (int ks = 0; ks < 8; ++ks) a = MFMA32(frag_rows(BI, 272, 32 * sb, 32 * ks, lane), frag_rows(CI, 272, 32 * qb, 32 * ks, lane), a);
                const int t = 32 * qb + (lane & 31); const float act = AC[t];
#pragma unroll
                for (int r = 0; r < 16; ++r) { const int s2 = 32 * sb + arow(r, hf); const bool keep = D == 0 ? (s2 <= t) : (s2 >= t); a[r] = keep ? a[r] * __expf(act - AC[s2]) * DTS[s2] : 0.f; }
                store_acc_nat(a, MI, 144, 32 * qb, 32 * sb, lane);
            } else {
#pragma unroll
                for (int r = 0; r < 16; ++r) accY[r] = 0.f;
#pragma unroll
                for (int ks = 0; ks < 8; ++ks) accY = MFMA32(frag_rows(CI, 272, 32 * tb, 32 * ks, lane), frag_rows(SPI, 272, 32 * qb, 32 * ks, lane), accY);
#pragma unroll
                for (int r = 0; r < 16; ++r) accY[r] *= EA[32 * tb + arow(r, hf)];
            }
            __syncthreads();
            if (wave < 4) {
#pragma unroll
                for (int ks = 0; ks < 4; ++ks) accY = MFMA32(frag_rows(MI, 144, 32 * tb, 32 * ks, lane), frag_tr(XI, 144, 16 * ks, 32 * qb, lane), accY);
#pragma unroll
                for (int r = 0; r < 16; ++r) YB[(32 * tb + arow(r, hf)) * 68 + 32 * qb + (lane & 31)] = accY[r];
            }
        }
        { const float el = AC[256];
#pragma unroll
          for (int r = 0; r < 16; ++r) accS[r] *= el;
#pragma unroll
          for (int ks = 0; ks < 4; ++ks) accS = MFMA32(frag_tr(BI, 272, 16 * ks, 32 * nb, lane), frag_tr(XE, 144, 16 * ks, 32 * pb, lane), accS);
          if (MODE != 0) store_acc_nat(accS, SPI, 272, 32 * pb, 32 * nb, lane); }
        __syncthreads();
        if (MODE != 0) {
            int t3 = tid; asm volatile("" : "+v"(t3)); const int t = t3 >> 3, p8 = (t3 & 7) * 8, row = r0 + t;
            const f32x4 y0 = *(const LAS f32x4*)(YB + t * 68 + p8), y1 = *(const LAS f32x4*)(YB + t * 68 + p8 + 4);
            LAS v4u* yp = (LAS v4u*)(YF + (row - row_begin) * 64 + p8);
            if (MODE == 1) { v4u w; w.x = pk2(y0.x, y0.y); w.y = pk2(y0.z, y0.w); w.z = pk2(y1.x, y1.y); w.w = pk2(y1.z, y1.w); *yp = w; }
            else { float yf[8], x8[8], z8[8]; unpack8(*yp, yf); unpack8(*(const LAS v4u*)(XI + t * 144 + p8 * 2), x8);
                GAS v4u* zp = (GAS v4u*)(sp.ZQ + (size_t)row * 2048 + h * 64 + p8); unpack8(pz, z8);
                float o[8] = {y0.x, y0.y, y0.z, y0.w, y1.x, y1.y, y1.z, y1.w}; float ss = 0.f;
#pragma unroll
                for (int i = 0; i < 8; ++i) { o[i] = (o[i] + yf[i] + dsk * x8[i]) * z8[i]; ss += o[i] * o[i]; }
                v4u w; w.x = pk2(o[0], o[1]); w.y = pk2(o[2], o[3]); w.z = pk2(o[4], o[5]); w.w = pk2(o[6], o[7]); *zp = w;
                ss += __shfl_xor(ss, 1); ss += __shfl_xor(ss, 2); ss += __shfl_xor(ss, 4);
                if ((t3 & 7) == 0) sp.STATS[(size_t)row * 16 + h] = ss; }
        }
    }
#undef SSD_LOAD
#undef SSD_LDX
    if (st_out) {
#pragma unroll
        for (int r = 0; r < 16; ++r) *(GAS unsigned short*)(st_out + (32 * nb + arow(r, hf)) * 64 + 32 * pb + (lane & 31)) = (unsigned short)f2bf(accS[r]); }
    if (dec_out && tid == 0) *dec_out = __expf(ltot);
    __syncthreads();
}
__device__ __forceinline__ void ssd_passA(const ScanPtrs& sp, LAS unsigned char* lds, int row_begin, int h, bf16* so_f, bf16* so_b, float* dec_f, float* dec_b, int tid) {
    const int lane = tid & 63, wave = __builtin_amdgcn_readfirstlane(tid >> 6), hf = lane >> 5, g = h >> 3, nb = wave >> 1, pb = wave & 1;
    LAS float* WT = (LAS float*)(lds + 73728); LAS float* WF = (LAS float*)(lds + 75264); LAS float* WB = (LAS float*)(lds + 77312); LAS float* SCR = (LAS float*)(lds + 79360);
    if (tid < 384) { const int j = tid >> 6, col = h * 64 + (tid & 63); WT[tid] = j < 5 ? sp.convw[j * 1536 + col] : sp.convb[col]; }
    { const float* dr = sp.DT + (size_t)(row_begin + tid) * 64; const float dtf = dr[h], dtb = dr[16 + h], laf = dr[32 + h], lab = dr[48 + h];
      float xf = laf, xb = lab;
#pragma unroll
      for (int o = 1; o < 64; o <<= 1) { const float vf = __shfl_up(xf, o), vb = __shfl_up(xb, o); if (lane >= o) { xf += vf; xb += vb; } }
      if (lane == 63) { SCR[wave] = xf; SCR[8 + wave] = xb; }
      __syncthreads();
      float of = 0.f, ob = 0.f, tf = 0.f, tb = 0.f;
#pragma unroll
      for (int w = 0; w < 8; ++w) { const float a = SCR[w], b = SCR[8 + w]; tf += a; tb += b; if (w < wave) { of += a; ob += b; } }
      WF[tid] = dtf * __expf(tf - (of + xf)); WB[tid] = dtb * __expf(ob + xb - lab);
      if (tid == 0) { *dec_f = __expf(tf); *dec_b = __expf(tb); } }
    f32x16 accF, accB;
#pragma unroll
    for (int r = 0; r < 16; ++r) { accF[r] = 0.f; accB[r] = 0.f; }
    v4u pxr[5], pb0, pb1; const v4u zero4 = {0u, 0u, 0u, 0u};
#define PA_LOAD(c_, tid) do { const int rb_ = row_begin + 64 * (c_); \
        _Pragma("unroll") for (int j_ = 0; j_ < 5; ++j_) { const int rr_ = rb_ + (tid >> 3) + j_ - 2; pxr[j_] = (rr_ >= 0 && rr_ < ML) ? *(const GAS v4u*)(sp.XBC + (size_t)rr_ * 1536 + h * 64 + (tid & 7) * 8) : zero4; } \
        { const GAS v4u* bp_ = (const GAS v4u*)(sp.BCC + (size_t)(rb_ + (tid >> 4)) * 512 + g * 128 + (tid & 15) * 8); pb0 = bp_[0]; pb1 = bp_[32 * 64]; } } while (0)
    PA_LOAD(0, tid);
    __syncthreads();
#pragma unroll 1
    for (int c = 0; c < SCL / 64; ++c) {
        int tl = tid; asm volatile("" : "+v"(tl));
        LAS unsigned char* XEF = lds + (c & 1) * 36864; LAS unsigned char* XEB = XEF + 9216; LAS unsigned char* BI = XEF + 18432;
        { const int t = tl >> 3, o8 = (tl & 7) * 8; float a8[8];
#pragma unroll
          for (int i = 0; i < 8; ++i) a8[i] = WT[320 + o8 + i];
#pragma unroll
          for (int j = 0; j < 5; ++j) { float x8[8]; unpack8(pxr[j], x8);
#pragma unroll
              for (int i = 0; i < 8; ++i) a8[i] += WT[j * 64 + o8 + i] * x8[i]; }
#pragma unroll
          for (int i = 0; i < 8; ++i) a8[i] = siluf(a8[i]);
          const float wf = WF[64 * c + t], wb = WB[64 * c + t]; v4u w1, w2;
          w1.x = pk2(a8[0] * wf, a8[1] * wf); w1.y = pk2(a8[2] * wf, a8[3] * wf); w1.z = pk2(a8[4] * wf, a8[5] * wf); w1.w = pk2(a8[6] * wf, a8[7] * wf);
          w2.x = pk2(a8[0] * wb, a8[1] * wb); w2.y = pk2(a8[2] * wb, a8[3] * wb); w2.z = pk2(a8[4] * wb, a8[5] * wb); w2.w = pk2(a8[6] * wb, a8[7] * wb);
          *(LAS v4u*)(XEF + t * 144 + o8 * 2) = w1; *(LAS v4u*)(XEB + t * 144 + o8 * 2) = w2; }
        { const int t = tl >> 4, o16 = (tl & 15) * 16; *(LAS v4u*)(BI + t * 272 + o16) = pb0; *(LAS v4u*)(BI + (32 + t) * 272 + o16) = pb1; }
        if (c + 1 < SCL / 64) PA_LOAD(c + 1, tl);
        __syncthreads();
#pragma unroll
        for (int ks = 0; ks < 4; ++ks) { const bf16x8 a = frag_tr(BI, 272, 16 * ks, 32 * nb, lane);
            accF = MFMA32(a, frag_tr(XEF, 144, 16 * ks, 32 * pb, lane), accF); accB = MFMA32(a, frag_tr(XEB, 144, 16 * ks, 32 * pb, lane), accB); }
    }
#undef PA_LOAD
#pragma unroll
    for (int r = 0; r < 16; ++r) { const int o = (32 * nb + arow(r, hf)) * 64 + 32 * pb + (lane & 31);
        *(GAS unsigned short*)(so_f + o) = (unsigned short)f2bf(accF[r]); *(GAS unsigned short*)(so_b + o) = (unsigned short)f2bf(accB[r]); }
    __syncthreads();
}
__device__ __forceinline__ void phase_convbc(const Params& p, int bid, int G, int tid) {
    const bf16* XBC = (const bf16*)(p.ws + WS_XBC); bf16* BCC = (bf16*)(p.ws + WS_BCC);
    const int gt = bid * 512 + tid, nt = G * 512;
    for (int u = gt; u < (M / 8) * 64; u += nt) {
        const int oct = u & 63, col = 1024 + oct * 8, r0 = (u >> 6) * 8, lo = r0 < ML ? 0 : ML, hi = r0 < ML ? ML : M;
        v4u raw[12]; const v4u zero4 = {0u, 0u, 0u, 0u};
#pragma unroll
        for (int i = 0; i < 12; ++i) { const int rr = r0 - 2 + i; raw[i] = (rr >= lo && rr < hi) ? *(const GAS v4u*)(XBC + (size_t)rr * 1536 + col) : zero4; }
        float w[5][8], b8[8];
#pragma unroll
        for (int j = 0; j < 5; ++j) { const f32x4 w0 = *(const GAS f32x4*)(p.in[I_CONVW] + j * 1536 + col), w1 = *(const GAS f32x4*)(p.in[I_CONVW] + j * 1536 + col + 4);
            w[j][0] = w0.x; w[j][1] = w0.y; w[j][2] = w0.z; w[j][3] = w0.w; w[j][4] = w1.x; w[j][5] = w1.y; w[j][6] = w1.z; w[j][7] = w1.w; }
        { const f32x4 b0 = *(const GAS f32x4*)(p.in[I_CONVB] + col), b1 = *(const GAS f32x4*)(p.in[I_CONVB] + col + 4); b8[0] = b0.x; b8[1] = b0.y; b8[2] = b0.z; b8[3] = b0.w; b8[4] = b1.x; b8[5] = b1.y; b8[6] = b1.z; b8[7] = b1.w; }
        float acc[8][8];
#pragma unroll
        for (int t = 0; t < 8; ++t)
#pragma unroll
            for (int i = 0; i < 8; ++i) acc[t][i] = b8[i];
#pragma unroll
        for (int i2 = 0; i2 < 12; ++i2) { float x8[8]; unpack8(raw[i2], x8);
#pragma unroll
            for (int t = 0; t < 8; ++t) { const int j = i2 - t; if (j >= 0 && j < 5) {
#pragma unroll
                for (int i = 0; i < 8; ++i) acc[t][i] += w[j][i] * x8[i]; } } }
#pragma unroll
        for (int t = 0; t < 8; ++t) { v4u o; o.x = pk2(siluf(acc[t][0]), siluf(acc[t][1])); o.y = pk2(siluf(acc[t][2]), siluf(acc[t][3])); o.z = pk2(siluf(acc[t][4]), siluf(acc[t][5])); o.w = pk2(siluf(acc[t][6]), siluf(acc[t][7]));
            *(GAS v4u*)(BCC + (size_t)(r0 + t) * 512 + oct * 8) = o; }
    }
}
template <int MODE, int D>
__device__ __forceinline__ void hg_scan(const ScanPtrs& sp, LAS unsigned char* lds, int row_begin, int nchunks, int hh, const bf16* st_in, bf16* st_out, float* dec_out, int tid) {
    const int lane = tid & 63, wave = __builtin_amdgcn_readfirstlane(tid >> 6), h = lane >> 5;
    LAS unsigned char* QP = lds; LAS unsigned char* KP = lds + 17408; LAS unsigned char* VI = lds + 34816; LAS unsigned char* ATT = lds + 52224; LAS unsigned char* STI = lds + 61440;
    LAS float* OB = (LAS float*)(lds + 96256); LAS float* PAR = (LAS float*)(lds + 132096); LAS float* EL = (LAS float*)(lds + 136192);
    f16* Fit = (row_begin < ML) ? sp.Flat + (size_t)row_begin * 2048 : sp.Fctx + (size_t)(row_begin - ML) * 2048;
    const int k0 = (tid & 63) * 2, tg = wave, kb = wave >> 1, vb0 = (wave & 1) * 2;
    asm volatile("" : "+s"(nchunks));
    f32x16 accS[2];
#pragma unroll
    for (int i = 0; i < 2; ++i)
#pragma unroll
        for (int r = 0; r < 16; ++r) accS[i][r] = st_in ? bf2f(*(const GAS unsigned short*)(st_in + (32 * kb + arow(r, h)) * 128 + 32 * (vb0 + i) + (lane & 31))) : 0.f;
    if (MODE != 0) { store_acc_nat(accS[0], STI, 272, 32 * vb0, 32 * kb, lane); store_acc_nat(accS[1], STI, 272, 32 * (vb0 + 1), 32 * kb, lane); }
    float ltot0 = 0.f, ltot1 = 0.f;
    unsigned plf[8], pq[8]; v4u pv0, pv1;
    const int vr = tid >> 3, vc = (tid & 7) * 16;
#define HG_LOAD(c_) do { const int rr_ = 64 * (c_); \
        _Pragma("unroll") for (int i = 0; i < 8; ++i) { plf[i] = *(const GAS unsigned*)(Fit + (size_t)(rr_ + 8 * tg + i) * 2048 + D * 1024 + hh * 128 + k0); \
            if (MODE != 0) pq[i] = *(const GAS unsigned*)(sp.ZQ + (size_t)(row_begin + rr_ + 8 * tg + i) * 2048 + 1024 + hh * 128 + k0); } \
        const GAS v4u* vp_ = (const GAS v4u*)(sp.V + (size_t)(row_begin + rr_ + vr) * 1024 + hh * 128 + vc); pv0 = vp_[0]; pv1 = vp_[1]; } while (0)
    HG_LOAD(D == 0 ? 0 : nchunks - 1);
#pragma unroll 1
    for (int ci = 0; ci < nchunks; ++ci) {
        const int c = D == 0 ? ci : nchunks - 1 - ci, r0 = 64 * c;
        v4u pof0, pof1, pg0, pg1;
        if (MODE == 2) { int t3 = tid; asm volatile("" : "+v"(t3)); const int t = t3 >> 3, c16 = (t3 & 7) * 16;
            const v4u* fp = (const v4u*)(Fit + (size_t)(r0 + t) * 2048 + hh * 128 + c16); pof0 = __builtin_nontemporal_load(fp); pof1 = __builtin_nontemporal_load(fp + 1);
            const GAS v4u* gp = (const GAS v4u*)(sp.G + (size_t)(row_begin + r0 + t) * 1024 + hh * 128 + c16); pg0 = gp[0]; pg1 = gp[1]; }
        float lf0[8], lf1[8], cs0[8], cs1[8]; float run0 = 0.f, run1 = 0.f;
#pragma unroll
        for (int i = 0; i < 8; ++i) { const f16x2 hr = __builtin_bit_cast(f16x2, plf[i]); lf0[i] = (float)hr.x; lf1[i] = (float)hr.y; }
#pragma unroll
        for (int ii = 0; ii < 8; ++ii) { const int i = D == 0 ? ii : 7 - ii; run0 += lf0[i]; run1 += lf1[i]; cs0[i] = run0; cs1[i] = run1; }
        *(LAS f32x2*)(PAR + tg * 128 + k0) = (f32x2){run0, run1};
        __syncthreads();
        float off0 = 0.f, off1 = 0.f, tot0 = 0.f, tot1 = 0.f;
#pragma unroll
        for (int j = 0; j < 8; ++j) { const f32x2 pj = *(const LAS f32x2*)(PAR + j * 128 + k0); tot0 += pj.x; tot1 += pj.y; if (D == 0 ? (j < tg) : (j > tg)) { off0 += pj.x; off1 += pj.y; } }
#pragma unroll
        for (int i = 0; i < 8; ++i) { const float bc0 = off0 + cs0[i], bc1 = off1 + cs1[i], kk0 = 1.f - __expf(lf0[i]), kk1 = 1.f - __expf(lf1[i]); const int t = 8 * tg + i;
            if (MODE != 0) *(LAS unsigned*)(QP + t * 272 + k0 * 2) = pk2(bf2f(pq[i] & 0xffffu) * __expf(bc0), bf2f(pq[i] >> 16) * __expf(bc1));
            *(LAS unsigned*)(KP + t * 272 + k0 * 2) = pk2(kk0 * __expf(-bc0), kk1 * __expf(-bc1)); }
        if (tg == 0) { *(LAS f32x2*)(EL + k0) = (f32x2){__expf(tot0), __expf(tot1)}; ltot0 += tot0; ltot1 += tot1; }
        *(LAS v4u*)(VI + vr * 272 + vc * 2) = pv0; *(LAS v4u*)(VI + vr * 272 + vc * 2 + 16) = pv1;
        if (ci + 1 < nchunks) HG_LOAD(D == 0 ? ci + 1 : nchunks - 2 - ci);
        __syncthreads();
        f32x16 accO;
        if (MODE != 0) {
            if (wave < 4) { const int sb = wave >> 1, tb = wave & 1; f32x16 a;
#pragma unroll
                for (int r = 0; r < 16; ++r) a[r] = 0.f;
#pragma unroll
                for (int ks = 0; ks < 8; ++ks) a = MFMA32(frag_rows(KP, 272, 32 * sb, 32 * ks, lane), frag_rows(QP, 272, 32 * tb, 32 * ks, lane), a);
                const int t = 32 * tb + (lane & 31);
#pragma unroll
                for (int r = 0; r < 16; ++r) { const int s = 32 * sb + arow(r, h); if (D == 0 ? (s > t) : (s < t)) a[r] = 0.f; }
                store_acc_nat(a, ATT, 144, 32 * tb, 32 * sb, lane); }
            const int tb = wave >> 2, vb = wave & 3;
#pragma unroll
            for (int r = 0; r < 16; ++r) accO[r] = 0.f;
#pragma unroll
            for (int ks = 0; ks < 8; ++ks) accO = MFMA32(frag_rows(QP, 272, 32 * tb, 32 * ks, lane), frag_rows(STI, 272, 32 * vb, 32 * ks, lane), accO);
            __syncthreads();
#pragma unroll
            for (int ks = 0; ks < 4; ++ks) accO = MFMA32(frag_rows(ATT, 144, 32 * tb, 32 * ks, lane), frag_tr(VI, 272, 16 * ks, 32 * vb, lane), accO);
#pragma unroll
            for (int r = 0; r < 16; ++r) OB[(32 * tb + arow(r, h)) * 132 + 32 * vb + (lane & 31)] = accO[r];
        }
#pragma unroll
        for (int ks = 0; ks < 4; ++ks) { const bf16x8 a = frag_tr(KP, 272, 16 * ks, 32 * kb, lane);
            accS[0] = MFMA32(a, frag_tr(VI, 272, 16 * ks, 32 * vb0, lane), accS[0]); accS[1] = MFMA32(a, frag_tr(VI, 272, 16 * ks, 32 * (vb0 + 1), lane), accS[1]); }
#pragma unroll
        for (int r = 0; r < 16; ++r) { const float e = EL[32 * kb + arow(r, h)]; accS[0][r] *= e; accS[1][r] *= e; }
        if (MODE != 0) { store_acc_nat(accS[0], STI, 272, 32 * vb0, 32 * kb, lane); store_acc_nat(accS[1], STI, 272, 32 * (vb0 + 1), 32 * kb, lane); }
        __syncthreads();
        if (MODE != 0) {
            const int t = tid >> 3, c16 = (tid & 7) * 16, row = row_begin + r0 + t;
            float o[16];
#pragma unroll
            for (int j = 0; j < 4; ++j) { const f32x4 x = *(const LAS f32x4*)(OB + t * 132 + c16 + 4 * j); o[4 * j] = x.x; o[4 * j + 1] = x.y; o[4 * j + 2] = x.z; o[4 * j + 3] = x.w; }
            f16* fp = Fit + (size_t)(r0 + t) * 2048 + hh * 128 + c16;
            if (MODE == 1) { f16x8 a, b;
#pragma unroll
                for (int j = 0; j < 8; ++j) { a[j] = (f16)o[j]; b[j] = (f16)o[8 + j]; }
                *(GAS f16x8*)fp = a; *(GAS f16x8*)(fp + 8) = b; }
            else { const f16x8 a = __builtin_bit_cast(f16x8, pof0), b = __builtin_bit_cast(f16x8, pof1); float ss = 0.f;
#pragma unroll
                for (int j = 0; j < 8; ++j) { o[j] += (float)a[j]; o[8 + j] += (float)b[j]; }
#pragma unroll
                for (int j = 0; j < 16; ++j) ss += o[j] * o[j];
                ss += __shfl_xor(ss, 1); ss += __shfl_xor(ss, 2); ss += __shfl_xor(ss, 4);
                const float rn = rsqrtf(ss * (1.f / 128.f) + EPS);
                float g8[8], g9[8]; unpack8(pg0, g8); unpack8(pg1, g9);
                const float* hn = sp.hgn + c16;
                v4u w0, w1;
                w0.x = pk2(o[0] * rn * hn[0] * g8[0], o[1] * rn * hn[1] * g8[1]); w0.y = pk2(o[2] * rn * hn[2] * g8[2], o[3] * rn * hn[3] * g8[3]); w0.z = pk2(o[4] * rn * hn[4] * g8[4], o[5] * rn * hn[5] * g8[5]); w0.w = pk2(o[6] * rn * hn[6] * g8[6], o[7] * rn * hn[7] * g8[7]);
                w1.x = pk2(o[8] * rn * hn[8] * g9[0], o[9] * rn * hn[9] * g9[1]); w1.y = pk2(o[10] * rn * hn[10] * g9[2], o[11] * rn * hn[11] * g9[3]); w1.z = pk2(o[12] * rn * hn[12] * g9[4], o[13] * rn * hn[13] * g9[5]); w1.w = pk2(o[14] * rn * hn[14] * g9[6], o[15] * rn * hn[15] * g9[7]);
                GAS v4u* zp = (GAS v4u*)(sp.ZQ + (size_t)row * 2048 + 1024 + hh * 128 + c16); zp[0] = w0; zp[1] = w1; }
        }
    }
#undef HG_LOAD
    if (st_out) {
#pragma unroll
        for (int i = 0; i < 2; ++i)
#pragma unroll
            for (int r = 0; r < 16; ++r) *(GAS unsigned short*)(st_out + (32 * kb + arow(r, h)) * 128 + 32 * (vb0 + i) + (lane & 31)) = (unsigned short)f2bf(accS[i][r]); }
    if (dec_out && tg == 0) { dec_out[k0] = __expf(ltot0); dec_out[k0 + 1] = __expf(ltot1); }
    __syncthreads();
}
__device__ __forceinline__ void wg_fence() { asm volatile("s_waitcnt vmcnt(0)" ::: "memory"); __syncthreads(); }

__device__ __forceinline__ int queue_next(gu32* ctr, volatile LAS unsigned* slot, int tid) {
    if (tid == 0) *slot = __hip_atomic_fetch_add(ctr, 1u, __ATOMIC_RELAXED, __HIP_MEMORY_SCOPE_AGENT);
    __syncthreads(); const int v = (int)*slot; __syncthreads(); return v;
}
__device__ __forceinline__ void phase_scanA1(const ScanPtrs& sp, LAS unsigned char* lds, gu32* qctr, volatile LAS unsigned* slot, int bid_hw, int tid) {
    const int q = bid_hw & 7;
    for (;;) { const int j = queue_next(qctr + 64 * q, slot, tid);
        if (j >= 65) break;
        if (j == 0) { const int hh = q;
            hg_scan<1, 0>(sp, lds, ML, MC / 64, hh, nullptr, sp.HG_ST + ((size_t)NSC * 16 + hh * 2 + 0) * 16384, nullptr, tid);
            wg_fence();
            hg_scan<2, 1>(sp, lds, ML, MC / 64, hh, nullptr, sp.HG_ST + ((size_t)NSC * 16 + hh * 2 + 1) * 16384, nullptr, tid);
        } else { const int it = (j - 1) * 8 + q, sc = it >> 4, chain = it & 15, hh = chain >> 1, d = chain & 1;
            bf16* so = sp.HG_ST + ((size_t)sc * 16 + chain) * 16384; float* dc = sp.HG_DEC + (sc * 16 + chain) * 128;
            if (d == 0) hg_scan<0, 0>(sp, lds, sc * SCL, SCL / 64, hh, nullptr, so, dc, tid); else hg_scan<0, 1>(sp, lds, sc * SCL, SCL / 64, hh, nullptr, so, dc, tid); }
    }
}
__device__ __forceinline__ void phase_scanA2(const ScanPtrs& sp, LAS unsigned char* lds, gu32* qctr, volatile LAS unsigned* slot, int bid_hw, int tid) {
    const int q = bid_hw & 7;
    for (;;) { const int j = queue_next(qctr + 64 * q, slot, tid);
        if (j >= 66) break;
        if (j < 2) { const int h = q + 8 * j;
            ssd_scan<1, 0>(sp, lds, ML, MC / 64, ML, M, h, nullptr, sp.SSD_ST + ((size_t)NSC * 32 + h * 2 + 0) * 8192, nullptr, tid);
            ssd_scan<2, 1>(sp, lds, ML, MC / 64, ML, M, h, nullptr, sp.SSD_ST + ((size_t)NSC * 32 + h * 2 + 1) * 8192, nullptr, tid);
        } else { const int j2 = j - 2, grp = (j2 >> 3) * 8 + q, sc = grp >> 1, g = grp & 1, h = g * 8 + (j2 & 7);
            ssd_passA(sp, lds, sc * SCL, h, sp.SSD_ST + ((size_t)sc * 32 + h * 2) * 8192, sp.SSD_ST + ((size_t)sc * 32 + h * 2 + 1) * 8192, sp.SSD_DEC + sc * 32 + h * 2, sp.SSD_DEC + sc * 32 + h * 2 + 1, tid); }
    }
}
__device__ __forceinline__ void phase_scanB(const ScanPtrs& sp, int bid, int G, int tid) {
    const int gt = bid * 512 + tid, nt = G * 512;
    for (int e = gt; e < 2 * 131072; e += nt) {
        const bool hg = e >= 131072; const int e2 = hg ? e - 131072 : e;
        const int chain = hg ? (e2 >> 13) : (e2 >> 12), pr = hg ? (e2 & 8191) : (e2 & 4095), d = chain & 1;
        const int nch = hg ? 16 : 32, ppc = hg ? 8192 : 4096;
        GAS unsigned* base = (GAS unsigned*)(hg ? sp.HG_ST : sp.SSD_ST);
        const unsigned w0 = base[((size_t)NSC * nch + chain) * ppc + pr];
        float r0 = bf2f(w0 & 0xffffu), r1 = bf2f(w0 >> 16);
        for (int i0 = 0; i0 < NSC; i0 += 8) {
            unsigned loc[8]; float dec[8];
#pragma unroll
            for (int j = 0; j < 8; ++j) { const int sc = d == 0 ? i0 + j : NSC - 1 - (i0 + j); loc[j] = base[((size_t)sc * nch + chain) * ppc + pr];
                dec[j] = hg ? sp.HG_DEC[(sc * 16 + chain) * 128 + (pr >> 6)] : sp.SSD_DEC[sc * 32 + chain]; }
#pragma unroll
            for (int j = 0; j < 8; ++j) { const int sc = d == 0 ? i0 + j : NSC - 1 - (i0 + j); base[((size_t)sc * nch + chain) * ppc + pr] = pk2(r0, r1);
                r0 = r0 * dec[j] + bf2f(loc[j] & 0xffffu); r1 = r1 * dec[j] + bf2f(loc[j] >> 16); }
        }
    }
}
__device__ __forceinline__ void phase_scanC(const ScanPtrs& sp, LAS unsigned char* lds, gu32* qctr, volatile LAS unsigned* slot, int bid_hw, int tid) {
    const int q = bid_hw & 7;
    for (;;) { const int j = queue_next(qctr + 64 * q, slot, tid);
        if (j >= 96) break;
        if (j < 32) { const int it = j * 8 + q, sc = it >> 3, hh = it & 7;
            hg_scan<1, 0>(sp, lds, sc * SCL, SCL / 64, hh, sp.HG_ST + ((size_t)sc * 16 + hh * 2 + 0) * 16384, nullptr, nullptr, tid);
            wg_fence();
            hg_scan<2, 1>(sp, lds, sc * SCL, SCL / 64, hh, sp.HG_ST + ((size_t)sc * 16 + hh * 2 + 1) * 16384, nullptr, nullptr, tid);
        } else { const int j2 = j - 32, grp = (j2 >> 3) * 8 + q, sc = grp >> 1, g = grp & 1, h = g * 8 + (j2 & 7);
            ssd_scan<1, 0>(sp, lds, sc * SCL, SCL / 64, 0, ML, h, sp.SSD_ST + ((size_t)sc * 32 + h * 2 + 0) * 8192, nullptr, nullptr, tid);
            ssd_scan<2, 1>(sp, lds, sc * SCL, SCL / 64, 0, ML, h, sp.SSD_ST + ((size_t)sc * 32 + h * 2 + 1) * 8192, nullptr, nullptr, tid); }
    }
}
__device__ __forceinline__ void phase_finish(const Params& p, LAS unsigned char* lds, int bid, int G, int tid, int wave, int lane) {
    unsigned char* ws = p.ws; bf16* ZQ = (bf16*)(ws + WS_ZQ); const float* stats = (const float*)(ws + WS_SMALL + SM_STATS); const float* sng = p.in[I_SSDN];
    const int gw = bid * NWAVES + wave, ngw = G * NWAVES;
    for (int row = gw; row < M; row += ngw) {
        const int grp = lane >> 5; const float* s8 = stats + (size_t)row * 16 + grp * 8;
        const float ss = ((s8[0] + s8[1]) + (s8[2] + s8[3])) + ((s8[4] + s8[5]) + (s8[6] + s8[7]));
        const float r = rsqrtf(ss * (1.f / 512.f) + EPS);
        GAS v4u* zp = (GAS v4u*)(ZQ + (size_t)row * 2048 + lane * 16);
#pragma unroll
        for (int q = 0; q < 2; ++q) { float x8[8]; unpack8(zp[q], x8); const float* g8 = sng + lane * 16 + q * 8;
            v4u o; o.x = pk2(x8[0] * r * g8[0], x8[1] * r * g8[1]); o.y = pk2(x8[2] * r * g8[2], x8[3] * r * g8[3]); o.z = pk2(x8[4] * r * g8[4], x8[5] * r * g8[5]); o.w = pk2(x8[6] * r * g8[6], x8[7] * r * g8[7]); zp[q] = o; }
    }
    LAS float* scr = (LAS float*)(lds + wave * 16384); unsigned char* wr = ws + WS_WREST;
    tr_job(p.in[I_EVOUT], 2048, 1024, 1, (bf16*)(wr + WO_OUT), scr, gw, ngw, lane);
    tr_job(p.in[I_WGATE], 1024, DFF, 2, (bf16*)(wr + WO_UP0), scr, gw, ngw, lane);
    tr_job(p.in[I_WUP], 1024, DFF, 3, (bf16*)(wr + WO_UP0), scr, gw, ngw, lane);
    tr_job(p.in[I_WDOWN], DFF, 1024, 1, (bf16*)(wr + WO_DOWN0), scr, gw, ngw, lane);
    tr_job(p.in[I_ODIN], 1024, 512, 1, (bf16*)(wr + WO_OD), scr, gw, ngw, lane);
}

struct S5Ptrs { const bf16* U; float* YS; bf16* A2; const float* LAM; const float* LAMP; const bf16* BBH; const bf16* CMH; const float* S5D; float* ST; };
template <int MODE, int D>
__device__ __forceinline__ void s5_wave(const S5Ptrs& sp, LAS unsigned char* SI  , int row0  , int g, int slot0, int lane) {
    const int n = lane & 31, hs = lane >> 5, dg = D * 32 + g;
    bf16x8 bq[4];
#pragma unroll
    for (int q = 0; q < 4; ++q) bq[q] = *(const GAS bf16x8*)(sp.BBH + ((size_t)(dg * 64 + (q & 1) * 32 + n) * 2 + (q >> 1)) * 16 + 8 * hs);
    bf16x8 cm[8];
    if (MODE != 0) {
#pragma unroll
        for (int ks = 0; ks < 8; ++ks) cm[ks] = n < 16 ? *(const GAS bf16x8*)(sp.CMH + ((size_t)(dg * 16 + n) * 128 + 16 * ks + 8 * hs)) : (bf16x8){0, 0, 0, 0, 0, 0, 0, 0}; }
    const float lr0 = sp.LAM[2 * (dg * 64 + n)], li0 = sp.LAM[2 * (dg * 64 + n) + 1], lr1 = sp.LAM[2 * (dg * 64 + 32 + n)], li1 = sp.LAM[2 * (dg * 64 + 32 + n) + 1];
    float hr0 = 0.f, hi0 = 0.f, hr1 = 0.f, hi1 = 0.f;
    float* stp = sp.ST + ((size_t)((slot0 + hs) * 2 + D) * 2048 + g * 64 + n) * 2;
    if (MODE != 0) { const f32x2 a = *(const GAS f32x2*)stp, b = *(const GAS f32x2*)(stp + 64); hr0 = a.x; hi0 = a.y; hr1 = b.x; hi1 = b.y; }
    const int astream = (n >> 2) & 1, aidx = 4 * (n >> 3) + (n & 3);
    const bf16* ua = sp.U + (size_t)(row0 + 128 * astream) * 512 + g * 16 + 8 * hs;
    bf16x8 afr = *(const GAS bf16x8*)(ua + (size_t)(D == 0 ? aidx : 127 - aidx) * 512);
#pragma unroll 1
    for (int i = 0; i < 8; ++i) {
        f32x16 acc[4];
#pragma unroll
        for (int q = 0; q < 4; ++q) {
#pragma unroll
            for (int r = 0; r < 16; ++r) acc[q][r] = 0.f;
            acc[q] = MFMA32(afr, bq[q], acc[q]); }
        if (i < 7) afr = *(const GAS bf16x8*)(ua + (size_t)(D == 0 ? 16 * (i + 1) + aidx : 127 - 16 * (i + 1) - aidx) * 512);
#pragma unroll
        for (int j = 0; j < 16; ++j) {
            const float nr0 = lr0 * hr0 - li0 * hi0 + acc[0][j], ni0 = lr0 * hi0 + li0 * hr0 + acc[2][j]; hr0 = nr0; hi0 = ni0; acc[0][j] = nr0; acc[2][j] = ni0;
            const float nr1 = lr1 * hr1 - li1 * hi1 + acc[1][j], ni1 = lr1 * hi1 + li1 * hr1 + acc[3][j]; hr1 = nr1; hi1 = ni1; acc[1][j] = nr1; acc[3][j] = ni1; }
        if (MODE != 0) {
            store_acc_nat(acc[0], SI, 72, 0, 0, lane); store_acc_nat(acc[1], SI, 72, 32, 0, lane); store_acc_nat(acc[2], SI, 72, 64, 0, lane); store_acc_nat(acc[3], SI, 72, 96, 0, lane);
            asm volatile("s_waitcnt lgkmcnt(0)" ::: "memory");
            f32x16 y;
#pragma unroll
            for (int r = 0; r < 16; ++r) y[r] = 0.f;
#pragma unroll
            for (int ks = 0; ks < 8; ++ks) y = MFMA32(frag_tr(SI, 72, 16 * ks, 0, lane), cm[ks], y);
            asm volatile("" ::: "memory");
            LAS float* YT = (LAS float*)(SI + 9216);
            if (n < 16) {
#pragma unroll
                for (int j = 0; j < 16; ++j) YT[arow(j, hs) * 20 + n] = y[j]; }
            asm volatile("s_waitcnt lgkmcnt(0)" ::: "memory");
            { const int m = lane >> 1, c8 = (lane & 1) * 8, ms = (m >> 2) & 1, mi = 4 * (m >> 3) + (m & 3);
              const int pos = D == 0 ? 16 * i + mi : 127 - 16 * i - mi, row = row0 + 128 * ms + pos;
              const f32x4 ya = *(const LAS f32x4*)(YT + m * 20 + c8), yb2 = *(const LAS f32x4*)(YT + m * 20 + c8 + 4);
              LAS v4u* yfp = (LAS v4u*)(SI + 11776 + (128 * ms + pos) * 32 + c8 * 2);
              if (MODE == 1) { v4u w; w.x = pk2(ya.x, ya.y); w.y = pk2(ya.z, ya.w); w.z = pk2(yb2.x, yb2.y); w.w = pk2(yb2.z, yb2.w); *yfp = w; }
              else { float f8[8]; unpack8(*yfp, f8); const f32x4 fa = {f8[0], f8[1], f8[2], f8[3]}, fb = {f8[4], f8[5], f8[6], f8[7]}; float u8[8]; unpack8(*(const GAS v4u*)(sp.U + (size_t)row * 512 + g * 16 + c8), u8);
                  const f32x4 d0 = *(const GAS f32x4*)(sp.S5D + g * 16 + c8), d1 = *(const GAS f32x4*)(sp.S5D + g * 16 + c8 + 4);
                  float v[8] = {ya.x + fa.x + d0.x * u8[0], ya.y + fa.y + d0.y * u8[1], ya.z + fa.z + d0.z * u8[2], ya.w + fa.w + d0.w * u8[3], yb2.x + fb.x + d1.x * u8[4], yb2.y + fb.y + d1.y * u8[5], yb2.z + fb.z + d1.z * u8[6], yb2.w + fb.w + d1.w * u8[7]};
#pragma unroll
                  for (int q = 0; q < 8; ++q) { const float tt = 0.7978845608f * (v[q] + 0.044715f * v[q] * v[q] * v[q]); v[q] = v[q] * (1.f - __builtin_amdgcn_rcpf(__expf(2.f * tt) + 1.f)); }
                  v4u w; w.x = pk2(v[0], v[1]); w.y = pk2(v[2], v[3]); w.z = pk2(v[4], v[5]); w.w = pk2(v[6], v[7]);
                  *(GAS v4u*)(sp.A2 + (size_t)row * 512 + g * 16 + c8) = w; } }
        }
    }
    if (MODE == 0) { *(GAS f32x2*)stp = (f32x2){hr0, hi0}; *(GAS f32x2*)(stp + 64) = (f32x2){hr1, hi1}; }
}
__device__ __forceinline__ void phase_s5A(const S5Ptrs& sp, LAS unsigned char* lds, int bid, int G, int wave, int lane) {
    LAS unsigned char* SI = lds + wave * 19968;
    for (int it = bid; it < 65 * 8; it += G) { const int col = it >> 3, gb = (it >> 1) & 3, d = it & 1, g = gb * 8 + wave;
        const int row0 = col < 64 ? col * 256 : ML, slot0 = col < 64 ? 2 * col : 128;
        if (d == 0) s5_wave<0, 0>(sp, SI, row0, g, slot0, lane); else s5_wave<0, 1>(sp, SI, row0, g, slot0, lane); }
}
__device__ __forceinline__ void phase_s5B(const S5Ptrs& sp, const Params& p, LAS unsigned char* lds, int bid, int G, int tid, int wave, int lane) {
    const int gt = bid * 512 + tid;
    if (bid >= 8 && G > 8) {
        const int gw = (bid - 8) * NWAVES + wave, ngw = (G - 8) * NWAVES; LAS float* scr = (LAS float*)(lds + wave * 16384); unsigned char* wr = p.ws + WS_WREST;
        tr_job(p.in[I_WVAL], 512, 1024, 2, (bf16*)(wr + WO_VG), scr, gw, ngw, lane);
        tr_job(p.in[I_WGATE2], 512, 1024, 3, (bf16*)(wr + WO_VG), scr, gw, ngw, lane);
        tr_job(p.in[I_WGATE] + (size_t)1024 * DFF, 1024, DFF, 2, (bf16*)(wr + WO_UP1), scr, gw, ngw, lane);
        tr_job(p.in[I_WUP] + (size_t)1024 * DFF, 1024, DFF, 3, (bf16*)(wr + WO_UP1), scr, gw, ngw, lane);
        tr_job(p.in[I_WDOWN] + (size_t)DFF * 1024, DFF, 1024, 1, (bf16*)(wr + WO_DOWN1), scr, gw, ngw, lane);
    }
    if (gt < 4096) { const int d = gt >> 11, gp = gt & 2047, s = d * 2048 + gp; const float pr = sp.LAMP[2 * s], pi = sp.LAMP[2 * s + 1];
        GAS f32x2* st = (GAS f32x2*)sp.ST; f32x2 run = {0.f, 0.f};
        for (int i0 = 0; i0 < 130; i0 += 10) { f32x2 loc[10];
#pragma unroll
            for (int j = 0; j < 10; ++j) { const int q = i0 + j, slot = d == 0 ? (q < 2 ? 128 + q : q - 2) : (q < 2 ? 129 - q : 129 - q); loc[j] = st[(size_t)(slot * 2 + d) * 2048 + gp]; }
#pragma unroll
            for (int j = 0; j < 10; ++j) { const int q = i0 + j, slot = d == 0 ? (q < 2 ? 128 + q : q - 2) : (q < 2 ? 129 - q : 129 - q); st[(size_t)(slot * 2 + d) * 2048 + gp] = run;
                const float nr = pr * run.x - pi * run.y + loc[j].x, ni = pr * run.y + pi * run.x + loc[j].y; run.x = nr; run.y = ni; } }
    }
}
__device__ __forceinline__ void phase_s5C(const S5Ptrs& sp, LAS unsigned char* lds, int bid, int G, int wave, int lane) {
    LAS unsigned char* SI = lds + wave * 19968;
    for (int it = bid; it < 256; it += G) { const int col = it >> 2, g = (it & 3) * 8 + wave;
        s5_wave<1, 0>(sp, SI, col * 256, g, 2 * col, lane);
        asm volatile("s_waitcnt lgkmcnt(0)" ::: "memory");
        s5_wave<2, 1>(sp, SI, col * 256, g, 2 * col, lane); }
}
__device__ __forceinline__ void phase_final(const Params& p, int bid, int G, int wave, int lane) {
    const int gw = bid * NWAVES + wave, ngw = G * NWAVES; const float* fg = p.in[I_FNORM];
    for (int row = gw; row < ML; row += ngw) { float* xr = p.out + (size_t)row * 1024;
        f32x4 v[4]; float ss = 0.f;
#pragma unroll
        for (int j = 0; j < 4; ++j) { v[j] = *(const GAS f32x4*)(xr + 4 * lane + 256 * j); ss += (v[j].x * v[j].x + v[j].y * v[j].y) + (v[j].z * v[j].z + v[j].w * v[j].w); }
        const float r = rsqrtf(wave_sum(ss) * (1.f / 1024.f) + EPS);
#pragma unroll
        for (int j = 0; j < 4; ++j) { const f32x4 g4 = *(const GAS f32x4*)(fg + 4 * lane + 256 * j); *(GAS f32x4*)(xr + 4 * lane + 256 * j) = (f32x4){v[j].x * r * g4.x, v[j].y * r * g4.y, v[j].z * r * g4.z, v[j].w * r * g4.w}; }
    }
}

__device__ __forceinline__ void ctx_mini_gemm(LAS unsigned char* lds, const bf16* A, const bf16* Bt, int K, const float* base, float* out, const float* gate, int bid, int G, int tid) {
    const int lane = tid & 63, wave = __builtin_amdgcn_readfirstlane(tid >> 6), hf = lane >> 5;
    LAS float* red = (LAS float*)lds;
    for (int t = bid; t < 256; t += G) {
        const int rb = t >> 5, cb = t & 31, kw = K >> 3;
        const bf16* ap = A + (size_t)(32 * rb + (lane & 31)) * K + wave * kw + 8 * hf;
        const bf16* bp = Bt + (size_t)(32 * cb + (lane & 31)) * K + wave * kw + 8 * hf;
        f32x16 acc;
#pragma unroll
        for (int r = 0; r < 16; ++r) acc[r] = 0.f;
        for (int k0 = 0; k0 < kw; k0 += 64) {
            bf16x8 af[4], bfr[4];
#pragma unroll
            for (int q = 0; q < 4; ++q) if (k0 + 16 * q < kw) { af[q] = *(const GAS bf16x8*)(ap + k0 + 16 * q); bfr[q] = *(const GAS bf16x8*)(bp + k0 + 16 * q); }
#pragma unroll
            for (int q = 0; q < 4; ++q) if (k0 + 16 * q < kw) acc = MFMA32(af[q], bfr[q], acc);
        }
#pragma unroll
        for (int r = 0; r < 16; ++r) red[(wave * 32 + arow(r, hf)) * 33 + (lane & 31)] = acc[r];
        __syncthreads();
#pragma unroll
        for (int q = 0; q < 2; ++q) { const int e = tid + 512 * q, r = e >> 5, c = e & 31; float v = 0.f;
#pragma unroll
            for (int w = 0; w < 8; ++w) v += red[(w * 32 + r) * 33 + c];
            const size_t o = (size_t)(32 * rb + r) * 1024 + 32 * cb + c; out[o] = base[o] + gate[32 * cb + c] * v; }
        __syncthreads();
    }
}
constexpr int N_PHASES = 22;
__device__ __forceinline__ void run_gmix(const Params& p, LAS unsigned char* lds, int bid, int G) {
    unsigned char* ws = p.ws;
    pg8::Gemm g{(const bf16*)(ws + WS_RX), (const bf16*)(ws + WS_WIN), M, NINP, 1024}; pg8::StaticOrder S; S.init(M, NINP, G, bid);
    pg8::EpiMix1 E{(bf16*)(ws + WS_ZQ), (bf16*)(ws + WS_XBC), (bf16*)(ws + WS_V), (bf16*)(ws + WS_G), (f16*)p.out, (f16*)(ws + WS_FCTX), (float*)(ws + WS_DT), (const float*)(ws + WS_SMALL + SM_LB), p.in[I_DTB], p.in[I_ALOG]};
    pg8::gemm_phase<pg8::EpiMix1, pg8::StaticOrder, true, true>(lds + RING_OFF, g, S, E);
}
__device__ __forceinline__ void run_gout(const Params& p, LAS unsigned char* lds, int bid, int G, int tid) {
    unsigned char* ws = p.ws; const float* mods = (const float*)(ws + WS_SMALL + SM_MODS);
    pg8::Gemm g{(const bf16*)(ws + WS_ZQ), (const bf16*)(ws + WS_WREST + WO_OUT), ML, 1024, 2048}; pg8::StaticOrder S; S.init(ML, 1024, G, bid);
    pg8::EpiResid E{p.in[I_X], p.in[I_CTX], p.out, (float*)(ws + WS_HCTX), mods + (0 * 2 + 0) * 6144 + 2 * 1024, mods + (0 * 2 + 1) * 6144 + 2 * 1024};
    pg8::gemm_phase<pg8::EpiResid, pg8::StaticOrder, true, true>(lds + RING_OFF, g, S, E);
    ctx_mini_gemm(lds, (const bf16*)(ws + WS_ZQ) + (size_t)ML * 2048, (const bf16*)(ws + WS_WREST + WO_OUT), 2048, p.in[I_CTX], (float*)(ws + WS_HCTX), mods + (0 * 2 + 1) * 6144 + 2 * 1024, bid, G, tid);
}
__device__ __forceinline__ void run_gup(const Params& p, LAS unsigned char* lds, int bid, int G, int layer) {
    unsigned char* ws = p.ws; const int rows = layer ? ML : M;
    pg8::Gemm g{(const bf16*)(ws + WS_RX), (const bf16*)(ws + WS_WREST + (layer ? WO_UP1 : WO_UP0)), rows, 2 * DFF, 1024}; pg8::StaticOrder S; S.init(rows, 2 * DFF, G, bid);
    pg8::EpiSwiglu E{(bf16*)(ws + WS_HID)};
    pg8::gemm_phase<pg8::EpiSwiglu, pg8::StaticOrder, true, true>(lds + RING_OFF, g, S, E);
}
__device__ __forceinline__ void run_gdown(const Params& p, LAS unsigned char* lds, int bid, int G, int layer, int tid) {
    unsigned char* ws = p.ws; const float* mods = (const float*)(ws + WS_SMALL + SM_MODS); float* Hctx = (float*)(ws + WS_HCTX);
    pg8::Gemm g{(const bf16*)(ws + WS_HID), (const bf16*)(ws + WS_WREST + (layer ? WO_DOWN1 : WO_DOWN0)), ML, 1024, DFF}; pg8::StaticOrder S; S.init(ML, 1024, G, bid);
    pg8::EpiResid E{p.out, Hctx, p.out, Hctx, mods + (layer * 2 + 0) * 6144 + 5 * 1024, mods + (layer * 2 + 1) * 6144 + 5 * 1024};
    pg8::gemm_phase<pg8::EpiResid, pg8::StaticOrder, true, true>(lds + RING_OFF, g, S, E);
    if (layer == 0) ctx_mini_gemm(lds, (const bf16*)(ws + WS_HID) + (size_t)ML * DFF, (const bf16*)(ws + WS_WREST + WO_DOWN0), DFF, Hctx, Hctx, mods + (0 * 2 + 1) * 6144 + 5 * 1024, bid, G, tid);
}
__device__ __forceinline__ void run_god(const Params& p, LAS unsigned char* lds, int bid, int G) {
    unsigned char* ws = p.ws;
    pg8::Gemm g{(const bf16*)(ws + WS_RX), (const bf16*)(ws + WS_WREST + WO_OD), M, 512, 1024}; pg8::StaticOrder S; S.init(M, 512, G, bid);
    pg8::EpiU E{(bf16*)(ws + WS_U)};
    pg8::gemm_phase<pg8::EpiU, pg8::StaticOrder, true, true>(lds + RING_OFF, g, S, E);
}
__device__ __forceinline__ void run_gvg(const Params& p, LAS unsigned char* lds, int bid, int G) {
    unsigned char* ws = p.ws; const float* mods = (const float*)(ws + WS_SMALL + SM_MODS);
    pg8::Gemm g{(const bf16*)(ws + WS_A2), (const bf16*)(ws + WS_WREST + WO_VG), ML, 2048, 512}; pg8::StaticOrder S; S.init(ML, 2048, G, bid);
    pg8::EpiValGate E{p.out, mods + (1 * 2 + 0) * 6144 + 2 * 1024};
    pg8::gemm_phase<pg8::EpiValGate, pg8::StaticOrder, true, true>(lds + RING_OFF, g, S, E);
}
__device__ __forceinline__ ScanPtrs make_scanptrs(const Params& p) {
    unsigned char* ws = p.ws; ScanPtrs sp; sp.XBC = (const bf16*)(ws + WS_XBC); sp.DT = (const float*)(ws + WS_DT); sp.ZQ = (bf16*)(ws + WS_ZQ); sp.V = (const bf16*)(ws + WS_V); sp.G = (const bf16*)(ws + WS_G); sp.Flat = (f16*)p.out; sp.Fctx = (f16*)(ws + WS_FCTX);
    sp.STATS = (float*)(ws + WS_SMALL + SM_STATS); sp.convw = p.in[I_CONVW]; sp.convb = p.in[I_CONVB]; sp.ssdd = p.in[I_SSDD]; sp.hgn = p.in[I_HGN];
    sp.SSD_ST = (bf16*)(ws + WS_RX); sp.HG_ST = (bf16*)(ws + WS_RX + SSD_ST_BYTES); sp.SSD_DEC = (float*)(ws + WS_SMALL + SM_SSDDEC); sp.HG_DEC = (float*)(ws + WS_SMALL + SM_HGDEC); sp.BCC = (const bf16*)(ws + WS_BCC); return sp;
}
__device__ __forceinline__ S5Ptrs make_s5ptrs(const Params& p) {
    unsigned char* ws = p.ws; S5Ptrs s5; s5.U = (const bf16*)(ws + WS_U); s5.YS = (float*)(ws + WS_YS); s5.A2 = (bf16*)(ws + WS_A2); s5.LAM = (const float*)(ws + WS_SMALL + SM_LAM); s5.LAMP = (const float*)(ws + WS_SMALL + SM_LAMP);
    s5.BBH = (const bf16*)(ws + WS_SMALL + SM_BB); s5.CMH = (const bf16*)(ws + WS_SMALL + SM_BB + 262144); s5.S5D = p.in[I_S5D]; s5.ST = (float*)(ws + WS_SMALL + SM_S5ST); return s5;
}
__global__ void __launch_bounds__(NWAVES * 64, 2) mk_fwd(Params p) {
    extern __shared__ __attribute__((aligned(16))) unsigned char lds_raw[];
    LAS unsigned char* lds = (LAS unsigned char*)lds_raw;
    volatile LAS unsigned* MISC = (volatile LAS unsigned*)(lds + MISC_OFF);
    const int tid = threadIdx.x, lane = tid & 63, wave = __builtin_amdgcn_readfirstlane(tid >> 6), G = gridDim.x, bid = blockIdx.x;
    gu32* ctl = (gu32*)(p.ws + WS_CTL);
    for (int u = tid; u < (LDS_BYTES - LDSCTL_OFF) / 4; u += NWAVES * 64) ((LAS unsigned*)(lds + LDSCTL_OFF))[u] = 0u;
    __syncthreads();
    XcdBarrier bar; bar.bar = (unsigned*)(ctl + CW_BAR); bar.x = 0; bar.st = nullptr;
    if (p.use_bar) bar = xcd_barrier_post((unsigned*)(ctl + CW_BAR), MISC + 8);
    const int lo = p.ph_lo, hi = p.ph_hi;
#ifndef MK_ONLYPH
#define MK_ONLYPH -1
#endif
#define IN(k) ((MK_ONLYPH < 0 || MK_ONLYPH == (k)) && lo <= (k) && (k) < hi)
#define SEAM(k) do { if ((k) + 1 < hi) xcd_barrier(bar); } while (0)
    if (IN(0)) { phase_prologue(p, lds, bid, G, tid, wave, lane); SEAM(0); }
    if (IN(1)) { phase_rownorm(p, lds, bid, G, tid, wave, lane, 0, 0, M, p.in[I_X], p.in[I_CTX], true); SEAM(1); }
    if (IN(2)) { run_gmix(p, lds, bid, G); SEAM(2); }
    if (IN(3)) { phase_convbc(p, bid, G, tid); const ScanPtrs sp = make_scanptrs(p); phase_scanA1(sp, lds, ctl + CW_QUEUE + 0 * 512, MISC + 12, bid, tid); SEAM(3); }
    if (IN(4)) { const ScanPtrs sp = make_scanptrs(p); phase_scanA2(sp, lds, ctl + CW_QUEUE + 1 * 512, MISC + 12, bid, tid); SEAM(4); }
    if (IN(5)) { const ScanPtrs sp = make_scanptrs(p); phase_scanB(sp, bid, G, tid); SEAM(5); }
    if (IN(6)) { const ScanPtrs sp = make_scanptrs(p); phase_scanC(sp, lds, ctl + CW_QUEUE + 2 * 512, MISC + 12, bid, tid); SEAM(6); }
    if (IN(7)) { phase_finish(p, lds, bid, G, tid, wave, lane); SEAM(7); }
    if (IN(8)) { run_gout(p, lds, bid, G, tid); SEAM(8); }
    if (IN(9)) { phase_rownorm(p, lds, bid, G, tid, wave, lane, 0, 1, M, p.out, (const float*)(p.ws + WS_HCTX), false); SEAM(9); }
    if (IN(10)) { run_gup(p, lds, bid, G, 0); SEAM(10); }
    if (IN(11)) { run_gdown(p, lds, bid, G, 0, tid); SEAM(11); }
    if (IN(12)) { phase_rownorm(p, lds, bid, G, tid, wave, lane, 1, 0, M, p.out, (const float*)(p.ws + WS_HCTX), false); SEAM(12); }
    if (IN(13)) { run_god(p, lds, bid, G); SEAM(13); }
    if (IN(14)) { const S5Ptrs s5 = make_s5ptrs(p); phase_s5A(s5, lds, bid, G, wave, lane); SEAM(14); }
    if (IN(15)) { const S5Ptrs s5 = make_s5ptrs(p); phase_s5B(s5, p, lds, bid, G, tid, wave, lane); SEAM(15); }
    if (IN(16)) { const S5Ptrs s5 = make_s5ptrs(p); phase_s5C(s5, lds, bid, G, wave, lane); SEAM(16); }
    if (IN(17)) { run_gvg(p, lds, bid, G); SEAM(17); }
    if (IN(18)) { phase_rownorm(p, lds, bid, G, tid, wave, lane, 1, 1, ML, p.out, (const float*)(p.ws + WS_HCTX), false); SEAM(18); }
    if (IN(19)) { run_gup(p, lds, bid, G, 1); SEAM(19); }
    if (IN(20)) { run_gdown(p, lds, bid, G, 1, tid); SEAM(20); }
    if (IN(21)) { phase_final(p, bid, G, wave, lane); }
#undef IN
#undef SEAM
}

extern "C" void kernel_launch(void* const* d_in, const int* in_sizes, int n_in, void* d_out, int out_size, void* d_ws, size_t ws_size, hipStream_t stream) {
    static int grid = 0;
    if (grid == 0) {
        if (n_in != 33 || out_size != ML * D || ws_size < 256 * MiB) { fprintf(stderr, "kernel_launch: unexpected shapes (n_in %d, out %d, ws %zu); nothing launched\n", n_in, out_size, ws_size); grid = -1; return; }
        int dev = 0, cus = 0, per_cu = 0;
        if (hipGetDevice(&dev) != hipSuccess || hipDeviceGetAttribute(&cus, hipDeviceAttributeMultiprocessorCount, dev) != hipSuccess) { grid = -1; return; }
        if (hipFuncSetAttribute((const void*)mk_fwd, hipFuncAttributeMaxDynamicSharedMemorySize, LDS_BYTES) != hipSuccess) { fprintf(stderr, "kernel_launch: hipFuncSetAttribute failed\n"); grid = -1; return; }
        if (hipOccupancyMaxActiveBlocksPerMultiprocessor(&per_cu, (const void*)mk_fwd, NWAVES * 64, LDS_BYTES) != hipSuccess || per_cu < 1) fprintf(stderr, "kernel_launch: occupancy query reports %d\n", per_cu);
        (void)hipGetLastError();
        grid = cus;
    }
    if (grid < 0) return;
    (void)hipMemsetAsync((char*)d_ws + WS_CTL, 0, CTL_ZERO_BYTES, stream);
    Params a{};
    for (int i = 0; i < 33; ++i) a.in[i] = (const float*)d_in[i];
    a.out = (float*)d_out; a.ws = (unsigned char*)d_ws;
#if MK_N_LAUNCHES == 1
    a.ph_lo = 0; a.ph_hi = N_PHASES; a.use_bar = 1;
    hipLaunchKernelGGL(mk_fwd, dim3(grid), dim3(NWAVES * 64), LDS_BYTES, stream, a);
#else
    for (int ph = 0; ph < N_PHASES; ++ph) { a.ph_lo = ph; a.ph_hi = ph + 1; a.use_bar = 0; hipLaunchKernelGGL(mk_fwd, dim3(grid), dim3(NWAVES * 64), LDS_BYTES, stream, a); }
#endif
}
```
